# Optimizing an MI355X kernel written in HIP

```python
import math
import jax
import jax.numpy as jnp
from jax import lax
import numpy as np

D_MODEL = 1024
BATCH = 2
SEQ = 16384
DEPTH = 2

MLA_HEADS = 8
MLA_NOPE = 64
MLA_ROPE = 32
MLA_V = 64
Q_LORA = 384
KV_LORA = 256
ROPE_THETA = 10000.0
SB_HEADS = 8
SB_HEAD_DIM = 64
MOBA_HEADS = 16
MOBA_HEAD_DIM = 64
MOBA_BLOCK = 256
MOBA_TOPK = 3
MOBA_GROUP = 128
REL_BUCKETS = 32
REL_MAX_EXACT = REL_BUCKETS // 2
REL_MAX_DIST = 128
D_FF_DENSE = 2048
N_EXPERTS = 8
TOP_K = 2
D_FF_EXPERT = 512
Q_BLOCK = 128
RMS_EPS = 1e-6
HI = lax.Precision.HIGHEST

EVEN_IN = Q_LORA + KV_LORA + MLA_ROPE + 3 * SB_HEADS * SB_HEAD_DIM
MIX_EVEN = MLA_HEADS * MLA_V + SB_HEADS * SB_HEAD_DIM
MIX_ODD = MOBA_HEADS * MOBA_HEAD_DIM
N_EVEN = (DEPTH + 1) // 2
N_ODD = DEPTH // 2

kernel_name = 'hybrid_mla_stickbreak_moba_moe'


def rmsnorm(x, g):
    xf = x.astype(jnp.float32)
    y = xf * lax.rsqrt(jnp.mean(xf * xf, axis=-1, keepdims=True) + RMS_EPS)
    return (y * g.astype(jnp.float32)).astype(x.dtype)


def to_heads(t, n_heads):
    b, s, _ = t.shape
    return t.reshape(b, s, n_heads, -1).transpose(0, 2, 1, 3)


def merge_heads(t):
    b, h, s, d = t.shape
    return t.transpose(0, 2, 1, 3).reshape(b, s, h * d)


def rope_tables(seq_len):
    inv = 1.0 / (ROPE_THETA ** (jnp.arange(0, MLA_ROPE, 2, dtype=jnp.float32) / MLA_ROPE))
    ang = jnp.arange(seq_len, dtype=jnp.float32)[:, None] * inv[None, :]
    return jnp.cos(ang), jnp.sin(ang)


def apply_rope(t, cos, sin):
    t1, t2 = jnp.split(t.astype(jnp.float32), 2, axis=-1)
    c = cos[None, :, None, :]
    s = sin[None, :, None, :]
    return jnp.concatenate([t1 * c - t2 * s, t2 * c + t1 * s], axis=-1).astype(t.dtype)


def causal_block_sweep(block_fn, q, k, v):
    outs = []
    for i in range(q.shape[2] // Q_BLOCK):
        end = (i + 1) * Q_BLOCK
        outs.append(block_fn(q[:, :, i * Q_BLOCK:end], k[:, :, :end], v[:, :, :end], i))
    return jnp.concatenate(outs, axis=2)


def mla_block(qi, ki, vi, i):
    scale = (MLA_NOPE + MLA_ROPE) ** -0.5
    qpos = i * Q_BLOCK + jnp.arange(Q_BLOCK)
    kpos = jnp.arange(ki.shape[2])
    logits = jnp.einsum('bhqd,bhkd->bhqk', qi, ki, preferred_element_type=jnp.float32) * scale
    logits = jnp.where(kpos[None, :] <= qpos[:, None], logits, -jnp.inf)
    p = jax.nn.softmax(logits, axis=-1)
    return jnp.einsum('bhqk,bhkd->bhqd', p.astype(vi.dtype), vi)


def stick_breaking_block(qi, ki, vi, i):
    b, h, _, _ = qi.shape
    n_kb = i + 1
    scale = SB_HEAD_DIM ** -0.5
    qpos = i * Q_BLOCK + jnp.arange(Q_BLOCK)
    kpos = jnp.arange(ki.shape[2])
    z = jnp.einsum('bhqd,bhkd->bhqk', qi, ki, preferred_element_type=jnp.float32) * scale
    past = kpos[None, :] < qpos[:, None]
    log_fail = jnp.where(past, jax.nn.log_sigmoid(-z), 0.0)
    lf = log_fail.reshape(b, h, Q_BLOCK, n_kb, Q_BLOCK)
    tri_in = jnp.tri(Q_BLOCK, k=-1, dtype=jnp.float32)
    tri_out = jnp.tri(n_kb, k=-1, dtype=jnp.float32)
    within = jnp.einsum('bhqnc,ce->bhqne', lf, tri_in, precision=HI)
    later_blocks = jnp.einsum('bhqm,mn->bhqn', jnp.sum(lf, axis=-1), tri_out, precision=HI)
    after = (within + later_blocks[..., None]).reshape(z.shape)
    w = jnp.where(past, jnp.exp(jax.nn.log_sigmoid(z) + after), 0.0)
    return jnp.einsum('bhqk,bhkd->bhqd', w.astype(vi.dtype), vi)


def t5_bucket(dist):
    n = jnp.maximum(dist, 0)
    nf = jnp.maximum(n, 1).astype(jnp.float32)
    large = REL_MAX_EXACT + (jnp.log(nf / REL_MAX_EXACT) / math.log(REL_MAX_DIST / REL_MAX_EXACT)
                             * (REL_BUCKETS - REL_MAX_EXACT)).astype(jnp.int32)
    large = jnp.minimum(large, REL_BUCKETS - 1)
    return jnp.where(n < REL_MAX_EXACT, n, large)


def moba_attention(q, k, v, rel_bias):
    b, h, s, d = q.shape
    scale = d ** -0.5
    nb = -(-s // MOBA_BLOCK)
    sp = nb * MOBA_BLOCK
    padw = ((0, 0), (0, 0), (0, sp - s), (0, 0))
    qb = jnp.pad(q, padw).reshape(b, h, nb, MOBA_BLOCK, d)
    kb = jnp.pad(k, padw).reshape(b, h, nb, MOBA_BLOCK, d)
    vb = jnp.pad(v, padw).reshape(b, h, nb, MOBA_BLOCK, d)
    offs = jnp.arange(MOBA_BLOCK)

    d_own = offs[:, None] - offs[None, :]
    l_own = jnp.einsum('bhnqd,bhnkd->bhnqk', qb, kb, preferred_element_type=jnp.float32) * scale
    l_own = l_own + rel_bias[:, t5_bucket(d_own)][None, :, None]
    l_own = jnp.where(d_own >= 0, l_own, -jnp.inf)
    m_own = jnp.max(l_own, axis=-1)
    p_own = jnp.exp(l_own - m_own[..., None])
    s_own = jnp.sum(p_own, axis=-1).reshape(b, h, sp)[:, :, :s]
    o_own = jnp.einsum('bhnqk,bhnkd->bhnqd', p_own.astype(v.dtype), vb,
                       preferred_element_type=jnp.float32).reshape(b, h, sp, d)[:, :, :s]
    m_own = m_own.reshape(b, h, sp)[:, :, :s]

    qpos = jnp.arange(s)
    qblk = qpos // MOBA_BLOCK
    k_mean = jnp.mean(kb.astype(jnp.float32), axis=3)
    gate = jnp.einsum('bhsd,bhnd->bhsn', q.astype(jnp.float32), k_mean)
    gate = jnp.where(jnp.arange(nb)[None, :] < qblk[:, None], gate, -jnp.inf)
    topk = min(MOBA_TOPK, nb)
    _, idx = lax.top_k(gate, topk)
    valid = idx < qblk[:, None]

    n_pairs = b * h * s * topk
    n_groups = b * h * nb
    bh = (jnp.arange(b)[:, None] * h + jnp.arange(h)[None, :])[:, :, None, None]
    group = (bh * nb + idx).reshape(-1)
    qrow = jnp.broadcast_to(bh * s + qpos[:, None], (b, h, s, topk)).reshape(-1)
    ppos = jnp.broadcast_to(qpos[:, None], (b, h, s, topk)).reshape(-1)
    pvalid = valid.reshape(-1)
    counts = jax.ops.segment_sum(jnp.ones((n_pairs,), jnp.int32), group, num_segments=n_groups)
    pcounts = (counts + MOBA_GROUP - 1) // MOBA_GROUP * MOBA_GROUP
    pend = jnp.cumsum(pcounts)
    pstart = pend - pcounts
    start = jnp.cumsum(counts) - counts
    order = jnp.argsort(group).astype(jnp.int32)
    g_sorted = group[order]
    dst_sorted = pstart[g_sorted] + jnp.arange(n_pairs, dtype=jnp.int32) - start[g_sorted]
    n_units = -(-n_pairs // MOBA_GROUP) + n_groups
    cap = n_units * MOBA_GROUP
    slot_pair = jnp.full((cap,), n_pairs, jnp.int32).at[dst_sorted].set(order).reshape(n_units, MOBA_GROUP)
    dst = jnp.zeros((n_pairs,), jnp.int32).at[order].set(dst_sorted)
    unit_group = jnp.minimum(jnp.searchsorted(pend, jnp.arange(n_units) * MOBA_GROUP, side='right'),
                             n_groups - 1)
    qrow_u = jnp.append(qrow, 0)[slot_pair]
    pos_u = jnp.append(ppos, 0)[slot_pair]
    ok_u = jnp.append(pvalid, False)[slot_pair]

    q_u = q.reshape(b * h * s, d)[qrow_u]
    k_u = kb.reshape(n_groups, MOBA_BLOCK, d)[unit_group]
    v_u = vb.reshape(n_groups, MOBA_BLOCK, d)[unit_group]
    head_u = (unit_group // nb) % h
    blk_u = unit_group % nb
    dist = pos_u[:, :, None] - (blk_u[:, None, None] * MOBA_BLOCK + offs)
    l_u = jnp.einsum('ugd,ucd->ugc', q_u, k_u, preferred_element_type=jnp.float32) * scale
    l_u = l_u + rel_bias[head_u[:, None, None], t5_bucket(dist)]
    l_u = jnp.where(ok_u[..., None], l_u, -jnp.inf)
    m_u = jnp.where(ok_u, jnp.max(l_u, axis=-1), 0.0)
    p_u = jnp.exp(l_u - m_u[..., None])
    s_u = jnp.sum(p_u, axis=-1)
    o_u = jnp.einsum('ugc,ucd->ugd', p_u.astype(v.dtype), v_u, preferred_element_type=jnp.float32)

    m_sel = jnp.where(valid, m_u.reshape(cap)[dst].reshape(b, h, s, topk), -jnp.inf)
    s_sel = s_u.reshape(cap)[dst].reshape(b, h, s, topk)
    o_sel = o_u.reshape(cap, d)[dst].reshape(b, h, s, topk, d)
    m_all = jnp.maximum(m_own, jnp.max(m_sel, axis=-1))
    w_own = jnp.exp(m_own - m_all)
    w_sel = jnp.exp(m_sel - m_all[..., None])
    num = w_own[..., None] * o_own + jnp.einsum('bhsk,bhskd->bhsd', w_sel, o_sel)
    den = w_own * s_own + jnp.sum(w_sel * s_sel, axis=-1)
    return (num / den[..., None]).astype(q.dtype)


def swiglu(h, w_gate, w_up, w_down):
    return (jax.nn.silu(h @ w_gate) * (h @ w_up)) @ w_down


def moe_swiglu(h, w_router, w_gate, w_up, w_down):
    logits = (h @ w_router).astype(jnp.float32)
    top_val, top_idx = lax.top_k(logits, TOP_K)
    top_w = jax.nn.softmax(top_val, axis=-1)
    gates = jnp.sum(jax.nn.one_hot(top_idx, N_EXPERTS, dtype=jnp.float32) * top_w[..., None], axis=-2)
    out = jnp.zeros_like(h)
    for e in range(N_EXPERTS):
        y = swiglu(h, w_gate[e], w_up[e], w_down[e])
        out = out + (gates[..., e:e + 1] * y).astype(h.dtype)
    return out


def mla_sb_mixer(h, w_in, q_norm, w_uq, kv_norm, w_ukv, w_o, cos, sin):
    b, s, _ = h.shape
    proj = h @ w_in
    c_q, c_kv, k_rope, sb_qkv = jnp.split(
        proj, [Q_LORA, Q_LORA + KV_LORA, Q_LORA + KV_LORA + MLA_ROPE], axis=-1)
    q = (rmsnorm(c_q, q_norm) @ w_uq).reshape(b, s, MLA_HEADS, MLA_NOPE + MLA_ROPE)
    q_nope, q_rope = jnp.split(q, [MLA_NOPE], axis=-1)
    q_rope = apply_rope(q_rope, cos, sin)
    kv = (rmsnorm(c_kv, kv_norm) @ w_ukv).reshape(b, s, MLA_HEADS, MLA_NOPE + MLA_V)
    k_nope, v_a = jnp.split(kv, [MLA_NOPE], axis=-1)
    k_rope = apply_rope(k_rope[:, :, None, :], cos, sin)
    k_a = jnp.concatenate([k_nope, jnp.broadcast_to(k_rope, (b, s, MLA_HEADS, MLA_ROPE))], axis=-1)
    q_a = jnp.concatenate([q_nope, q_rope], axis=-1)
    o_a = causal_block_sweep(mla_block, q_a.transpose(0, 2, 1, 3), k_a.transpose(0, 2, 1, 3),
                             v_a.transpose(0, 2, 1, 3))
    q_b, k_b, v_b = jnp.split(sb_qkv, 3, axis=-1)
    o_b = causal_block_sweep(stick_breaking_block, to_heads(q_b, SB_HEADS), to_heads(k_b, SB_HEADS),
                             to_heads(v_b, SB_HEADS))
    return jnp.concatenate([merge_heads(o_a), merge_heads(o_b)], axis=-1) @ w_o


def moba_mixer(h, w_qkv, w_o, rel_bias):
    q, k, v = jnp.split(h @ w_qkv, 3, axis=-1)
    o = moba_attention(to_heads(q, MOBA_HEADS), to_heads(k, MOBA_HEADS), to_heads(v, MOBA_HEADS), rel_bias)
    return merge_heads(o) @ w_o


def setup_inputs(seed: int = 0) -> dict:
    key = jax.random.key(seed)
    ks = jax.random.split(key, 22)

    def dense(k, shape):
        return jax.random.normal(k, shape, jnp.float32) * (shape[-2] ** -0.5)

    def gain(k, shape):
        return 1.0 + 0.02 * jax.random.normal(k, shape, jnp.float32)

    return {
        'x': jax.random.normal(ks[0], (BATCH, SEQ, D_MODEL), jnp.float32),
        'ev_attn_norm': gain(ks[1], (N_EVEN, D_MODEL)),
        'ev_w_in': dense(ks[2], (N_EVEN, D_MODEL, EVEN_IN)),
        'ev_q_norm': gain(ks[3], (N_EVEN, Q_LORA)),
        'ev_w_uq': dense(ks[4], (N_EVEN, Q_LORA, MLA_HEADS * (MLA_NOPE + MLA_ROPE))),
        'ev_kv_norm': gain(ks[5], (N_EVEN, KV_LORA)),
        'ev_w_ukv': dense(ks[6], (N_EVEN, KV_LORA, MLA_HEADS * (MLA_NOPE + MLA_V))),
        'ev_w_o': dense(ks[7], (N_EVEN, MIX_EVEN, D_MODEL)),
        'ev_ffn_norm': gain(ks[8], (N_EVEN, D_MODEL)),
        'ev_w_gate': dense(ks[9], (N_EVEN, D_MODEL, D_FF_DENSE)),
        'ev_w_up': dense(ks[10], (N_EVEN, D_MODEL, D_FF_DENSE)),
        'ev_w_down': dense(ks[11], (N_EVEN, D_FF_DENSE, D_MODEL)),
        'od_attn_norm': gain(ks[12], (N_ODD, D_MODEL)),
        'od_w_qkv': dense(ks[13], (N_ODD, D_MODEL, 3 * MIX_ODD)),
        'od_w_o': dense(ks[14], (N_ODD, MIX_ODD, D_MODEL)),
        'od_ffn_norm': gain(ks[15], (N_ODD, D_MODEL)),
        'od_w_router': dense(ks[16], (N_ODD, D_MODEL, N_EXPERTS)),
        'od_w_gate': dense(ks[17], (N_ODD, N_EXPERTS, D_MODEL, D_FF_EXPERT)),
        'od_w_up': dense(ks[18], (N_ODD, N_EXPERTS, D_MODEL, D_FF_EXPERT)),
        'od_w_down': dense(ks[19], (N_ODD, N_EXPERTS, D_FF_EXPERT, D_MODEL)),
        'rel_bias': 0.5 * jax.random.normal(ks[20], (MOBA_HEADS, REL_BUCKETS), jnp.float32),
        'final_norm': gain(ks[21], (D_MODEL,)),
    }


def reference(x, ev_attn_norm, ev_w_in, ev_q_norm, ev_w_uq, ev_kv_norm, ev_w_ukv, ev_w_o,
              ev_ffn_norm, ev_w_gate, ev_w_up, ev_w_down,
              od_attn_norm, od_w_qkv, od_w_o, od_ffn_norm, od_w_router, od_w_gate, od_w_up, od_w_down,
              rel_bias, final_norm):
    cos, sin = rope_tables(x.shape[1])
    for layer in range(DEPTH):
        j = layer // 2
        if layer % 2 == 0:
            x = x + mla_sb_mixer(rmsnorm(x, ev_attn_norm[j]), ev_w_in[j], ev_q_norm[j], ev_w_uq[j],
                                 ev_kv_norm[j], ev_w_ukv[j], ev_w_o[j], cos, sin)
            x = x + swiglu(rmsnorm(x, ev_ffn_norm[j]), ev_w_gate[j], ev_w_up[j], ev_w_down[j])
        else:
            x = x + moba_mixer(rmsnorm(x, od_attn_norm[j]), od_w_qkv[j], od_w_o[j], rel_bias)
            x = x + moe_swiglu(rmsnorm(x, od_ffn_norm[j]), od_w_router[j], od_w_gate[j],
                               od_w_up[j], od_w_down[j])
    return rmsnorm(x, final_norm)
```

```cpp
#include <hip/hip_runtime.h>
#include <cstdio>
#include <cstdint>
#ifndef MK_ONE_LAUNCH
#define MK_ONE_LAUNCH 1
#endif
#ifndef PROBE_DUP
#define PROBE_DUP 0
#endif
namespace pg8 {
#define PG8_LAS __attribute__((address_space(3)))
typedef unsigned short bf16_t;
typedef short bf16x8 __attribute__((ext_vector_type(8)));
typedef float f32x4 __attribute__((ext_vector_type(4)));
typedef unsigned u32x4 __attribute__((ext_vector_type(4)));
constexpr int BM = 256, BK = 64, HALF = 128, HTB = HALF * BK * 2  , STAGE_BYTES = 8 * HTB, NXCD = 8, WGM = 8;

__host__ __device__ __forceinline__ int lds_byte(int r, int c) { const int st = (r >> 4) * 2 + (c >> 5), rr = r & 15, cc = c & 31, ob = rr * 64 + cc * 2; return st * 1024 + (ob ^ (((ob >> 9) & 1) << 5)); }
__host__ __device__ __forceinline__ void stage_rc(int b, int& R, int& C) { const int st = b / 1024, sb = b % 1024, swz = sb ^ (((sb >> 9) & 1) << 5); R = (st >> 1) * 16 + swz / 64; C = (st & 1) * 32 + (swz % 64) / 2; }
__host__ __device__ __forceinline__ int perm32(int rho) { const int n = rho >> 4, i = rho & 15; return 8 * (i >> 2) + 4 * n + (i & 3); }

struct Unit { int pm, pn; };
struct Gemm { const bf16_t* A; const bf16_t* Bt; int M, N, K; const int* aidx; };

struct StaticOrder {
    int nM, nN, nwg, G, c;
    __host__ __device__ void init(int M, int N, int G_, int c_) { nM = M / BM; nN = N / BM; nwg = nM * nN; G = G_; c = c_; }
    __host__ __device__ bool next(int i, Unit& u) const {
        const long L = (long)i * G + c; if (L >= nwg) return false;
        int wgid = (int)L; { const int q = nwg / NXCD, r = nwg % NXCD, xcd = wgid % NXCD, off = wgid / NXCD; wgid = (xcd < r ? xcd * (q + 1) : r * (q + 1) + (xcd - r) * q) + off; }
        const int nig = WGM * nN, gid = wgid / nig, fm = gid * WGM, gsz = (nM - fm) < WGM ? (nM - fm) : WGM;
        u.pm = fm + ((wgid % nig) % gsz); u.pn = (wgid % nig) / gsz; return true;
    }
    __device__ __forceinline__ void a_ready(const Unit&) const {}
    __device__ __forceinline__ void done(const Unit&) const {}
};

__device__ __forceinline__ unsigned cvt_pk_bf16(float lo, float hi) { unsigned r; asm volatile("v_cvt_pk_bf16_f32 %0, %1, %2" : "=v"(r) : "v"(lo), "v"(hi)); return r; }
typedef float f32x2 __attribute__((ext_vector_type(2)));
template <class Epi, class Sched, bool ALIGN_EPI = false, bool SP2 = false, bool GATHER = false>
__device__ __forceinline__ void gemm_phase(PG8_LAS unsigned char* lds, const Gemm g, const Sched& S, const Epi& E) {
    static_assert(!GATHER || SP2, "the gather A path is wired into the two-super-phase loop only");
    int tid_ = threadIdx.x; asm volatile("" : "+v"(tid_));
    const int tid = tid_, wid = __builtin_amdgcn_readfirstlane(tid >> 6), lane = tid & 63, wr = wid >> 2, wc = wid & 3, fr = lane & 15, fq = lane >> 4;
    const int K = g.K, nt = K / BK;
    unsigned voffA[2], voffB[2];
#pragma unroll
    for (int i = 0; i < 2; ++i) { int R, C; stage_rc(tid * 16 + i * 8192, R, C); const int Rb = Epi::PERM ? ((R & ~31) + perm32(R & 31)) : R;
        voffA[i] = (unsigned)(R * K + C) * 2u; voffB[i] = (unsigned)(Rb * K + C) * 2u; }
    unsigned gA[2][2] = {{0u, 0u}, {0u, 0u}}, gN[2][2] = {{0u, 0u}, {0u, 0u}}; int gR[2] = {0, 0}, gC[2] = {0, 0};
    if constexpr (GATHER) {
#pragma unroll
        for (int i = 0; i < 2; ++i) stage_rc(tid * 16 + i * 8192, gR[i], gC[i]); }
#define PG8_GIDX(dst, pm) do { _Pragma("unroll") for (int _h = 0; _h < 2; ++_h) _Pragma("unroll") for (int _i = 0; _i < 2; ++_i) \
        dst[_h][_i] = (unsigned)(g.aidx[(pm) * BM + _h * HALF + gR[_i]] * K + gC[_i]) * 2u; } while (0)
    const size_t kstep = (size_t)(BK * 2);
    const size_t hstep = (size_t)HALF * K * 2;
    const size_t tstep = 2 * hstep;
    const unsigned ldsw = (unsigned)wid * 1024u;
    const int aoff = lds_byte(wr * 64 + fr, fq * 8), boff = lds_byte(wc * 32 + fr, fq * 8);
#define PG8_SA(b, h) (((b) * 2 + (h)) * HTB)
#define PG8_SB(b, h) ((4 + (b) * 2 + (h)) * HTB)
#define PG8_STAGE(bufoff, gbase, voff) do { _Pragma("unroll") for (int _i = 0; _i < 2; ++_i) \
        __builtin_amdgcn_global_load_lds((const unsigned*)((const char*)(gbase) + (voff)[_i]), (PG8_LAS unsigned*)(lds + (bufoff) + ldsw + _i * 8192), 16, 0, 0); } while (0)
#define PG8_STAGE_A(bufoff, gbase, hh, nx) do { if constexpr (GATHER) { _Pragma("unroll") for (int _i = 0; _i < 2; ++_i) \
        __builtin_amdgcn_global_load_lds((const unsigned*)((const char*)(gbase) + ((nx) ? gN[hh][_i] : gA[hh][_i])), (PG8_LAS unsigned*)(lds + (bufoff) + ldsw + _i * 8192), 16, 0, 0); } \
    else { PG8_STAGE(bufoff, (gbase) + (hh) * hstep, voffA); } } while (0)
#define PG8_LDA(dst, b, h) do { _Pragma("unroll") for (int m = 0; m < 4; ++m) _Pragma("unroll") for (int k = 0; k < 2; ++k) dst[m][k] = *(const PG8_LAS bf16x8*)(lds + PG8_SA(b, h) + aoff + m * 2048 + k * 1024); } while (0)
#define PG8_LDB(dst, b, h) do { _Pragma("unroll") for (int n = 0; n < 2; ++n) _Pragma("unroll") for (int k = 0; k < 2; ++k) dst[n][k] = *(const PG8_LAS bf16x8*)(lds + PG8_SB(b, h) + boff + n * 2048 + k * 1024); } while (0)
#define PG8_MMA(ai, bj, At, Bt) do { __builtin_amdgcn_s_setprio(1); _Pragma("unroll") for (int m = 0; m < 4; ++m) _Pragma("unroll") for (int n = 0; n < 2; ++n) _Pragma("unroll") for (int k = 0; k < 2; ++k) \
        acc[ai][bj][m][n] = __builtin_amdgcn_mfma_f32_16x16x32_bf16(Bt[n][k], At[m][k], acc[ai][bj][m][n], 0, 0, 0); __builtin_amdgcn_s_setprio(0); } while (0)
#define PG8_WAIT_V(n) asm volatile("s_waitcnt vmcnt(" #n ")" ::: "memory")
#define PG8_WAIT_L(n) asm volatile("s_waitcnt lgkmcnt(" #n ")" ::: "memory")
#define PG8_BAR __builtin_amdgcn_s_barrier()
#define PG8_SCHED __builtin_amdgcn_sched_barrier(0)
    Unit cur, nxt; int ui = 0;
    if (!S.next(0, cur)) return;
    f32x4 acc[2][2][4][2];
#pragma unroll
    for (int a = 0; a < 2; ++a)
#pragma unroll
        for (int b = 0; b < 2; ++b)
#pragma unroll
            for (int m = 0; m < 4; ++m)
#pragma unroll
                for (int n = 0; n < 2; ++n) acc[a][b][m][n] = (f32x4){0.f, 0.f, 0.f, 0.f};
    bf16x8 At[4][2], B0[2][2], B1[2][2];
    const char* cA = GATHER ? (const char*)g.A : (const char*)g.A + (size_t)cur.pm * tstep; const char* cB = (const char*)g.Bt + (size_t)cur.pn * tstep;
    if constexpr (GATHER) { PG8_GIDX(gA, cur.pm); }
    S.a_ready(cur);
    if constexpr (SP2) {
        PG8_STAGE(PG8_SB(0, 0), cB, voffB); PG8_STAGE(PG8_SB(0, 1), cB + hstep, voffB); PG8_STAGE_A(PG8_SA(0, 0), cA, 0, false); PG8_STAGE_A(PG8_SA(0, 1), cA, 1, false);
        if (wr == 1) PG8_BAR;
        PG8_WAIT_V(2); PG8_BAR;
        PG8_STAGE(PG8_SB(1, 0), cB + kstep, voffB); PG8_STAGE_A(PG8_SA(1, 0), cA + kstep, 0, false); PG8_STAGE(PG8_SB(1, 1), cB + hstep + kstep, voffB);
        PG8_WAIT_V(6); PG8_BAR;
    } else {
        PG8_STAGE(PG8_SB(0, 0), cB, voffB); PG8_STAGE(PG8_SA(0, 0), cA, voffA); PG8_STAGE(PG8_SB(0, 1), cB + hstep, voffB); PG8_STAGE(PG8_SA(0, 1), cA + hstep, voffA);
        if (wr == 1) PG8_BAR;
        PG8_WAIT_V(4); PG8_BAR;
        PG8_STAGE(PG8_SB(1, 0), cB + kstep, voffB); PG8_STAGE(PG8_SA(1, 0), cA + kstep, voffA); PG8_STAGE(PG8_SB(1, 1), cB + hstep + kstep, voffB);
        PG8_WAIT_V(6); PG8_BAR;
    }
    for (;;) {
        const bool has_next = S.next(ui + 1, nxt);
        const char* nA = GATHER ? (const char*)g.A : (has_next ? (const char*)g.A + (size_t)nxt.pm * tstep : cA); const char* nB = has_next ? (const char*)g.Bt + (size_t)nxt.pn * tstep : cB;
        if constexpr (GATHER) { if (has_next) { PG8_GIDX(gN, nxt.pm); } else { _Pragma("unroll") for (int _h = 0; _h < 2; ++_h) _Pragma("unroll") for (int _i = 0; _i < 2; ++_i) gN[_h][_i] = gA[_h][_i]; } }
#pragma unroll 1
        for (int t = 0; t < nt; t += 2) {
            const bool last = (t == nt - 2);
            const char* a1 = cA + (size_t)(t + 1) * kstep;
            const char* a2 = last ? nA : cA + (size_t)(t + 2) * kstep; const char* b2 = last ? nB : cB + (size_t)(t + 2) * kstep;
            const char* a3 = a2 + kstep; const char* b3 = b2 + kstep;
            if (last && has_next) S.a_ready(nxt);
            if constexpr (SP2) {
            PG8_LDB(B0, 0, 0); PG8_LDB(B1, 0, 1); PG8_SCHED; PG8_LDA(At, 0, 0); PG8_STAGE_A(PG8_SA(1, 1), a1, 1, false);
            PG8_WAIT_V(8); PG8_WAIT_L(0); PG8_BAR; PG8_MMA(0, 0, At, B0); PG8_MMA(0, 1, At, B1); PG8_BAR; PG8_SCHED;
            PG8_LDA(At, 0, 1); PG8_STAGE(PG8_SB(0, 0), b2, voffB); PG8_STAGE(PG8_SB(0, 1), b2 + hstep, voffB); PG8_STAGE_A(PG8_SA(0, 0), a2, 0, last);
            PG8_WAIT_V(8); PG8_WAIT_L(0); PG8_BAR; PG8_MMA(1, 0, At, B0); PG8_MMA(1, 1, At, B1); PG8_BAR; PG8_SCHED;
            PG8_LDB(B0, 1, 0); PG8_LDB(B1, 1, 1); PG8_SCHED; PG8_LDA(At, 1, 0); PG8_STAGE_A(PG8_SA(0, 1), a2, 1, last);
            PG8_WAIT_V(8); PG8_WAIT_L(0); PG8_BAR; PG8_MMA(0, 0, At, B0); PG8_MMA(0, 1, At, B1); PG8_BAR; PG8_SCHED;
            PG8_LDA(At, 1, 1); PG8_STAGE(PG8_SB(1, 0), b3, voffB); PG8_STAGE(PG8_SB(1, 1), b3 + hstep, voffB); PG8_STAGE_A(PG8_SA(1, 0), a3, 0, last);
            PG8_WAIT_V(8); PG8_WAIT_L(0); PG8_BAR; PG8_MMA(1, 0, At, B0); PG8_MMA(1, 1, At, B1); PG8_BAR; PG8_SCHED;
            } else {
            PG8_LDB(B0, 0, 0); PG8_SCHED; PG8_LDA(At, 0, 0); PG8_STAGE(PG8_SA(1, 1), a1 + hstep, voffA);
            PG8_WAIT_L(8); PG8_BAR; PG8_WAIT_L(0); PG8_MMA(0, 0, At, B0); PG8_BAR; PG8_SCHED;
            PG8_LDB(B1, 0, 1); PG8_STAGE(PG8_SB(0, 0), b2, voffB);
            PG8_BAR; PG8_WAIT_L(0); PG8_MMA(0, 1, At, B1); PG8_BAR;
            PG8_LDA(At, 0, 1); PG8_STAGE(PG8_SA(0, 0), a2, voffA);
            PG8_BAR; PG8_WAIT_L(0); PG8_MMA(1, 0, At, B0); PG8_BAR; PG8_SCHED;
            PG8_STAGE(PG8_SB(0, 1), b2 + hstep, voffB);
            PG8_WAIT_V(6); PG8_BAR; PG8_MMA(1, 1, At, B1); PG8_BAR;
            PG8_LDB(B0, 1, 0); PG8_SCHED; PG8_LDA(At, 1, 0); PG8_STAGE(PG8_SA(0, 1), a2 + hstep, voffA);
            PG8_WAIT_L(8); PG8_BAR; PG8_WAIT_L(0); PG8_MMA(0, 0, At, B0); PG8_BAR; PG8_SCHED;
            PG8_LDB(B1, 1, 1); PG8_STAGE(PG8_SB(1, 0), b3, voffB);
            PG8_BAR; PG8_WAIT_L(0); PG8_MMA(0, 1, At, B1); PG8_BAR;
            PG8_LDA(At, 1, 1); PG8_STAGE(PG8_SA(1, 0), a3, voffA);
            PG8_BAR; PG8_WAIT_L(0); PG8_MMA(1, 0, At, B0); PG8_BAR; PG8_SCHED;
            PG8_STAGE(PG8_SB(1, 1), b3 + hstep, voffB);
            PG8_WAIT_V(6); PG8_BAR; PG8_MMA(1, 1, At, B1); PG8_BAR;
            }
        }
        if constexpr (ALIGN_EPI) { if (wr == 0) PG8_BAR; }
        if constexpr (!Epi::AFTER_DRAIN) { E(acc, cur, wr, wc, fr, fq); S.done(cur); }
        if (!has_next) break;
#pragma unroll
        for (int a = 0; a < 2; ++a)
#pragma unroll
            for (int b = 0; b < 2; ++b)
#pragma unroll
                for (int m = 0; m < 4; ++m)
#pragma unroll
                    for (int n = 0; n < 2; ++n) acc[a][b][m][n] = (f32x4){0.f, 0.f, 0.f, 0.f};
        cur = nxt; cA = nA; cB = nB; ++ui;
        if constexpr (GATHER) { _Pragma("unroll") for (int _h = 0; _h < 2; ++_h) _Pragma("unroll") for (int _i = 0; _i < 2; ++_i) gA[_h][_i] = gN[_h][_i]; }
        if constexpr (ALIGN_EPI) { if (wr == 1) PG8_BAR; }
    }
    PG8_WAIT_V(0);
    if constexpr (!ALIGN_EPI) { if (wr == 0) PG8_BAR; }
    PG8_BAR;
    if constexpr (Epi::AFTER_DRAIN) { E.fused(acc, cur, wr, wc, fr, fq, lds, wid, lane); S.done(cur); }
#undef PG8_SA
#undef PG8_SB
#undef PG8_STAGE
#undef PG8_STAGE_A
#undef PG8_GIDX
#undef PG8_LDA
#undef PG8_LDB
#undef PG8_MMA
#undef PG8_WAIT_V
#undef PG8_WAIT_L
#undef PG8_BAR
#undef PG8_SCHED
}
}

#define DI __device__ __forceinline__
#define LAS __attribute__((address_space(3)))
#define GAS __attribute__((address_space(1)))
typedef unsigned short bf16;
constexpr int BATCH = 2, SEQ = 16384, T = BATCH * SEQ, DM = 1024;
constexpr float LOG2E = 1.4426950408889634f;
constexpr float RMS_EPS = 1e-6f;
DI int rfl(int v) { return __builtin_amdgcn_readfirstlane(v); }
DI float bflo(unsigned w) { return __uint_as_float(w << 16); }
DI float bfhi(unsigned w) { return __uint_as_float(w & 0xffff0000u); }
typedef float f32x2_t __attribute__((ext_vector_type(2))); typedef __bf16 bf16x2_t __attribute__((ext_vector_type(2)));
DI unsigned cvtpk(float lo, float hi) { f32x2_t v = {lo, hi}; bf16x2_t b = __builtin_convertvector(v, bf16x2_t); return __builtin_bit_cast(unsigned, b); }
typedef float f32x4 __attribute__((ext_vector_type(4)));
typedef unsigned v4u __attribute__((ext_vector_type(4)));
DI float ex2(float x) { return __builtin_amdgcn_exp2f(x); }
DI float lg2(float x) { return __builtin_amdgcn_logf(x); }
DI float wave_sum(float v) {
#pragma unroll
    for (int o = 1; o < 64; o <<= 1) v += __shfl_xor(v, o);
    return v;
}

namespace att {
typedef short bf16x8 __attribute__((ext_vector_type(8)));
typedef short s16x4 __attribute__((ext_vector_type(4)));
typedef float f32x16 __attribute__((ext_vector_type(16)));
typedef unsigned u32x4 __attribute__((ext_vector_type(4)));
typedef LAS const char* lcp;
typedef short v4i16_t __attribute__((ext_vector_type(4)));
DI int crow(int r, int hi) { return (r & 3) + 8 * (r >> 2) + 4 * hi; }
DI void glds16(const void* gsrc, unsigned lds_dst) { unsigned keep;
    asm volatile("s_mov_b32 %0, m0\n\ts_mov_b32 m0, %2\n\ts_nop 0\n\tglobal_load_lds_dwordx4 %1, off\n\ts_mov_b32 m0, %0" : "=&s"(keep) : "v"(gsrc), "s"(lds_dst) : "memory"); }
#define ATT_WAITV_BAR() asm volatile("s_waitcnt vmcnt(0) lgkmcnt(0)\n\ts_barrier" ::: "memory")
#define ATT_BAR() asm volatile("s_waitcnt lgkmcnt(0)\n\ts_barrier" ::: "memory")
#define WAVE_LDS_SYNC() asm volatile("" ::: "memory")
DI s16x4 vtr(lcp p) { return __builtin_bit_cast(s16x4, __builtin_amdgcn_ds_read_tr16_b64_v4i16((LAS v4i16_t*)p)); }
DI float hmax(float x) { auto rr = __builtin_amdgcn_permlane32_swap(__float_as_uint(x), __float_as_uint(x), false, false); return fmaxf(__uint_as_float(rr[0]), __uint_as_float(rr[1])); }
DI float hsum(float x) { auto rr = __builtin_amdgcn_permlane32_swap(__float_as_uint(x), __float_as_uint(x), false, false); return __uint_as_float(rr[0]) + __uint_as_float(rr[1]); }

template <int NK> DI void qk_tile(f32x16& p0, f32x16& p1, lcp kfr, const bf16x8* qr) {
    f32x16 z;
#pragma unroll
    for (int r = 0; r < 16; ++r) z[r] = 0.f;
    p0 = z; p1 = z;
    bf16x8 kf[2 * NK];
#pragma unroll
    for (int d0 = 0; d0 < NK; ++d0) { kf[2 * d0] = *(const LAS bf16x8*)(kfr + d0 * 2048); kf[2 * d0 + 1] = *(const LAS bf16x8*)(kfr + d0 * 2048 + 512); }
    __builtin_amdgcn_sched_barrier(0);
#pragma unroll
    for (int d0 = 0; d0 < NK; ++d0) { p0 = __builtin_amdgcn_mfma_f32_32x32x16_bf16(kf[2 * d0], qr[d0], p0, 0, 0, 0); p1 = __builtin_amdgcn_mfma_f32_32x32x16_bf16(kf[2 * d0 + 1], qr[d0], p1, 0, 0, 0); }
    __builtin_amdgcn_sched_barrier(0);
}
DI void pv_tile(f32x16* o, lcp vfr, const f32x16& p0, const f32x16& p1) {
    u32x4 pw[4];
    pw[0] = (u32x4){cvtpk(p0[0], p0[1]), cvtpk(p0[2], p0[3]), cvtpk(p0[4], p0[5]), cvtpk(p0[6], p0[7])};
    pw[1] = (u32x4){cvtpk(p0[8], p0[9]), cvtpk(p0[10], p0[11]), cvtpk(p0[12], p0[13]), cvtpk(p0[14], p0[15])};
    pw[2] = (u32x4){cvtpk(p1[0], p1[1]), cvtpk(p1[2], p1[3]), cvtpk(p1[4], p1[5]), cvtpk(p1[6], p1[7])};
    pw[3] = (u32x4){cvtpk(p1[8], p1[9]), cvtpk(p1[10], p1[11]), cvtpk(p1[12], p1[13]), cvtpk(p1[14], p1[15])};
#pragma unroll
    for (int d0 = 0; d0 < 2; ++d0) {
        s16x4 lo[4], hh[4];
#pragma unroll
        for (int ks = 0; ks < 4; ++ks) { lo[ks] = vtr(vfr + d0 * 4096 + ks * 1024); hh[ks] = vtr(vfr + d0 * 4096 + ks * 1024 + 512); }
        __builtin_amdgcn_sched_barrier(0);
#pragma unroll
        for (int ks = 0; ks < 4; ++ks) { const bf16x8 vf = (bf16x8){lo[ks][0], lo[ks][1], lo[ks][2], lo[ks][3], hh[ks][0], hh[ks][1], hh[ks][2], hh[ks][3]};
            o[d0] = __builtin_amdgcn_mfma_f32_32x32x16_bf16(__builtin_bit_cast(bf16x8, pw[ks]), vf, o[d0], 0, 0, 0); }
        __builtin_amdgcn_sched_barrier(0);
    }
}
DI void smax_update(f32x16& p0, f32x16& p1, float& mref, float& lsum, f32x16* o, LAS float* wsf, int r32, int hi) {
    float rm = fmaxf(p0[0], p1[0]);
#pragma unroll
    for (int r = 1; r < 16; ++r) rm = fmaxf(rm, fmaxf(p0[r], p1[r]));
    rm = hmax(rm);
    if (__any(rm > mref + 8.f)) {
        const float mnew = fmaxf(mref, rm);
        const float alpha = (mnew == mref) ? 1.f : ex2(mref - mnew);
        lsum *= alpha; mref = mnew;
        if (hi == 0) wsf[r32] = alpha;
        WAVE_LDS_SYNC();
#pragma unroll
        for (int r = 0; r < 16; ++r) { const float a = wsf[crow(r, hi)]; o[0][r] *= a; o[1][r] *= a; }
        WAVE_LDS_SYNC();
    }
    float s = 0.f;
#pragma unroll
    for (int r = 0; r < 16; ++r) { p0[r] = ex2(p0[r] - mref); p1[r] = ex2(p1[r] - mref); s += p0[r] + p1[r]; }
    lsum += s;
}
DI void stage_o(const f32x16* o, LAS bf16* stg, const LAS float* rowscale, int r32, int hi) {
    WAVE_LDS_SYNC();
#pragma unroll
    for (int r = 0; r < 16; ++r) { const int orow = crow(r, hi); const float sc = rowscale ? rowscale[orow] : 1.f;
        const unsigned a = cvtpk(o[0][r] * sc, o[1][r] * sc);
        stg[orow * 64 + r32] = (bf16)(a & 0xffffu); stg[orow * 64 + 32 + r32] = (bf16)(a >> 16); }
    WAVE_LDS_SYNC();
}

constexpr int MLA_KSLOT = 12288, VSLOT = 8192;
constexpr int MLA_OFF_V = 3 * MLA_KSLOT, MLA_OFF_WS = MLA_OFF_V + 3 * VSLOT, MLA_OFF_ST = MLA_OFF_WS + 8 * 256, MLA_LDS = MLA_OFF_ST + 8 * 4096;
template <int NK> DI void qk_tile_ref(f32x16& p0, f32x16& p1, lcp kfr, const bf16x8* qr, const f32x16& negm) {
    p0 = negm; p1 = negm;
    constexpr int H = NK / 2;
#pragma unroll
    for (int hb = 0; hb < 2; ++hb) {
        bf16x8 kf[2 * H];
#pragma unroll
        for (int d = 0; d < H; ++d) { const int d0 = hb * H + d; kf[2 * d] = *(const LAS bf16x8*)(kfr + d0 * 2048); kf[2 * d + 1] = *(const LAS bf16x8*)(kfr + d0 * 2048 + 512); }
        __builtin_amdgcn_sched_barrier(0);
#pragma unroll
        for (int d = 0; d < H; ++d) { const int d0 = hb * H + d; p0 = __builtin_amdgcn_mfma_f32_32x32x16_bf16(kf[2 * d], qr[d0], p0, 0, 0, 0); p1 = __builtin_amdgcn_mfma_f32_32x32x16_bf16(kf[2 * d + 1], qr[d0], p1, 0, 0, 0); }
        __builtin_amdgcn_sched_barrier(0);
    }
}
DI void smax_update_ref(f32x16& p0, f32x16& p1, float& mref, f32x16& negm, float& lsum, f32x16* o, LAS float* wsf, int r32, int hi, bool first) {
    float ra = __builtin_fmaxf(__builtin_fmaxf(p0[0], p0[1]), p1[0]), rb = __builtin_fmaxf(__builtin_fmaxf(p0[2], p0[3]), p1[1]);
    ra = __builtin_fmaxf(__builtin_fmaxf(ra, p1[2]), p1[3]);
#pragma unroll
    for (int r = 4; r < 16; r += 4) { ra = __builtin_fmaxf(__builtin_fmaxf(ra, p0[r]), p0[r + 1]); rb = __builtin_fmaxf(__builtin_fmaxf(rb, p0[r + 2]), p0[r + 3]);
        ra = __builtin_fmaxf(__builtin_fmaxf(ra, p1[r]), p1[r + 1]); rb = __builtin_fmaxf(__builtin_fmaxf(rb, p1[r + 2]), p1[r + 3]); }
    const float rm = hmax(fmaxf(ra, rb));
    if (first || __any(rm > 8.f)) {
        const float dl = first ? rm : fmaxf(rm, 0.f);
        mref += dl;
#pragma unroll
        for (int r = 0; r < 16; ++r) { p0[r] -= dl; p1[r] -= dl; }
#pragma unroll
        for (int r = 0; r < 16; ++r) negm[r] = -mref;
        if (!first) { const float alpha = ex2(-dl); lsum *= alpha;
            if (hi == 0) wsf[r32] = alpha;
            WAVE_LDS_SYNC();
#pragma unroll
            for (int r = 0; r < 16; ++r) { const float a = wsf[crow(r, hi)]; o[0][r] *= a; o[1][r] *= a; }
            WAVE_LDS_SYNC(); }
    }
    float s = 0.f;
#pragma unroll
    for (int r = 0; r < 16; ++r) { p0[r] = ex2(p0[r]); p1[r] = ex2(p1[r]); s += p0[r] + p1[r]; }
    lsum += s;
}
DI void mla_unit(int bh, int qb, const bf16* QA, const bf16* KN, const bf16* KR, const bf16* VA, bf16* OC, LAS unsigned char* lds) {
    int tid_ = threadIdx.x; asm volatile("" : "+v"(tid_));
    const int tid = tid_, lane = tid & 63, r32 = lane & 31, hi = lane >> 5, wid = rfl(tid >> 6);
    const int b = bh >> 3, h = bh & 7; const long rowbase = (long)b * SEQ; const int q0 = qb * 256;
    const unsigned lds0 = (unsigned)(size_t)lds;
    LAS float* wsf = (LAS float*)(lds + MLA_OFF_WS) + wid * 64;
    LAS bf16* stg = (LAS bf16*)(lds + MLA_OFF_ST) + wid * 2048;
    const bf16* ksrc = KN + (rowbase + lane) * 512 + h * 64 + wid * 8;
    const bf16* rsrc = KR + (rowbase + lane) * 32 + (wid & 3) * 8;
    const bf16* vsrc = VA + (rowbase + 16 * (wid & 3) + (lane >> 2)) * 512 + h * 64 + (wid >> 2) * 32 + (lane & 3) * 8;
#define MLA_DMA_K(t, s) do { glds16(ksrc + (long)(t) * 64 * 512, (unsigned)rfl((int)(lds0 + (s) * MLA_KSLOT + wid * 1024))); \
        if (wid < 4) glds16(rsrc + (long)(t) * 64 * 32, (unsigned)rfl((int)(lds0 + (s) * MLA_KSLOT + (8 + wid) * 1024))); } while (0)
#define MLA_DMA_V(t, s) glds16(vsrc + (long)(t) * 64 * 512, (unsigned)rfl((int)(lds0 + MLA_OFF_V + (s) * VSLOT + wid * 1024)))
    const bf16* qp = QA + (rowbase + q0 + wid * 32 + r32) * 768 + h * 96 + hi * 8;
    bf16x8 qr[6];
#pragma unroll
    for (int d0 = 0; d0 < 6; ++d0) qr[d0] = *(const bf16x8*)(qp + d0 * 16);
    const int NT = 4 * (qb + 1);
    const lcp kfr = (lcp)lds + hi * 1024 + r32 * 16;
    const lcp vfr = (lcp)lds + MLA_OFF_V + ((lane >> 4) & 1) * 32 + (lane & 3) * 8 + (4 * hi + ((lane & 15) >> 2)) * 64;
    float mref = 0.f, lsum = 0.f; f32x16 o[2], negm;
#pragma unroll
    for (int r = 0; r < 16; ++r) { o[0][r] = 0.f; o[1][r] = 0.f; negm[r] = 0.f; }
    const int qrel = 32 * wid + r32;
#define MLA_MASK(P0, P1, t) do { const int jb_ = (t) - (NT - 4); if (jb_ >= 0 && 64 * jb_ + 63 > 32 * wid) { \
        _Pragma("unroll") for (int r = 0; r < 16; ++r) { const int kv = 64 * jb_ + crow(r, hi); if (kv > qrel) P0[r] = -INFINITY; if (kv + 32 > qrel) P1[r] = -INFINITY; } } } while (0)
#define MLA_ROWMAX(P0, P1, rm) do { float ra_ = __builtin_fmaxf(__builtin_fmaxf(P0[0], P0[1]), P1[0]), rb_ = __builtin_fmaxf(__builtin_fmaxf(P0[2], P0[3]), P1[1]); ra_ = __builtin_fmaxf(__builtin_fmaxf(ra_, P1[2]), P1[3]); \
        _Pragma("unroll") for (int r = 4; r < 16; r += 4) { ra_ = __builtin_fmaxf(__builtin_fmaxf(ra_, P0[r]), P0[r + 1]); rb_ = __builtin_fmaxf(__builtin_fmaxf(rb_, P0[r + 2]), P0[r + 3]); \
            ra_ = __builtin_fmaxf(__builtin_fmaxf(ra_, P1[r]), P1[r + 1]); rb_ = __builtin_fmaxf(__builtin_fmaxf(rb_, P1[r + 2]), P1[r + 3]); } rm = hmax(fmaxf(ra_, rb_)); } while (0)
    MLA_DMA_K(0, 0); MLA_DMA_V(0, 0); MLA_DMA_K(1, 1);
    ATT_WAITV_BAR();
    MLA_DMA_K(2, 2); MLA_DMA_V(1, 1);
    f32x16 pa0, pa1, pb0, pb1;
    qk_tile_ref<6>(pa0, pa1, kfr, qr, negm); MLA_MASK(pa0, pa1, 0);
    { float rm; MLA_ROWMAX(pa0, pa1, rm); mref = rm;
#pragma unroll
      for (int r = 0; r < 16; ++r) { pa0[r] = ex2(pa0[r] - rm); pa1[r] = ex2(pa1[r] - rm); negm[r] = -rm; } }
    int kc = 1, kn = 2, kf_ = 0, vc = 0, vn = 1, vf_ = 2;
#define MLA_KLD(i) kf_##i = *(const LAS bf16x8*)(kb_ + ((i) >> 1) * 2048 + ((i) & 1) * 512)
#define MLA_VLD(i) do { vl_[i] = vtr(vb_ + ((i) >> 2) * 4096 + ((i) & 3) * 1024); vh_[i] = vtr(vb_ + ((i) >> 2) * 4096 + ((i) & 3) * 1024 + 512); } while (0)
#define MLA_PIN(x) asm volatile("" : "+v"(x))
#define MLA_STEP(C0, C1, P0, P1, t) do { \
        ATT_WAITV_BAR();                                               \
        if ((t) + 2 < NT) MLA_DMA_K((t) + 2, kf_); \
        if ((t) + 1 < NT) MLA_DMA_V((t) + 1, vf_); \
          \
        const lcp kb_ = kfr + kc * MLA_KSLOT; const lcp vb_ = vfr + vc * VSLOT; \
        bf16x8 kf_0, kf_1, kf_2, kf_3, kf_4, kf_5, kf_6, kf_7, kf_8, kf_9, kf_10, kf_11; s16x4 vl_[8], vh_[8]; u32x4 pw_[4]; float sacc_ = 0.f; \
        MLA_KLD(0); MLA_KLD(1); MLA_KLD(2); MLA_KLD(3); \
        MLA_KLD(4); C0 = __builtin_amdgcn_mfma_f32_32x32x16_bf16(kf_0, qr[0], negm, 0, 0, 0); sacc_ += P0[0]; sacc_ += P0[1]; sacc_ += P0[2]; MLA_PIN(sacc_); pw_[0][0] = cvtpk(P0[0], P0[1]); MLA_PIN(pw_[0]); __builtin_amdgcn_sched_barrier(0); \
        MLA_KLD(5); C1 = __builtin_amdgcn_mfma_f32_32x32x16_bf16(kf_1, qr[0], negm, 0, 0, 0); sacc_ += P0[3]; sacc_ += P0[4]; sacc_ += P0[5]; MLA_PIN(sacc_); pw_[0][1] = cvtpk(P0[2], P0[3]); MLA_PIN(pw_[0]); __builtin_amdgcn_sched_barrier(0); \
        MLA_KLD(6); C0 = __builtin_amdgcn_mfma_f32_32x32x16_bf16(kf_2, qr[1], C0, 0, 0, 0); sacc_ += P0[6]; sacc_ += P0[7]; sacc_ += P0[8]; MLA_PIN(sacc_); pw_[0][2] = cvtpk(P0[4], P0[5]); MLA_PIN(pw_[0]); __builtin_amdgcn_sched_barrier(0); \
        MLA_KLD(7); C1 = __builtin_amdgcn_mfma_f32_32x32x16_bf16(kf_3, qr[1], C1, 0, 0, 0); sacc_ += P0[9]; sacc_ += P0[10]; sacc_ += P0[11]; MLA_PIN(sacc_); pw_[0][3] = cvtpk(P0[6], P0[7]); MLA_PIN(pw_[0]); __builtin_amdgcn_sched_barrier(0); \
        MLA_KLD(8); MLA_VLD(0); C0 = __builtin_amdgcn_mfma_f32_32x32x16_bf16(kf_4, qr[2], C0, 0, 0, 0); sacc_ += P0[12]; sacc_ += P0[13]; sacc_ += P0[14]; MLA_PIN(sacc_); pw_[1][0] = cvtpk(P0[8], P0[9]); MLA_PIN(pw_[1]); pw_[1][1] = cvtpk(P0[10], P0[11]); MLA_PIN(pw_[1]); __builtin_amdgcn_sched_barrier(0); \
        MLA_KLD(9); MLA_VLD(1); C1 = __builtin_amdgcn_mfma_f32_32x32x16_bf16(kf_5, qr[2], C1, 0, 0, 0); sacc_ += P0[15]; sacc_ += P1[0]; sacc_ += P1[1]; MLA_PIN(sacc_); pw_[1][2] = cvtpk(P0[12], P0[13]); MLA_PIN(pw_[1]); pw_[1][3] = cvtpk(P0[14], P0[15]); MLA_PIN(pw_[1]); __builtin_amdgcn_sched_barrier(0); \
        MLA_KLD(10); MLA_VLD(2); C0 = __builtin_amdgcn_mfma_f32_32x32x16_bf16(kf_6, qr[3], C0, 0, 0, 0); sacc_ += P1[2]; sacc_ += P1[3]; sacc_ += P1[4]; MLA_PIN(sacc_); pw_[2][0] = cvtpk(P1[0], P1[1]); MLA_PIN(pw_[2]); pw_[2][1] = cvtpk(P1[2], P1[3]); MLA_PIN(pw_[2]); __builtin_amdgcn_sched_barrier(0); \
        MLA_KLD(11); MLA_VLD(3); C1 = __builtin_amdgcn_mfma_f32_32x32x16_bf16(kf_7, qr[3], C1, 0, 0, 0); sacc_ += P1[5]; sacc_ += P1[6]; sacc_ += P1[7]; MLA_PIN(sacc_); pw_[2][2] = cvtpk(P1[4], P1[5]); MLA_PIN(pw_[2]); pw_[2][3] = cvtpk(P1[6], P1[7]); MLA_PIN(pw_[2]); __builtin_amdgcn_sched_barrier(0); \
        MLA_VLD(4); C0 = __builtin_amdgcn_mfma_f32_32x32x16_bf16(kf_8, qr[4], C0, 0, 0, 0); sacc_ += P1[8]; sacc_ += P1[9]; MLA_PIN(sacc_); pw_[3][0] = cvtpk(P1[8], P1[9]); MLA_PIN(pw_[3]); __builtin_amdgcn_sched_barrier(0); \
        MLA_VLD(5); C1 = __builtin_amdgcn_mfma_f32_32x32x16_bf16(kf_9, qr[4], C1, 0, 0, 0); sacc_ += P1[10]; sacc_ += P1[11]; MLA_PIN(sacc_); pw_[3][1] = cvtpk(P1[10], P1[11]); MLA_PIN(pw_[3]); __builtin_amdgcn_sched_barrier(0); \
        MLA_VLD(6); C0 = __builtin_amdgcn_mfma_f32_32x32x16_bf16(kf_10, qr[5], C0, 0, 0, 0); sacc_ += P1[12]; sacc_ += P1[13]; MLA_PIN(sacc_); pw_[3][2] = cvtpk(P1[12], P1[13]); MLA_PIN(pw_[3]); __builtin_amdgcn_sched_barrier(0); \
        MLA_VLD(7); C1 = __builtin_amdgcn_mfma_f32_32x32x16_bf16(kf_11, qr[5], C1, 0, 0, 0); sacc_ += P1[14]; sacc_ += P1[15]; MLA_PIN(sacc_); pw_[3][3] = cvtpk(P1[14], P1[15]); MLA_PIN(pw_[3]); __builtin_amdgcn_sched_barrier(0); \
        lsum += sacc_; \
          \
        __builtin_amdgcn_sched_barrier(0); \
        o[0] = __builtin_amdgcn_mfma_f32_32x32x16_bf16(__builtin_bit_cast(bf16x8, pw_[0]), (bf16x8){vl_[0][0], vl_[0][1], vl_[0][2], vl_[0][3], vh_[0][0], vh_[0][1], vh_[0][2], vh_[0][3]}, o[0], 0, 0, 0); o[1] = __builtin_amdgcn_mfma_f32_32x32x16_bf16(__builtin_bit_cast(bf16x8, pw_[0]), (bf16x8){vl_[4][0], vl_[4][1], vl_[4][2], vl_[4][3], vh_[4][0], vh_[4][1], vh_[4][2], vh_[4][3]}, o[1], 0, 0, 0); \
        MLA_MASK(C0, C1, t); \
        float rm_; MLA_ROWMAX(C0, C1, rm_); \
        bool resc_ = false; float alpha_ = 1.f; \
        if (__any(rm_ > 8.f)) { const float dl = fmaxf(rm_, 0.f); mref += dl; alpha_ = ex2(-dl); lsum *= alpha_; resc_ = true; \
            _Pragma("unroll") for (int r = 0; r < 16; ++r) { C0[r] -= dl; C1[r] -= dl; negm[r] = -mref; } } \
          \
        __builtin_amdgcn_sched_barrier(0); \
        o[0] = __builtin_amdgcn_mfma_f32_32x32x16_bf16(__builtin_bit_cast(bf16x8, pw_[1]), (bf16x8){vl_[1][0], vl_[1][1], vl_[1][2], vl_[1][3], vh_[1][0], vh_[1][1], vh_[1][2], vh_[1][3]}, o[0], 0, 0, 0); C0[0] = ex2(C0[0]); C0[1] = ex2(C0[1]); C0[2] = ex2(C0[2]); C0[3] = ex2(C0[3]); C0[4] = ex2(C0[4]); MLA_PIN(C0); MLA_PIN(C1); __builtin_amdgcn_sched_barrier(0); \
        o[1] = __builtin_amdgcn_mfma_f32_32x32x16_bf16(__builtin_bit_cast(bf16x8, pw_[1]), (bf16x8){vl_[5][0], vl_[5][1], vl_[5][2], vl_[5][3], vh_[5][0], vh_[5][1], vh_[5][2], vh_[5][3]}, o[1], 0, 0, 0); C0[5] = ex2(C0[5]); C0[6] = ex2(C0[6]); C0[7] = ex2(C0[7]); C0[8] = ex2(C0[8]); C0[9] = ex2(C0[9]); MLA_PIN(C0); MLA_PIN(C1); __builtin_amdgcn_sched_barrier(0); \
        o[0] = __builtin_amdgcn_mfma_f32_32x32x16_bf16(__builtin_bit_cast(bf16x8, pw_[2]), (bf16x8){vl_[2][0], vl_[2][1], vl_[2][2], vl_[2][3], vh_[2][0], vh_[2][1], vh_[2][2], vh_[2][3]}, o[0], 0, 0, 0); C0[10] = ex2(C0[10]); C0[11] = ex2(C0[11]); C0[12] = ex2(C0[12]); C0[13] = ex2(C0[13]); C0[14] = ex2(C0[14]); MLA_PIN(C0); MLA_PIN(C1); __builtin_amdgcn_sched_barrier(0); \
        o[1] = __builtin_amdgcn_mfma_f32_32x32x16_bf16(__builtin_bit_cast(bf16x8, pw_[2]), (bf16x8){vl_[6][0], vl_[6][1], vl_[6][2], vl_[6][3], vh_[6][0], vh_[6][1], vh_[6][2], vh_[6][3]}, o[1], 0, 0, 0); C0[15] = ex2(C0[15]); C1[0] = ex2(C1[0]); C1[1] = ex2(C1[1]); C1[2] = ex2(C1[2]); C1[3] = ex2(C1[3]); MLA_PIN(C0); MLA_PIN(C1); __builtin_amdgcn_sched_barrier(0); \
        o[0] = __builtin_amdgcn_mfma_f32_32x32x16_bf16(__builtin_bit_cast(bf16x8, pw_[3]), (bf16x8){vl_[3][0], vl_[3][1], vl_[3][2], vl_[3][3], vh_[3][0], vh_[3][1], vh_[3][2], vh_[3][3]}, o[0], 0, 0, 0); C1[4] = ex2(C1[4]); C1[5] = ex2(C1[5]); C1[6] = ex2(C1[6]); C1[7] = ex2(C1[7]); C1[8] = ex2(C1[8]); MLA_PIN(C0); MLA_PIN(C1); __builtin_amdgcn_sched_barrier(0); \
        o[1] = __builtin_amdgcn_mfma_f32_32x32x16_bf16(__builtin_bit_cast(bf16x8, pw_[3]), (bf16x8){vl_[7][0], vl_[7][1], vl_[7][2], vl_[7][3], vh_[7][0], vh_[7][1], vh_[7][2], vh_[7][3]}, o[1], 0, 0, 0); C1[9] = ex2(C1[9]); C1[10] = ex2(C1[10]); C1[11] = ex2(C1[11]); C1[12] = ex2(C1[12]); C1[13] = ex2(C1[13]); MLA_PIN(C0); MLA_PIN(C1); __builtin_amdgcn_sched_barrier(0); \
        C1[14] = ex2(C1[14]); C1[15] = ex2(C1[15]); \
        if (resc_) { if (hi == 0) wsf[r32] = alpha_; WAVE_LDS_SYNC(); \
            _Pragma("unroll") for (int r = 0; r < 16; ++r) { const float a = wsf[crow(r, hi)]; o[0][r] *= a; o[1][r] *= a; } WAVE_LDS_SYNC(); } \
        { const int t_ = kc; kc = kn; kn = kf_; kf_ = t_; } { const int t_ = vc; vc = vn; vn = vf_; vf_ = t_; } } while (0)
    for (int t = 1; t + 1 < NT; t += 2) { MLA_STEP(pb0, pb1, pa0, pa1, t); MLA_STEP(pa0, pa1, pb0, pb1, t + 1); }
    MLA_STEP(pb0, pb1, pa0, pa1, NT - 1);
    { float s_ = 0.f;
#pragma unroll
      for (int r = 0; r < 16; ++r) s_ += pb0[r] + pb1[r];
      lsum += s_; ATT_WAITV_BAR(); pv_tile(o, vfr + vc * VSLOT, pb0, pb1); }
#undef MLA_STEP
#undef MLA_KLD
#undef MLA_VLD
#undef MLA_PIN
#undef MLA_ROWMAX
#undef MLA_MASK
#undef MLA_DMA_K
#undef MLA_DMA_V
    lsum = hsum(lsum);
    if (hi == 0) wsf[32 + r32] = __builtin_amdgcn_rcpf(lsum);
    stage_o(o, stg, wsf + 32, r32, hi);
    bf16* Ow = OC + (rowbase + q0 + wid * 32) * 1024 + h * 64;
#pragma unroll
    for (int i = 0; i < 4; ++i) { const int row = i * 8 + (lane >> 3), ch = lane & 7; const u32x4 v = *(const LAS u32x4*)(stg + row * 64 + ch * 8); *(u32x4*)(Ow + (long)row * 1024 + ch * 8) = v; }
    ATT_BAR();
}

constexpr int SB_KSLOT = 8192, SB_OFF_V = 2 * SB_KSLOT, SB_OFF_WS = SB_OFF_V + 2 * VSLOT, SB_OFF_ST = SB_OFF_WS + 8 * 256, SB_OFF_FL = SB_OFF_ST + 8 * 4096, SB_LDS = SB_OFF_FL + 64;
DI void sb_unit(int bh, int qb, const bf16* Q, const bf16* K, const bf16* V, bf16* OC, LAS unsigned char* lds) {
    int tid_ = threadIdx.x; asm volatile("" : "+v"(tid_));
    const int tid = tid_, lane = tid & 63, r32 = lane & 31, hi = lane >> 5, wid = rfl(tid >> 6);
    const int b = bh >> 3, h = bh & 7; const long rowbase = (long)b * SEQ; const int q0 = qb * 256;
    const unsigned lds0 = (unsigned)(size_t)lds;
    LAS bf16* stg = (LAS bf16*)(lds + SB_OFF_ST) + wid * 2048;
    volatile LAS unsigned* fl = (volatile LAS unsigned*)(lds + SB_OFF_FL);
    const bf16* ksrc = K + (rowbase + lane) * 512 + h * 64 + wid * 8;
    const bf16* vsrc = V + (rowbase + 16 * (wid & 3) + (lane >> 2)) * 512 + h * 64 + (wid >> 2) * 32 + (lane & 3) * 8;
#define SB_DMA(t, s) do { glds16(ksrc + (long)(t) * 64 * 512, (unsigned)rfl((int)(lds0 + (s) * SB_KSLOT + wid * 1024))); \
        glds16(vsrc + (long)(t) * 64 * 512, (unsigned)rfl((int)(lds0 + SB_OFF_V + (s) * VSLOT + wid * 1024))); } while (0)
    const bf16* qp = Q + (rowbase + q0 + wid * 32 + r32) * 512 + h * 64 + hi * 8;
    bf16x8 qr[4];
#pragma unroll
    for (int d0 = 0; d0 < 4; ++d0) qr[d0] = *(const bf16x8*)(qp + d0 * 16);
    const int NT = 4 * (qb + 1);
    const lcp kfr = (lcp)lds + hi * 1024 + r32 * 16;
    const lcp vfr = (lcp)lds + SB_OFF_V + ((lane >> 4) & 1) * 32 + (lane & 3) * 8 + (4 * hi + ((lane & 15) >> 2)) * 64;
    float carry = 1.f; f32x16 o[2];
#pragma unroll
    for (int r = 0; r < 16; ++r) { o[0][r] = 0.f; o[1][r] = 0.f; }
    if (tid == 0) { fl[0] = 0u; fl[1] = 0u; fl[2] = 0u; }
    SB_DMA(NT - 1, 0);
    for (int i = 0; i < NT; ++i) {
        const int t = NT - 1 - i;
        ATT_WAITV_BAR();
        if (i > 0 && fl[(i - 1) % 3] == 0u) break;
        if (tid == 0) fl[(i + 1) % 3] = 0u;
        const int s = i & 1;
        if (t > 0) SB_DMA(t - 1, s ^ 1);
        const int jb = t - (NT - 4), qlo = 32 * wid;
        const bool skip = (jb >= 0 && 64 * jb >= qlo + 31);
        const bool dead = __all(carry == 0.f) != 0;
        if (!skip && !dead) {
            f32x16 p0, p1; qk_tile<4>(p0, p1, kfr + s * SB_KSLOT, qr);
            f32x16 f0, f1;
#pragma unroll
            for (int r = 0; r < 16; ++r) {
                { const float y = p0[r], e = ex2(-fabsf(y)), rr = __builtin_amdgcn_rcpf(1.f + e), er = e * rr; const bool pos = y >= 0.f; p0[r] = pos ? rr : er; f0[r] = pos ? er : rr; }
                { const float y = p1[r], e = ex2(-fabsf(y)), rr = __builtin_amdgcn_rcpf(1.f + e), er = e * rr; const bool pos = y >= 0.f; p1[r] = pos ? rr : er; f1[r] = pos ? er : rr; }
            }
            if (jb >= 0 && 64 * jb + 63 >= qlo) { const int qrel = qlo + r32;
#pragma unroll
                for (int r = 0; r < 16; ++r) { const int kv = 64 * jb + crow(r, hi);
                    if (kv >= qrel) { f0[r] = 1.f; p0[r] = 0.f; } if (kv + 32 >= qrel) { f1[r] = 1.f; p1[r] = 0.f; } } }
            float mine[8], oth[8], ps[8];
#pragma unroll
            for (int g = 0; g < 4; ++g) {
                { const float a0 = f0[4 * g], a1 = f0[4 * g + 1], a2 = f0[4 * g + 2], a3 = f0[4 * g + 3]; const float e1 = a3 * a2, e0 = e1 * a1;
                  f0[4 * g + 3] = 1.f; f0[4 * g + 2] = a3; f0[4 * g + 1] = e1; f0[4 * g] = e0; mine[g] = e0 * a0; }
                { const float a0 = f1[4 * g], a1 = f1[4 * g + 1], a2 = f1[4 * g + 2], a3 = f1[4 * g + 3]; const float e1 = a3 * a2, e0 = e1 * a1;
                  f1[4 * g + 3] = 1.f; f1[4 * g + 2] = a3; f1[4 * g + 1] = e1; f1[4 * g] = e0; mine[4 + g] = e0 * a0; }
            }
#pragma unroll
            for (int g = 0; g < 8; ++g) { auto rr = __builtin_amdgcn_permlane32_swap(__float_as_uint(mine[g]), __float_as_uint(mine[g]), false, false);
                const float x0 = __uint_as_float(rr[0]), x1 = __uint_as_float(rr[1]); oth[g] = hi ? x0 : x1; ps[g] = x0 * x1; }
            float sp = 1.f; float off[8];
#pragma unroll
            for (int g = 7; g >= 0; --g) { off[g] = sp * (hi ? 1.f : oth[g]) * carry; sp *= ps[g]; }
#pragma unroll
            for (int g = 0; g < 4; ++g)
#pragma unroll
                for (int j = 0; j < 4; ++j) { p0[4 * g + j] = p0[4 * g + j] * f0[4 * g + j] * off[g]; p1[4 * g + j] = p1[4 * g + j] * f1[4 * g + j] * off[4 + g]; }
            carry *= sp;
            pv_tile(o, vfr + s * VSLOT, p0, p1);
        }
        if (t > 0 && __any(carry != 0.f) && lane == 0) fl[i % 3] = 1u;
    }
#undef SB_DMA
    ATT_WAITV_BAR();
    stage_o(o, stg, nullptr, r32, hi);
    bf16* Ow = OC + (rowbase + q0 + wid * 32) * 1024 + 512 + h * 64;
#pragma unroll
    for (int i = 0; i < 4; ++i) { const int row = i * 8 + (lane >> 3), ch = lane & 7; const u32x4 v = *(const LAS u32x4*)(stg + row * 64 + ch * 8); *(u32x4*)(Ow + (long)row * 1024 + ch * 8) = v; }
    ATT_BAR();
}

constexpr int MB_NB = SEQ / 256;
constexpr int MB_OFF_K = 0, MB_OFF_V = 32768, MB_OFF_WS = 65536, MB_OFF_ST = MB_OFF_WS + 8 * 256, MB_OFF_TAB = MB_OFF_ST + 8 * 4096, MB_OFF_RING = MB_OFF_TAB + 512,
              MB_OFF_WC = MB_OFF_RING + 32768, MB_OFF_Q = MB_OFF_WC + 64, MB_LDS = MB_OFF_Q + 64;
DI int t5_bucket(int d) { if (d < 16) return d; const int l = 16 + (int)(__logf((float)d * (1.f / 16.f)) * (16.f / 2.0794415416798357f)); return l < 31 ? l : 31; }
DI void mb_load_kv(const bf16* K2, const bf16* V2, long row0, int h, unsigned lds0, int lane, int wid) {
    const bf16* ksrc = K2 + (row0 + lane) * 1024 + h * 64 + wid * 8;
    const bf16* vsrc = V2 + (row0 + 16 * (wid & 3) + (lane >> 2)) * 1024 + h * 64 + (wid >> 2) * 32 + (lane & 3) * 8;
#pragma unroll
    for (int t = 0; t < 4; ++t) { glds16(ksrc + (long)t * 64 * 1024, (unsigned)rfl((int)(lds0 + MB_OFF_K + t * 8192 + wid * 1024)));
        glds16(vsrc + (long)t * 64 * 1024, (unsigned)rfl((int)(lds0 + MB_OFF_V + t * 8192 + wid * 1024))); }
}
DI void mb_fill_tab(const float* rel_bias, int h, LAS float* tab, int tid) { if (tid < 128) tab[tid] = rel_bias[h * 32 + t5_bucket(tid)] * LOG2E; }

DI void top3_ins(float v, unsigned i, float& v0, unsigned& i0, float& v1, unsigned& i1, float& v2, unsigned& i2) {
    const bool b0 = v > v0 || (v == v0 && i < i0), b1 = v > v1 || (v == v1 && i < i1), b2 = v > v2 || (v == v2 && i < i2);
    const float n2 = b1 ? v1 : (b2 ? v : v2); const unsigned m2 = b1 ? i1 : (b2 ? i : i2);
    const float n1 = b0 ? v0 : (b1 ? v : v1); const unsigned m1 = b0 ? i0 : (b1 ? i : i1);
    const float n0 = b0 ? v : v0; const unsigned m0 = b0 ? i : i0;
    v0 = n0; i0 = m0; v1 = n1; i1 = m1; v2 = n2; i2 = m2;
}
DI void moba_gate_unit(int bh, int g, const bf16* Q2, const float* KMP, unsigned* SEL, unsigned* MASK32, LAS unsigned char* lds) {
    using namespace att;
    int tid_ = threadIdx.x; asm volatile("" : "+v"(tid_));
    const int tid = tid_, lane = tid & 63, r32 = lane & 31, hi = lane >> 5, wid = rfl(tid >> 6);
    const int b = bh >> 4, h = bh & 15;
    LAS bf16* khi = (LAS bf16*)lds; LAS bf16* klo = (LAS bf16*)(lds + 8192);
#pragma unroll
    for (int i = tid; i < 4096; i += 512) { const int n = i >> 6, d = i & 63; const size_t src = (size_t)(b * MB_NB + n) * 1024 + h * 64 + d;
        const float v = (KMP[src] + KMP[(size_t)(T / 256) * 1024 + src]) * (1.f / 256.f);
        const unsigned ph = cvtpk(v, 0.f) & 0xffffu; const float rem = v - __uint_as_float(ph << 16); const unsigned pl = cvtpk(rem, 0.f) & 0xffffu;
        const int off = (d >> 3) * 512 + n * 8 + (d & 7); khi[off] = (bf16)ph; klo[off] = (bf16)pl; }
    const bf16* qbase = Q2 + ((long)b * SEQ + wid * 32 + r32) * 1024 + h * 64 + hi * 8;
    bf16x8 qn[4];
#pragma unroll
    for (int d0 = 0; d0 < 4; ++d0) qn[d0] = *(const bf16x8*)(qbase + (long)g * 256 * 1024 + d0 * 16);
    __syncthreads();
    const lcp kfr = (lcp)lds + hi * 1024 + r32 * 16;
#pragma unroll 1
    for (int j = 0; j < 8; ++j) {
        const int qb = g + 8 * j;
        bf16x8 qr[4] = {qn[0], qn[1], qn[2], qn[3]};
        if (j < 7) {
#pragma unroll
            for (int d0 = 0; d0 < 4; ++d0) qn[d0] = *(const bf16x8*)(qbase + (long)(qb + 8) * 256 * 1024 + d0 * 16); }
        f32x16 p0, p1, q0, q1; qk_tile<4>(p0, p1, kfr, qr); qk_tile<4>(q0, q1, kfr + 8192, qr);
        float v0 = -INFINITY, v1 = -INFINITY, v2 = -INFINITY; unsigned i0 = 0xFFu, i1 = 0xFFu, i2 = 0xFFu;
#pragma unroll
        for (int r = 0; r < 16; ++r) { const unsigned n = (unsigned)crow(r, hi); const bool in = (int)n < qb;
            top3_ins(in ? p0[r] + q0[r] : -INFINITY, in ? n : 0xFFu, v0, i0, v1, i1, v2, i2); }
        if (qb > 32) {
#pragma unroll
            for (int r = 0; r < 16; ++r) { const unsigned n = 32u + (unsigned)crow(r, hi); const bool in = (int)n < qb;
                top3_ins(in ? p1[r] + q1[r] : -INFINITY, in ? n : 0xFFu, v0, i0, v1, i1, v2, i2); } }
        { float pa, pb, pc; unsigned qa, qb_, qc;
#define MB_SWAPF(dst, src) do { auto rr_ = __builtin_amdgcn_permlane32_swap(__float_as_uint(src), __float_as_uint(src), false, false); dst = __uint_as_float(hi ? rr_[0] : rr_[1]); } while (0)
#define MB_SWAPU(dst, src) do { auto rr_ = __builtin_amdgcn_permlane32_swap(src, src, false, false); dst = hi ? rr_[0] : rr_[1]; } while (0)
          MB_SWAPF(pa, v0); MB_SWAPF(pb, v1); MB_SWAPF(pc, v2); MB_SWAPU(qa, i0); MB_SWAPU(qb_, i1); MB_SWAPU(qc, i2);
#undef MB_SWAPF
#undef MB_SWAPU
          top3_ins(pa, qa, v0, i0, v1, i1, v2, i2); top3_ins(pb, qb_, v0, i0, v1, i1, v2, i2); top3_ins(pc, qc, v0, i0, v1, i1, v2, i2); }
        if (hi == 0) SEL[(size_t)bh * SEQ + qb * 256 + wid * 32 + r32] = i0 | (i1 << 8) | (i2 << 16);
        for (int n = 0; n < qb; ++n) { const unsigned m0 = (unsigned)__ballot(i0 == (unsigned)n), m1 = (unsigned)__ballot(i1 == (unsigned)n), m2 = (unsigned)__ballot(i2 == (unsigned)n);
            if (lane == 0) { unsigned* dst = MASK32 + ((((size_t)bh * 64 + n) * 64 + qb) * 3) * 8 + wid; dst[0] = m0; dst[8] = m1; dst[16] = m2; } }
    }
    __syncthreads();
}

DI void moba_sel_unit(int bh, int n, const bf16* Q2, const bf16* K2, const bf16* V2, const unsigned long long* MASK, const float* rel_bias, bf16* PO0, bf16* PO1, bf16* PO2, bf16* PO3, float2* PMS, LAS unsigned char* lds) {
    using namespace att;
    int tid_ = threadIdx.x; asm volatile("" : "+v"(tid_));
    const int tid = tid_, lane = tid & 63, r32 = lane & 31, hi = lane >> 5, wid = rfl(tid >> 6);
    const int b = bh >> 4, h = bh & 15; const unsigned lds0 = (unsigned)(size_t)lds;
    mb_load_kv(K2, V2, (long)b * SEQ + n * 256, h, lds0, lane, wid);
    mb_fill_tab(rel_bias, h, (LAS float*)(lds + MB_OFF_TAB), tid);
    LAS unsigned short* list = (LAS unsigned short*)(lds + MB_OFF_RING);
    volatile LAS unsigned* wc = (volatile LAS unsigned*)(lds + MB_OFF_WC);
    bf16x8 qo[4];
    { const bf16* qp = Q2 + ((long)b * SEQ + n * 256 + wid * 32 + r32) * 1024 + h * 64 + hi * 8;
#pragma unroll
      for (int d0 = 0; d0 < 4; ++d0) qo[d0] = *(const bf16x8*)(qp + d0 * 16); }
    const unsigned* mw = (const unsigned*)(MASK + (((size_t)bh * 64 + n) * 64 + (n + 1)) * 12);
    const int nwords = (63 - n) * 24;
    unsigned w[3]; unsigned c = 0;
#pragma unroll
    for (int i = 0; i < 3; ++i) { const int j = tid + 512 * i; w[i] = j < nwords ? mw[j] : 0u; c += (unsigned)__popc(w[i]); }
    unsigned inc = c;
#pragma unroll
    for (int o = 1; o < 64; o <<= 1) { const unsigned t = __shfl_up(inc, o); if (lane >= o) inc += t; }
    if (lane == 63) wc[wid] = inc;
    ATT_WAITV_BAR();
    unsigned base = inc - c, total = 0;
#pragma unroll
    for (int i = 0; i < 8; ++i) { const unsigned x = wc[i]; total += x; if (i < wid) base += x; }
#pragma unroll
    for (int i = 0; i < 3; ++i) { const int j = tid + 512 * i; const int qb = n + 1 + j / 24, rem = j % 24, k = rem >> 3, s0 = qb * 256 + (rem & 7) * 32; unsigned ww = w[i];
        while (ww) { const int bit = __ffs(ww) - 1; ww &= ww - 1u; list[base++] = (unsigned short)(((unsigned)(s0 + bit) << 2) | (unsigned)k); } }
    ATT_BAR();
    const int nchunk = ((int)total + 255) >> 8;
    LAS float* wsf = (LAS float*)(lds + MB_OFF_WS) + wid * 64;
    LAS bf16* stg = (LAS bf16*)(lds + MB_OFF_ST) + wid * 2048;
    const LAS float* tab = (const LAS float*)(lds + MB_OFF_TAB);
    const lcp kfr = (lcp)lds + MB_OFF_K + hi * 1024 + r32 * 16;
    const lcp vfr = (lcp)lds + MB_OFF_V + ((lane >> 4) & 1) * 32 + (lane & 3) * 8 + (4 * hi + ((lane & 15) >> 2)) * 64;
    const int nchunk_ = ((int)total + 255) >> 8;
    const bf16* qbase = Q2 + (long)b * SEQ * 1024 + h * 64 + hi * 8;
    const int kend = n * 256 + 255;
    bf16x8 qn[4]; unsigned en = 0; bool vn = false;
#define MB_QLOAD(cc) do { const int idx_ = (cc) * 256 + 32 * wid + r32; vn = idx_ < (int)total; en = vn ? (unsigned)list[idx_] : 0u; const bf16* qp_ = qbase + (long)(en >> 2) * 1024; \
        _Pragma("unroll") for (int d0 = 0; d0 < 4; ++d0) { bf16x8 z_; _Pragma("unroll") for (int j_ = 0; j_ < 8; ++j_) z_[j_] = 0; qn[d0] = vn ? *(const bf16x8*)(qp_ + d0 * 16) : z_; } } while (0)
    if (nchunk_ > 0) MB_QLOAD(0);
    { float mref = -INFINITY, lsum = 0.f; f32x16 o[2];
#pragma unroll
      for (int r = 0; r < 16; ++r) { o[0][r] = 0.f; o[1][r] = 0.f; }
      const int qrel = 32 * wid + r32, tlast = wid >> 1;
#pragma unroll 1
      for (int t = 0; t <= tlast; ++t) {
          f32x16 p0, p1; qk_tile<4>(p0, p1, kfr + t * 8192, qo);
          const int dbase = qrel - 64 * t;
#pragma unroll
          for (int r = 0; r < 16; ++r) { const int d0 = dbase - crow(r, hi), d1 = d0 - 32;
              const int c0 = d0 > 127 ? 127 : (d0 < 0 ? 0 : d0), c1 = d1 > 127 ? 127 : (d1 < 0 ? 0 : d1);
              p0[r] = d0 < 0 ? -INFINITY : p0[r] + tab[c0]; p1[r] = d1 < 0 ? -INFINITY : p1[r] + tab[c1]; }
          smax_update(p0, p1, mref, lsum, o, wsf, r32, hi);
          pv_tile(o, vfr + t * 8192, p0, p1);
      }
      lsum = hsum(lsum);
      const int sq = n * 256 + qrel;
      if (hi == 0) PMS[((size_t)(3 * 32 + bh)) * SEQ + sq] = make_float2(mref, lsum);
      stage_o(o, stg, nullptr, r32, hi);
#pragma unroll
      for (int i = 0; i < 4; ++i) { const int row = i * 8 + (lane >> 3), ch = lane & 7;
          const u32x4 v = *(const LAS u32x4*)(stg + row * 64 + ch * 8); __builtin_nontemporal_store(v, (u32x4*)(PO3 + ((size_t)bh * SEQ + (n * 256 + 32 * wid + row)) * 64 + ch * 8)); }
      WAVE_LDS_SYNC(); }
#if defined(PROBE_DUP) && ((PROBE_DUP >> 19) & 1)
    for (int prb_ = 0; prb_ < 2; ++prb_) {
#else
    {
#endif
#if defined(PROBE_DUP) && ((PROBE_DUP >> 19) & 1)
    if (prb_ > 0 && nchunk > 0) MB_QLOAD(0);
#endif
    if (wid >= 4) __builtin_amdgcn_s_sleep(10);
#pragma unroll 1
    for (int cc = 0; cc < nchunk; ++cc) {
        const int cnt = ((int)total - cc * 256) < 256 ? ((int)total - cc * 256) : 256;
        bf16x8 qr[4] = {qn[0], qn[1], qn[2], qn[3]}; const unsigned e = en; const bool valid = vn;
        if (cc + 1 < nchunk) MB_QLOAD(cc + 1);
        if (32 * wid >= cnt) continue;
        const bool far = __all(!valid || ((int)(e >> 2) - kend >= 113)) != 0;
        float mref = 0.f, lsum = 0.f; f32x16 o[2], negm;
#pragma unroll
        for (int r = 0; r < 16; ++r) { o[0][r] = 0.f; o[1][r] = 0.f; negm[r] = 0.f; }
#pragma unroll 1
        for (int t = 0; t < 4; ++t) {
            f32x16 p0, p1; qk_tile_ref<4>(p0, p1, kfr + t * 8192, qr, negm);
            if (!far) { const int dbase = (int)(e >> 2) - (n * 256 + 64 * t);
#pragma unroll
                for (int r = 0; r < 16; ++r) { int d0 = dbase - crow(r, hi), d1 = d0 - 32; d0 = d0 > 127 ? 127 : (d0 < 0 ? 0 : d0); d1 = d1 > 127 ? 127 : (d1 < 0 ? 0 : d1); p0[r] += tab[d0]; p1[r] += tab[d1]; } }
            smax_update_ref(p0, p1, mref, negm, lsum, o, wsf, r32, hi, t == 0);
            pv_tile(o, vfr + t * 8192, p0, p1);
        }
        lsum = hsum(lsum);
        if (far) mref += tab[127];
        if (valid && hi == 0) { unsigned e_ = e; asm volatile("" : "+v"(e_)); PMS[((size_t)((int)(e_ & 3u) * 32 + bh)) * SEQ + (int)(e_ >> 2)] = make_float2(mref, lsum); }
        stage_o(o, stg, nullptr, r32, hi);
#pragma unroll
        for (int i = 0; i < 4; ++i) { const int row = i * 8 + (lane >> 3), ch = lane & 7; const int ridx = 32 * wid + row;
            if (ridx < cnt) { const unsigned e2 = list[cc * 256 + ridx]; const int s2 = (int)(e2 >> 2), k2 = (int)(e2 & 3u);
                const u32x4 v = *(const LAS u32x4*)(stg + row * 64 + ch * 8); bf16* pob = k2 == 0 ? PO0 : (k2 == 1 ? PO1 : PO2); __builtin_nontemporal_store(v, (u32x4*)(pob + ((size_t)bh * SEQ + s2) * 64 + ch * 8)); } }
        WAVE_LDS_SYNC();
    }
    }
#undef MB_QLOAD
    ATT_BAR();
}

DI void moba_merge(int gw, int ngw, const unsigned* SEL, const bf16* PO0, const bf16* PO1, const bf16* PO2, const bf16* PO3, const float2* PMS, bf16* O2) {
    using namespace att;
    int tid_ = threadIdx.x; asm volatile("" : "+v"(tid_));
    const int lane = tid_ & 63, sub = lane >> 3, ch = lane & 7;
    const int NST = 32 * (SEQ / 8);
    unsigned nsel = 0u; float2 nms[4]; u32x4 npv[4];
#define MB_MLOAD(st) do { const int bh_ = (st) / (SEQ / 8), s_ = ((st) % (SEQ / 8)) * 8 + sub; const size_t it_ = (size_t)bh_ * SEQ + s_; nsel = SEL[it_]; \
        _Pragma("unroll") for (int k = 0; k < 4; ++k) { nms[k] = PMS[(size_t)k * 32 * SEQ + it_]; const bf16* pob = k == 0 ? PO0 : (k == 1 ? PO1 : (k == 2 ? PO2 : PO3)); npv[k] = __builtin_nontemporal_load((const u32x4*)(pob + it_ * 64 + ch * 8)); } } while (0)
    if (gw < NST) MB_MLOAD(gw);
    for (int st = gw; st < NST; st += ngw) {
        const int bh = st / (SEQ / 8), s = (st % (SEQ / 8)) * 8 + sub;
        const unsigned sel = nsel; float2 ms[4] = {nms[0], nms[1], nms[2], nms[3]}; u32x4 pv[4] = {npv[0], npv[1], npv[2], npv[3]};
        if (st + ngw < NST) MB_MLOAD(st + ngw);
        float mall = ms[3].x;
#pragma unroll
        for (int k = 0; k < 3; ++k) { const bool ok = ((sel >> (8 * k)) & 0xFFu) != 0xFFu; if (!ok) { ms[k].x = -INFINITY; ms[k].y = 0.f; pv[k] = (u32x4){0u, 0u, 0u, 0u}; } mall = fmaxf(mall, ms[k].x); }
        float den = 0.f, acc[8] = {0.f, 0.f, 0.f, 0.f, 0.f, 0.f, 0.f, 0.f};
#pragma unroll
        for (int k = 0; k < 4; ++k) { const float w = ex2(ms[k].x - mall); den += w * ms[k].y; const u32x4 v = pv[k];
            acc[0] += w * bflo(v.x); acc[1] += w * bfhi(v.x); acc[2] += w * bflo(v.y); acc[3] += w * bfhi(v.y); acc[4] += w * bflo(v.z); acc[5] += w * bfhi(v.z); acc[6] += w * bflo(v.w); acc[7] += w * bfhi(v.w); }
        const float rd = __builtin_amdgcn_rcpf(den);
        const u32x4 ov = (u32x4){cvtpk(acc[0] * rd, acc[1] * rd), cvtpk(acc[2] * rd, acc[3] * rd), cvtpk(acc[4] * rd, acc[5] * rd), cvtpk(acc[6] * rd, acc[7] * rd)};
        *(u32x4*)(O2 + ((size_t)(bh >> 4) * SEQ + s) * 1024 + (bh & 15) * 64 + ch * 8) = ov;
    }
#undef MB_MLOAD
}
}

constexpr size_t MiB = 1u << 20;
constexpr int NSLOT = 2 * T + 8 * 256;
constexpr size_t WS_CTL = 0, CTL_ZERO_BYTES = 64 * 1024;
constexpr size_t WS_RSTD0 = 1 * MiB, WS_TOKW = WS_RSTD0 + 128 * 1024, WS_TOKR = WS_TOKW + 256 * 1024, WS_TOKE = WS_TOKR + 128 * 1024, WS_PRANK = WS_TOKE + 128 * 1024;
constexpr size_t WS_PQKV = 2 * MiB, WS_PS1 = 6 * MiB, WS_PS2 = 8 * MiB, WS_PS3 = 10 * MiB, WS_ROPE = 12 * MiB, WS_KMP = 14 * MiB;
constexpr size_t WS_SDST = 15 * MiB, WS_SW = WS_SDST + 272 * 1024, WS_SRS = WS_SW + 272 * 1024;
constexpr size_t WS_WRT = 16 * MiB, WS_CNT = WS_WRT + 64 * 1024, WS_TILEE = WS_CNT + 64 * 1024;
constexpr size_t WS_STOK = 17 * MiB;
constexpr size_t WS_SEL = 18 * MiB;
constexpr size_t WS_W = 20 * MiB;
constexpr size_t W_IN = WS_W, W_UQ = W_IN + (size_t)2304 * 1024 * 2, W_UKV = W_UQ + (size_t)768 * 384 * 2, W_O0 = W_UKV + (size_t)1024 * 256 * 2, W_GU0 = W_O0 + (size_t)1024 * 1024 * 2,
                 W_DN0 = W_GU0 + (size_t)4096 * 1024 * 2, W_QKV = W_DN0 + (size_t)1024 * 2048 * 2, W_O1 = W_QKV + (size_t)3072 * 1024 * 2, W_EGU = W_O1 + (size_t)1024 * 1024 * 2,
                 W_EDN = W_EGU + (size_t)8192 * 1024 * 2, W_END = W_EDN + (size_t)8192 * 512 * 2;
static_assert(W_END <= 76 * MiB, "weights region");
constexpr size_t WS_XB = 76 * MiB, WS_OCAT = 76 * MiB, WS_SBQ = 140 * MiB, WS_SBK = 172 * MiB, WS_SBV = 204 * MiB, WS_CQ = 236 * MiB, WS_CKV = 260 * MiB, WS_KR = 276 * MiB,
                 WS_QA = 278 * MiB, WS_KN = 326 * MiB, WS_VA = 358 * MiB, WS_X1B = 390 * MiB, WS_HID = 76 * MiB;
constexpr size_t WS_Q2 = 204 * MiB, WS_K2 = 268 * MiB, WS_V2 = 332 * MiB, WS_PO0 = 76 * MiB, WS_PO1 = 140 * MiB, WS_PO2 = 396 * MiB, WS_PMS = 460 * MiB;
constexpr size_t WS_X3B = 268 * MiB, WS_XPERM = 332 * MiB, WS_YP = 332 * MiB, WS_HIDE = 76 * MiB;
constexpr size_t WS_MASK = 476 * MiB;
constexpr size_t WS_NEED = 489 * MiB;
static_assert(WS_SBK == WS_SBQ + 32 * MiB && WS_SBV == WS_SBQ + 64 * MiB && WS_VA == WS_KN + 32 * MiB && WS_K2 == WS_Q2 + 64 * MiB && WS_V2 == WS_Q2 + 128 * MiB, "epilogue pointer arithmetic");
static_assert(WS_XPERM + (size_t)NSLOT * 2048 <= 464 * MiB && WS_HIDE + (size_t)NSLOT * 1024 <= 204 * MiB && WS_SRS + 272 * 1024 <= 16 * MiB && NSLOT * 4 <= 272 * 1024, "ws map");
constexpr int CW_BAR = 4096, CW_QUEUE = 8192, CW_NRT = 8256;
static_assert((8320 + 64) * 4 <= (int)CTL_ZERO_BYTES && CW_BAR + 3456 <= CW_QUEUE, "control words inside the zeroed region");
constexpr int RING_BYTES = 131072, LDS_BYTES = 147456, MISC_OFF = LDS_BYTES - 256, PHASE_LDS = LDS_BYTES - 512;
static_assert(att::MLA_LDS <= PHASE_LDS && att::SB_LDS <= PHASE_LDS && att::MB_LDS <= PHASE_LDS && RING_BYTES <= PHASE_LDS, "phase LDS");

#define XB_TMO      128
#define XB_XCNT(j)  (256  + 64 * (j))
#define XB_XSUB(j)  (1280 + 64 * (j))
#define XB_XGEN(j)  (2304 + 64 * (j))
#define XB_TOP      3328
#define XB_TOPGEN   3392
#define XCD_BAR_WORDS 3456
#define XB_SPIN_CAP (1u << 18)
__device__ __forceinline__ unsigned xb_ld(unsigned* p)              { return __hip_atomic_load(p, __ATOMIC_RELAXED, __HIP_MEMORY_SCOPE_AGENT); }
__device__ __forceinline__ unsigned xb_add(unsigned* p, unsigned v) { return __hip_atomic_fetch_add(p, v, __ATOMIC_RELAXED, __HIP_MEMORY_SCOPE_AGENT); }
__device__ __forceinline__ unsigned xb_xcc_id() { return (unsigned)__builtin_amdgcn_s_getreg((3 << 11) | 20) & 0xFu; }
#define XB_SPIN(cond, bar) do { unsigned _sp = 0; while (cond) { __builtin_amdgcn_s_sleep(1); \
    if ((++_sp & 255u) == 0u) { if (xb_ld(&(bar)[XB_TMO])) break; if (_sp > XB_SPIN_CAP) { atomicAdd(&(bar)[XB_TMO], 1u); break; } } } } while (0)
struct XcdBarrier { unsigned* bar; unsigned x; volatile LAS unsigned* st; };
__device__ __forceinline__ XcdBarrier xcd_barrier_post(unsigned* bar, volatile LAS unsigned* st) {
    XcdBarrier b; b.bar = bar; b.x = xb_xcc_id(); b.st = st;
    if (threadIdx.x == 0) (void)xb_add(&bar[XB_XCNT(b.x)], 1u);
    return b;
}
__device__ __forceinline__ void xcd_barrier_complete(unsigned* bar, unsigned x, unsigned& nloc, unsigned& nx) {
    const unsigned G = gridDim.x * gridDim.y * gridDim.z;
    unsigned sum, cnt, mine, sp = 0u;
    for (;;) {
        sum = 0u; cnt = 0u; mine = 0u;
#pragma unroll
        for (unsigned j = 0; j < 16; ++j) { const unsigned c = xb_ld(&bar[XB_XCNT(j)]); sum += c; cnt += (c > 0u) ? 1u : 0u; mine = (j == x) ? c : mine; }
        if (sum == G) break;
        __builtin_amdgcn_s_sleep(1);
        if ((++sp & 255u) == 0u) { if (xb_ld(&bar[XB_TMO])) break; if (sp > XB_SPIN_CAP) { atomicAdd(&bar[XB_TMO], 1u); break; } }
    }
    nloc = mine > 0u ? mine : 1u; nx = cnt > 0u ? cnt : 1u;
}
__device__ __forceinline__ void xcd_barrier(const XcdBarrier& b) {
    asm volatile("s_waitcnt vmcnt(0)" ::: "memory");
    __syncthreads();
    if (threadIdx.x == 0) {
        unsigned* bar = b.bar;
        __builtin_amdgcn_s_waitcnt(0);
        unsigned nloc = b.st[0], nx = b.st[1];
        if (nloc == 0u) { xcd_barrier_complete(bar, b.x, nloc, nx); b.st[0] = nloc; b.st[1] = nx; }
        const unsigned old = xb_add(&bar[XB_XSUB(b.x)], 1u);
        const unsigned gen = old / nloc;
        if (old + 1u == (gen + 1u) * nloc) {
            __builtin_amdgcn_fence(__ATOMIC_RELEASE, "agent");
            asm volatile("s_waitcnt vmcnt(0)" ::: "memory");
            const unsigned og = xb_add(&bar[XB_TOP], 1u);
            const unsigned tg = og / nx;
            if (og + 1u == (tg + 1u) * nx) xb_add(&bar[XB_TOPGEN], 1u);
            else XB_SPIN(xb_ld(&bar[XB_TOPGEN]) == tg, bar);
            __builtin_amdgcn_fence(__ATOMIC_ACQUIRE, "agent");
            xb_add(&bar[XB_XGEN(b.x)], 1u);
            asm volatile("s_waitcnt vmcnt(0)" ::: "memory");
        } else {
            XB_SPIN(xb_ld(&bar[XB_XGEN(b.x)]) == gen, bar);
            __builtin_amdgcn_fence(__ATOMIC_ACQUIRE, "agent");
            asm volatile("s_waitcnt vmcnt(0)" ::: "memory");
        }
    }
    __syncthreads();
}

struct Args { const float* in[22]; float* out; unsigned char* ws; int ph_lo, ph_hi; };
enum { I_X = 0, I_EV_AN, I_EV_WIN, I_EV_QN, I_EV_WUQ, I_EV_KVN, I_EV_WUKV, I_EV_WO, I_EV_FN, I_EV_WG, I_EV_WU, I_EV_WD, I_OD_AN, I_OD_WQKV, I_OD_WO, I_OD_FN, I_OD_WR, I_OD_WG, I_OD_WU, I_OD_WD, I_RELB, I_FINN };
constexpr int NPH = 17;

constexpr float C_MLA = 0.10206207261596575f * LOG2E;
constexpr float C_64 = 0.125f * LOG2E;
DI int map_rope32(int p) { return 16 * ((p >> 2) & 1) + 4 * (p >> 3) + (p & 3); }
DI void cvt_item(const float* W, int ld, int col, float scale, const float* gain, int K, bf16* WT, int k0, LAS float* scr, int lane) {
    const int colc = col < 0 ? 0 : col; const float sc = col < 0 ? 0.f : scale;
    const float* wp = W + (size_t)(k0 + (lane >> 5)) * ld + colc;
    float v[32];
#pragma unroll
    for (int i = 0; i < 32; ++i) v[i] = __builtin_nontemporal_load(wp + (size_t)(2 * i) * ld);
    const int c = lane & 7;
    f32x4 g0 = (f32x4){1.f, 1.f, 1.f, 1.f}, g1 = g0;
    if (gain) { g0 = *(const f32x4*)(gain + k0 + 8 * c); g1 = *(const f32x4*)(gain + k0 + 8 * c + 4); }
#pragma unroll
    for (int i = 0; i < 32; ++i) scr[(2 * i + (lane >> 5)) * 33 + (lane & 31)] = v[i] * sc;
    asm volatile("s_waitcnt lgkmcnt(0)" ::: "memory");
#pragma unroll
    for (int j = 0; j < 4; ++j) { const int n = (lane >> 3) + 8 * j; const LAS float* s = scr + (8 * c) * 33 + n;
        v4u o; o.x = cvtpk(s[0 * 33] * g0[0], s[1 * 33] * g0[1]); o.y = cvtpk(s[2 * 33] * g0[2], s[3 * 33] * g0[3]); o.z = cvtpk(s[4 * 33] * g1[0], s[5 * 33] * g1[1]); o.w = cvtpk(s[6 * 33] * g1[2], s[7 * 33] * g1[3]);
        *(v4u*)(WT + (size_t)n * K + k0 + 8 * c) = o; }
    asm volatile("s_waitcnt lgkmcnt(0)" ::: "memory");
}
DI void p0_prologue(const Args& a, LAS unsigned char* lds, int vcu, int G) {
    int tid_ = threadIdx.x; asm volatile("" : "+v"(tid_)); const int tid = tid_, lane = tid & 63, wave = rfl(tid >> 6);
    LAS float* scr = (LAS float*)(lds + wave * 8704);
    const int gw = vcu * 8 + wave, NGW = G * 8;
    unsigned char* ws = a.ws;
    constexpr int J0 = 72 * 16, J1 = J0 + 24 * 6, J2 = J1 + 32 * 4, J3 = J2 + 32 * 16, J4 = J3 + 128 * 16, J5 = J4 + 32 * 32, J6 = J5 + 96 * 16, J7 = J6 + 32 * 16, J8 = J7 + 256 * 16, J9 = J8 + 256 * 8;
    for (int it = gw; it < J9; it += NGW) {
        const int ln = lane & 31;
        if (it < J0) { const int nb = it / 16, kb = it % 16, n = nb * 32 + ln; int col; float sc = 1.f;
            if (n < 1536) { col = 672 + n; if (n < 512) sc = C_64; } else if (n < 1920) col = n - 1536; else if (n < 2176) col = 384 + (n - 1920); else if (n < 2208) col = 640 + map_rope32(n - 2176); else col = -1;
            cvt_item(a.in[I_EV_WIN], 2208, col, sc, a.in[I_EV_AN], 1024, (bf16*)(ws + W_IN) + (size_t)nb * 32 * 1024, kb * 64, scr, lane); }
        else if (it < J1) { const int r = it - J0, nb = r / 6, kb = r % 6, n = nb * 32 + ln; const int col = (nb % 3 == 2) ? nb * 32 + map_rope32(ln) : n;
            cvt_item(a.in[I_EV_WUQ], 768, col, C_MLA, a.in[I_EV_QN], 384, (bf16*)(ws + W_UQ) + (size_t)nb * 32 * 384, kb * 64, scr, lane); }
        else if (it < J2) { const int r = it - J1, nb = r / 4, kb = r % 4, n = nb * 32 + ln; const int col = n < 512 ? (n >> 6) * 128 + (n & 63) : ((n - 512) >> 6) * 128 + 64 + ((n - 512) & 63);
            cvt_item(a.in[I_EV_WUKV], 1024, col, 1.f, a.in[I_EV_KVN], 256, (bf16*)(ws + W_UKV) + (size_t)nb * 32 * 256, kb * 64, scr, lane); }
        else if (it < J3) { const int r = it - J2, nb = r / 16, kb = r % 16;
            cvt_item(a.in[I_EV_WO], 1024, nb * 32 + ln, 1.f, nullptr, 1024, (bf16*)(ws + W_O0) + (size_t)nb * 32 * 1024, kb * 64, scr, lane); }
        else if (it < J4) { const int r = it - J3, nb = r / 16, kb = r % 16, n = nb * 32 + ln; const int tile = n >> 8, half = (n >> 7) & 1, col = tile * 128 + (n & 127);
            cvt_item(half ? a.in[I_EV_WU] : a.in[I_EV_WG], 2048, col, 1.f, a.in[I_EV_FN], 1024, (bf16*)(ws + W_GU0) + (size_t)nb * 32 * 1024, kb * 64, scr, lane); }
        else if (it < J5) { const int r = it - J4, nb = r / 32, kb = r % 32;
            cvt_item(a.in[I_EV_WD], 1024, nb * 32 + ln, 1.f, nullptr, 2048, (bf16*)(ws + W_DN0) + (size_t)nb * 32 * 2048, kb * 64, scr, lane); }
        else if (it < J6) { const int r = it - J5, nb = r / 16, kb = r % 16, n = nb * 32 + ln;
            cvt_item(a.in[I_OD_WQKV], 3072, n, n < 1024 ? C_64 : 1.f, a.in[I_OD_AN], 1024, (bf16*)(ws + W_QKV) + (size_t)nb * 32 * 1024, kb * 64, scr, lane); }
        else if (it < J7) { const int r = it - J6, nb = r / 16, kb = r % 16;
            cvt_item(a.in[I_OD_WO], 1024, nb * 32 + ln, 1.f, nullptr, 1024, (bf16*)(ws + W_O1) + (size_t)nb * 32 * 1024, kb * 64, scr, lane); }
        else if (it < J8) { const int r = it - J7, nb = r / 16, kb = r % 16, n = nb * 32 + ln; const int e = n >> 10, m = n & 1023, tile = m >> 8, half = (m >> 7) & 1, col = tile * 128 + (m & 127);
            cvt_item((half ? a.in[I_OD_WU] : a.in[I_OD_WG]) + (size_t)e * 1024 * 512, 512, col, 1.f, a.in[I_OD_FN], 1024, (bf16*)(ws + W_EGU) + (size_t)nb * 32 * 1024, kb * 64, scr, lane); }
        else { const int r = it - J8, nb = r / 8, kb = r % 8, n = nb * 32 + ln; const int e = n >> 10, m = n & 1023;
            cvt_item(a.in[I_OD_WD] + (size_t)e * 512 * 1024, 1024, m, 1.f, nullptr, 512, (bf16*)(ws + W_EDN) + (size_t)nb * 32 * 512, kb * 64, scr, lane); }
    }
    { const float* x = a.in[I_X]; bf16* XB = (bf16*)(ws + WS_XB); float* rs0 = (float*)(ws + WS_RSTD0);
      f32x4 nv[4];
      if (gw < T) { const f32x4* xr = (const f32x4*)(x + (size_t)gw * DM) + lane;
#pragma unroll
          for (int j = 0; j < 4; ++j) nv[j] = __builtin_nontemporal_load(xr + 64 * j); }
      for (int m = gw; m < T; m += NGW) { f32x4 v[4]; float s = 0.f;
#pragma unroll
          for (int j = 0; j < 4; ++j) v[j] = nv[j];
          if (m + NGW < T) { const f32x4* xr = (const f32x4*)(x + (size_t)(m + NGW) * DM) + lane;
#pragma unroll
              for (int j = 0; j < 4; ++j) nv[j] = __builtin_nontemporal_load(xr + 64 * j); }
#pragma unroll
          for (int j = 0; j < 4; ++j) s += (v[j].x * v[j].x + v[j].y * v[j].y) + (v[j].z * v[j].z + v[j].w * v[j].w);
          s = wave_sum(s); if (lane == 0) rs0[m] = rsqrtf(s * (1.f / DM) + RMS_EPS);
          unsigned long long* o8 = (unsigned long long*)(XB + (size_t)m * DM) + lane;
#pragma unroll
          for (int j = 0; j < 4; ++j) o8[64 * j] = (unsigned long long)cvtpk(v[j].x, v[j].y) | ((unsigned long long)cvtpk(v[j].z, v[j].w) << 32); } }
    { float2* rope = (float2*)(ws + WS_ROPE); const int gt = vcu * 512 + tid, NT_ = G * 512;
      for (int i = gt; i < SEQ * 16; i += NT_) { const int pos = i >> 4, f = i & 15;
          const double inv = (f & 8 ? 0.01 : 1.0) * (f & 4 ? 0.1 : 1.0) * (f & 2 ? 0.31622776601683794 : 1.0) * (f & 1 ? 0.5623413251903491 : 1.0);
          double rev = (double)pos * inv * 0.15915494309189535; rev -= __builtin_rint(rev);
          rope[i] = make_float2(__builtin_amdgcn_cosf((float)rev), __builtin_amdgcn_sinf((float)rev)); } }
    { float* wrt = (float*)(ws + WS_WRT); const int gt = vcu * 512 + tid, NT_ = G * 512;
      for (int i = gt; i < 8 * 1024; i += NT_) { const int e = i >> 10, k = i & 1023; wrt[i] = a.in[I_OD_FN][k] * a.in[I_OD_WR][k * 8 + e]; } }
}

using pg8::Unit;
typedef const f32x4 (&AccRef)[2][2][4][2];
DI v4u pack8(f32x4 a, f32x4 b) { v4u w; w.x = cvtpk(a[0], a[1]); w.y = cvtpk(a[2], a[3]); w.z = cvtpk(b[0], b[1]); w.w = cvtpk(b[2], b[3]); return w; }
DI float sumsq8(f32x4 a, f32x4 b) { return (a[0] * a[0] + a[1] * a[1]) + (a[2] * a[2] + a[3] * a[3]) + (b[0] * b[0] + b[1] * b[1]) + (b[2] * b[2] + b[3] * b[3]); }
DI float fq_sum(float s) { s += __shfl_xor(s, 16); s += __shfl_xor(s, 32); return s; }
DI float rstd_from(const float* P, int n4, float invn) { float s = 0.f;
#pragma unroll 4
    for (int i = 0; i < n4; ++i) { const f32x4 v = ((const f32x4*)P)[i]; s += (v[0] + v[1]) + (v[2] + v[3]); } return rsqrtf(s * invn + RMS_EPS); }
DI void rope_pair(f32x4& t1, f32x4& t2, const float2* rp  ) {
#pragma unroll
    for (int j = 0; j < 4; ++j) { const float2 cs = rp[j]; const float a = t1[j], b = t2[j]; t1[j] = a * cs.x - b * cs.y; t2[j] = b * cs.x + a * cs.y; }
}
DI unsigned long long pack4(f32x4 a) { return (unsigned long long)cvtpk(a[0], a[1]) | ((unsigned long long)cvtpk(a[2], a[3]) << 32); }

#define EPI_ROW(q) (u.pm * 256 + ((q) >> 2) * 128 + wr * 64 + ((q) & 3) * 16 + fr)
#define EPI_RSTD8(rs, NP4, P, stride, off, invn) do { f32x4 pv_[8]; const int fqc_ = fq < (NP4) ? fq : 0; \
        _Pragma("unroll") for (int q = 0; q < 8; ++q) pv_[q] = *(const f32x4*)((P) + (size_t)EPI_ROW(q) * (stride) + (off) + fqc_ * 4); \
        _Pragma("unroll") for (int q = 0; q < 8; ++q) { float s_ = (pv_[q][0] + pv_[q][1]) + (pv_[q][2] + pv_[q][3]); if (fq >= (NP4)) s_ = 0.f; s_ = fq_sum(s_); rs[q] = rsqrtf(s_ * (invn) + RMS_EPS); } } while (0)
struct EpiInProj {
    static constexpr bool PERM = true, AFTER_DRAIN = false;
    bf16 *SBQ, *CQ, *CKV, *KR; const float* rstd0; float* PQKV; const float2* rope;
    DI void operator()(AccRef acc, const Unit& u, int wr, int wc, int fr, int fq) const {
        { int ln_ = (int)__builtin_amdgcn_mbcnt_hi(~0u, __builtin_amdgcn_mbcnt_lo(~0u, 0u)); asm volatile("" : "+v"(ln_)); fr = ln_ & 15; fq = ln_ >> 4; }
        float rs[8];
#pragma unroll
        for (int q = 0; q < 8; ++q) rs[q] = rstd0[EPI_ROW(q)];
#pragma unroll
        for (int bj = 0; bj < 2; ++bj) {
            const int col0 = u.pn * 256 + bj * 128, cw = wc * 32 + fq * 8;
#pragma unroll
            for (int q = 0; q < 8; ++q) { const int ai = q >> 2, m = q & 3; const int r = EPI_ROW(q);
                f32x4 v0 = acc[ai][bj][m][0] * rs[q], v1 = acc[ai][bj][m][1] * rs[q];
                if (col0 < 1536) { bf16* dst = SBQ + (size_t)(col0 >> 9) * (size_t)(16u << 20) + (size_t)r * 512 + (col0 & 511) + cw; *(v4u*)dst = pack8(v0, v1); }
                else if (col0 < 1920) { *(v4u*)(CQ + (size_t)r * 384 + (col0 - 1536) + cw) = pack8(v0, v1); const float s = fq_sum(sumsq8(v0, v1)); if (fq == 0) PQKV[(size_t)r * 32 + (col0 - 1536) / 32 + wc] = s; }
                else if (col0 < 2176) { *(v4u*)(CKV + (size_t)r * 256 + (col0 - 1920) + cw) = pack8(v0, v1); const float s = fq_sum(sumsq8(v0, v1)); if (fq == 0) PQKV[(size_t)r * 32 + 16 + (col0 - 1920) / 32 + wc] = s; }
                else if (wc == 0) {
                    const f32x4* rp = (const f32x4*)(rope + (size_t)(r & (SEQ - 1)) * 16 + 4 * fq); const f32x4 ca = rp[0], cb = rp[1];
                    const float c[4] = {ca[0], ca[2], cb[0], cb[2]}, sn[4] = {ca[1], ca[3], cb[1], cb[3]};
#pragma unroll
                    for (int j = 0; j < 4; ++j) { const float a = v0[j], b = v1[j]; v0[j] = a * c[j] - b * sn[j]; v1[j] = b * c[j] + a * sn[j]; }
                    *(unsigned long long*)(KR + (size_t)r * 32 + 4 * fq) = pack4(v0); *(unsigned long long*)(KR + (size_t)r * 32 + 16 + 4 * fq) = pack4(v1); }
            }
        }
    }
};
struct EpiQUp {
    static constexpr bool PERM = true, AFTER_DRAIN = false;
    bf16* QA; const float* PQKV; const float2* rope;
    DI void operator()(AccRef acc, const Unit& u, int wr, int wc, int fr, int fq) const {
        { int ln_ = (int)__builtin_amdgcn_mbcnt_hi(~0u, __builtin_amdgcn_mbcnt_lo(~0u, 0u)); asm volatile("" : "+v"(ln_)); fr = ln_ & 15; fq = ln_ >> 4; }
        float rs[8]; EPI_RSTD8(rs, 3, PQKV, 32, 0, 1.f / 384.f);
        const bool rope0 = (u.pn * 8 + wc) % 3 == 2, rope1 = (u.pn * 8 + 4 + wc) % 3 == 2;
#pragma unroll
        for (int hb = 0; hb < 2; ++hb) {
            f32x4 cs[4][2];
            if (rope0 || rope1) {
#pragma unroll
                for (int qq = 0; qq < 4; ++qq) { const f32x4* rp = (const f32x4*)(rope + (size_t)(EPI_ROW(hb * 4 + qq) & (SEQ - 1)) * 16 + 4 * fq); cs[qq][0] = rp[0]; cs[qq][1] = rp[1]; } }
#pragma unroll
            for (int qq = 0; qq < 4; ++qq) { const int q = hb * 4 + qq, ai = q >> 2, m = q & 3; const int r = EPI_ROW(q);
#pragma unroll
                for (int bj = 0; bj < 2; ++bj) { const int gi = u.pn * 8 + bj * 4 + wc; const bool isr = bj ? rope1 : rope0;
                    f32x4 v0 = acc[ai][bj][m][0] * rs[q], v1 = acc[ai][bj][m][1] * rs[q];
                    if (!isr) *(v4u*)(QA + (size_t)r * 768 + gi * 32 + fq * 8) = pack8(v0, v1);
                    else { const float c[4] = {cs[qq][0][0], cs[qq][0][2], cs[qq][1][0], cs[qq][1][2]}, sn[4] = {cs[qq][0][1], cs[qq][0][3], cs[qq][1][1], cs[qq][1][3]};
#pragma unroll
                        for (int j = 0; j < 4; ++j) { const float a = v0[j], b = v1[j]; v0[j] = a * c[j] - b * sn[j]; v1[j] = b * c[j] + a * sn[j]; }
                        *(unsigned long long*)(QA + (size_t)r * 768 + gi * 32 + 4 * fq) = pack4(v0); *(unsigned long long*)(QA + (size_t)r * 768 + gi * 32 + 16 + 4 * fq) = pack4(v1); } }
            }
        }
    }
};
struct EpiKvUp {
    static constexpr bool PERM = true, AFTER_DRAIN = false;
    bf16* KN; const float* PQKV;
    DI void operator()(AccRef acc, const Unit& u, int wr, int wc, int fr, int fq) const {
        { int ln_ = (int)__builtin_amdgcn_mbcnt_hi(~0u, __builtin_amdgcn_mbcnt_lo(~0u, 0u)); asm volatile("" : "+v"(ln_)); fr = ln_ & 15; fq = ln_ >> 4; }
        float rs[8]; EPI_RSTD8(rs, 2, PQKV, 32, 16, 1.f / 256.f);
#pragma unroll
        for (int q = 0; q < 8; ++q) { const int ai = q >> 2, m = q & 3; const int r = EPI_ROW(q);
#pragma unroll
            for (int bj = 0; bj < 2; ++bj) { const int c = u.pn * 256 + bj * 128 + wc * 32 + fq * 8;
                bf16* dst = KN + (size_t)(c >> 9) * (size_t)(16u << 20) + (size_t)r * 512 + (c & 511);
                *(v4u*)dst = pack8(acc[ai][bj][m][0] * rs[q], acc[ai][bj][m][1] * rs[q]); }
        }
    }
};
template <bool RES_F32> struct EpiRes {
    static constexpr bool PERM = true, AFTER_DRAIN = false;
    const void* res; bf16* Y; float* PS;
    DI void operator()(AccRef acc, const Unit& u, int wr, int wc, int fr, int fq) const {
        { int ln_ = (int)__builtin_amdgcn_mbcnt_hi(~0u, __builtin_amdgcn_mbcnt_lo(~0u, 0u)); asm volatile("" : "+v"(ln_)); fr = ln_ & 15; fq = ln_ >> 4; }
        const size_t cb = (size_t)u.pn * 256 + wc * 32 + fq * 8;
#pragma unroll
        for (int hb = 0; hb < 2; ++hb) {
            f32x4 x0[4][2], x1[4][2];
#pragma unroll
            for (int qq = 0; qq < 4; ++qq)
#pragma unroll
                for (int bj = 0; bj < 2; ++bj) { const size_t o = (size_t)EPI_ROW(hb * 4 + qq) * 1024 + cb + bj * 128;
                    if (RES_F32) { x0[qq][bj] = *(const f32x4*)((const float*)res + o); x1[qq][bj] = *(const f32x4*)((const float*)res + o + 4); }
                    else { const v4u w = *(const v4u*)((const bf16*)res + o); x0[qq][bj] = (f32x4){bflo(w.x), bfhi(w.x), bflo(w.y), bfhi(w.y)}; x1[qq][bj] = (f32x4){bflo(w.z), bfhi(w.z), bflo(w.w), bfhi(w.w)}; } }
#pragma unroll
            for (int qq = 0; qq < 4; ++qq) { const int q = hb * 4 + qq, ai = q >> 2, m = q & 3; const int r = EPI_ROW(q); float ss = 0.f;
#pragma unroll
                for (int bj = 0; bj < 2; ++bj) { const f32x4 v0 = acc[ai][bj][m][0] + x0[qq][bj], v1 = acc[ai][bj][m][1] + x1[qq][bj]; ss += sumsq8(v0, v1); *(v4u*)(Y + (size_t)r * 1024 + cb + bj * 128) = pack8(v0, v1); }
                ss = fq_sum(ss); if (fq == 0) PS[(size_t)r * 16 + u.pn * 4 + wc] = ss; }
        }
    }
};
DI f32x4 silu_mul(f32x4 g, f32x4 u) { f32x4 o;
#pragma unroll
    for (int j = 0; j < 4; ++j) o[j] = g[j] * u[j] * __builtin_amdgcn_rcpf(1.f + ex2(-g[j] * LOG2E)); return o; }
struct EpiSwiGLU {
    static constexpr bool PERM = true, AFTER_DRAIN = false;
    bf16* H; int ldh, ntile; const float* PS; const float* srs;
    DI void operator()(AccRef acc, const Unit& u, int wr, int wc, int fr, int fq) const {
        { int ln_ = (int)__builtin_amdgcn_mbcnt_hi(~0u, __builtin_amdgcn_mbcnt_lo(~0u, 0u)); asm volatile("" : "+v"(ln_)); fr = ln_ & 15; fq = ln_ >> 4; }
        float rs[8];
        if (PS) EPI_RSTD8(rs, 4, PS, 16, 0, 1.f / 1024.f);
        else {
#pragma unroll
            for (int q = 0; q < 8; ++q) rs[q] = srs[EPI_ROW(q)]; }
#pragma unroll
        for (int q = 0; q < 8; ++q) { const int ai = q >> 2, m = q & 3; const int r = EPI_ROW(q);
            const f32x4 h0 = silu_mul(acc[ai][0][m][0] * rs[q], acc[ai][1][m][0] * rs[q]), h1 = silu_mul(acc[ai][0][m][1] * rs[q], acc[ai][1][m][1] * rs[q]);
            *(v4u*)(H + (size_t)r * ldh + (u.pn % ntile) * 128 + wc * 32 + fq * 8) = pack8(h0, h1); }
    }
};
struct EpiQkv {
    static constexpr bool PERM = true, AFTER_DRAIN = false;
    bf16* Q2; const float* PS; float* KMP;
    DI void operator()(AccRef acc, const Unit& u, int wr, int wc, int fr, int fq) const {
        { int ln_ = (int)__builtin_amdgcn_mbcnt_hi(~0u, __builtin_amdgcn_mbcnt_lo(~0u, 0u)); asm volatile("" : "+v"(ln_)); fr = ln_ & 15; fq = ln_ >> 4; }
        float rs[8]; EPI_RSTD8(rs, 4, PS, 16, 0, 1.f / 1024.f);
        const int sec = u.pn >> 2; bf16* dstb = Q2 + (size_t)sec * (size_t)(32u << 20);
        f32x4 cs[2][2];
#pragma unroll
        for (int bj = 0; bj < 2; ++bj) { cs[bj][0] = (f32x4){0.f, 0.f, 0.f, 0.f}; cs[bj][1] = cs[bj][0]; }
#pragma unroll
        for (int q = 0; q < 8; ++q) { const int ai = q >> 2, m = q & 3; const int r = EPI_ROW(q);
#pragma unroll
            for (int bj = 0; bj < 2; ++bj) { const f32x4 v0 = acc[ai][bj][m][0] * rs[q], v1 = acc[ai][bj][m][1] * rs[q]; cs[bj][0] += v0; cs[bj][1] += v1;
                *(v4u*)(dstb + (size_t)r * 1024 + (u.pn & 3) * 256 + bj * 128 + wc * 32 + fq * 8) = pack8(v0, v1); }
        }
        if (sec == 1) {
#pragma unroll
            for (int bj = 0; bj < 2; ++bj)
#pragma unroll
                for (int n = 0; n < 2; ++n) { f32x4 s = cs[bj][n];
#pragma unroll
                    for (int j = 0; j < 4; ++j) { float t = s[j]; t += __shfl_xor(t, 1); t += __shfl_xor(t, 2); t += __shfl_xor(t, 4); t += __shfl_xor(t, 8); s[j] = t; }
                    if (fr == 0) *(f32x4*)(KMP + ((size_t)wr * (T / 256) + u.pm) * 1024 + (u.pn & 3) * 256 + bj * 128 + wc * 32 + fq * 8 + n * 4) = s; }
        }
    }
};
struct EpiMoeDown {
    static constexpr bool PERM = true, AFTER_DRAIN = false;
    bf16* YP; const int* sdst; const float* sw;
    DI void operator()(AccRef acc, const Unit& u, int wr, int wc, int fr, int fq) const {
        { int ln_ = (int)__builtin_amdgcn_mbcnt_hi(~0u, __builtin_amdgcn_mbcnt_lo(~0u, 0u)); asm volatile("" : "+v"(ln_)); fr = ln_ & 15; fq = ln_ >> 4; }
        int d[8]; float w[8];
#pragma unroll
        for (int q = 0; q < 8; ++q) { d[q] = sdst[EPI_ROW(q)]; w[q] = sw[EPI_ROW(q)]; }
#pragma unroll
        for (int q = 0; q < 8; ++q) { const int ai = q >> 2, m = q & 3;
            if (d[q] >= 0) {
#pragma unroll
                for (int bj = 0; bj < 2; ++bj) __builtin_nontemporal_store(pack8(acc[ai][bj][m][0] * w[q], acc[ai][bj][m][1] * w[q]), (v4u*)(YP + (size_t)d[q] * 1024 + (u.pn & 3) * 256 + bj * 128 + wc * 32 + fq * 8)); }
        }
    }
};
struct MoeOrder {
    const int* tile_e; int nrt, G, c;
    DI bool next(int i, Unit& u) const { const long L = (long)i * G + c; if (L >= (long)nrt * 4) return false; const int rt = (int)(L >> 2); u.pm = rt; u.pn = tile_e[rt] * 4 + (int)(L & 3); return true; }
    DI void a_ready(const Unit&) const {}
    DI void done(const Unit&) const {}
};

#ifndef DBG_CHECK
#define DBG_CHECK 0
#endif
constexpr int CW_ERR = 8320;
#if DBG_CHECK
DI float bf2f(bf16 v) { return __uint_as_float((unsigned)v << 16); }
DI void dbg_flag(unsigned* ctl, unsigned bit) { atomicOr(ctl + CW_ERR, bit); }
DI float blk_max(float v, LAS float* red, int tid) { red[tid] = v; __syncthreads(); for (int o = 256; o > 0; o >>= 1) { if (tid < o) red[tid] = fmaxf(red[tid], red[tid + o]); __syncthreads(); } const float r = red[0]; __syncthreads(); return r; }
DI float blk_sum(float v, LAS float* red, int tid) { red[tid] = v; __syncthreads(); for (int o = 256; o > 0; o >>= 1) { if (tid < o) red[tid] = red[tid] + red[tid + o]; __syncthreads(); } const float r = red[0]; __syncthreads(); return r; }
DI unsigned dbg_hash(unsigned i) { i ^= i >> 16; i *= 0x7feb352du; i ^= i >> 15; i *= 0x846ca68bu; i ^= i >> 16; return i; }
DI int dbg_pos(int i) { switch (i) { case 0: return 0; case 1: return 1; case 2: return 31; case 3: return 32; case 4: return 63; case 5: return 64; case 6: return 65; case 7: return 255; case 8: return 256; case 9: return 257;
    case 10: return 511; case 11: return 512; case 12: return 4095; case 13: return 4096; case 14: return 8191; case 15: return 16383; default: return (int)(dbg_hash((unsigned)i) % SEQ); } }
template <int MODE> DI void naive_attn(const Args& a, int b, int h, int s, LAS unsigned char* lds, unsigned sel) {
    const int tid = threadIdx.x; unsigned char* ws = a.ws;
    LAS float* lg = (LAS float*)lds; LAS float* red = (LAS float*)(lds + 65536); LAS float* qv = (LAS float*)(lds + 67584); LAS float* opart = (LAS float*)(lds + 68096); LAS float* oref = (LAS float*)(lds + 70144);
    const size_t r = (size_t)b * SEQ + s;
    const int DQ = MODE == 0 ? 96 : 64; float mblk = 0.f;
    if (tid < DQ) { float q;
        if (MODE == 0) q = bf2f(((const bf16*)(ws + WS_QA))[r * 768 + h * 96 + tid]); else if (MODE == 1) q = bf2f(((const bf16*)(ws + WS_SBQ))[r * 512 + h * 64 + tid]); else q = bf2f(((const bf16*)(ws + WS_Q2))[r * 1024 + h * 64 + tid]);
        qv[tid] = q; }
    __syncthreads();
    const int nk = MODE == 1 ? s : s + 1;
    float lmax = -INFINITY;
    for (int k = tid; k < nk; k += 512) { const size_t kr = (size_t)b * SEQ + k; float acc = 0.f;
        if (MODE == 0) { const bf16* kn = (const bf16*)(ws + WS_KN) + kr * 512 + h * 64; const bf16* kp = (const bf16*)(ws + WS_KR) + kr * 32;
            for (int d = 0; d < 64; ++d) acc += qv[d] * bf2f(kn[d]); for (int d = 0; d < 32; ++d) acc += qv[64 + d] * bf2f(kp[d]); }
        else if (MODE == 1) { const bf16* kk = (const bf16*)(ws + WS_SBK) + kr * 512 + h * 64; for (int d = 0; d < 64; ++d) acc += qv[d] * bf2f(kk[d]); }
        else { const int kb = k >> 8, qb = s >> 8; (void)qb; const bool ok = (MODE == 2 && kb == qb) || kb == (int)(sel & 0xFFu) || kb == (int)((sel >> 8) & 0xFFu) || kb == (int)((sel >> 16) & 0xFFu);
            if (ok) { const bf16* kk = (const bf16*)(ws + WS_K2) + kr * 1024 + h * 64; for (int d = 0; d < 64; ++d) acc += qv[d] * bf2f(kk[d]);
                const int dist = s - k; int bucket = dist; if (dist >= 16) { bucket = 16 + (int)(logf((float)dist / 16.f) / 2.0794415416798357f * 16.f); if (bucket > 31) bucket = 31; }
                acc += a.in[I_RELB][h * 32 + bucket] * LOG2E; } else acc = -INFINITY; }
        lg[k] = acc; lmax = fmaxf(lmax, acc); }
    __syncthreads();
    float tot = 1.f;
    if (MODE == 1) { if (tid == 0) { float run = 0.f; for (int k = nk - 1; k >= 0; --k) { const float y = lg[k]; const float sp = fmaxf(y, 0.f) + log2f(1.f + exp2f(-fabsf(y))); lg[k] = exp2f(y - sp + run); run -= sp; } } __syncthreads(); }
    else { const float m = blk_max(lmax, red, tid); mblk = m; float ls = 0.f; for (int k = tid; k < nk; k += 512) { const float p = exp2f(lg[k] - m); lg[k] = p; ls += p; } __syncthreads(); tot = blk_sum(ls, red, tid); }
    { const int g = tid >> 6, d = tid & 63; float acc = 0.f;
      for (int k = g; k < nk; k += 8) { const size_t kr = (size_t)b * SEQ + k; float v;
          if (MODE == 0) v = bf2f(((const bf16*)(ws + WS_VA))[kr * 512 + h * 64 + d]); else if (MODE == 1) v = bf2f(((const bf16*)(ws + WS_SBV))[kr * 512 + h * 64 + d]); else v = bf2f(((const bf16*)(ws + WS_V2))[kr * 1024 + h * 64 + d]);
          const float p = lg[k]; if (p != 0.f) acc += p * v; }
      opart[g * 64 + d] = acc; }
    __syncthreads();
    if (tid < 64) { float acc = 0.f; for (int g = 0; g < 8; ++g) acc += opart[g * 64 + tid]; oref[tid] = acc / tot; }
    if (tid == 0) oref[64] = mblk + log2f(tot);
    __syncthreads();
}
DI void dbg_cmp64(const bf16* got, LAS unsigned char* lds, unsigned* ctl, unsigned bit) {
    const int tid = threadIdx.x; LAS float* red = (LAS float*)(lds + 65536); LAS float* oref = (LAS float*)(lds + 70144);
    const float v = tid < 64 ? fabsf(oref[tid]) : 0.f; const float mx = blk_max(v, red, tid);
    if (tid < 64) { const float g = bf2f(got[tid]); if (!(fabsf(g - oref[tid]) <= 0.02f * mx + 2e-3f)) dbg_flag(ctl, bit); }
    __syncthreads();
}
DI void dbg_check_a(const Args& a, LAS unsigned char* lds, unsigned* ctl, int bx, int G) {
    const int tid = threadIdx.x; unsigned char* ws = a.ws;
    LAS float* red = (LAS float*)(lds + 65536); LAS float* hrow = (LAS float*)lds;
    LAS float* cq = (LAS float*)(lds + 4096); LAS float* ckv = (LAS float*)(lds + 8192);
    const float2* rope = (const float2*)(ws + WS_ROPE);
    for (int i = bx; i < 256; i += G) {
        const int b = i & 1, s = dbg_pos(i >> 1); const size_t r = (size_t)b * SEQ + s;
        float ss = 0.f; for (int k = tid; k < 1024; k += 512) { const float x = a.in[I_X][r * 1024 + k]; ss += x * x; }
        const float rs = rsqrtf(blk_sum(ss, red, tid) / 1024.f + RMS_EPS);
        for (int k = tid; k < 1024; k += 512) hrow[k] = a.in[I_X][r * 1024 + k] * rs * a.in[I_EV_AN][k];
        __syncthreads();
        for (int j = tid; j < 2208; j += 512) { float acc = 0.f; for (int k = 0; k < 1024; ++k) acc += hrow[k] * a.in[I_EV_WIN][(size_t)k * 2208 + j];
            float got, ref = acc; bool cmp = true;
            if (j < 384) got = bf2f(((const bf16*)(ws + WS_CQ))[r * 384 + j]);
            else if (j < 640) got = bf2f(((const bf16*)(ws + WS_CKV))[r * 256 + (j - 384)]);
            else if (j < 672) { cmp = false; got = 0.f; }
            else if (j < 1184) { got = bf2f(((const bf16*)(ws + WS_SBQ))[r * 512 + (j - 672)]); ref = acc * C_64; }
            else if (j < 1696) got = bf2f(((const bf16*)(ws + WS_SBK))[r * 512 + (j - 1184)]);
            else got = bf2f(((const bf16*)(ws + WS_SBV))[r * 512 + (j - 1696)]);
            if (cmp && !(fabsf(got - ref) <= 0.03f * fabsf(ref) + 0.03f)) dbg_flag(ctl, 1u); }
        if (tid < 16) { float t1 = 0.f, t2 = 0.f; for (int k = 0; k < 1024; ++k) { t1 += hrow[k] * a.in[I_EV_WIN][(size_t)k * 2208 + 640 + tid]; t2 += hrow[k] * a.in[I_EV_WIN][(size_t)k * 2208 + 656 + tid]; }
            const float ang = (float)s * powf(10000.f, -(float)tid / 16.f); const float c = cosf(ang), sn = sinf(ang);
            const float o1 = t1 * c - t2 * sn, o2 = t2 * c + t1 * sn; const float g1 = bf2f(((const bf16*)(ws + WS_KR))[r * 32 + tid]), g2 = bf2f(((const bf16*)(ws + WS_KR))[r * 32 + 16 + tid]);
            if (!(fabsf(g1 - o1) <= 0.03f * fabsf(o1) + 0.03f) || !(fabsf(g2 - o2) <= 0.03f * fabsf(o2) + 0.03f)) dbg_flag(ctl, 1u);
            const float2 tb = rope[(size_t)s * 16 + tid]; if (!(fabsf(tb.x - c) < 2e-3f && fabsf(tb.y - sn) < 2e-3f)) dbg_flag(ctl, 1u); }
        __syncthreads();
        float s1 = 0.f, s2 = 0.f;
        if (tid < 384) { const float v = bf2f(((const bf16*)(ws + WS_CQ))[r * 384 + tid]); s1 = v * v; cq[tid] = v; }
        if (tid < 256) { const float v = bf2f(((const bf16*)(ws + WS_CKV))[r * 256 + tid]); s2 = v * v; ckv[tid] = v; }
        const float rq = rsqrtf(blk_sum(s1, red, tid) / 384.f + RMS_EPS), rk = rsqrtf(blk_sum(s2, red, tid) / 256.f + RMS_EPS);
        if (tid < 384) cq[tid] *= rq * a.in[I_EV_QN][tid];
        if (tid < 256) ckv[tid] *= rk * a.in[I_EV_KVN][tid];
        __syncthreads();
        for (int j = tid; j < 768; j += 512) { const int hh = j / 96, dd = j % 96; float acc = 0.f; for (int k = 0; k < 384; ++k) acc += cq[k] * a.in[I_EV_WUQ][(size_t)k * 768 + j];
            float ref = acc;
            if (dd >= 64) { const int ri = dd - 64, pi = ri < 16 ? ri : ri - 16; const int jp = hh * 96 + 64 + (ri < 16 ? ri + 16 : ri - 16); float accp = 0.f; for (int k = 0; k < 384; ++k) accp += cq[k] * a.in[I_EV_WUQ][(size_t)k * 768 + jp];
                const float ang = (float)s * powf(10000.f, -(float)pi / 16.f); const float c = cosf(ang), sn = sinf(ang); ref = ri < 16 ? acc * c - accp * sn : acc * c + accp * sn; }
            ref *= C_MLA; const float got = bf2f(((const bf16*)(ws + WS_QA))[r * 768 + j]);
            if (!(fabsf(got - ref) <= 0.03f * fabsf(ref) + 0.02f)) dbg_flag(ctl, 1u); }
        for (int j = tid; j < 1024; j += 512) { const int hh = j >> 7, dd = j & 127; float acc = 0.f; for (int k = 0; k < 256; ++k) acc += ckv[k] * a.in[I_EV_WUKV][(size_t)k * 1024 + j];
            const float got = dd < 64 ? bf2f(((const bf16*)(ws + WS_KN))[r * 512 + hh * 64 + dd]) : bf2f(((const bf16*)(ws + WS_VA))[r * 512 + hh * 64 + dd - 64]);
            if (!(fabsf(got - acc) <= 0.03f * fabsf(acc) + 0.03f)) dbg_flag(ctl, 1u); }
        __syncthreads();
        const int h = (int)(dbg_hash((unsigned)i * 7u + 1u) & 7u);
        naive_attn<0>(a, b, h, s, lds, 0u); dbg_cmp64((const bf16*)(ws + WS_OCAT) + r * 1024 + h * 64, lds, ctl, 2u);
        naive_attn<1>(a, b, h, s, lds, 0u); dbg_cmp64((const bf16*)(ws + WS_OCAT) + r * 1024 + 512 + h * 64, lds, ctl, 4u);
    }
}
DI void dbg_check_b(const Args& a, LAS unsigned char* lds, unsigned* ctl, int bx, int G, const bf16* O2) {
    const int tid = threadIdx.x; unsigned char* ws = a.ws;
    LAS float* red = (LAS float*)(lds + 65536); LAS float* hrow = (LAS float*)lds; LAS float* gate = (LAS float*)(lds + 8192);
    const bf16* X2 = (const bf16*)a.out;
    for (int i = bx; i < 256; i += G) {
        const int b = i & 1, s = dbg_pos(i >> 1), h = (int)(dbg_hash((unsigned)i * 11u + 5u) & 15u); const size_t r = (size_t)b * SEQ + s;
        float ss = 0.f; for (int k = tid; k < 1024; k += 512) { const float x = bf2f(X2[r * 1024 + k]); ss += x * x; }
        const float rs = rsqrtf(blk_sum(ss, red, tid) / 1024.f + RMS_EPS);
        for (int k = tid; k < 1024; k += 512) hrow[k] = bf2f(X2[r * 1024 + k]) * rs * a.in[I_OD_AN][k];
        __syncthreads();
        for (int j = tid; j < 3072; j += 512) { float acc = 0.f; for (int k = 0; k < 1024; ++k) acc += hrow[k] * a.in[I_OD_WQKV][(size_t)k * 3072 + j];
            float ref = acc; float got;
            if (j < 1024) { ref = acc * C_64; got = bf2f(((const bf16*)(ws + WS_Q2))[r * 1024 + j]); } else if (j < 2048) got = bf2f(((const bf16*)(ws + WS_K2))[r * 1024 + j - 1024]); else got = bf2f(((const bf16*)(ws + WS_V2))[r * 1024 + j - 2048]);
            if (!(fabsf(got - ref) <= 0.03f * fabsf(ref) + 0.03f)) dbg_flag(ctl, 8u); }
        __syncthreads();
        const int qb = s >> 8; const unsigned sel = ((const unsigned*)(ws + WS_SEL))[((size_t)(b * 16 + h)) * SEQ + s];
        if (tid < 64) gate[tid] = -INFINITY;
        __syncthreads();
        { const int n = tid >> 3, part = tid & 7;
          float acc = 0.f; if (n < qb) { for (int kk = part * 32; kk < part * 32 + 32; ++kk) { const size_t kr = (size_t)b * SEQ + n * 256 + kk; for (int d = 0; d < 64; ++d) acc += bf2f(((const bf16*)(ws + WS_Q2))[r * 1024 + h * 64 + d]) * bf2f(((const bf16*)(ws + WS_K2))[kr * 1024 + h * 64 + d]); } }
          acc += __shfl_xor(acc, 1); acc += __shfl_xor(acc, 2); acc += __shfl_xor(acc, 4); if (part == 0 && n < qb) gate[n] = acc / 256.f; }
        __syncthreads();
        if (tid == 0) { const int nsel_exp = qb < 3 ? qb : 3; int nsel = 0; float gmin = INFINITY; bool bad = false;
            for (int k = 0; k < 3; ++k) { const unsigned e = (sel >> (8 * k)) & 0xFFu; if (e != 0xFFu) { if ((int)e >= qb) bad = true; else { ++nsel; gmin = fminf(gmin, gate[e]); } } }
            if (nsel != nsel_exp) bad = true;
            if ((sel & 0xFFu) != 0xFFu && ((sel & 0xFFu) == ((sel >> 8) & 0xFFu) || (sel & 0xFFu) == ((sel >> 16) & 0xFFu))) bad = true;
            if (((sel >> 8) & 0xFFu) != 0xFFu && ((sel >> 8) & 0xFFu) == ((sel >> 16) & 0xFFu)) bad = true;
            if (!bad && nsel > 0) { float gsc = 0.f; for (int n = 0; n < qb; ++n) gsc = fmaxf(gsc, fabsf(gate[n]));
                for (int n = 0; n < qb; ++n) { const bool chosen = n == (int)(sel & 0xFFu) || n == (int)((sel >> 8) & 0xFFu) || n == (int)((sel >> 16) & 0xFFu); if (!chosen && gate[n] > gmin + 0.02f * gsc + 1e-3f) bad = true; } }
            if (bad) dbg_flag(ctl, 8u); }
        __syncthreads();
        { LAS float* oref = (LAS float*)(lds + 70144); float* dref = (float*)(ws + WS_WRT + 256 * 1024) + (size_t)i * 64;
          naive_attn<2>(a, b, h, s, lds, 0xFFFFFFu);
          { const float v = tid < 64 ? fabsf(oref[tid]) : 0.f; const float mx = blk_max(v, red, tid);
            const float2 ms = ((const float2*)(ws + WS_PMS))[((size_t)(3 * 32 + b * 16 + h)) * SEQ + s]; const bf16* pob = (const bf16*)a.out + (size_t)32 * 1024 * 1024 + (((size_t)(b * 16 + h)) * SEQ + s) * 64;
            if (tid == 0) { if (!(fabsf(ms.x + log2f(ms.y) - oref[64]) <= 0.05f)) dbg_flag(ctl, 8u); }
            if (tid < 64) { const float g = bf2f(pob[tid]) / ms.y; if (!(fabsf(g - oref[tid]) <= 0.02f * mx + 2e-3f)) dbg_flag(ctl, 8u); }
            __syncthreads(); }
          naive_attn<2>(a, b, h, s, lds, sel);
          if (tid < 64) dref[tid] = oref[tid];
          __syncthreads(); }
    }
}
DI void dbg_check_b2(const Args& a, LAS unsigned char* lds, unsigned* ctl, int bx, int G, const bf16* O2) {
    const int tid = threadIdx.x; unsigned char* ws = a.ws; LAS float* red = (LAS float*)(lds + 65536);
    for (int i = bx; i < 256; i += G) {
        const int b = i & 1, s = dbg_pos(i >> 1), h = (int)(dbg_hash((unsigned)i * 11u + 5u) & 15u); const size_t r = (size_t)b * SEQ + s;
        const float* dref = (const float*)(ws + WS_WRT + 256 * 1024) + (size_t)i * 64;
        const float rf = tid < 64 ? dref[tid] : 0.f; const float mx = blk_max(fabsf(rf), red, tid);
        if (tid < 64) { const float g = bf2f(O2[r * 1024 + h * 64 + tid]); if (!(fabsf(g - rf) <= 0.02f * mx + 2e-3f)) dbg_flag(ctl, 8u); }
        __syncthreads();
    }
}
#endif

DI void router_chunk(const Args& a, int ch, LAS unsigned char* lds) {
    int tid_ = threadIdx.x; asm volatile("" : "+v"(tid_)); const int tid = tid_, lane = tid & 63, wave = rfl(tid >> 6);
    unsigned char* ws = a.ws;
    const bf16* X3 = (const bf16*)(ws + WS_X3B); const float* PS3 = (const float*)(ws + WS_PS3);
    const LAS float* wrt = (const LAS float*)lds;
    volatile LAS unsigned* te = (volatile LAS unsigned*)(lds + 32768);
    float2* TOKW = (float2*)(ws + WS_TOKW); float* TOKR = (float*)(ws + WS_TOKR); unsigned* TOKE = (unsigned*)(ws + WS_TOKE);
    v4u nw0 = *((const v4u*)(X3 + (size_t)(ch * 128 + wave * 16) * 1024) + lane), nw1 = *((const v4u*)(X3 + (size_t)(ch * 128 + wave * 16) * 1024 + 512) + lane);
    float npss = PS3[(size_t)(ch * 128 + wave * 16) * 16 + (lane & 15)];
#pragma unroll 1
    for (int i = 0; i < 16; ++i) {
        const int tl = wave * 16 + i, tok = ch * 128 + tl;
        const v4u w0 = nw0, w1 = nw1; float pss = npss;
        if (i < 15) { nw0 = *((const v4u*)(X3 + (size_t)(tok + 1) * 1024) + lane); nw1 = *((const v4u*)(X3 + (size_t)(tok + 1) * 1024 + 512) + lane); npss = PS3[(size_t)(tok + 1) * 16 + (lane & 15)]; }
        float xv[16] = {bflo(w0.x), bfhi(w0.x), bflo(w0.y), bfhi(w0.y), bflo(w0.z), bfhi(w0.z), bflo(w0.w), bfhi(w0.w), bflo(w1.x), bfhi(w1.x), bflo(w1.y), bfhi(w1.y), bflo(w1.z), bfhi(w1.z), bflo(w1.w), bfhi(w1.w)};
        float lg[8];
#pragma unroll
        for (int e = 0; e < 8; ++e) { const LAS f32x4* p0 = (const LAS f32x4*)(wrt + e * 1024 + lane * 8); const LAS f32x4* p1 = (const LAS f32x4*)(wrt + e * 1024 + 512 + lane * 8);
            const f32x4 a0 = p0[0], a1 = p0[1], b0 = p1[0], b1 = p1[1];
            float s = xv[0] * a0[0] + xv[1] * a0[1] + xv[2] * a0[2] + xv[3] * a0[3] + xv[4] * a1[0] + xv[5] * a1[1] + xv[6] * a1[2] + xv[7] * a1[3];
            s += xv[8] * b0[0] + xv[9] * b0[1] + xv[10] * b0[2] + xv[11] * b0[3] + xv[12] * b1[0] + xv[13] * b1[1] + xv[14] * b1[2] + xv[15] * b1[3];
            lg[e] = wave_sum(s); }
        pss += __shfl_xor(pss, 1); pss += __shfl_xor(pss, 2); pss += __shfl_xor(pss, 4); pss += __shfl_xor(pss, 8);
        const float rs = rsqrtf(pss * (1.f / 1024.f) + RMS_EPS);
        float v1 = -INFINITY, v2 = -INFINITY; unsigned i1 = 0, i2 = 0;
#pragma unroll
        for (int e = 0; e < 8; ++e) { const float l = lg[e] * rs; if (l > v1) { v2 = v1; i2 = i1; v1 = l; i1 = (unsigned)e; } else if (l > v2) { v2 = l; i2 = (unsigned)e; } }
        const float w1g = 1.f / (1.f + __expf(v2 - v1));
        if (lane == 0) { TOKW[tok] = make_float2(w1g, 1.f - w1g); TOKR[tok] = rs; TOKE[tok] = i1 | (i2 << 8); te[tl] = i1 | (i2 << 8); }
    }
    __syncthreads();
    { const unsigned e = (unsigned)wave; const unsigned ta = te[2 * lane], tb = te[2 * lane + 1];
      const unsigned m0 = (ta & 0xFFu) == e, m1 = ((ta >> 8) & 0xFFu) == e, m2 = (tb & 0xFFu) == e, m3 = ((tb >> 8) & 0xFFu) == e;
      const unsigned c = m0 + m1 + m2 + m3; unsigned inc = c;
#pragma unroll
      for (int o = 1; o < 64; o <<= 1) { const unsigned t = __shfl_up(inc, o); if (lane >= o) inc += t; }
      unsigned base = inc - c; int* PR = (int*)(ws + WS_PRANK) + (size_t)ch * 256 + 4 * lane;
      if (m0) { PR[0] = (int)base; ++base; } if (m1) { PR[1] = (int)base; ++base; } if (m2) { PR[2] = (int)base; ++base; } if (m3) { PR[3] = (int)base; ++base; }
      if (lane == 63) ((int*)(ws + WS_CNT))[ch * 8 + wave] = (int)inc; }
    __syncthreads();
}

DI void permute_phase(const Args& a, LAS unsigned char* lds, int G) {
    int tid_ = threadIdx.x; asm volatile("" : "+v"(tid_)); const int tid = tid_;
    unsigned char* ws = a.ws;
    LAS int* cnt = (LAS int*)lds;
    LAS int* off = (LAS int*)(lds + 8192);
    LAS int* ebase = (LAS int*)(lds + 16384);
    const int* CNT = (const int*)(ws + WS_CNT);
    for (int i = tid; i < 2048; i += 512) cnt[i] = CNT[i];
    __syncthreads();
    if (tid < 8) { int s = 0; for (int c = 0; c < 256; ++c) { off[c * 8 + tid] = s; s += cnt[c * 8 + tid]; } ebase[16 + tid] = s; }
    __syncthreads();
    if (tid == 0) { int s = 0; for (int e = 0; e < 8; ++e) { ebase[e] = s; s += (ebase[16 + e] + 255) & ~255; } ebase[8] = s; }
    __syncthreads();
    int* SDST = (int*)(ws + WS_SDST); float* SW = (float*)(ws + WS_SW); float* SRS = (float*)(ws + WS_SRS);
    int* STOK = (int*)(ws + WS_STOK);
    const float2* TOKW = (const float2*)(ws + WS_TOKW); const float* TOKR = (const float*)(ws + WS_TOKR); const unsigned* TOKE = (const unsigned*)(ws + WS_TOKE); const int* PRANK = (const int*)(ws + WS_PRANK);
    if (blockIdx.x == 0) {
        int* TE = (int*)(ws + WS_TILEE); const int nrt = ebase[8] >> 8;
        for (int rt = tid; rt < nrt; rt += 512) { int e = 0; for (int k = 1; k < 8; ++k) if (rt * 256 >= ebase[k]) e = k; TE[rt] = e; }
        if (tid == 0) ((unsigned*)(ws + WS_CTL))[CW_NRT] = (unsigned)nrt;
    }
    for (int e = blockIdx.x; e < 8; e += G) {
        const int lo = ebase[e] + ebase[16 + e], hi = ebase[e + 1];
        for (int s = lo + tid; s < hi; s += 512) { SDST[s] = -1; SW[s] = 0.f; SRS[s] = 0.f; STOK[s] = 0; }
    }
    for (int ch = blockIdx.x; ch < 256; ch += G) {
        if (tid < 256) { const int tok = ch * 128 + (tid >> 1), k = tid & 1; const unsigned te = TOKE[tok]; const int e = (int)((te >> (8 * k)) & 0xFFu);
            const int slot = ebase[e] + off[ch * 8 + e] + PRANK[(size_t)ch * 256 + tid];
            const float2 w = TOKW[tok]; SDST[slot] = tok * 2 + k; SW[slot] = k ? w.y : w.x; SRS[slot] = TOKR[tok]; STOK[slot] = tok; }
    }
}

DI void final_phase(const Args& a, int vcu, int G, float oscale) {
    int tid_ = threadIdx.x; asm volatile("" : "+v"(tid_)); const int tid = tid_, lane = tid & 63, wave = rfl(tid >> 6);
    const bf16* X3 = (const bf16*)(a.ws + WS_X3B); const bf16* YP = (const bf16*)(a.ws + WS_YP); const float* g = a.in[I_FINN];
    const int gw = vcu * 8 + wave, NGW = G * 8;
    f32x4 gv[4];
#pragma unroll
    for (int j = 0; j < 4; ++j) gv[j] = *((const f32x4*)g + 2 * lane + (j & 1) + 128 * (j >> 1));
    v4u nx[2], ny0[2], ny1[2];
#define FN_LOAD(m) do { _Pragma("unroll") for (int hlf = 0; hlf < 2; ++hlf) { nx[hlf] = __builtin_nontemporal_load((const v4u*)(X3 + (size_t)(m) * 1024 + hlf * 512) + lane); \
        ny0[hlf] = __builtin_nontemporal_load((const v4u*)(YP + (size_t)(2 * (m)) * 1024 + hlf * 512) + lane); ny1[hlf] = __builtin_nontemporal_load((const v4u*)(YP + (size_t)(2 * (m) + 1) * 1024 + hlf * 512) + lane); } } while (0)
    if (gw < T) FN_LOAD(gw);
    for (int m = gw; m < T; m += NGW) {
        float v[16]; float ss = 0.f;
        const v4u cx[2] = {nx[0], nx[1]}, cy0[2] = {ny0[0], ny0[1]}, cy1[2] = {ny1[0], ny1[1]};
        if (m + NGW < T) FN_LOAD(m + NGW);
#pragma unroll
        for (int hlf = 0; hlf < 2; ++hlf) {
            const v4u x = cx[hlf], y0 = cy0[hlf], y1 = cy1[hlf];
            const unsigned xs[4] = {x.x, x.y, x.z, x.w}, as[4] = {y0.x, y0.y, y0.z, y0.w}, bs[4] = {y1.x, y1.y, y1.z, y1.w};
#pragma unroll
            for (int j = 0; j < 4; ++j) { const float lo = bflo(xs[j]) + (bflo(as[j]) + bflo(bs[j])), hh = bfhi(xs[j]) + (bfhi(as[j]) + bfhi(bs[j])); v[hlf * 8 + 2 * j] = lo; v[hlf * 8 + 2 * j + 1] = hh; ss += lo * lo + hh * hh; }
        }
        ss = wave_sum(ss); const float rs = rsqrtf(ss * (1.f / 1024.f) + RMS_EPS) * oscale;
        float* o = a.out + (size_t)m * 1024;
#pragma unroll
        for (int hlf = 0; hlf < 2; ++hlf) { f32x4 o0, o1;
#pragma unroll
            for (int j = 0; j < 4; ++j) { o0[j] = v[hlf * 8 + j] * rs * gv[hlf * 2][j]; o1[j] = v[hlf * 8 + 4 + j] * rs * gv[hlf * 2 + 1][j]; }
            __builtin_nontemporal_store(o0, (f32x4*)(o + hlf * 512) + 2 * lane); __builtin_nontemporal_store(o1, (f32x4*)(o + hlf * 512) + 2 * lane + 1); }
    }
}

__global__ void __launch_bounds__(512, 2) hybrid_fwd(Args args) {
    extern __shared__ __attribute__((aligned(16))) unsigned char lds_raw[];
    LAS unsigned char* lds = (LAS unsigned char*)lds_raw;
    volatile LAS unsigned* MISC = (volatile LAS unsigned*)(lds + MISC_OFF);
    const int tid = threadIdx.x, wave = rfl(tid >> 6), lane = tid & 63;
    const int G = gridDim.x; const int bx = blockIdx.x; const int vcu = (G % 8 == 0) ? (bx % 8) * (G / 8) + bx / 8 : bx;
    unsigned char* ws = args.ws;
    unsigned* ctl = (unsigned*)(ws + WS_CTL);
    for (int u = tid; u < (LDS_BYTES - PHASE_LDS) / 4; u += 512) ((LAS unsigned*)(lds + PHASE_LDS))[u] = 0u;
    __syncthreads();
    XcdBarrier bar; bar.bar = ctl + CW_BAR; bar.x = 0; bar.st = nullptr;
#if MK_ONE_LAUNCH
    (void)xcd_barrier_post(ctl + CW_BAR, MISC + 8);
#define GRID_BAR() do { XcdBarrier b_; b_.bar = (unsigned*)(args.ws + WS_CTL) + CW_BAR; b_.x = xb_xcc_id(); b_.st = (volatile LAS unsigned*)(lds + MISC_OFF) + 8; xcd_barrier(b_); } while (0)
#else
#define GRID_BAR() do { } while (0)
#endif
    const int lo = args.ph_lo, hi = args.ph_hi;
#ifndef PH_MASK
#define PH_MASK 0x1FFFF
#endif
#define IN(k) (((PH_MASK >> (k)) & 1) && lo <= (k) && (k) < hi)
#if defined(PROBE_DUP) && ((PROBE_DUP >> 20) & 1)
#define SEAM(k) do { if (IN((k) + 1)) { GRID_BAR(); GRID_BAR(); } } while (0)
#else
#define SEAM(k) do { if (IN((k) + 1)) GRID_BAR(); } while (0)
#endif
#ifndef PROBE_DUP
#define PROBE_DUP 0
#endif
#define REP(k) for (int rep_ = 0; rep_ < (((PROBE_DUP >> (k)) & 1) ? 2 : 1); ++rep_)
    (void)lane; (void)wave;

    bf16* XB = (bf16*)(ws + WS_XB); bf16* OCAT = (bf16*)(ws + WS_OCAT);
    bf16 *SBQ = (bf16*)(ws + WS_SBQ), *SBK = (bf16*)(ws + WS_SBK), *SBV = (bf16*)(ws + WS_SBV), *CQ = (bf16*)(ws + WS_CQ), *CKV = (bf16*)(ws + WS_CKV), *KR = (bf16*)(ws + WS_KR);
    bf16 *QA = (bf16*)(ws + WS_QA), *KN = (bf16*)(ws + WS_KN), *VA = (bf16*)(ws + WS_VA), *X1B = (bf16*)(ws + WS_X1B), *HID = (bf16*)(ws + WS_HID), *X2B = (bf16*)args.out;
    bf16 *Q2 = (bf16*)(ws + WS_Q2), *K2 = (bf16*)(ws + WS_K2), *V2 = (bf16*)(ws + WS_V2), *X3B = (bf16*)(ws + WS_X3B), *YP = (bf16*)(ws + WS_YP), *HIDE = (bf16*)(ws + WS_HIDE);
    float *PQKV = (float*)(ws + WS_PQKV), *PS1 = (float*)(ws + WS_PS1), *PS2 = (float*)(ws + WS_PS2), *PS3 = (float*)(ws + WS_PS3), *KMP = (float*)(ws + WS_KMP);
    bf16* O2 = Q2;
    bf16* PO3 = (bf16*)args.out + (size_t)32 * 1024 * 1024;
    const float2* ROPE = (const float2*)(ws + WS_ROPE); unsigned* SEL = (unsigned*)(ws + WS_SEL); float2* PMS = (float2*)(ws + WS_PMS);

    if (IN(0)) REP(0) { p0_prologue(args, lds, vcu, G); SEAM(0); }
    if (IN(1)) REP(1) {
        pg8::Gemm g{XB, (const bf16*)(ws + W_IN), T, 2304, 1024}; pg8::StaticOrder S; S.init(T, 2304, G, bx);
        EpiInProj E{SBQ, CQ, CKV, KR, (const float*)(ws + WS_RSTD0), PQKV, ROPE};
        pg8::gemm_phase<EpiInProj, pg8::StaticOrder, true, true>(lds, g, S, E);
        SEAM(1);
    }
    if (IN(2)) REP(2) {
        { pg8::Gemm g{CQ, (const bf16*)(ws + W_UQ), T, 768, 384}; pg8::StaticOrder S; S.init(T, 768, G, bx);
          EpiQUp E{QA, PQKV, ROPE}; pg8::gemm_phase<EpiQUp, pg8::StaticOrder, true, true>(lds, g, S, E); }
        __syncthreads();
        { pg8::Gemm g{CKV, (const bf16*)(ws + W_UKV), T, 1024, 256}; pg8::StaticOrder S; S.init(T, 1024, G, bx);
          EpiKvUp E{KN, PQKV}; pg8::gemm_phase<EpiKvUp, pg8::StaticOrder, true, true>(lds, g, S, E); }
        SEAM(2);
    }
    if (IN(3)) REP(3) {
        REP(17) for (int v = vcu; v < 256; v += G) { const int bh = v >> 4, s = v & 15;
            att::mla_unit(bh, 63 - s, QA, KN, KR, VA, OCAT, lds); att::mla_unit(bh, 32 + s, QA, KN, KR, VA, OCAT, lds);
            att::mla_unit(bh, 31 - s, QA, KN, KR, VA, OCAT, lds); att::mla_unit(bh, s, QA, KN, KR, VA, OCAT, lds); }
        REP(18) for (int v = vcu; v < 1024; v += G) att::sb_unit(v >> 6, v & 63, SBQ, SBK, SBV, OCAT, lds);
        SEAM(3);
#if DBG_CHECK & 1
        dbg_check_a(args, lds, ctl, bx, G);
#endif
    }
    if (IN(4)) REP(4) {
        pg8::Gemm g{OCAT, (const bf16*)(ws + W_O0), T, 1024, 1024}; pg8::StaticOrder S; S.init(T, 1024, G, bx);
        EpiRes<true> E{args.in[I_X], X1B, PS1}; pg8::gemm_phase<EpiRes<true>, pg8::StaticOrder, true, true>(lds, g, S, E);
        SEAM(4);
    }
    if (IN(5)) REP(5) {
        pg8::Gemm g{X1B, (const bf16*)(ws + W_GU0), T, 4096, 1024}; pg8::StaticOrder S; S.init(T, 4096, G, bx);
        EpiSwiGLU E{HID, 2048, 16, PS1, nullptr}; pg8::gemm_phase<EpiSwiGLU, pg8::StaticOrder, true, true>(lds, g, S, E);
        SEAM(5);
    }
    if (IN(6)) REP(6) {
        pg8::Gemm g{HID, (const bf16*)(ws + W_DN0), T, 1024, 2048}; pg8::StaticOrder S; S.init(T, 1024, G, bx);
        EpiRes<false> E{X1B, X2B, PS2}; pg8::gemm_phase<EpiRes<false>, pg8::StaticOrder, true, true>(lds, g, S, E);
        SEAM(6);
    }
    if (IN(7)) REP(7) {
        pg8::Gemm g{X2B, (const bf16*)(ws + W_QKV), T, 3072, 1024}; pg8::StaticOrder S; S.init(T, 3072, G, bx);
        EpiQkv E{Q2, PS2, KMP}; pg8::gemm_phase<EpiQkv, pg8::StaticOrder, true, true>(lds, g, S, E);
        SEAM(7);
    }
    if (IN(8)) REP(8) {
        for (int v = vcu; v < 256; v += G) att::moba_gate_unit(v & 31, v >> 5, Q2, KMP, SEL, (unsigned*)(ws + WS_MASK), lds);
        SEAM(8);
    }
    if (IN(9)) REP(9) {
        volatile LAS int* qslot = (volatile LAS int*)(lds + att::MB_OFF_Q);
        if (tid == 0) qslot[0] = (int)atomicAdd(ctl + CW_QUEUE + 64 * rep_, 1u);
        __syncthreads();
        int uidx = qslot[0];
        __syncthreads();
        while (uidx < 64 * 32) {
            unsigned nx = 0u; if (tid == 0) nx = atomicAdd(ctl + CW_QUEUE + 64 * rep_, 1u);
            att::moba_sel_unit(uidx & 31, uidx >> 5, Q2, K2, V2, (const unsigned long long*)(ws + WS_MASK), args.in[I_RELB], (bf16*)(ws + WS_PO0), (bf16*)(ws + WS_PO1), (bf16*)(ws + WS_PO2), PO3, PMS, lds);
            if (tid == 0) qslot[0] = (int)nx;
            __syncthreads();
            uidx = qslot[0];
            __syncthreads();
        }
        SEAM(9);
#if DBG_CHECK & 2
        dbg_check_b(args, lds, ctl, bx, G, O2); GRID_BAR();
#endif
    }
    if (IN(10)) REP(10) {
        att::moba_merge(vcu * 8 + wave, G * 8, SEL, (const bf16*)(ws + WS_PO0), (const bf16*)(ws + WS_PO1), (const bf16*)(ws + WS_PO2), PO3, PMS, O2);
        SEAM(10);
#if DBG_CHECK & 2
        dbg_check_b2(args, lds, ctl, bx, G, O2);
#endif
    }
    if (IN(11)) REP(11) {
        pg8::Gemm g{O2, (const bf16*)(ws + W_O1), T, 1024, 1024}; pg8::StaticOrder S; S.init(T, 1024, G, bx);
        EpiRes<false> E{X2B, X3B, PS3}; pg8::gemm_phase<EpiRes<false>, pg8::StaticOrder, true, true>(lds, g, S, E);
        SEAM(11);
    }
    if (IN(12)) REP(12) {
        { const f32x4* wrt = (const f32x4*)(ws + WS_WRT); f32x4 t_[4];
#pragma unroll
          for (int i = 0; i < 4; ++i) t_[i] = wrt[tid + 512 * i];
#pragma unroll
          for (int i = 0; i < 4; ++i) ((LAS f32x4*)lds)[tid + 512 * i] = t_[i]; }
        __syncthreads();
        for (int ch = bx; ch < 256; ch += G) router_chunk(args, ch, lds);
        SEAM(12);
    }
    if (IN(13)) REP(13) { permute_phase(args, lds, G); SEAM(13); }
    if (IN(14)) REP(14) {
        const int nrt = (int)ctl[CW_NRT];
        pg8::Gemm g{X3B, (const bf16*)(ws + W_EGU), NSLOT, 8192, 1024, (const int*)(ws + WS_STOK)}; MoeOrder S{(const int*)(ws + WS_TILEE), nrt, G, bx};
        EpiSwiGLU E{HIDE, 512, 4, nullptr, (const float*)(ws + WS_SRS)}; pg8::gemm_phase<EpiSwiGLU, MoeOrder, true, true, true>(lds, g, S, E);
        SEAM(14);
    }
    if (IN(15)) REP(15) {
        const int nrt = (int)ctl[CW_NRT];
        pg8::Gemm g{HIDE, (const bf16*)(ws + W_EDN), NSLOT, 8192, 512}; MoeOrder S{(const int*)(ws + WS_TILEE), nrt, G, bx};
        EpiMoeDown E{YP, (const int*)(ws + WS_SDST), (const float*)(ws + WS_SW)}; pg8::gemm_phase<EpiMoeDown, MoeOrder, true, true>(lds, g, S, E);
        SEAM(15);
    }
    if (IN(16)) REP(16) {
        float oscale = 1.f;
#if DBG_CHECK
        oscale = 1.f + 0.25f * (float)__hip_atomic_load(ctl + CW_ERR, __ATOMIC_RELAXED, __HIP_MEMORY_SCOPE_AGENT);
#endif
        final_phase(args, vcu, G, oscale);
#if MK_ONE_LAUNCH
        if (bx == 0 && tid == 0) { if (__hip_atomic_load(ctl + CW_BAR + XB_TMO, __ATOMIC_RELAXED, __HIP_MEMORY_SCOPE_AGENT) != 0u) args.out[0] = __builtin_nanf(""); }
#endif
    }
#undef IN
#undef SEAM
}

extern "C" void kernel_launch(void* const* d_in, const int* in_sizes, int n_in, void* d_out, int out_size, void* d_ws, size_t ws_size, hipStream_t stream) {
    static int grid = 0;
    if (grid == 0) {
        if (n_in != 22 || in_sizes[0] != T * DM || out_size != T * DM || ws_size < WS_NEED) { fprintf(stderr, "kernel_launch: unexpected shapes (n_in %d, in0 %d, out %d, ws %zu < %zu); nothing launched\n", n_in, n_in > 0 ? in_sizes[0] : -1, out_size, ws_size, (size_t)WS_NEED); grid = -1; return; }
        int dev = 0, cus = 0, per_cu = 0;
        if (hipGetDevice(&dev) != hipSuccess || hipDeviceGetAttribute(&cus, hipDeviceAttributeMultiprocessorCount, dev) != hipSuccess) { grid = -1; return; }
        if (hipFuncSetAttribute((const void*)hybrid_fwd, hipFuncAttributeMaxDynamicSharedMemorySize, LDS_BYTES) != hipSuccess) { fprintf(stderr, "kernel_launch: hipFuncSetAttribute failed\n"); grid = -1; return; }
        if (hipOccupancyMaxActiveBlocksPerMultiprocessor(&per_cu, (const void*)hybrid_fwd, 512, LDS_BYTES) != hipSuccess || per_cu < 1) fprintf(stderr, "kernel_launch: occupancy query reports %d workgroups per CU\n", per_cu);
        (void)hipGetLastError();
        grid = cus;
    }
    if (grid < 0) return;
    if (hipMemsetAsync((char*)d_ws + WS_CTL, 0, CTL_ZERO_BYTES, stream) != hipSuccess) return;
    Args a{};
    for (int i = 0; i < 22; ++i) a.in[i] = (const float*)d_in[i];
    a.out = (float*)d_out; a.ws = (unsigned char*)d_ws;
#if MK_ONE_LAUNCH
    a.ph_lo = 0; a.ph_hi = NPH;
    hipLaunchKernelGGL(hybrid_fwd, dim3(grid), dim3(512), LDS_BYTES, stream, a);
#else
    for (int p = 0; p < NPH; ++p) { a.ph_lo = p; a.ph_hi = p + 1; hipLaunchKernelGGL(hybrid_fwd, dim3(grid), dim3(512), LDS_BYTES, stream, a); }
#endif
}
```

```cpp
#include <hip/hip_runtime.h>
#include <cstdio>
#include <cstdint>
#ifndef MK_ONE_LAUNCH
#define MK_ONE_LAUNCH 1
#endif
#ifndef PROBE_SEAMS
#define PROBE_SEAMS 0xFFFFF
#endif
#ifndef PROBE_DUP
#define PROBE_DUP 0
#endif
namespace pg8 {
#define PG8_LAS __attribute__((address_space(3)))
typedef unsigned short bf16_t;
typedef short bf16x8 __attribute__((ext_vector_type(8)));
typedef float f32x4 __attribute__((ext_vector_type(4)));
typedef unsigned u32x4 __attribute__((ext_vector_type(4)));
constexpr int BM = 256, BK = 64, HALF = 128, HTB = HALF * BK * 2  , STAGE_BYTES = 8 * HTB, NXCD = 8, WGM = 8;

__host__ __device__ __forceinline__ int lds_byte(int r, int c) { const int st = (r >> 4) * 2 + (c >> 5), rr = r & 15, cc = c & 31, ob = rr * 64 + cc * 2; return st * 1024 + (ob ^ (((ob >> 9) & 1) << 5)); }
__host__ __device__ __forceinline__ void stage_rc(int b, int& R, int& C) { const int st = b / 1024, sb = b % 1024, swz = sb ^ (((sb >> 9) & 1) << 5); R = (st >> 1) * 16 + swz / 64; C = (st & 1) * 32 + (swz % 64) / 2; }
__host__ __device__ __forceinline__ int perm32(int rho) { const int n = rho >> 4, i = rho & 15; return 8 * (i >> 2) + 4 * n + (i & 3); }

struct Unit { int pm, pn; };
struct Gemm { const bf16_t* A; const bf16_t* Bt; int M, N, K; const int* aidx; };

struct StaticOrder {
    int nM, nN, nwg, G, c;
    __host__ __device__ void init(int M, int N, int G_, int c_) { nM = M / BM; nN = N / BM; nwg = nM * nN; G = G_; c = c_; }
    __host__ __device__ bool next(int i, Unit& u) const {
        const long L = (long)i * G + c; if (L >= nwg) return false;
        int wgid = (int)L; { const int q = nwg / NXCD, r = nwg % NXCD, xcd = wgid % NXCD, off = wgid / NXCD; wgid = (xcd < r ? xcd * (q + 1) : r * (q + 1) + (xcd - r) * q) + off; }
        const int nig = WGM * nN, gid = wgid / nig, fm = gid * WGM, gsz = (nM - fm) < WGM ? (nM - fm) : WGM;
        u.pm = fm + ((wgid % nig) % gsz); u.pn = (wgid % nig) / gsz; return true;
    }
    __device__ __forceinline__ void a_ready(const Unit&) const {}
    __device__ __forceinline__ void done(const Unit&) const {}
};

__device__ __forceinline__ unsigned cvt_pk_bf16(float lo, float hi) { unsigned r; asm volatile("v_cvt_pk_bf16_f32 %0, %1, %2" : "=v"(r) : "v"(lo), "v"(hi)); return r; }
typedef float f32x2 __attribute__((ext_vector_type(2)));
template <class Epi, class Sched, bool ALIGN_EPI = false, bool SP2 = false, bool GATHER = false>
__device__ __forceinline__ void gemm_phase(PG8_LAS unsigned char* lds, const Gemm g, const Sched& S, const Epi& E) {
    static_assert(!GATHER || SP2, "the gather A path is wired into the two-super-phase loop only");
    int tid_ = threadIdx.x; asm volatile("" : "+v"(tid_));
    const int tid = tid_, wid = __builtin_amdgcn_readfirstlane(tid >> 6), lane = tid & 63, wr = wid >> 2, wc = wid & 3, fr = lane & 15, fq = lane >> 4;
    const int K = g.K, nt = K / BK;
    unsigned voffA[2], voffB[2];
#pragma unroll
    for (int i = 0; i < 2; ++i) { int R, C; stage_rc(tid * 16 + i * 8192, R, C); const int Rb = Epi::PERM ? ((R & ~31) + perm32(R & 31)) : R;
        voffA[i] = (unsigned)(R * K + C) * 2u; voffB[i] = (unsigned)(Rb * K + C) * 2u; }
    unsigned gA[2][2] = {{0u, 0u}, {0u, 0u}}, gN[2][2] = {{0u, 0u}, {0u, 0u}}; int gR[2] = {0, 0}, gC[2] = {0, 0};
    if constexpr (GATHER) {
#pragma unroll
        for (int i = 0; i < 2; ++i) stage_rc(tid * 16 + i * 8192, gR[i], gC[i]); }
#define PG8_GIDX(dst, pm) do { _Pragma("unroll") for (int _h = 0; _h < 2; ++_h) _Pragma("unroll") for (int _i = 0; _i < 2; ++_i) \
        dst[_h][_i] = (unsigned)(g.aidx[(pm) * BM + _h * HALF + gR[_i]] * K + gC[_i]) * 2u; } while (0)
    const size_t kstep = (size_t)(BK * 2);
    const size_t hstep = (size_t)HALF * K * 2;
    const size_t tstep = 2 * hstep;
    const unsigned ldsw = (unsigned)wid * 1024u;
    const int aoff = lds_byte(wr * 64 + fr, fq * 8), boff = lds_byte(wc * 32 + fr, fq * 8);
#define PG8_SA(b, h) (((b) * 2 + (h)) * HTB)
#define PG8_SB(b, h) ((4 + (b) * 2 + (h)) * HTB)
#define PG8_STAGE(bufoff, gbase, voff) do { _Pragma("unroll") for (int _i = 0; _i < 2; ++_i) \
        __builtin_amdgcn_global_load_lds((const unsigned*)((const char*)(gbase) + (voff)[_i]), (PG8_LAS unsigned*)(lds + (bufoff) + ldsw + _i * 8192), 16, 0, 0); } while (0)
#define PG8_STAGE_A(bufoff, gbase, hh, nx) do { if constexpr (GATHER) { _Pragma("unroll") for (int _i = 0; _i < 2; ++_i) \
        __builtin_amdgcn_global_load_lds((const unsigned*)((const char*)(gbase) + ((nx) ? gN[hh][_i] : gA[hh][_i])), (PG8_LAS unsigned*)(lds + (bufoff) + ldsw + _i * 8192), 16, 0, 0); } \
    else { PG8_STAGE(bufoff, (gbase) + (hh) * hstep, voffA); } } while (0)
#define PG8_LDA(dst, b, h) do { _Pragma("unroll") for (int m = 0; m < 4; ++m) _Pragma("unroll") for (int k = 0; k < 2; ++k) dst[m][k] = *(const PG8_LAS bf16x8*)(lds + PG8_SA(b, h) + aoff + m * 2048 + k * 1024); } while (0)
#define PG8_LDB(dst, b, h) do { _Pragma("unroll") for (int n = 0; n < 2; ++n) _Pragma("unroll") for (int k = 0; k < 2; ++k) dst[n][k] = *(const PG8_LAS bf16x8*)(lds + PG8_SB(b, h) + boff + n * 2048 + k * 1024); } while (0)
#define PG8_MMA(ai, bj, At, Bt) do { __builtin_amdgcn_s_setprio(1); _Pragma("unroll") for (int m = 0; m < 4; ++m) _Pragma("unroll") for (int n = 0; n < 2; ++n) _Pragma("unroll") for (int k = 0; k < 2; ++k) \
        acc[ai][bj][m][n] = __builtin_amdgcn_mfma_f32_16x16x32_bf16(Bt[n][k], At[m][k], acc[ai][bj][m][n], 0, 0, 0); __builtin_amdgcn_s_setprio(0); } while (0)
#define PG8_WAIT_V(n) asm volatile("s_waitcnt vmcnt(" #n ")" ::: "memory")
#define PG8_WAIT_L(n) asm volatile("s_waitcnt lgkmcnt(" #n ")" ::: "memory")
#define PG8_BAR __builtin_amdgcn_s_barrier()
#define PG8_SCHED __builtin_amdgcn_sched_barrier(0)
    Unit cur, nxt; int ui = 0;
    if (!S.next(0, cur)) return;
    f32x4 acc[2][2][4][2];
#pragma unroll
    for (int a = 0; a < 2; ++a)
#pragma unroll
        for (int b = 0; b < 2; ++b)
#pragma unroll
            for (int m = 0; m < 4; ++m)
#pragma unroll
                for (int n = 0; n < 2; ++n) acc[a][b][m][n] = (f32x4){0.f, 0.f, 0.f, 0.f};
    bf16x8 At[4][2], B0[2][2], B1[2][2];
    const char* cA = GATHER ? (const char*)g.A : (const char*)g.A + (size_t)cur.pm * tstep; const char* cB = (const char*)g.Bt + (size_t)cur.pn * tstep;
    if constexpr (GATHER) { PG8_GIDX(gA, cur.pm); }
    S.a_ready(cur);
    if constexpr (SP2) {
        PG8_STAGE(PG8_SB(0, 0), cB, voffB); PG8_STAGE(PG8_SB(0, 1), cB + hstep, voffB); PG8_STAGE_A(PG8_SA(0, 0), cA, 0, false); PG8_STAGE_A(PG8_SA(0, 1), cA, 1, false);
        if (wr == 1) PG8_BAR;
        PG8_WAIT_V(2); PG8_BAR;
        PG8_STAGE(PG8_SB(1, 0), cB + kstep, voffB); PG8_STAGE_A(PG8_SA(1, 0), cA + kstep, 0, false); PG8_STAGE(PG8_SB(1, 1), cB + hstep + kstep, voffB);
        PG8_WAIT_V(6); PG8_BAR;
    } else {
        PG8_STAGE(PG8_SB(0, 0), cB, voffB); PG8_STAGE(PG8_SA(0, 0), cA, voffA); PG8_STAGE(PG8_SB(0, 1), cB + hstep, voffB); PG8_STAGE(PG8_SA(0, 1), cA + hstep, voffA);
        if (wr == 1) PG8_BAR;
        PG8_WAIT_V(4); PG8_BAR;
        PG8_STAGE(PG8_SB(1, 0), cB + kstep, voffB); PG8_STAGE(PG8_SA(1, 0), cA + kstep, voffA); PG8_STAGE(PG8_SB(1, 1), cB + hstep + kstep, voffB);
        PG8_WAIT_V(6); PG8_BAR;
    }
    for (;;) {
        const bool has_next = S.next(ui + 1, nxt);
        const char* nA = GATHER ? (const char*)g.A : (has_next ? (const char*)g.A + (size_t)nxt.pm * tstep : cA); const char* nB = has_next ? (const char*)g.Bt + (size_t)nxt.pn * tstep : cB;
        if constexpr (GATHER) { if (has_next) { PG8_GIDX(gN, nxt.pm); } else { _Pragma("unroll") for (int _h = 0; _h < 2; ++_h) _Pragma("unroll") for (int _i = 0; _i < 2; ++_i) gN[_h][_i] = gA[_h][_i]; } }
#pragma unroll 1
        for (int t = 0; t < nt; t += 2) {
            const bool last = (t == nt - 2);
            const char* a1 = cA + (size_t)(t + 1) * kstep;
            const char* a2 = last ? nA : cA + (size_t)(t + 2) * kstep; const char* b2 = last ? nB : cB + (size_t)(t + 2) * kstep;
            const char* a3 = a2 + kstep; const char* b3 = b2 + kstep;
            if (last && has_next) S.a_ready(nxt);
            if constexpr (SP2) {
            PG8_LDB(B0, 0, 0); PG8_LDB(B1, 0, 1); PG8_SCHED; PG8_LDA(At, 0, 0); PG8_STAGE_A(PG8_SA(1, 1), a1, 1, false);
            PG8_WAIT_V(8); PG8_WAIT_L(0); PG8_BAR; PG8_MMA(0, 0, At, B0); PG8_MMA(0, 1, At, B1); PG8_BAR; PG8_SCHED;
            PG8_LDA(At, 0, 1); PG8_STAGE(PG8_SB(0, 0), b2, voffB); PG8_STAGE(PG8_SB(0, 1), b2 + hstep, voffB); PG8_STAGE_A(PG8_SA(0, 0), a2, 0, last);
            PG8_WAIT_V(8); PG8_WAIT_L(0); PG8_BAR; PG8_MMA(1, 0, At, B0); PG8_MMA(1, 1, At, B1); PG8_BAR; PG8_SCHED;
            PG8_LDB(B0, 1, 0); PG8_LDB(B1, 1, 1); PG8_SCHED; PG8_LDA(At, 1, 0); PG8_STAGE_A(PG8_SA(0, 1), a2, 1, last);
            PG8_WAIT_V(8); PG8_WAIT_L(0); PG8_BAR; PG8_MMA(0, 0, At, B0); PG8_MMA(0, 1, At, B1); PG8_BAR; PG8_SCHED;
            PG8_LDA(At, 1, 1); PG8_STAGE(PG8_SB(1, 0), b3, voffB); PG8_STAGE(PG8_SB(1, 1), b3 + hstep, voffB); PG8_STAGE_A(PG8_SA(1, 0), a3, 0, last);
            PG8_WAIT_V(8); PG8_WAIT_L(0); PG8_BAR; PG8_MMA(1, 0, At, B0); PG8_MMA(1, 1, At, B1); PG8_BAR; PG8_SCHED;
            } else {
            PG8_LDB(B0, 0, 0); PG8_SCHED; PG8_LDA(At, 0, 0); PG8_STAGE(PG8_SA(1, 1), a1 + hstep, voffA);
            PG8_WAIT_L(8); PG8_BAR; PG8_WAIT_L(0); PG8_MMA(0, 0, At, B0); PG8_BAR; PG8_SCHED;
            PG8_LDB(B1, 0, 1); PG8_STAGE(PG8_SB(0, 0), b2, voffB);
            PG8_BAR; PG8_WAIT_L(0); PG8_MMA(0, 1, At, B1); PG8_BAR;
            PG8_LDA(At, 0, 1); PG8_STAGE(PG8_SA(0, 0), a2, voffA);
            PG8_BAR; PG8_WAIT_L(0); PG8_MMA(1, 0, At, B0); PG8_BAR; PG8_SCHED;
            PG8_STAGE(PG8_SB(0, 1), b2 + hstep, voffB);
            PG8_WAIT_V(6); PG8_BAR; PG8_MMA(1, 1, At, B1); PG8_BAR;
            PG8_LDB(B0, 1, 0); PG8_SCHED; PG8_LDA(At, 1, 0); PG8_STAGE(PG8_SA(0, 1), a2 + hstep, voffA);
            PG8_WAIT_L(8); PG8_BAR; PG8_WAIT_L(0); PG8_MMA(0, 0, At, B0); PG8_BAR; PG8_SCHED;
            PG8_LDB(B1, 1, 1); PG8_STAGE(PG8_SB(1, 0), b3, voffB);
            PG8_BAR; PG8_WAIT_L(0); PG8_MMA(0, 1, At, B1); PG8_BAR;
            PG8_LDA(At, 1, 1); PG8_STAGE(PG8_SA(1, 0), a3, voffA);
            PG8_BAR; PG8_WAIT_L(0); PG8_MMA(1, 0, At, B0); PG8_BAR; PG8_SCHED;
            PG8_STAGE(PG8_SB(1, 1), b3 + hstep, voffB);
            PG8_WAIT_V(6); PG8_BAR; PG8_MMA(1, 1, At, B1); PG8_BAR;
            }
        }
        if constexpr (ALIGN_EPI) { if (wr == 0) PG8_BAR; }
        if constexpr (!Epi::AFTER_DRAIN) { E(acc, cur, wr, wc, fr, fq); S.done(cur); }
        if (!has_next) break;
#pragma unroll
        for (int a = 0; a < 2; ++a)
#pragma unroll
            for (int b = 0; b < 2; ++b)
#pragma unroll
                for (int m = 0; m < 4; ++m)
#pragma unroll
                    for (int n = 0; n < 2; ++n) acc[a][b][m][n] = (f32x4){0.f, 0.f, 0.f, 0.f};
        cur = nxt; cA = nA; cB = nB; ++ui;
        if constexpr (GATHER) { _Pragma("unroll") for (int _h = 0; _h < 2; ++_h) _Pragma("unroll") for (int _i = 0; _i < 2; ++_i) gA[_h][_i] = gN[_h][_i]; }
        if constexpr (ALIGN_EPI) { if (wr == 1) PG8_BAR; }
    }
    PG8_WAIT_V(0);
    if constexpr (!ALIGN_EPI) { if (wr == 0) PG8_BAR; }
    PG8_BAR;
    if constexpr (Epi::AFTER_DRAIN) { E.fused(acc, cur, wr, wc, fr, fq, lds, wid, lane); S.done(cur); }
#undef PG8_SA
#undef PG8_SB
#undef PG8_STAGE
#undef PG8_STAGE_A
#undef PG8_GIDX
#undef PG8_LDA
#undef PG8_LDB
#undef PG8_MMA
#undef PG8_WAIT_V
#undef PG8_WAIT_L
#undef PG8_BAR
#undef PG8_SCHED
}
}

#define DI __device__ __forceinline__
#define LAS __attribute__((address_space(3)))
#define GAS __attribute__((address_space(1)))
typedef unsigned short bf16;
constexpr int BATCH = 2, SEQ = 16384, T = BATCH * SEQ, DM = 1024;
constexpr float LOG2E = 1.4426950408889634f;
constexpr float RMS_EPS = 1e-6f;
DI int rfl(int v) { return __builtin_amdgcn_readfirstlane(v); }
DI float bflo(unsigned w) { return __uint_as_float(w << 16); }
DI float bfhi(unsigned w) { return __uint_as_float(w & 0xffff0000u); }
typedef float f32x2_t __attribute__((ext_vector_type(2))); typedef __bf16 bf16x2_t __attribute__((ext_vector_type(2)));
DI unsigned cvtpk(float lo, float hi) { f32x2_t v = {lo, hi}; bf16x2_t b = __builtin_convertvector(v, bf16x2_t); return __builtin_bit_cast(unsigned, b); }
typedef float f32x4 __attribute__((ext_vector_type(4)));
typedef unsigned v4u __attribute__((ext_vector_type(4)));
DI float ex2(float x) { return __builtin_amdgcn_exp2f(x); }
DI float lg2(float x) { return __builtin_amdgcn_logf(x); }
DI float wave_sum(float v) {
#pragma unroll
    for (int o = 1; o < 64; o <<= 1) v += __shfl_xor(v, o);
    return v;
}

namespace att {
typedef short bf16x8 __attribute__((ext_vector_type(8)));
typedef short s16x4 __attribute__((ext_vector_type(4)));
typedef float f32x16 __attribute__((ext_vector_type(16)));
typedef unsigned u32x4 __attribute__((ext_vector_type(4)));
typedef LAS const char* lcp;
typedef short v4i16_t __attribute__((ext_vector_type(4)));
DI int crow(int r, int hi) { return (r & 3) + 8 * (r >> 2) + 4 * hi; }
DI void glds16(const void* gsrc, unsigned lds_dst) { unsigned keep;
    asm volatile("s_mov_b32 %0, m0\n\ts_mov_b32 m0, %2\n\ts_nop 0\n\tglobal_load_lds_dwordx4 %1, off\n\ts_mov_b32 m0, %0" : "=&s"(keep) : "v"(gsrc), "s"(lds_dst) : "memory"); }
#define ATT_WAITV_BAR() asm volatile("s_waitcnt vmcnt(0) lgkmcnt(0)\n\ts_barrier" ::: "memory")
#define ATT_BAR() asm volatile("s_waitcnt lgkmcnt(0)\n\ts_barrier" ::: "memory")
#define WAVE_LDS_SYNC() asm volatile("" ::: "memory")
DI s16x4 vtr(lcp p) { return __builtin_bit_cast(s16x4, __builtin_amdgcn_ds_read_tr16_b64_v4i16((LAS v4i16_t*)p)); }
DI float hmax(float x) { auto rr = __builtin_amdgcn_permlane32_swap(__float_as_uint(x), __float_as_uint(x), false, false); return fmaxf(__uint_as_float(rr[0]), __uint_as_float(rr[1])); }
DI float hsum(float x) { auto rr = __builtin_amdgcn_permlane32_swap(__float_as_uint(x), __float_as_uint(x), false, false); return __uint_as_float(rr[0]) + __uint_as_float(rr[1]); }

template <int NK> DI void qk_tile(f32x16& p0, f32x16& p1, lcp kfr, const bf16x8* qr) {
    f32x16 z;
#pragma unroll
    for (int r = 0; r < 16; ++r) z[r] = 0.f;
    p0 = z; p1 = z;
    bf16x8 kf[2 * NK];
#pragma unroll
    for (int d0 = 0; d0 < NK; ++d0) { kf[2 * d0] = *(const LAS bf16x8*)(kfr + d0 * 2048); kf[2 * d0 + 1] = *(const LAS bf16x8*)(kfr + d0 * 2048 + 512); }
    __builtin_amdgcn_sched_barrier(0);
#pragma unroll
    for (int d0 = 0; d0 < NK; ++d0) { p0 = __builtin_amdgcn_mfma_f32_32x32x16_bf16(kf[2 * d0], qr[d0], p0, 0, 0, 0); p1 = __builtin_amdgcn_mfma_f32_32x32x16_bf16(kf[2 * d0 + 1], qr[d0], p1, 0, 0, 0); }
    __builtin_amdgcn_sched_barrier(0);
}
DI void pv_tile(f32x16* o, lcp vfr, const f32x16& p0, const f32x16& p1) {
    u32x4 pw[4];
    pw[0] = (u32x4){cvtpk(p0[0], p0[1]), cvtpk(p0[2], p0[3]), cvtpk(p0[4], p0[5]), cvtpk(p0[6], p0[7])};
    pw[1] = (u32x4){cvtpk(p0[8], p0[9]), cvtpk(p0[10], p0[11]), cvtpk(p0[12], p0[13]), cvtpk(p0[14], p0[15])};
    pw[2] = (u32x4){cvtpk(p1[0], p1[1]), cvtpk(p1[2], p1[3]), cvtpk(p1[4], p1[5]), cvtpk(p1[6], p1[7])};
    pw[3] = (u32x4){cvtpk(p1[8], p1[9]), cvtpk(p1[10], p1[11]), cvtpk(p1[12], p1[13]), cvtpk(p1[14], p1[15])};
#pragma unroll
    for (int d0 = 0; d0 < 2; ++d0) {
        s16x4 lo[4], hh[4];
#pragma unroll
        for (int ks = 0; ks < 4; ++ks) { lo[ks] = vtr(vfr + d0 * 4096 + ks * 1024); hh[ks] = vtr(vfr + d0 * 4096 + ks * 1024 + 512); }
        __builtin_amdgcn_sched_barrier(0);
#pragma unroll
        for (int ks = 0; ks < 4; ++ks) { const bf16x8 vf = (bf16x8){lo[ks][0], lo[ks][1], lo[ks][2], lo[ks][3], hh[ks][0], hh[ks][1], hh[ks][2], hh[ks][3]};
            o[d0] = __builtin_amdgcn_mfma_f32_32x32x16_bf16(__builtin_bit_cast(bf16x8, pw[ks]), vf, o[d0], 0, 0, 0); }
        __builtin_amdgcn_sched_barrier(0);
    }
}
DI void smax_update(f32x16& p0, f32x16& p1, float& mref, float& lsum, f32x16* o, LAS float* wsf, int r32, int hi) {
    float rm = fmaxf(p0[0], p1[0]);
#pragma unroll
    for (int r = 1; r < 16; ++r) rm = fmaxf(rm, fmaxf(p0[r], p1[r]));
    rm = hmax(rm);
    if (__any(rm > mref + 8.f)) {
        const float mnew = fmaxf(mref, rm);
        const float alpha = (mnew == mref) ? 1.f : ex2(mref - mnew);
        lsum *= alpha; mref = mnew;
        if (hi == 0) wsf[r32] = alpha;
        WAVE_LDS_SYNC();
#pragma unroll
        for (int r = 0; r < 16; ++r) { const float a = wsf[crow(r, hi)]; o[0][r] *= a; o[1][r] *= a; }
        WAVE_LDS_SYNC();
    }
    float s = 0.f;
#pragma unroll
    for (int r = 0; r < 16; ++r) { p0[r] = ex2(p0[r] - mref); p1[r] = ex2(p1[r] - mref); s += p0[r] + p1[r]; }
    lsum += s;
}
DI void stage_o(const f32x16* o, LAS bf16* stg, const LAS float* rowscale, int r32, int hi) {
    WAVE_LDS_SYNC();
#pragma unroll
    for (int r = 0; r < 16; ++r) { const int orow = crow(r, hi); const float sc = rowscale ? rowscale[orow] : 1.f;
        const unsigned a = cvtpk(o[0][r] * sc, o[1][r] * sc);
        stg[orow * 64 + r32] = (bf16)(a & 0xffffu); stg[orow * 64 + 32 + r32] = (bf16)(a >> 16); }
    WAVE_LDS_SYNC();
}

constexpr int MLA_KSLOT = 12288, VSLOT = 8192;
constexpr int MLA_OFF_V = 3 * MLA_KSLOT, MLA_OFF_WS = MLA_OFF_V + 3 * VSLOT, MLA_OFF_ST = MLA_OFF_WS + 8 * 256, MLA_LDS = MLA_OFF_ST + 8 * 4096;
template <int NK> DI void qk_tile_ref(f32x16& p0, f32x16& p1, lcp kfr, const bf16x8* qr, const f32x16& negm) {
    p0 = negm; p1 = negm;
    constexpr int H = NK / 2;
#pragma unroll
    for (int hb = 0; hb < 2; ++hb) {
        bf16x8 kf[2 * H];
#pragma unroll
        for (int d = 0; d < H; ++d) { const int d0 = hb * H + d; kf[2 * d] = *(const LAS bf16x8*)(kfr + d0 * 2048); kf[2 * d + 1] = *(const LAS bf16x8*)(kfr + d0 * 2048 + 512); }
        __builtin_amdgcn_sched_barrier(0);
#pragma unroll
        for (int d = 0; d < H; ++d) { const int d0 = hb * H + d; p0 = __builtin_amdgcn_mfma_f32_32x32x16_bf16(kf[2 * d], qr[d0], p0, 0, 0, 0); p1 = __builtin_amdgcn_mfma_f32_32x32x16_bf16(kf[2 * d + 1], qr[d0], p1, 0, 0, 0); }
        __builtin_amdgcn_sched_barrier(0);
    }
}
DI void smax_update_ref(f32x16& p0, f32x16& p1, float& mref, f32x16& negm, float& lsum, f32x16* o, LAS float* wsf, int r32, int hi, bool first) {
    float ra = __builtin_fmaxf(__builtin_fmaxf(p0[0], p0[1]), p1[0]), rb = __builtin_fmaxf(__builtin_fmaxf(p0[2], p0[3]), p1[1]);
    ra = __builtin_fmaxf(__builtin_fmaxf(ra, p1[2]), p1[3]);
#pragma unroll
    for (int r = 4; r < 16; r += 4) { ra = __builtin_fmaxf(__builtin_fmaxf(ra, p0[r]), p0[r + 1]); rb = __builtin_fmaxf(__builtin_fmaxf(rb, p0[r + 2]), p0[r + 3]);
        ra = __builtin_fmaxf(__builtin_fmaxf(ra, p1[r]), p1[r + 1]); rb = __builtin_fmaxf(__builtin_fmaxf(rb, p1[r + 2]), p1[r + 3]); }
    const float rm = hmax(fmaxf(ra, rb));
    if (first || __any(rm > 8.f)) {
        const float dl = first ? rm : fmaxf(rm, 0.f);
        mref += dl;
#pragma unroll
        for (int r = 0; r < 16; ++r) { p0[r] -= dl; p1[r] -= dl; }
#pragma unroll
        for (int r = 0; r < 16; ++r) negm[r] = -mref;
        if (!first) { const float alpha = ex2(-dl); lsum *= alpha;
            if (hi == 0) wsf[r32] = alpha;
            WAVE_LDS_SYNC();
#pragma unroll
            for (int r = 0; r < 16; ++r) { const float a = wsf[crow(r, hi)]; o[0][r] *= a; o[1][r] *= a; }
            WAVE_LDS_SYNC(); }
    }
    float s = 0.f;
#pragma unroll
    for (int r = 0; r < 16; ++r) { p0[r] = ex2(p0[r]); p1[r] = ex2(p1[r]); s += p0[r] + p1[r]; }
    lsum += s;
}
DI void mla_unit(int bh, int qb, const bf16* QA, const bf16* KN, const bf16* KR, const bf16* VA, bf16* OC, LAS unsigned char* lds) {
    int tid_ = threadIdx.x; asm volatile("" : "+v"(tid_));
    const int tid = tid_, lane = tid & 63, r32 = lane & 31, hi = lane >> 5, wid = rfl(tid >> 6);
    const int b = bh >> 3, h = bh & 7; const long rowbase = (long)b * SEQ; const int q0 = qb * 256;
    const unsigned lds0 = (unsigned)(size_t)lds;
    LAS float* wsf = (LAS float*)(lds + MLA_OFF_WS) + wid * 64;
    LAS bf16* stg = (LAS bf16*)(lds + MLA_OFF_ST) + wid * 2048;
    const bf16* ksrc = KN + (rowbase + lane) * 512 + h * 64 + wid * 8;
    const bf16* rsrc = KR + (rowbase + lane) * 32 + (wid & 3) * 8;
    const bf16* vsrc = VA + (rowbase + 16 * (wid & 3) + (lane >> 2)) * 512 + h * 64 + (wid >> 2) * 32 + (lane & 3) * 8;
#define MLA_DMA_K(t, s) do { glds16(ksrc + (long)(t) * 64 * 512, (unsigned)rfl((int)(lds0 + (s) * MLA_KSLOT + wid * 1024))); \
        if (wid < 4) glds16(rsrc + (long)(t) * 64 * 32, (unsigned)rfl((int)(lds0 + (s) * MLA_KSLOT + (8 + wid) * 1024))); } while (0)
#define MLA_DMA_V(t, s) glds16(vsrc + (long)(t) * 64 * 512, (unsigned)rfl((int)(lds0 + MLA_OFF_V + (s) * VSLOT + wid * 1024)))
    const bf16* qp = QA + (rowbase + q0 + wid * 32 + r32) * 768 + h * 96 + hi * 8;
    bf16x8 qr[6];
#pragma unroll
    for (int d0 = 0; d0 < 6; ++d0) qr[d0] = *(const bf16x8*)(qp + d0 * 16);
    const int NT = 4 * (qb + 1);
    const lcp kfr = (lcp)lds + hi * 1024 + r32 * 16;
    const lcp vfr = (lcp)lds + MLA_OFF_V + ((lane >> 4) & 1) * 32 + (lane & 3) * 8 + (4 * hi + ((lane & 15) >> 2)) * 64;
    float mref = 0.f, lsum = 0.f; f32x16 o[2], negm;
#pragma unroll
    for (int r = 0; r < 16; ++r) { o[0][r] = 0.f; o[1][r] = 0.f; negm[r] = 0.f; }
    const int qrel = 32 * wid + r32;
#define MLA_MASK(P0, P1, t) do { const int jb_ = (t) - (NT - 4); if (jb_ >= 0 && 64 * jb_ + 63 > 32 * wid) { \
        _Pragma("unroll") for (int r = 0; r < 16; ++r) { const int kv = 64 * jb_ + crow(r, hi); if (kv > qrel) P0[r] = -INFINITY; if (kv + 32 > qrel) P1[r] = -INFINITY; } } } while (0)
#define MLA_ROWMAX(P0, P1, rm) do { float ra_ = __builtin_fmaxf(__builtin_fmaxf(P0[0], P0[1]), P1[0]), rb_ = __builtin_fmaxf(__builtin_fmaxf(P0[2], P0[3]), P1[1]); ra_ = __builtin_fmaxf(__builtin_fmaxf(ra_, P1[2]), P1[3]); \
        _Pragma("unroll") for (int r = 4; r < 16; r += 4) { ra_ = __builtin_fmaxf(__builtin_fmaxf(ra_, P0[r]), P0[r + 1]); rb_ = __builtin_fmaxf(__builtin_fmaxf(rb_, P0[r + 2]), P0[r + 3]); \
            ra_ = __builtin_fmaxf(__builtin_fmaxf(ra_, P1[r]), P1[r + 1]); rb_ = __builtin_fmaxf(__builtin_fmaxf(rb_, P1[r + 2]), P1[r + 3]); } rm = hmax(fmaxf(ra_, rb_)); } while (0)
    MLA_DMA_K(0, 0); MLA_DMA_V(0, 0); MLA_DMA_K(1, 1);
    ATT_WAITV_BAR();
    MLA_DMA_K(2, 2); MLA_DMA_V(1, 1);
    f32x16 pa0, pa1, pb0, pb1;
    qk_tile_ref<6>(pa0, pa1, kfr, qr, negm); MLA_MASK(pa0, pa1, 0);
    { float rm; MLA_ROWMAX(pa0, pa1, rm); mref = rm;
#pragma unroll
      for (int r = 0; r < 16; ++r) { pa0[r] = ex2(pa0[r] - rm); pa1[r] = ex2(pa1[r] - rm); negm[r] = -rm; } }
    int kc = 1, kn = 2, kf_ = 0, vc = 0, vn = 1, vf_ = 2;
#define MLA_KLD(i) kf_##i = *(const LAS bf16x8*)(kb_ + ((i) >> 1) * 2048 + ((i) & 1) * 512)
#define MLA_VLD(i) do { vl_[i] = vtr(vb_ + ((i) >> 2) * 4096 + ((i) & 3) * 1024); vh_[i] = vtr(vb_ + ((i) >> 2) * 4096 + ((i) & 3) * 1024 + 512); } while (0)
#define MLA_PIN(x) asm volatile("" : "+v"(x))
#define MLA_STEP(C0, C1, P0, P1, t) do { \
        ATT_WAITV_BAR();                                               \
        if ((t) + 2 < NT) MLA_DMA_K((t) + 2, kf_); \
        if ((t) + 1 < NT) MLA_DMA_V((t) + 1, vf_); \
          \
        const lcp kb_ = kfr + kc * MLA_KSLOT; const lcp vb_ = vfr + vc * VSLOT; \
        bf16x8 kf_0, kf_1, kf_2, kf_3, kf_4, kf_5, kf_6, kf_7, kf_8, kf_9, kf_10, kf_11; s16x4 vl_[8], vh_[8]; u32x4 pw_[4]; float sacc_ = 0.f; \
        MLA_KLD(0); MLA_KLD(1); MLA_KLD(2); MLA_KLD(3); \
        MLA_KLD(4); C0 = __builtin_amdgcn_mfma_f32_32x32x16_bf16(kf_0, qr[0], negm, 0, 0, 0); sacc_ += P0[0]; sacc_ += P0[1]; sacc_ += P0[2]; MLA_PIN(sacc_); pw_[0][0] = cvtpk(P0[0], P0[1]); MLA_PIN(pw_[0]); __builtin_amdgcn_sched_barrier(0); \
        MLA_KLD(5); C1 = __builtin_amdgcn_mfma_f32_32x32x16_bf16(kf_1, qr[0], negm, 0, 0, 0); sacc_ += P0[3]; sacc_ += P0[4]; sacc_ += P0[5]; MLA_PIN(sacc_); pw_[0][1] = cvtpk(P0[2], P0[3]); MLA_PIN(pw_[0]); __builtin_amdgcn_sched_barrier(0); \
        MLA_KLD(6); C0 = __builtin_amdgcn_mfma_f32_32x32x16_bf16(kf_2, qr[1], C0, 0, 0, 0); sacc_ += P0[6]; sacc_ += P0[7]; sacc_ += P0[8]; MLA_PIN(sacc_); pw_[0][2] = cvtpk(P0[4], P0[5]); MLA_PIN(pw_[0]); __builtin_amdgcn_sched_barrier(0); \
        MLA_KLD(7); C1 = __builtin_amdgcn_mfma_f32_32x32x16_bf16(kf_3, qr[1], C1, 0, 0, 0); sacc_ += P0[9]; sacc_ += P0[10]; sacc_ += P0[11]; MLA_PIN(sacc_); pw_[0][3] = cvtpk(P0[6], P0[7]); MLA_PIN(pw_[0]); __builtin_amdgcn_sched_barrier(0); \
        MLA_KLD(8); MLA_VLD(0); C0 = __builtin_amdgcn_mfma_f32_32x32x16_bf16(kf_4, qr[2], C0, 0, 0, 0); sacc_ += P0[12]; sacc_ += P0[13]; sacc_ += P0[14]; MLA_PIN(sacc_); pw_[1][0] = cvtpk(P0[8], P0[9]); MLA_PIN(pw_[1]); pw_[1][1] = cvtpk(P0[10], P0[11]); MLA_PIN(pw_[1]); __builtin_amdgcn_sched_barrier(0); \
        MLA_KLD(9); MLA_VLD(1); C1 = __builtin_amdgcn_mfma_f32_32x32x16_bf16(kf_5, qr[2], C1, 0, 0, 0); sacc_ += P0[15]; sacc_ += P1[0]; sacc_ += P1[1]; MLA_PIN(sacc_); pw_[1][2] = cvtpk(P0[12], P0[13]); MLA_PIN(pw_[1]); pw_[1][3] = cvtpk(P0[14], P0[15]); MLA_PIN(pw_[1]); __builtin_amdgcn_sched_barrier(0); \
        MLA_KLD(10); MLA_VLD(2); C0 = __builtin_amdgcn_mfma_f32_32x32x16_bf16(kf_6, qr[3], C0, 0, 0, 0); sacc_ += P1[2]; sacc_ += P1[3]; sacc_ += P1[4]; MLA_PIN(sacc_); pw_[2][0] = cvtpk(P1[0], P1[1]); MLA_PIN(pw_[2]); pw_[2][1] = cvtpk(P1[2], P1[3]); MLA_PIN(pw_[2]); __builtin_amdgcn_sched_barrier(0); \
        MLA_KLD(11); MLA_VLD(3); C1 = __builtin_amdgcn_mfma_f32_32x32x16_bf16(kf_7, qr[3], C1, 0, 0, 0); sacc_ += P1[5]; sacc_ += P1[6]; sacc_ += P1[7]; MLA_PIN(sacc_); pw_[2][2] = cvtpk(P1[4], P1[5]); MLA_PIN(pw_[2]); pw_[2][3] = cvtpk(P1[6], P1[7]); MLA_PIN(pw_[2]); __builtin_amdgcn_sched_barrier(0); \
        MLA_VLD(4); C0 = __builtin_amdgcn_mfma_f32_32x32x16_bf16(kf_8, qr[4], C0, 0, 0, 0); sacc_ += P1[8]; sacc_ += P1[9]; MLA_PIN(sacc_); pw_[3][0] = cvtpk(P1[8], P1[9]); MLA_PIN(pw_[3]); __builtin_amdgcn_sched_barrier(0); \
        MLA_VLD(5); C1 = __builtin_amdgcn_mfma_f32_32x32x16_bf16(kf_9, qr[4], C1, 0, 0, 0); sacc_ += P1[10]; sacc_ += P1[11]; MLA_PIN(sacc_); pw_[3][1] = cvtpk(P1[10], P1[11]); MLA_PIN(pw_[3]); __builtin_amdgcn_sched_barrier(0); \
        MLA_VLD(6); C0 = __builtin_amdgcn_mfma_f32_32x32x16_bf16(kf_10, qr[5], C0, 0, 0, 0); sacc_ += P1[12]; sacc_ += P1[13]; MLA_PIN(sacc_); pw_[3][2] = cvtpk(P1[12], P1[13]); MLA_PIN(pw_[3]); __builtin_amdgcn_sched_barrier(0); \
        MLA_VLD(7); C1 = __builtin_amdgcn_mfma_f32_32x32x16_bf16(kf_11, qr[5], C1, 0, 0, 0); sacc_ += P1[14]; sacc_ += P1[15]; MLA_PIN(sacc_); pw_[3][3] = cvtpk(P1[14], P1[15]); MLA_PIN(pw_[3]); __builtin_amdgcn_sched_barrier(0); \
        lsum += sacc_; \
          \
        __builtin_amdgcn_sched_barrier(0); \
        o[0] = __builtin_amdgcn_mfma_f32_32x32x16_bf16(__builtin_bit_cast(bf16x8, pw_[0]), (bf16x8){vl_[0][0], vl_[0][1], vl_[0][2], vl_[0][3], vh_[0][0], vh_[0][1], vh_[0][2], vh_[0][3]}, o[0], 0, 0, 0); o[1] = __builtin_amdgcn_mfma_f32_32x32x16_bf16(__builtin_bit_cast(bf16x8, pw_[0]), (bf16x8){vl_[4][0], vl_[4][1], vl_[4][2], vl_[4][3], vh_[4][0], vh_[4][1], vh_[4][2], vh_[4][3]}, o[1], 0, 0, 0); \
        MLA_MASK(C0, C1, t); \
        float rm_; MLA_ROWMAX(C0, C1, rm_); \
        bool resc_ = false; float alpha_ = 1.f; \
        if (__any(rm_ > 8.f)) { const float dl = fmaxf(rm_, 0.f); mref += dl; alpha_ = ex2(-dl); lsum *= alpha_; resc_ = true; \
            _Pragma("unroll") for (int r = 0; r < 16; ++r) { C0[r] -= dl; C1[r] -= dl; negm[r] = -mref; } } \
          \
        __builtin_amdgcn_sched_barrier(0); \
        o[0] = __builtin_amdgcn_mfma_f32_32x32x16_bf16(__builtin_bit_cast(bf16x8, pw_[1]), (bf16x8){vl_[1][0], vl_[1][1], vl_[1][2], vl_[1][3], vh_[1][0], vh_[1][1], vh_[1][2], vh_[1][3]}, o[0], 0, 0, 0); C0[0] = ex2(C0[0]); C0[1] = ex2(C0[1]); C0[2] = ex2(C0[2]); C0[3] = ex2(C0[3]); C0[4] = ex2(C0[4]); MLA_PIN(C0); MLA_PIN(C1); __builtin_amdgcn_sched_barrier(0); \
        o[1] = __builtin_amdgcn_mfma_f32_32x32x16_bf16(__builtin_bit_cast(bf16x8, pw_[1]), (bf16x8){vl_[5][0], vl_[5][1], vl_[5][2], vl_[5][3], vh_[5][0], vh_[5][1], vh_[5][2], vh_[5][3]}, o[1], 0, 0, 0); C0[5] = ex2(C0[5]); C0[6] = ex2(C0[6]); C0[7] = ex2(C0[7]); C0[8] = ex2(C0[8]); C0[9] = ex2(C0[9]); MLA_PIN(C0); MLA_PIN(C1); __builtin_amdgcn_sched_barrier(0); \
        o[0] = __builtin_amdgcn_mfma_f32_32x32x16_bf16(__builtin_bit_cast(bf16x8, pw_[2]), (bf16x8){vl_[2][0], vl_[2][1], vl_[2][2], vl_[2][3], vh_[2][0], vh_[2][1], vh_[2][2], vh_[2][3]}, o[0], 0, 0, 0); C0[10] = ex2(C0[10]); C0[11] = ex2(C0[11]); C0[12] = ex2(C0[12]); C0[13] = ex2(C0[13]); C0[14] = ex2(C0[14]); MLA_PIN(C0); MLA_PIN(C1); __builtin_amdgcn_sched_barrier(0); \
        o[1] = __builtin_amdgcn_mfma_f32_32x32x16_bf16(__builtin_bit_cast(bf16x8, pw_[2]), (bf16x8){vl_[6][0], vl_[6][1], vl_[6][2], vl_[6][3], vh_[6][0], vh_[6][1], vh_[6][2], vh_[6][3]}, o[1], 0, 0, 0); C0[15] = ex2(C0[15]); C1[0] = ex2(C1[0]); C1[1] = ex2(C1[1]); C1[2] = ex2(C1[2]); C1[3] = ex2(C1[3]); MLA_PIN(C0); MLA_PIN(C1); __builtin_amdgcn_sched_barrier(0); \
        o[0] = __builtin_amdgcn_mfma_f32_32x32x16_bf16(__builtin_bit_cast(bf16x8, pw_[3]), (bf16x8){vl_[3][0], vl_[3][1], vl_[3][2], vl_[3][3], vh_[3][0], vh_[3][1], vh_[3][2], vh_[3][3]}, o[0], 0, 0, 0); C1[4] = ex2(C1[4]); C1[5] = ex2(C1[5]); C1[6] = ex2(C1[6]); C1[7] = ex2(C1[7]); C1[8] = ex2(C1[8]); MLA_PIN(C0); MLA_PIN(C1); __builtin_amdgcn_sched_barrier(0); \
        o[1] = __builtin_amdgcn_mfma_f32_32x32x16_bf16(__builtin_bit_cast(bf16x8, pw_[3]), (bf16x8){vl_[7][0], vl_[7][1], vl_[7][2], vl_[7][3], vh_[7][0], vh_[7][1], vh_[7][2], vh_[7][3]}, o[1], 0, 0, 0); C1[9] = ex2(C1[9]); C1[10] = ex2(C1[10]); C1[11] = ex2(C1[11]); C1[12] = ex2(C1[12]); C1[13] = ex2(C1[13]); MLA_PIN(C0); MLA_PIN(C1); __builtin_amdgcn_sched_barrier(0); \
        C1[14] = ex2(C1[14]); C1[15] = ex2(C1[15]); \
        if (resc_) { if (hi == 0) wsf[r32] = alpha_; WAVE_LDS_SYNC(); \
            _Pragma("unroll") for (int r = 0; r < 16; ++r) { const float a = wsf[crow(r, hi)]; o[0][r] *= a; o[1][r] *= a; } WAVE_LDS_SYNC(); } \
        { const int t_ = kc; kc = kn; kn = kf_; kf_ = t_; } { const int t_ = vc; vc = vn; vn = vf_; vf_ = t_; } } while (0)
    for (int t = 1; t + 1 < NT; t += 2) { MLA_STEP(pb0, pb1, pa0, pa1, t); MLA_STEP(pa0, pa1, pb0, pb1, t + 1); }
    MLA_STEP(pb0, pb1, pa0, pa1, NT - 1);
    { float s_ = 0.f;
#pragma unroll
      for (int r = 0; r < 16; ++r) s_ += pb0[r] + pb1[r];
      lsum += s_; ATT_WAITV_BAR(); pv_tile(o, vfr + vc * VSLOT, pb0, pb1); }
#undef MLA_STEP
#undef MLA_KLD
#undef MLA_VLD
#undef MLA_PIN
#undef MLA_ROWMAX
#undef MLA_MASK
#undef MLA_DMA_K
#undef MLA_DMA_V
    lsum = hsum(lsum);
    if (hi == 0) wsf[32 + r32] = __builtin_amdgcn_rcpf(lsum);
    stage_o(o, stg, wsf + 32, r32, hi);
    bf16* Ow = OC + (rowbase + q0 + wid * 32) * 1024 + h * 64;
#pragma unroll
    for (int i = 0; i < 4; ++i) { const int row = i * 8 + (lane >> 3), ch = lane & 7; const u32x4 v = *(const LAS u32x4*)(stg + row * 64 + ch * 8); *(u32x4*)(Ow + (long)row * 1024 + ch * 8) = v; }
    ATT_WAITV_BAR();
}

constexpr int SB_KSLOT = 8192, SB_OFF_V = 2 * SB_KSLOT, SB_OFF_WS = SB_OFF_V + 2 * VSLOT, SB_OFF_ST = SB_OFF_WS + 8 * 256, SB_OFF_FL = SB_OFF_ST + 8 * 4096, SB_LDS = SB_OFF_FL + 64;
DI void sb_unit(int bh, int qb, const bf16* Q, const bf16* K, const bf16* V, bf16* OC, LAS unsigned char* lds) {
    int tid_ = threadIdx.x; asm volatile("" : "+v"(tid_));
    const int tid = tid_, lane = tid & 63, r32 = lane & 31, hi = lane >> 5, wid = rfl(tid >> 6);
    const int b = bh >> 3, h = bh & 7; const long rowbase = (long)b * SEQ; const int q0 = qb * 256;
    const unsigned lds0 = (unsigned)(size_t)lds;
    LAS bf16* stg = (LAS bf16*)(lds + SB_OFF_ST) + wid * 2048;
    volatile LAS unsigned* fl = (volatile LAS unsigned*)(lds + SB_OFF_FL);
    const bf16* ksrc = K + (rowbase + lane) * 512 + h * 64 + wid * 8;
    const bf16* vsrc = V + (rowbase + 16 * (wid & 3) + (lane >> 2)) * 512 + h * 64 + (wid >> 2) * 32 + (lane & 3) * 8;
#define SB_DMA(t, s) do { glds16(ksrc + (long)(t) * 64 * 512, (unsigned)rfl((int)(lds0 + (s) * SB_KSLOT + wid * 1024))); \
        glds16(vsrc + (long)(t) * 64 * 512, (unsigned)rfl((int)(lds0 + SB_OFF_V + (s) * VSLOT + wid * 1024))); } while (0)
    const bf16* qp = Q + (rowbase + q0 + wid * 32 + r32) * 512 + h * 64 + hi * 8;
    bf16x8 qr[4];
#pragma unroll
    for (int d0 = 0; d0 < 4; ++d0) qr[d0] = *(const bf16x8*)(qp + d0 * 16);
    const int NT = 4 * (qb + 1);
    const lcp kfr = (lcp)lds + hi * 1024 + r32 * 16;
    const lcp vfr = (lcp)lds + SB_OFF_V + ((lane >> 4) & 1) * 32 + (lane & 3) * 8 + (4 * hi + ((lane & 15) >> 2)) * 64;
    float carry = 1.f; f32x16 o[2];
#pragma unroll
    for (int r = 0; r < 16; ++r) { o[0][r] = 0.f; o[1][r] = 0.f; }
    if (tid == 0) { fl[0] = 0u; fl[1] = 0u; fl[2] = 0u; }
    SB_DMA(NT - 1, 0);
    for (int i = 0; i < NT; ++i) {
        const int t = NT - 1 - i;
        ATT_WAITV_BAR();
        if (i > 0 && fl[(i - 1) % 3] == 0u) break;
        if (tid == 0) fl[(i + 1) % 3] = 0u;
        const int s = i & 1;
        if (t > 0) SB_DMA(t - 1, s ^ 1);
        const int jb = t - (NT - 4), qlo = 32 * wid;
        const bool skip = (jb >= 0 && 64 * jb >= qlo + 31);
        const bool dead = __all(carry == 0.f) != 0;
        if (!skip && !dead) {
            f32x16 p0, p1; qk_tile<4>(p0, p1, kfr + s * SB_KSLOT, qr);
            f32x16 f0, f1;
#pragma unroll
            for (int r = 0; r < 16; ++r) {
                { const float y = p0[r], e = ex2(-fabsf(y)), rr = __builtin_amdgcn_rcpf(1.f + e), er = e * rr; const bool pos = y >= 0.f; p0[r] = pos ? rr : er; f0[r] = pos ? er : rr; }
                { const float y = p1[r], e = ex2(-fabsf(y)), rr = __builtin_amdgcn_rcpf(1.f + e), er = e * rr; const bool pos = y >= 0.f; p1[r] = pos ? rr : er; f1[r] = pos ? er : rr; }
            }
            if (jb >= 0 && 64 * jb + 63 >= qlo) { const int qrel = qlo + r32;
#pragma unroll
                for (int r = 0; r < 16; ++r) { const int kv = 64 * jb + crow(r, hi);
                    if (kv >= qrel) { f0[r] = 1.f; p0[r] = 0.f; } if (kv + 32 >= qrel) { f1[r] = 1.f; p1[r] = 0.f; } } }
            float mine[8], oth[8], ps[8];
#pragma unroll
            for (int g = 0; g < 4; ++g) {
                { const float a0 = f0[4 * g], a1 = f0[4 * g + 1], a2 = f0[4 * g + 2], a3 = f0[4 * g + 3]; const float e1 = a3 * a2, e0 = e1 * a1;
                  f0[4 * g + 3] = 1.f; f0[4 * g + 2] = a3; f0[4 * g + 1] = e1; f0[4 * g] = e0; mine[g] = e0 * a0; }
                { const float a0 = f1[4 * g], a1 = f1[4 * g + 1], a2 = f1[4 * g + 2], a3 = f1[4 * g + 3]; const float e1 = a3 * a2, e0 = e1 * a1;
                  f1[4 * g + 3] = 1.f; f1[4 * g + 2] = a3; f1[4 * g + 1] = e1; f1[4 * g] = e0; mine[4 + g] = e0 * a0; }
            }
#pragma unroll
            for (int g = 0; g < 8; ++g) { auto rr = __builtin_amdgcn_permlane32_swap(__float_as_uint(mine[g]), __float_as_uint(mine[g]), false, false);
                const float x0 = __uint_as_float(rr[0]), x1 = __uint_as_float(rr[1]); oth[g] = hi ? x0 : x1; ps[g] = x0 * x1; }
            float sp = 1.f; float off[8];
#pragma unroll
            for (int g = 7; g >= 0; --g) { off[g] = sp * (hi ? 1.f : oth[g]) * carry; sp *= ps[g]; }
#pragma unroll
            for (int g = 0; g < 4; ++g)
#pragma unroll
                for (int j = 0; j < 4; ++j) { p0[4 * g + j] = p0[4 * g + j] * f0[4 * g + j] * off[g]; p1[4 * g + j] = p1[4 * g + j] * f1[4 * g + j] * off[4 + g]; }
            carry *= sp;
            pv_tile(o, vfr + s * VSLOT, p0, p1);
        }
        if (t > 0 && __any(carry != 0.f) && lane == 0) fl[i % 3] = 1u;
    }
#undef SB_DMA
    ATT_WAITV_BAR();
    stage_o(o, stg, nullptr, r32, hi);
    bf16* Ow = OC + (rowbase + q0 + wid * 32) * 1024 + 512 + h * 64;
#pragma unroll
    for (int i = 0; i < 4; ++i) { const int row = i * 8 + (lane >> 3), ch = lane & 7; const u32x4 v = *(const LAS u32x4*)(stg + row * 64 + ch * 8); *(u32x4*)(Ow + (long)row * 1024 + ch * 8) = v; }
    ATT_WAITV_BAR();
}

constexpr int MB_NB = SEQ / 256;
constexpr int MB_OFF_K = 0, MB_OFF_V = 32768, MB_OFF_WS = 65536, MB_OFF_ST = MB_OFF_WS + 8 * 256, MB_OFF_TAB = MB_OFF_ST + 8 * 4096, MB_OFF_RING = MB_OFF_TAB + 512,
              MB_OFF_WC = MB_OFF_RING + 32768, MB_OFF_Q = MB_OFF_WC + 64, MB_LDS = MB_OFF_Q + 64;
DI int t5_bucket(int d) { if (d < 16) return d; const int l = 16 + (int)(__logf((float)d * (1.f / 16.f)) * (16.f / 2.0794415416798357f)); return l < 31 ? l : 31; }
DI void mb_load_kv(const bf16* K2, const bf16* V2, long row0, int h, unsigned lds0, int lane, int wid) {
    const bf16* ksrc = K2 + (row0 + lane) * 1024 + h * 64 + wid * 8;
    const bf16* vsrc = V2 + (row0 + 16 * (wid & 3) + (lane >> 2)) * 1024 + h * 64 + (wid >> 2) * 32 + (lane & 3) * 8;
#pragma unroll
    for (int t = 0; t < 4; ++t) { glds16(ksrc + (long)t * 64 * 1024, (unsigned)rfl((int)(lds0 + MB_OFF_K + t * 8192 + wid * 1024)));
        glds16(vsrc + (long)t * 64 * 1024, (unsigned)rfl((int)(lds0 + MB_OFF_V + t * 8192 + wid * 1024))); }
}
DI void mb_fill_tab(const float* rel_bias, int h, LAS float* tab, int tid) { if (tid < 128) tab[tid] = rel_bias[h * 32 + t5_bucket(tid)] * LOG2E; }

DI void top3_ins(float v, unsigned i, float& v0, unsigned& i0, float& v1, unsigned& i1, float& v2, unsigned& i2) {
    const bool b0 = v > v0 || (v == v0 && i < i0), b1 = v > v1 || (v == v1 && i < i1), b2 = v > v2 || (v == v2 && i < i2);
    const float n2 = b1 ? v1 : (b2 ? v : v2); const unsigned m2 = b1 ? i1 : (b2 ? i : i2);
    const float n1 = b0 ? v0 : (b1 ? v : v1); const unsigned m1 = b0 ? i0 : (b1 ? i : i1);
    const float n0 = b0 ? v : v0; const unsigned m0 = b0 ? i : i0;
    v0 = n0; i0 = m0; v1 = n1; i1 = m1; v2 = n2; i2 = m2;
}
DI void moba_gate_unit(int bh, int g, const bf16* Q2, const float* KMP, unsigned* SEL, unsigned* MASK32, LAS unsigned char* lds) {
    using namespace att;
    int tid_ = threadIdx.x; asm volatile("" : "+v"(tid_));
    const int tid = tid_, lane = tid & 63, r32 = lane & 31, hi = lane >> 5, wid = rfl(tid >> 6);
    const int b = bh >> 4, h = bh & 15;
    LAS bf16* khi = (LAS bf16*)lds; LAS bf16* klo = (LAS bf16*)(lds + 8192);
#pragma unroll
    for (int it_ = 0; it_ < 8; ++it_) { const int i = tid + 512 * it_; const int n = i >> 6, d = i & 63; const size_t src = (size_t)(b * MB_NB + n) * 1024 + h * 64 + d;
        const float v = (KMP[src] + KMP[(size_t)(T / 256) * 1024 + src]) * (1.f / 256.f);
        const unsigned ph = cvtpk(v, 0.f) & 0xffffu; const float rem = v - __uint_as_float(ph << 16); const unsigned pl = cvtpk(rem, 0.f) & 0xffffu;
        const int off = (d >> 3) * 512 + n * 8 + (d & 7); khi[off] = (bf16)ph; klo[off] = (bf16)pl; }
    const bf16* qbase = Q2 + ((long)b * SEQ + wid * 32 + r32) * 1024 + h * 64 + hi * 8;
    bf16x8 qn[4];
#pragma unroll
    for (int d0 = 0; d0 < 4; ++d0) qn[d0] = *(const bf16x8*)(qbase + (long)g * 256 * 1024 + d0 * 16);
    __syncthreads();
    const lcp kfr = (lcp)lds + hi * 1024 + r32 * 16;
#pragma unroll 1
    for (int j = 0; j < 8; ++j) {
        const int qb = g + 8 * j;
        bf16x8 qr[4] = {qn[0], qn[1], qn[2], qn[3]};
        if (j < 7) {
#pragma unroll
            for (int d0 = 0; d0 < 4; ++d0) qn[d0] = *(const bf16x8*)(qbase + (long)(qb + 8) * 256 * 1024 + d0 * 16); }
        f32x16 p0, p1, q0, q1; qk_tile<4>(p0, p1, kfr, qr); qk_tile<4>(q0, q1, kfr + 8192, qr);
        float v0 = -INFINITY, v1 = -INFINITY, v2 = -INFINITY; unsigned i0 = 0xFFu, i1 = 0xFFu, i2 = 0xFFu;
#pragma unroll
        for (int r = 0; r < 16; ++r) { const unsigned n = (unsigned)crow(r, hi); const bool in = (int)n < qb;
            top3_ins(in ? p0[r] + q0[r] : -INFINITY, in ? n : 0xFFu, v0, i0, v1, i1, v2, i2); }
        if (qb > 32) {
#pragma unroll
            for (int r = 0; r < 16; ++r) { const unsigned n = 32u + (unsigned)crow(r, hi); const bool in = (int)n < qb;
                top3_ins(in ? p1[r] + q1[r] : -INFINITY, in ? n : 0xFFu, v0, i0, v1, i1, v2, i2); } }
        { float pa, pb, pc; unsigned qa, qb_, qc;
#define MB_SWAPF(dst, src) do { auto rr_ = __builtin_amdgcn_permlane32_swap(__float_as_uint(src), __float_as_uint(src), false, false); dst = __uint_as_float(hi ? rr_[0] : rr_[1]); } while (0)
#define MB_SWAPU(dst, src) do { auto rr_ = __builtin_amdgcn_permlane32_swap(src, src, false, false); dst = hi ? rr_[0] : rr_[1]; } while (0)
          MB_SWAPF(pa, v0); MB_SWAPF(pb, v1); MB_SWAPF(pc, v2); MB_SWAPU(qa, i0); MB_SWAPU(qb_, i1); MB_SWAPU(qc, i2);
#undef MB_SWAPF
#undef MB_SWAPU
          top3_ins(pa, qa, v0, i0, v1, i1, v2, i2); top3_ins(pb, qb_, v0, i0, v1, i1, v2, i2); top3_ins(pc, qc, v0, i0, v1, i1, v2, i2); }
        if (hi == 0) SEL[(size_t)bh * SEQ + qb * 256 + wid * 32 + r32] = i0 | (i1 << 8) | (i2 << 16);
        for (int n = 0; n < qb; ++n) { const unsigned m0 = (unsigned)__ballot(i0 == (unsigned)n), m1 = (unsigned)__ballot(i1 == (unsigned)n), m2 = (unsigned)__ballot(i2 == (unsigned)n);
            if (lane == 0) { unsigned* dst = MASK32 + ((((size_t)bh * 64 + n) * 64 + qb) * 3) * 8 + wid; dst[0] = m0; dst[8] = m1; dst[16] = m2; } }
    }
    __syncthreads();
}

DI void moba_sel_unit(int bh, int n, const bf16* Q2, const bf16* K2, const bf16* V2, const unsigned long long* MASK, const float* rel_bias, bf16* PO0, bf16* PO1, bf16* PO2, bf16* PO3, float2* PMS, LAS unsigned char* lds) {
    using namespace att;
    int tid_ = threadIdx.x; asm volatile("" : "+v"(tid_));
    const int tid = tid_, lane = tid & 63, r32 = lane & 31, hi = lane >> 5, wid = rfl(tid >> 6);
    const int b = bh >> 4, h = bh & 15; const unsigned lds0 = (unsigned)(size_t)lds;
    mb_load_kv(K2, V2, (long)b * SEQ + n * 256, h, lds0, lane, wid);
    mb_fill_tab(rel_bias, h, (LAS float*)(lds + MB_OFF_TAB), tid);
    LAS unsigned short* list = (LAS unsigned short*)(lds + MB_OFF_RING);
    volatile LAS unsigned* wc = (volatile LAS unsigned*)(lds + MB_OFF_WC);
    bf16x8 qo[4];
    { const bf16* qp = Q2 + ((long)b * SEQ + n * 256 + wid * 32 + r32) * 1024 + h * 64 + hi * 8;
#pragma unroll
      for (int d0 = 0; d0 < 4; ++d0) qo[d0] = *(const bf16x8*)(qp + d0 * 16); }
    const unsigned* mw = (const unsigned*)(MASK + (((size_t)bh * 64 + n) * 64 + (n + 1)) * 12);
    const int nwords = (63 - n) * 24;
    unsigned w[3]; unsigned c = 0;
#pragma unroll
    for (int i = 0; i < 3; ++i) { const int j = tid + 512 * i; w[i] = j < nwords ? mw[j] : 0u; c += (unsigned)__popc(w[i]); }
    unsigned inc = c;
#pragma unroll
    for (int o = 1; o < 64; o <<= 1) { const unsigned t = __shfl_up(inc, o); if (lane >= o) inc += t; }
    if (lane == 63) wc[wid] = inc;
    ATT_WAITV_BAR();
    unsigned base = inc - c, total = 0;
#pragma unroll
    for (int i = 0; i < 8; ++i) { const unsigned x = wc[i]; total += x; if (i < wid) base += x; }
#pragma unroll
    for (int i = 0; i < 3; ++i) { const int j = tid + 512 * i; const int qb = n + 1 + j / 24, rem = j % 24, k = rem >> 3, s0 = qb * 256 + (rem & 7) * 32; unsigned ww = w[i];
        while (ww) { const int bit = __ffs(ww) - 1; ww &= ww - 1u; list[base++] = (unsigned short)(((unsigned)(s0 + bit) << 2) | (unsigned)k); } }
    ATT_BAR();
    const int nchunk = ((int)total + 255) >> 8;
    LAS float* wsf = (LAS float*)(lds + MB_OFF_WS) + wid * 64;
    LAS bf16* stg = (LAS bf16*)(lds + MB_OFF_ST) + wid * 2048;
    const LAS float* tab = (const LAS float*)(lds + MB_OFF_TAB);
    const lcp kfr = (lcp)lds + MB_OFF_K + hi * 1024 + r32 * 16;
    const lcp vfr = (lcp)lds + MB_OFF_V + ((lane >> 4) & 1) * 32 + (lane & 3) * 8 + (4 * hi + ((lane & 15) >> 2)) * 64;
    const int nchunk_ = ((int)total + 255) >> 8;
    const bf16* qbase = Q2 + (long)b * SEQ * 1024 + h * 64 + hi * 8;
    const int kend = n * 256 + 255;
    bf16x8 qn[4]; unsigned en = 0; bool vn = false;
#define MB_QLOAD(cc) do { const int idx_ = (cc) * 256 + 32 * wid + r32; vn = idx_ < (int)total; en = vn ? (unsigned)list[idx_] : 0u; const bf16* qp_ = qbase + (long)(en >> 2) * 1024; \
        _Pragma("unroll") for (int d0 = 0; d0 < 4; ++d0) { bf16x8 z_; _Pragma("unroll") for (int j_ = 0; j_ < 8; ++j_) z_[j_] = 0; qn[d0] = vn ? *(const bf16x8*)(qp_ + d0 * 16) : z_; } } while (0)
    if (nchunk_ > 0) MB_QLOAD(0);
    { float mref = -INFINITY, lsum = 0.f; f32x16 o[2];
#pragma unroll
      for (int r = 0; r < 16; ++r) { o[0][r] = 0.f; o[1][r] = 0.f; }
      const int qrel = 32 * wid + r32, tlast = wid >> 1;
#pragma unroll 1
      for (int t = 0; t <= tlast; ++t) {
          f32x16 p0, p1; qk_tile<4>(p0, p1, kfr + t * 8192, qo);
          const int dbase = qrel - 64 * t;
#pragma unroll
          for (int r = 0; r < 16; ++r) { const int d0 = dbase - crow(r, hi), d1 = d0 - 32;
              const int c0 = d0 > 127 ? 127 : (d0 < 0 ? 0 : d0), c1 = d1 > 127 ? 127 : (d1 < 0 ? 0 : d1);
              p0[r] = d0 < 0 ? -INFINITY : p0[r] + tab[c0]; p1[r] = d1 < 0 ? -INFINITY : p1[r] + tab[c1]; }
          smax_update(p0, p1, mref, lsum, o, wsf, r32, hi);
          pv_tile(o, vfr + t * 8192, p0, p1);
      }
      lsum = hsum(lsum);
      const int sq = n * 256 + qrel;
      if (hi == 0) PMS[((size_t)(3 * 32 + bh)) * SEQ + sq] = make_float2(mref, lsum);
      stage_o(o, stg, nullptr, r32, hi);
#pragma unroll
      for (int i = 0; i < 4; ++i) { const int row = i * 8 + (lane >> 3), ch = lane & 7;
          const u32x4 v = *(const LAS u32x4*)(stg + row * 64 + ch * 8); __builtin_nontemporal_store(v, (u32x4*)(PO3 + ((size_t)bh * SEQ + (n * 256 + 32 * wid + row)) * 64 + ch * 8)); }
      WAVE_LDS_SYNC(); }
#if defined(PROBE_DUP) && ((PROBE_DUP >> 19) & 1)
    for (int prb_ = 0; prb_ < 2; ++prb_) {
#else
    {
#endif
#if defined(PROBE_DUP) && ((PROBE_DUP >> 19) & 1)
    if (prb_ > 0 && nchunk > 0) MB_QLOAD(0);
#endif
    if (wid >= 4) __builtin_amdgcn_s_sleep(10);
#pragma unroll 1
    for (int cc = 0; cc < nchunk; ++cc) {
        const int cnt = ((int)total - cc * 256) < 256 ? ((int)total - cc * 256) : 256;
        bf16x8 qr[4] = {qn[0], qn[1], qn[2], qn[3]}; const unsigned e = en; const bool valid = vn;
        if (cc + 1 < nchunk) MB_QLOAD(cc + 1);
        if (32 * wid >= cnt) continue;
        const bool far = __all(!valid || ((int)(e >> 2) - kend >= 113)) != 0;
        float mref = 0.f, lsum = 0.f; f32x16 o[2], negm;
#pragma unroll
        for (int r = 0; r < 16; ++r) { o[0][r] = 0.f; o[1][r] = 0.f; negm[r] = 0.f; }
#pragma unroll 1
        for (int t = 0; t < 4; ++t) {
            f32x16 p0, p1; qk_tile_ref<4>(p0, p1, kfr + t * 8192, qr, negm);
            if (!far) { const int dbase = (int)(e >> 2) - (n * 256 + 64 * t);
#pragma unroll
                for (int r = 0; r < 16; ++r) { int d0 = dbase - crow(r, hi), d1 = d0 - 32; d0 = d0 > 127 ? 127 : (d0 < 0 ? 0 : d0); d1 = d1 > 127 ? 127 : (d1 < 0 ? 0 : d1); p0[r] += tab[d0]; p1[r] += tab[d1]; } }
            smax_update_ref(p0, p1, mref, negm, lsum, o, wsf, r32, hi, t == 0);
            pv_tile(o, vfr + t * 8192, p0, p1);
        }
        lsum = hsum(lsum);
        if (far) mref += tab[127];
        if (valid && hi == 0) { unsigned e_ = e; asm volatile("" : "+v"(e_)); PMS[((size_t)((int)(e_ & 3u) * 32 + bh)) * SEQ + (int)(e_ >> 2)] = make_float2(mref, lsum); }
        stage_o(o, stg, nullptr, r32, hi);
#pragma unroll
        for (int i = 0; i < 4; ++i) { const int row = i * 8 + (lane >> 3), ch = lane & 7; const int ridx = 32 * wid + row;
            if (ridx < cnt) { const unsigned e2 = list[cc * 256 + ridx]; const int s2 = (int)(e2 >> 2), k2 = (int)(e2 & 3u);
                const u32x4 v = *(const LAS u32x4*)(stg + row * 64 + ch * 8); bf16* pob = k2 == 0 ? PO0 : (k2 == 1 ? PO1 : PO2); __builtin_nontemporal_store(v, (u32x4*)(pob + ((size_t)bh * SEQ + s2) * 64 + ch * 8)); } }
        WAVE_LDS_SYNC();
    }
    }
#undef MB_QLOAD
    ATT_WAITV_BAR();
}

DI void moba_merge(int gw, int ngw, const unsigned* SEL, const bf16* PO0, const bf16* PO1, const bf16* PO2, const bf16* PO3, const float2* PMS, bf16* O2) {
    using namespace att;
    int tid_ = threadIdx.x; asm volatile("" : "+v"(tid_));
    const int lane = tid_ & 63, sub = lane >> 3, ch = lane & 7;
    const int NST = 32 * (SEQ / 8);
    unsigned nsel = 0u; float2 nms[4]; u32x4 npv[4];
#define MB_MLOAD(st) do { const int bh_ = (st) / (SEQ / 8), s_ = ((st) % (SEQ / 8)) * 8 + sub; const size_t it_ = (size_t)bh_ * SEQ + s_; nsel = SEL[it_]; \
        _Pragma("unroll") for (int k = 0; k < 4; ++k) { nms[k] = PMS[(size_t)k * 32 * SEQ + it_]; const bf16* pob = k == 0 ? PO0 : (k == 1 ? PO1 : (k == 2 ? PO2 : PO3)); npv[k] = __builtin_nontemporal_load((const u32x4*)(pob + it_ * 64 + ch * 8)); } } while (0)
    if (gw < NST) MB_MLOAD(gw);
    for (int st = gw; st < NST; st += ngw) {
        const int bh = st / (SEQ / 8), s = (st % (SEQ / 8)) * 8 + sub;
        const unsigned sel = nsel; float2 ms[4] = {nms[0], nms[1], nms[2], nms[3]}; u32x4 pv[4] = {npv[0], npv[1], npv[2], npv[3]};
        if (st + ngw < NST) MB_MLOAD(st + ngw);
        float mall = ms[3].x;
#pragma unroll
        for (int k = 0; k < 3; ++k) { const bool ok = ((sel >> (8 * k)) & 0xFFu) != 0xFFu; if (!ok) { ms[k].x = -INFINITY; ms[k].y = 0.f; pv[k] = (u32x4){0u, 0u, 0u, 0u}; } mall = fmaxf(mall, ms[k].x); }
        float den = 0.f, acc[8] = {0.f, 0.f, 0.f, 0.f, 0.f, 0.f, 0.f, 0.f};
#pragma unroll
        for (int k = 0; k < 4; ++k) { const float w = ex2(ms[k].x - mall); den += w * ms[k].y; const u32x4 v = pv[k];
            acc[0] += w * bflo(v.x); acc[1] += w * bfhi(v.x); acc[2] += w * bflo(v.y); acc[3] += w * bfhi(v.y); acc[4] += w * bflo(v.z); acc[5] += w * bfhi(v.z); acc[6] += w * bflo(v.w); acc[7] += w * bfhi(v.w); }
        const float rd = __builtin_amdgcn_rcpf(den);
        const u32x4 ov = (u32x4){cvtpk(acc[0] * rd, acc[1] * rd), cvtpk(acc[2] * rd, acc[3] * rd), cvtpk(acc[4] * rd, acc[5] * rd), cvtpk(acc[6] * rd, acc[7] * rd)};
        *(u32x4*)(O2 + ((size_t)(bh >> 4) * SEQ + s) * 1024 + (bh & 15) * 64 + ch * 8) = ov;
    }
#undef MB_MLOAD
}
}

constexpr size_t MiB = 1u << 20;
constexpr int NSLOT = 2 * T + 8 * 256;
constexpr size_t WS_CTL = 0, CTL_ZERO_BYTES = 64 * 1024;
constexpr size_t WS_RSTD0 = 1 * MiB, WS_TOKW = WS_RSTD0 + 128 * 1024, WS_TOKR = WS_TOKW + 256 * 1024, WS_TOKE = WS_TOKR + 128 * 1024, WS_PRANK = WS_TOKE + 128 * 1024;
constexpr size_t WS_PQKV = 2 * MiB, WS_PS1 = 6 * MiB, WS_PS2 = 8 * MiB, WS_PS3 = 10 * MiB, WS_ROPE = 12 * MiB, WS_KMP = 14 * MiB;
constexpr size_t WS_SDST = 15 * MiB, WS_SW = WS_SDST + 272 * 1024, WS_SRS = WS_SW + 272 * 1024;
constexpr size_t WS_WRT = 16 * MiB, WS_CNT = WS_WRT + 64 * 1024, WS_TILEE = WS_CNT + 64 * 1024;
constexpr size_t WS_STOK = 17 * MiB;
constexpr size_t WS_SEL = 18 * MiB;
constexpr size_t WS_W = 20 * MiB;
constexpr size_t W_IN = WS_W, W_UQ = W_IN + (size_t)2304 * 1024 * 2, W_UKV = W_UQ + (size_t)768 * 384 * 2, W_O0 = W_UKV + (size_t)1024 * 256 * 2, W_GU0 = W_O0 + (size_t)1024 * 1024 * 2,
                 W_DN0 = W_GU0 + (size_t)4096 * 1024 * 2, W_QKV = W_DN0 + (size_t)1024 * 2048 * 2, W_O1 = W_QKV + (size_t)3072 * 1024 * 2, W_EGU = W_O1 + (size_t)1024 * 1024 * 2,
                 W_EDN = W_EGU + (size_t)8192 * 1024 * 2, W_END = W_EDN + (size_t)8192 * 512 * 2;
static_assert(W_END <= 76 * MiB, "weights region");
constexpr size_t WS_XB = 76 * MiB, WS_OCAT = 76 * MiB, WS_SBQ = 140 * MiB, WS_SBK = 172 * MiB, WS_SBV = 204 * MiB, WS_CQ = 236 * MiB, WS_CKV = 260 * MiB, WS_KR = 276 * MiB,
                 WS_QA = 278 * MiB, WS_KN = 326 * MiB, WS_VA = 358 * MiB, WS_X1B = 390 * MiB, WS_HID = 76 * MiB;
constexpr size_t WS_Q2 = 204 * MiB, WS_K2 = 268 * MiB, WS_V2 = 332 * MiB, WS_PO0 = 76 * MiB, WS_PO1 = 140 * MiB, WS_PO2 = 396 * MiB, WS_PMS = 460 * MiB;
constexpr size_t WS_X3B = 268 * MiB, WS_XPERM = 332 * MiB, WS_YP = 332 * MiB, WS_HIDE = 76 * MiB;
constexpr size_t WS_MASK = 476 * MiB;
constexpr size_t WS_NEED = 489 * MiB;
static_assert(WS_SBK == WS_SBQ + 32 * MiB && WS_SBV == WS_SBQ + 64 * MiB && WS_VA == WS_KN + 32 * MiB && WS_K2 == WS_Q2 + 64 * MiB && WS_V2 == WS_Q2 + 128 * MiB, "epilogue pointer arithmetic");
static_assert(WS_XPERM + (size_t)NSLOT * 2048 <= 464 * MiB && WS_HIDE + (size_t)NSLOT * 1024 <= 204 * MiB && WS_SRS + 272 * 1024 <= 16 * MiB && NSLOT * 4 <= 272 * 1024, "ws map");
constexpr int CW_BAR = 4096, CW_QUEUE = 8192, CW_NRT = 8256;
static_assert((8320 + 64) * 4 <= (int)CTL_ZERO_BYTES && CW_BAR + 3456 <= CW_QUEUE, "control words inside the zeroed region");
constexpr int RING_BYTES = 131072, LDS_BYTES = 147456, MISC_OFF = LDS_BYTES - 256, PHASE_LDS = LDS_BYTES - 512;
static_assert(att::MLA_LDS <= PHASE_LDS && att::SB_LDS <= PHASE_LDS && att::MB_LDS <= PHASE_LDS && RING_BYTES <= PHASE_LDS, "phase LDS");

#define XB_TMO      128
#define XB_XCNT(j)  (256  + 64 * (j))
#define XB_XSUB(j)  (1280 + 64 * (j))
#define XB_XGEN(j)  (2304 + 64 * (j))
#define XB_TOP      3328
#define XB_TOPGEN   3392
#define XCD_BAR_WORDS 3456
#define XB_SPIN_CAP (1u << 18)
__device__ __forceinline__ unsigned xb_ld(unsigned* p)              { return __hip_atomic_load(p, __ATOMIC_RELAXED, __HIP_MEMORY_SCOPE_AGENT); }
__device__ __forceinline__ unsigned xb_add(unsigned* p, unsigned v) { return __hip_atomic_fetch_add(p, v, __ATOMIC_RELAXED, __HIP_MEMORY_SCOPE_AGENT); }
__device__ __forceinline__ unsigned xb_xcc_id() { return (unsigned)__builtin_amdgcn_s_getreg((3 << 11) | 20) & 0xFu; }
#define XB_SPIN(cond, bar) do { unsigned _sp = 0; while (cond) { __builtin_amdgcn_s_sleep(1); \
    if ((++_sp & 255u) == 0u) { if (xb_ld(&(bar)[XB_TMO])) break; if (_sp > XB_SPIN_CAP) { atomicAdd(&(bar)[XB_TMO], 1u); break; } } } } while (0)
struct XcdBarrier { unsigned* bar; unsigned x; volatile LAS unsigned* st; };
__device__ __forceinline__ XcdBarrier xcd_barrier_post(unsigned* bar, volatile LAS unsigned* st) {
    XcdBarrier b; b.bar = bar; b.x = xb_xcc_id(); b.st = st;
    if (threadIdx.x == 0) (void)xb_add(&bar[XB_XCNT(b.x)], 1u);
    return b;
}
__device__ __forceinline__ void xcd_barrier_complete(unsigned* bar, unsigned x, unsigned& nloc, unsigned& nx) {
    const unsigned G = gridDim.x * gridDim.y * gridDim.z;
    unsigned sum, cnt, mine, sp = 0u;
    for (;;) {
        sum = 0u; cnt = 0u; mine = 0u;
#pragma unroll
        for (unsigned j = 0; j < 16; ++j) { const unsigned c = xb_ld(&bar[XB_XCNT(j)]); sum += c; cnt += (c > 0u) ? 1u : 0u; mine = (j == x) ? c : mine; }
        if (sum == G) break;
        __builtin_amdgcn_s_sleep(1);
        if ((++sp & 255u) == 0u) { if (xb_ld(&bar[XB_TMO])) break; if (sp > XB_SPIN_CAP) { atomicAdd(&bar[XB_TMO], 1u); break; } }
    }
    nloc = mine > 0u ? mine : 1u; nx = cnt > 0u ? cnt : 1u;
}
__device__ __forceinline__ void xcd_barrier(const XcdBarrier& b) {
    asm volatile("s_waitcnt vmcnt(0)" ::: "memory");
    __syncthreads();
    if (threadIdx.x == 0) {
        unsigned* bar = b.bar;
        __builtin_amdgcn_s_waitcnt(0);
        unsigned nloc = b.st[0], nx = b.st[1];
        if (nloc == 0u) { xcd_barrier_complete(bar, b.x, nloc, nx); b.st[0] = nloc; b.st[1] = nx; }
        const unsigned old = xb_add(&bar[XB_XSUB(b.x)], 1u);
        const unsigned gen = old / nloc;
        if (old + 1u == (gen + 1u) * nloc) {
            __builtin_amdgcn_fence(__ATOMIC_RELEASE, "agent");
            asm volatile("s_waitcnt vmcnt(0)" ::: "memory");
            const unsigned og = xb_add(&bar[XB_TOP], 1u);
            const unsigned tg = og / nx;
            if (og + 1u == (tg + 1u) * nx) xb_add(&bar[XB_TOPGEN], 1u);
            else XB_SPIN(xb_ld(&bar[XB_TOPGEN]) == tg, bar);
            __builtin_amdgcn_fence(__ATOMIC_ACQUIRE, "agent");
            xb_add(&bar[XB_XGEN(b.x)], 1u);
            asm volatile("s_waitcnt vmcnt(0)" ::: "memory");
        } else {
            XB_SPIN(xb_ld(&bar[XB_XGEN(b.x)]) == gen, bar);
            __builtin_amdgcn_fence(__ATOMIC_ACQUIRE, "agent");
            asm volatile("s_waitcnt vmcnt(0)" ::: "memory");
        }
    }
    __syncthreads();
}

struct Args { const float* in[22]; float* out; unsigned char* ws; int ph_lo, ph_hi; };
enum { I_X = 0, I_EV_AN, I_EV_WIN, I_EV_QN, I_EV_WUQ, I_EV_KVN, I_EV_WUKV, I_EV_WO, I_EV_FN, I_EV_WG, I_EV_WU, I_EV_WD, I_OD_AN, I_OD_WQKV, I_OD_WO, I_OD_FN, I_OD_WR, I_OD_WG, I_OD_WU, I_OD_WD, I_RELB, I_FINN };
constexpr int NPH = 17;

constexpr float C_MLA = 0.10206207261596575f * LOG2E;
constexpr float C_64 = 0.125f * LOG2E;
DI int map_rope32(int p) { return 16 * ((p >> 2) & 1) + 4 * (p >> 3) + (p & 3); }
DI void cvt_item(const float* W, int ld, int col, float scale, const float* gain, int K, bf16* WT, int k0, LAS float* scr, int lane) {
    const int colc = col < 0 ? 0 : col; const float sc = col < 0 ? 0.f : scale;
    const float* wp = W + (size_t)(k0 + (lane >> 5)) * ld + colc;
    float v[32];
#pragma unroll
    for (int i = 0; i < 32; ++i) v[i] = __builtin_nontemporal_load(wp + (size_t)(2 * i) * ld);
    const int c = lane & 7;
    f32x4 g0 = (f32x4){1.f, 1.f, 1.f, 1.f}, g1 = g0;
    if (gain) { g0 = *(const f32x4*)(gain + k0 + 8 * c); g1 = *(const f32x4*)(gain + k0 + 8 * c + 4); }
#pragma unroll
    for (int i = 0; i < 32; ++i) scr[(2 * i + (lane >> 5)) * 33 + (lane & 31)] = v[i] * sc;
    asm volatile("s_waitcnt lgkmcnt(0)" ::: "memory");
#pragma unroll
    for (int j = 0; j < 4; ++j) { const int n = (lane >> 3) + 8 * j; const LAS float* s = scr + (8 * c) * 33 + n;
        v4u o; o.x = cvtpk(s[0 * 33] * g0[0], s[1 * 33] * g0[1]); o.y = cvtpk(s[2 * 33] * g0[2], s[3 * 33] * g0[3]); o.z = cvtpk(s[4 * 33] * g1[0], s[5 * 33] * g1[1]); o.w = cvtpk(s[6 * 33] * g1[2], s[7 * 33] * g1[3]);
        *(v4u*)(WT + (size_t)n * K + k0 + 8 * c) = o; }
    asm volatile("s_waitcnt lgkmcnt(0)" ::: "memory");
}
DI void p0_weights(const Args& a, LAS unsigned char* lds, int gw, int NGW, bool layer1) {
    int tid_ = threadIdx.x; asm volatile("" : "+v"(tid_)); const int tid = tid_, lane = tid & 63, wave = rfl(tid >> 6);
    LAS float* scr = (LAS float*)(lds + wave * 8704);
    unsigned char* ws = a.ws;
    constexpr int J0 = 72 * 16, J1 = J0 + 24 * 6, J2 = J1 + 32 * 4, J3 = J2 + 32 * 16, J4 = J3 + 128 * 16, J5 = J4 + 32 * 32, J6 = J5 + 96 * 16, J7 = J6 + 32 * 16, J8 = J7 + 256 * 16, J9 = J8 + 256 * 8;
    for (int it = (layer1 ? J5 : 0) + gw; it < (layer1 ? J9 : J5); it += NGW) {
        const int ln = lane & 31;
        if (it < J0) { const int nb = it / 16, kb = it % 16, n = nb * 32 + ln; int col; float sc = 1.f;
            if (n < 1536) { col = 672 + n; if (n < 512) sc = C_64; } else if (n < 1920) col = n - 1536; else if (n < 2176) col = 384 + (n - 1920); else if (n < 2208) col = 640 + map_rope32(n - 2176); else col = -1;
            cvt_item(a.in[I_EV_WIN], 2208, col, sc, a.in[I_EV_AN], 1024, (bf16*)(ws + W_IN) + (size_t)nb * 32 * 1024, kb * 64, scr, lane); }
        else if (it < J1) { const int r = it - J0, nb = r / 6, kb = r % 6, n = nb * 32 + ln; const int col = (nb % 3 == 2) ? nb * 32 + map_rope32(ln) : n;
            cvt_item(a.in[I_EV_WUQ], 768, col, C_MLA, a.in[I_EV_QN], 384, (bf16*)(ws + W_UQ) + (size_t)nb * 32 * 384, kb * 64, scr, lane); }
        else if (it < J2) { const int r = it - J1, nb = r / 4, kb = r % 4, n = nb * 32 + ln; const int col = n < 512 ? (n >> 6) * 128 + (n & 63) : ((n - 512) >> 6) * 128 + 64 + ((n - 512) & 63);
            cvt_item(a.in[I_EV_WUKV], 1024, col, 1.f, a.in[I_EV_KVN], 256, (bf16*)(ws + W_UKV) + (size_t)nb * 32 * 256, kb * 64, scr, lane); }
        else if (it < J3) { const int r = it - J2, nb = r / 16, kb = r % 16;
            cvt_item(a.in[I_EV_WO], 1024, nb * 32 + ln, 1.f, nullptr, 1024, (bf16*)(ws + W_O0) + (size_t)nb * 32 * 1024, kb * 64, scr, lane); }
        else if (it < J4) { const int r = it - J3, nb = r / 16, kb = r % 16, n = nb * 32 + ln; const int tile = n >> 8, half = (n >> 7) & 1, col = tile * 128 + (n & 127);
            cvt_item(half ? a.in[I_EV_WU] : a.in[I_EV_WG], 2048, col, 1.f, a.in[I_EV_FN], 1024, (bf16*)(ws + W_GU0) + (size_t)nb * 32 * 1024, kb * 64, scr, lane); }
        else if (it < J5) { const int r = it - J4, nb = r / 32, kb = r % 32;
            cvt_item(a.in[I_EV_WD], 1024, nb * 32 + ln, 1.f, nullptr, 2048, (bf16*)(ws + W_DN0) + (size_t)nb * 32 * 2048, kb * 64, scr, lane); }
        else if (it < J6) { const int r = it - J5, nb = r / 16, kb = r % 16, n = nb * 32 + ln;
            cvt_item(a.in[I_OD_WQKV], 3072, n, n < 1024 ? C_64 : 1.f, a.in[I_OD_AN], 1024, (bf16*)(ws + W_QKV) + (size_t)nb * 32 * 1024, kb * 64, scr, lane); }
        else if (it < J7) { const int r = it - J6, nb = r / 16, kb = r % 16;
            cvt_item(a.in[I_OD_WO], 1024, nb * 32 + ln, 1.f, nullptr, 1024, (bf16*)(ws + W_O1) + (size_t)nb * 32 * 1024, kb * 64, scr, lane); }
        else if (it < J8) { const int r = it - J7, nb = r / 16, kb = r % 16, n = nb * 32 + ln; const int e = n >> 10, m = n & 1023, tile = m >> 8, half = (m >> 7) & 1, col = tile * 128 + (m & 127);
            cvt_item((half ? a.in[I_OD_WU] : a.in[I_OD_WG]) + (size_t)e * 1024 * 512, 512, col, 1.f, a.in[I_OD_FN], 1024, (bf16*)(ws + W_EGU) + (size_t)nb * 32 * 1024, kb * 64, scr, lane); }
        else { const int r = it - J8, nb = r / 8, kb = r % 8, n = nb * 32 + ln; const int e = n >> 10, m = n & 1023;
            cvt_item(a.in[I_OD_WD] + (size_t)e * 512 * 1024, 1024, m, 1.f, nullptr, 512, (bf16*)(ws + W_EDN) + (size_t)nb * 32 * 512, kb * 64, scr, lane); }
    }
}
DI void p0_prologue(const Args& a, LAS unsigned char* lds, int vcu, int G) {
    int tid_ = threadIdx.x; asm volatile("" : "+v"(tid_)); const int tid = tid_, lane = tid & 63, wave = rfl(tid >> 6);
    const int gw = vcu * 8 + wave, NGW = G * 8;
    unsigned char* ws = a.ws;
    p0_weights(a, lds, gw, NGW, false);
    { const float* x = a.in[I_X]; bf16* XB = (bf16*)(ws + WS_XB); float* rs0 = (float*)(ws + WS_RSTD0);
      f32x4 nv[4];
      if (gw < T) { const f32x4* xr = (const f32x4*)(x + (size_t)gw * DM) + lane;
#pragma unroll
          for (int j = 0; j < 4; ++j) nv[j] = __builtin_nontemporal_load(xr + 64 * j); }
      for (int m = gw; m < T; m += NGW) { f32x4 v[4]; float s = 0.f;
#pragma unroll
          for (int j = 0; j < 4; ++j) v[j] = nv[j];
          if (m + NGW < T) { const f32x4* xr = (const f32x4*)(x + (size_t)(m + NGW) * DM) + lane;
#pragma unroll
              for (int j = 0; j < 4; ++j) nv[j] = __builtin_nontemporal_load(xr + 64 * j); }
#pragma unroll
          for (int j = 0; j < 4; ++j) s += (v[j].x * v[j].x + v[j].y * v[j].y) + (v[j].z * v[j].z + v[j].w * v[j].w);
          s = wave_sum(s); if (lane == 0) rs0[m] = rsqrtf(s * (1.f / DM) + RMS_EPS);
          unsigned long long* o8 = (unsigned long long*)(XB + (size_t)m * DM) + lane;
#pragma unroll
          for (int j = 0; j < 4; ++j) o8[64 * j] = (unsigned long long)cvtpk(v[j].x, v[j].y) | ((unsigned long long)cvtpk(v[j].z, v[j].w) << 32); } }
    { float2* rope = (float2*)(ws + WS_ROPE); const int gt = vcu * 512 + tid, NT_ = G * 512;
      for (int i = gt; i < SEQ * 16; i += NT_) { const int pos = i >> 4, f = i & 15;
          const double inv = (f & 8 ? 0.01 : 1.0) * (f & 4 ? 0.1 : 1.0) * (f & 2 ? 0.31622776601683794 : 1.0) * (f & 1 ? 0.5623413251903491 : 1.0);
          double rev = (double)pos * inv * 0.15915494309189535; rev -= __builtin_rint(rev);
          rope[i] = make_float2(__builtin_amdgcn_cosf((float)rev), __builtin_amdgcn_sinf((float)rev)); } }
    { float* wrt = (float*)(ws + WS_WRT); const int gt = vcu * 512 + tid, NT_ = G * 512;
      for (int i = gt; i < 8 * 1024; i += NT_) { const int e = i >> 10, k = i & 1023; wrt[i] = a.in[I_OD_FN][k] * a.in[I_OD_WR][k * 8 + e]; } }
}

using pg8::Unit;
typedef const f32x4 (&AccRef)[2][2][4][2];
DI v4u pack8(f32x4 a, f32x4 b) { v4u w; w.x = cvtpk(a[0], a[1]); w.y = cvtpk(a[2], a[3]); w.z = cvtpk(b[0], b[1]); w.w = cvtpk(b[2], b[3]); return w; }
DI float sumsq8(f32x4 a, f32x4 b) { return (a[0] * a[0] + a[1] * a[1]) + (a[2] * a[2] + a[3] * a[3]) + (b[0] * b[0] + b[1] * b[1]) + (b[2] * b[2] + b[3] * b[3]); }
DI float fq_sum(float s) { s += __shfl_xor(s, 16); s += __shfl_xor(s, 32); return s; }
DI float rstd_from(const float* P, int n4, float invn) { float s = 0.f;
#pragma unroll 4
    for (int i = 0; i < n4; ++i) { const f32x4 v = ((const f32x4*)P)[i]; s += (v[0] + v[1]) + (v[2] + v[3]); } return rsqrtf(s * invn + RMS_EPS); }
DI void rope_pair(f32x4& t1, f32x4& t2, const float2* rp  ) {
#pragma unroll
    for (int j = 0; j < 4; ++j) { const float2 cs = rp[j]; const float a = t1[j], b = t2[j]; t1[j] = a * cs.x - b * cs.y; t2[j] = b * cs.x + a * cs.y; }
}
DI unsigned long long pack4(f32x4 a) { return (unsigned long long)cvtpk(a[0], a[1]) | ((unsigned long long)cvtpk(a[2], a[3]) << 32); }

#define EPI_ROW(q) (u.pm * 256 + ((q) >> 2) * 128 + wr * 64 + ((q) & 3) * 16 + fr)
#define EPI_RSTD8(rs, NP4, P, stride, off, invn) do { f32x4 pv_[8]; const int fqc_ = fq < (NP4) ? fq : 0; \
        _Pragma("unroll") for (int q = 0; q < 8; ++q) pv_[q] = *(const f32x4*)((P) + (size_t)EPI_ROW(q) * (stride) + (off) + fqc_ * 4); \
        _Pragma("unroll") for (int q = 0; q < 8; ++q) { float s_ = (pv_[q][0] + pv_[q][1]) + (pv_[q][2] + pv_[q][3]); if (fq >= (NP4)) s_ = 0.f; s_ = fq_sum(s_); rs[q] = rsqrtf(s_ * (invn) + RMS_EPS); } } while (0)
struct EpiInProj {
    static constexpr bool PERM = true, AFTER_DRAIN = false;
    bf16 *SBQ, *CQ, *CKV, *KR; const float* rstd0; float* PQKV; const float2* rope;
    DI void operator()(AccRef acc, const Unit& u, int wr, int wc, int fr, int fq) const {
        { int ln_ = (int)__builtin_amdgcn_mbcnt_hi(~0u, __builtin_amdgcn_mbcnt_lo(~0u, 0u)); asm volatile("" : "+v"(ln_)); fr = ln_ & 15; fq = ln_ >> 4; }
        float rs[8];
#pragma unroll
        for (int q = 0; q < 8; ++q) rs[q] = rstd0[EPI_ROW(q)];
#pragma unroll
        for (int bj = 0; bj < 2; ++bj) {
            const int col0 = u.pn * 256 + bj * 128, cw = wc * 32 + fq * 8;
#pragma unroll
            for (int q = 0; q < 8; ++q) { const int ai = q >> 2, m = q & 3; const int r = EPI_ROW(q);
                f32x4 v0 = acc[ai][bj][m][0] * rs[q], v1 = acc[ai][bj][m][1] * rs[q];
                if (col0 < 1536) { bf16* dst = SBQ + (size_t)(col0 >> 9) * (size_t)(16u << 20) + (size_t)r * 512 + (col0 & 511) + cw; *(v4u*)dst = pack8(v0, v1); }
                else if (col0 < 1920) { *(v4u*)(CQ + (size_t)r * 384 + (col0 - 1536) + cw) = pack8(v0, v1); const float s = fq_sum(sumsq8(v0, v1)); if (fq == 0) PQKV[(size_t)r * 32 + (col0 - 1536) / 32 + wc] = s; }
                else if (col0 < 2176) { *(v4u*)(CKV + (size_t)r * 256 + (col0 - 1920) + cw) = pack8(v0, v1); const float s = fq_sum(sumsq8(v0, v1)); if (fq == 0) PQKV[(size_t)r * 32 + 16 + (col0 - 1920) / 32 + wc] = s; }
                else if (wc == 0) {
                    const f32x4* rp = (const f32x4*)(rope + (size_t)(r & (SEQ - 1)) * 16 + 4 * fq); const f32x4 ca = rp[0], cb = rp[1];
                    const float c[4] = {ca[0], ca[2], cb[0], cb[2]}, sn[4] = {ca[1], ca[3], cb[1], cb[3]};
#pragma unroll
                    for (int j = 0; j < 4; ++j) { const float a = v0[j], b = v1[j]; v0[j] = a * c[j] - b * sn[j]; v1[j] = b * c[j] + a * sn[j]; }
                    *(unsigned long long*)(KR + (size_t)r * 32 + 4 * fq) = pack4(v0); *(unsigned long long*)(KR + (size_t)r * 32 + 16 + 4 * fq) = pack4(v1); }
            }
        }
    }
};
struct EpiQUp {
    static constexpr bool PERM = true, AFTER_DRAIN = false;
    bf16* QA; const float* PQKV; const float2* rope;
    DI void operator()(AccRef acc, const Unit& u, int wr, int wc, int fr, int fq) const {
        { int ln_ = (int)__builtin_amdgcn_mbcnt_hi(~0u, __builtin_amdgcn_mbcnt_lo(~0u, 0u)); asm volatile("" : "+v"(ln_)); fr = ln_ & 15; fq = ln_ >> 4; }
        float rs[8]; EPI_RSTD8(rs, 3, PQKV, 32, 0, 1.f / 384.f);
        const bool rope0 = (u.pn * 8 + wc) % 3 == 2, rope1 = (u.pn * 8 + 4 + wc) % 3 == 2;
#pragma unroll
        for (int hb = 0; hb < 2; ++hb) {
            f32x4 cs[4][2];
            if (rope0 || rope1) {
#pragma unroll
                for (int qq = 0; qq < 4; ++qq) { const f32x4* rp = (const f32x4*)(rope + (size_t)(EPI_ROW(hb * 4 + qq) & (SEQ - 1)) * 16 + 4 * fq); cs[qq][0] = rp[0]; cs[qq][1] = rp[1]; } }
#pragma unroll
            for (int qq = 0; qq < 4; ++qq) { const int q = hb * 4 + qq, ai = q >> 2, m = q & 3; const int r = EPI_ROW(q);
#pragma unroll
                for (int bj = 0; bj < 2; ++bj) { const int gi = u.pn * 8 + bj * 4 + wc; const bool isr = bj ? rope1 : rope0;
                    f32x4 v0 = acc[ai][bj][m][0] * rs[q], v1 = acc[ai][bj][m][1] * rs[q];
                    if (!isr) *(v4u*)(QA + (size_t)r * 768 + gi * 32 + fq * 8) = pack8(v0, v1);
                    else { const float c[4] = {cs[qq][0][0], cs[qq][0][2], cs[qq][1][0], cs[qq][1][2]}, sn[4] = {cs[qq][0][1], cs[qq][0][3], cs[qq][1][1], cs[qq][1][3]};
#pragma unroll
                        for (int j = 0; j < 4; ++j) { const float a = v0[j], b = v1[j]; v0[j] = a * c[j] - b * sn[j]; v1[j] = b * c[j] + a * sn[j]; }
                        *(unsigned long long*)(QA + (size_t)r * 768 + gi * 32 + 4 * fq) = pack4(v0); *(unsigned long long*)(QA + (size_t)r * 768 + gi * 32 + 16 + 4 * fq) = pack4(v1); } }
            }
        }
    }
};
struct EpiKvUp {
    static constexpr bool PERM = true, AFTER_DRAIN = false;
    bf16* KN; const float* PQKV;
    DI void operator()(AccRef acc, const Unit& u, int wr, int wc, int fr, int fq) const {
        { int ln_ = (int)__builtin_amdgcn_mbcnt_hi(~0u, __builtin_amdgcn_mbcnt_lo(~0u, 0u)); asm volatile("" : "+v"(ln_)); fr = ln_ & 15; fq = ln_ >> 4; }
        float rs[8]; EPI_RSTD8(rs, 2, PQKV, 32, 16, 1.f / 256.f);
#pragma unroll
        for (int q = 0; q < 8; ++q) { const int ai = q >> 2, m = q & 3; const int r = EPI_ROW(q);
#pragma unroll
            for (int bj = 0; bj < 2; ++bj) { const int c = u.pn * 256 + bj * 128 + wc * 32 + fq * 8;
                bf16* dst = KN + (size_t)(c >> 9) * (size_t)(16u << 20) + (size_t)r * 512 + (c & 511);
                *(v4u*)dst = pack8(acc[ai][bj][m][0] * rs[q], acc[ai][bj][m][1] * rs[q]); }
        }
    }
};
template <bool RES_F32> struct EpiRes {
    static constexpr bool PERM = true, AFTER_DRAIN = false;
    const void* res; bf16* Y; float* PS;
    DI void operator()(AccRef acc, const Unit& u, int wr, int wc, int fr, int fq) const {
        { int ln_ = (int)__builtin_amdgcn_mbcnt_hi(~0u, __builtin_amdgcn_mbcnt_lo(~0u, 0u)); asm volatile("" : "+v"(ln_)); fr = ln_ & 15; fq = ln_ >> 4; }
        const size_t cb = (size_t)u.pn * 256 + wc * 32 + fq * 8;
#pragma unroll
        for (int hb = 0; hb < 2; ++hb) {
            f32x4 x0[4][2], x1[4][2];
#pragma unroll
            for (int qq = 0; qq < 4; ++qq)
#pragma unroll
                for (int bj = 0; bj < 2; ++bj) { const size_t o = (size_t)EPI_ROW(hb * 4 + qq) * 1024 + cb + bj * 128;
                    if (RES_F32) { x0[qq][bj] = *(const f32x4*)((const float*)res + o); x1[qq][bj] = *(const f32x4*)((const float*)res + o + 4); }
                    else { const v4u w = *(const v4u*)((const bf16*)res + o); x0[qq][bj] = (f32x4){bflo(w.x), bfhi(w.x), bflo(w.y), bfhi(w.y)}; x1[qq][bj] = (f32x4){bflo(w.z), bfhi(w.z), bflo(w.w), bfhi(w.w)}; } }
#pragma unroll
            for (int qq = 0; qq < 4; ++qq) { const int q = hb * 4 + qq, ai = q >> 2, m = q & 3; const int r = EPI_ROW(q); float ss = 0.f;
#pragma unroll
                for (int bj = 0; bj < 2; ++bj) { const f32x4 v0 = acc[ai][bj][m][0] + x0[qq][bj], v1 = acc[ai][bj][m][1] + x1[qq][bj]; ss += sumsq8(v0, v1); *(v4u*)(Y + (size_t)r * 1024 + cb + bj * 128) = pack8(v0, v1); }
                ss = fq_sum(ss); if (fq == 0) PS[(size_t)r * 16 + u.pn * 4 + wc] = ss; }
        }
    }
};
DI f32x4 silu_mul(f32x4 g, f32x4 u) { f32x4 o;
#pragma unroll
    for (int j = 0; j < 4; ++j) o[j] = g[j] * u[j] * __builtin_amdgcn_rcpf(1.f + ex2(-g[j] * LOG2E)); return o; }
struct EpiSwiGLU {
    static constexpr bool PERM = true, AFTER_DRAIN = false;
    bf16* H; int ldh, ntile; const float* PS; const float* srs;
    DI void operator()(AccRef acc, const Unit& u, int wr, int wc, int fr, int fq) const {
        { int ln_ = (int)__builtin_amdgcn_mbcnt_hi(~0u, __builtin_amdgcn_mbcnt_lo(~0u, 0u)); asm volatile("" : "+v"(ln_)); fr = ln_ & 15; fq = ln_ >> 4; }
        float rs[8];
        if (PS) EPI_RSTD8(rs, 4, PS, 16, 0, 1.f / 1024.f);
        else {
#pragma unroll
            for (int q = 0; q < 8; ++q) rs[q] = srs[EPI_ROW(q)]; }
#pragma unroll
        for (int q = 0; q < 8; ++q) { const int ai = q >> 2, m = q & 3; const int r = EPI_ROW(q);
            const f32x4 h0 = silu_mul(acc[ai][0][m][0] * rs[q], acc[ai][1][m][0] * rs[q]), h1 = silu_mul(acc[ai][0][m][1] * rs[q], acc[ai][1][m][1] * rs[q]);
            *(v4u*)(H + (size_t)r * ldh + (u.pn % ntile) * 128 + wc * 32 + fq * 8) = pack8(h0, h1); }
    }
};
struct EpiQkv {
    static constexpr bool PERM = true, AFTER_DRAIN = false;
    bf16* Q2; const float* PS; float* KMP;
    DI void operator()(AccRef acc, const Unit& u, int wr, int wc, int fr, int fq) const {
        { int ln_ = (int)__builtin_amdgcn_mbcnt_hi(~0u, __builtin_amdgcn_mbcnt_lo(~0u, 0u)); asm volatile("" : "+v"(ln_)); fr = ln_ & 15; fq = ln_ >> 4; }
        float rs[8]; EPI_RSTD8(rs, 4, PS, 16, 0, 1.f / 1024.f);
        const int sec = u.pn >> 2; bf16* dstb = Q2 + (size_t)sec * (size_t)(32u << 20);
        f32x4 cs[2][2];
#pragma unroll
        for (int bj = 0; bj < 2; ++bj) { cs[bj][0] = (f32x4){0.f, 0.f, 0.f, 0.f}; cs[bj][1] = cs[bj][0]; }
#pragma unroll
        for (int q = 0; q < 8; ++q) { const int ai = q >> 2, m = q & 3; const int r = EPI_ROW(q);
#pragma unroll
            for (int bj = 0; bj < 2; ++bj) { const f32x4 v0 = acc[ai][bj][m][0] * rs[q], v1 = acc[ai][bj][m][1] * rs[q]; cs[bj][0] += v0; cs[bj][1] += v1;
                *(v4u*)(dstb + (size_t)r * 1024 + (u.pn & 3) * 256 + bj * 128 + wc * 32 + fq * 8) = pack8(v0, v1); }
        }
        if (sec == 1) {
#pragma unroll
            for (int bj = 0; bj < 2; ++bj)
#pragma unroll
                for (int n = 0; n < 2; ++n) { f32x4 s = cs[bj][n];
#pragma unroll
                    for (int j = 0; j < 4; ++j) { float t = s[j]; t += __shfl_xor(t, 1); t += __shfl_xor(t, 2); t += __shfl_xor(t, 4); t += __shfl_xor(t, 8); s[j] = t; }
                    if (fr == 0) *(f32x4*)(KMP + ((size_t)wr * (T / 256) + u.pm) * 1024 + (u.pn & 3) * 256 + bj * 128 + wc * 32 + fq * 8 + n * 4) = s; }
        }
    }
};
struct EpiMoeDown {
    static constexpr bool PERM = true, AFTER_DRAIN = false;
    bf16* YP; const int* sdst; const float* sw;
    DI void operator()(AccRef acc, const Unit& u, int wr, int wc, int fr, int fq) const {
        { int ln_ = (int)__builtin_amdgcn_mbcnt_hi(~0u, __builtin_amdgcn_mbcnt_lo(~0u, 0u)); asm volatile("" : "+v"(ln_)); fr = ln_ & 15; fq = ln_ >> 4; }
        int d[8]; float w[8];
#pragma unroll
        for (int q = 0; q < 8; ++q) { d[q] = sdst[EPI_ROW(q)]; w[q] = sw[EPI_ROW(q)]; }
#pragma unroll
        for (int q = 0; q < 8; ++q) { const int ai = q >> 2, m = q & 3;
            if (d[q] >= 0) {
#pragma unroll
                for (int bj = 0; bj < 2; ++bj) __builtin_nontemporal_store(pack8(acc[ai][bj][m][0] * w[q], acc[ai][bj][m][1] * w[q]), (v4u*)(YP + (size_t)d[q] * 1024 + (u.pn & 3) * 256 + bj * 128 + wc * 32 + fq * 8)); }
        }
    }
};
struct MoeOrder {
    const int* tile_e; int nrt, G, c;
    DI bool next(int i, Unit& u) const { const long L = (long)i * G + c; if (L >= (long)nrt * 4) return false; const int rt = (int)(L >> 2); u.pm = rt; u.pn = tile_e[rt] * 4 + (int)(L & 3); return true; }
    DI void a_ready(const Unit&) const {}
    DI void done(const Unit&) const {}
};

#ifndef DBG_CHECK
#define DBG_CHECK 0
#endif
constexpr int CW_ERR = 8320;
#if DBG_CHECK
DI float bf2f(bf16 v) { return __uint_as_float((unsigned)v << 16); }
DI void dbg_flag(unsigned* ctl, unsigned bit) { atomicOr(ctl + CW_ERR, bit); }
DI float blk_max(float v, LAS float* red, int tid) { red[tid] = v; __syncthreads(); for (int o = 256; o > 0; o >>= 1) { if (tid < o) red[tid] = fmaxf(red[tid], red[tid + o]); __syncthreads(); } const float r = red[0]; __syncthreads(); return r; }
DI float blk_sum(float v, LAS float* red, int tid) { red[tid] = v; __syncthreads(); for (int o = 256; o > 0; o >>= 1) { if (tid < o) red[tid] = red[tid] + red[tid + o]; __syncthreads(); } const float r = red[0]; __syncthreads(); return r; }
DI unsigned dbg_hash(unsigned i) { i ^= i >> 16; i *= 0x7feb352du; i ^= i >> 15; i *= 0x846ca68bu; i ^= i >> 16; return i; }
DI int dbg_pos(int i) { switch (i) { case 0: return 0; case 1: return 1; case 2: return 31; case 3: return 32; case 4: return 63; case 5: return 64; case 6: return 65; case 7: return 255; case 8: return 256; case 9: return 257;
    case 10: return 511; case 11: return 512; case 12: return 4095; case 13: return 4096; case 14: return 8191; case 15: return 16383; default: return (int)(dbg_hash((unsigned)i) % SEQ); } }
template <int MODE> DI void naive_attn(const Args& a, int b, int h, int s, LAS unsigned char* lds, unsigned sel) {
    const int tid = threadIdx.x; unsigned char* ws = a.ws;
    LAS float* lg = (LAS float*)lds; LAS float* red = (LAS float*)(lds + 65536); LAS float* qv = (LAS float*)(lds + 67584); LAS float* opart = (LAS float*)(lds + 68096); LAS float* oref = (LAS float*)(lds + 70144);
    const size_t r = (size_t)b * SEQ + s;
    const int DQ = MODE == 0 ? 96 : 64; float mblk = 0.f;
    if (tid < DQ) { float q;
        if (MODE == 0) q = bf2f(((const bf16*)(ws + WS_QA))[r * 768 + h * 96 + tid]); else if (MODE == 1) q = bf2f(((const bf16*)(ws + WS_SBQ))[r * 512 + h * 64 + tid]); else q = bf2f(((const bf16*)(ws + WS_Q2))[r * 1024 + h * 64 + tid]);
        qv[tid] = q; }
    __syncthreads();
    const int nk = MODE == 1 ? s : s + 1;
    float lmax = -INFINITY;
    for (int k = tid; k < nk; k += 512) { const size_t kr = (size_t)b * SEQ + k; float acc = 0.f;
        if (MODE == 0) { const bf16* kn = (const bf16*)(ws + WS_KN) + kr * 512 + h * 64; const bf16* kp = (const bf16*)(ws + WS_KR) + kr * 32;
            for (int d = 0; d < 64; ++d) acc += qv[d] * bf2f(kn[d]); for (int d = 0; d < 32; ++d) acc += qv[64 + d] * bf2f(kp[d]); }
        else if (MODE == 1) { const bf16* kk = (const bf16*)(ws + WS_SBK) + kr * 512 + h * 64; for (int d = 0; d < 64; ++d) acc += qv[d] * bf2f(kk[d]); }
        else { const int kb = k >> 8, qb = s >> 8; (void)qb; const bool ok = (MODE == 2 && kb == qb) || kb == (int)(sel & 0xFFu) || kb == (int)((sel >> 8) & 0xFFu) || kb == (int)((sel >> 16) & 0xFFu);
            if (ok) { const bf16* kk = (const bf16*)(ws + WS_K2) + kr * 1024 + h * 64; for (int d = 0; d < 64; ++d) acc += qv[d] * bf2f(kk[d]);
                const int dist = s - k; int bucket = dist; if (dist >= 16) { bucket = 16 + (int)(logf((float)dist / 16.f) / 2.0794415416798357f * 16.f); if (bucket > 31) bucket = 31; }
                acc += a.in[I_RELB][h * 32 + bucket] * LOG2E; } else acc = -INFINITY; }
        lg[k] = acc; lmax = fmaxf(lmax, acc); }
    __syncthreads();
    float tot = 1.f;
    if (MODE == 1) { if (tid == 0) { float run = 0.f; for (int k = nk - 1; k >= 0; --k) { const float y = lg[k]; const float sp = fmaxf(y, 0.f) + log2f(1.f + exp2f(-fabsf(y))); lg[k] = exp2f(y - sp + run); run -= sp; } } __syncthreads(); }
    else { const float m = blk_max(lmax, red, tid); mblk = m; float ls = 0.f; for (int k = tid; k < nk; k += 512) { const float p = exp2f(lg[k] - m); lg[k] = p; ls += p; } __syncthreads(); tot = blk_sum(ls, red, tid); }
    { const int g = tid >> 6, d = tid & 63; float acc = 0.f;
      for (int k = g; k < nk; k += 8) { const size_t kr = (size_t)b * SEQ + k; float v;
          if (MODE == 0) v = bf2f(((const bf16*)(ws + WS_VA))[kr * 512 + h * 64 + d]); else if (MODE == 1) v = bf2f(((const bf16*)(ws + WS_SBV))[kr * 512 + h * 64 + d]); else v = bf2f(((const bf16*)(ws + WS_V2))[kr * 1024 + h * 64 + d]);
          const float p = lg[k]; if (p != 0.f) acc += p * v; }
      opart[g * 64 + d] = acc; }
    __syncthreads();
    if (tid < 64) { float acc = 0.f; for (int g = 0; g < 8; ++g) acc += opart[g * 64 + tid]; oref[tid] = acc / tot; }
    if (tid == 0) oref[64] = mblk + log2f(tot);
    __syncthreads();
}
DI void dbg_cmp64(const bf16* got, LAS unsigned char* lds, unsigned* ctl, unsigned bit) {
    const int tid = threadIdx.x; LAS float* red = (LAS float*)(lds + 65536); LAS float* oref = (LAS float*)(lds + 70144);
    const float v = tid < 64 ? fabsf(oref[tid]) : 0.f; const float mx = blk_max(v, red, tid);
    if (tid < 64) { const float g = bf2f(got[tid]); if (!(fabsf(g - oref[tid]) <= 0.02f * mx + 2e-3f)) dbg_flag(ctl, bit); }
    __syncthreads();
}
DI void dbg_check_a(const Args& a, LAS unsigned char* lds, unsigned* ctl, int bx, int G) {
    const int tid = threadIdx.x; unsigned char* ws = a.ws;
    LAS float* red = (LAS float*)(lds + 65536); LAS float* hrow = (LAS float*)lds;
    LAS float* cq = (LAS float*)(lds + 4096); LAS float* ckv = (LAS float*)(lds + 8192);
    const float2* rope = (const float2*)(ws + WS_ROPE);
    for (int i = bx; i < 256; i += G) {
        const int b = i & 1, s = dbg_pos(i >> 1); const size_t r = (size_t)b * SEQ + s;
        float ss = 0.f; for (int k = tid; k < 1024; k += 512) { const float x = a.in[I_X][r * 1024 + k]; ss += x * x; }
        const float rs = rsqrtf(blk_sum(ss, red, tid) / 1024.f + RMS_EPS);
        for (int k = tid; k < 1024; k += 512) hrow[k] = a.in[I_X][r * 1024 + k] * rs * a.in[I_EV_AN][k];
        __syncthreads();
        for (int j = tid; j < 2208; j += 512) { float acc = 0.f; for (int k = 0; k < 1024; ++k) acc += hrow[k] * a.in[I_EV_WIN][(size_t)k * 2208 + j];
            float got, ref = acc; bool cmp = true;
            if (j < 384) got = bf2f(((const bf16*)(ws + WS_CQ))[r * 384 + j]);
            else if (j < 640) got = bf2f(((const bf16*)(ws + WS_CKV))[r * 256 + (j - 384)]);
            else if (j < 672) { cmp = false; got = 0.f; }
            else if (j < 1184) { got = bf2f(((const bf16*)(ws + WS_SBQ))[r * 512 + (j - 672)]); ref = acc * C_64; }
            else if (j < 1696) got = bf2f(((const bf16*)(ws + WS_SBK))[r * 512 + (j - 1184)]);
            else got = bf2f(((const bf16*)(ws + WS_SBV))[r * 512 + (j - 1696)]);
            if (cmp && !(fabsf(got - ref) <= 0.03f * fabsf(ref) + 0.03f)) dbg_flag(ctl, 1u); }
        if (tid < 16) { float t1 = 0.f, t2 = 0.f; for (int k = 0; k < 1024; ++k) { t1 += hrow[k] * a.in[I_EV_WIN][(size_t)k * 2208 + 640 + tid]; t2 += hrow[k] * a.in[I_EV_WIN][(size_t)k * 2208 + 656 + tid]; }
            const float ang = (float)s * powf(10000.f, -(float)tid / 16.f); const float c = cosf(ang), sn = sinf(ang);
            const float o1 = t1 * c - t2 * sn, o2 = t2 * c + t1 * sn; const float g1 = bf2f(((const bf16*)(ws + WS_KR))[r * 32 + tid]), g2 = bf2f(((const bf16*)(ws + WS_KR))[r * 32 + 16 + tid]);
            if (!(fabsf(g1 - o1) <= 0.03f * fabsf(o1) + 0.03f) || !(fabsf(g2 - o2) <= 0.03f * fabsf(o2) + 0.03f)) dbg_flag(ctl, 1u);
            const float2 tb = rope[(size_t)s * 16 + tid]; if (!(fabsf(tb.x - c) < 2e-3f && fabsf(tb.y - sn) < 2e-3f)) dbg_flag(ctl, 1u); }
        __syncthreads();
        float s1 = 0.f, s2 = 0.f;
        if (tid < 384) { const float v = bf2f(((const bf16*)(ws + WS_CQ))[r * 384 + tid]); s1 = v * v; cq[tid] = v; }
        if (tid < 256) { const float v = bf2f(((const bf16*)(ws + WS_CKV))[r * 256 + tid]); s2 = v * v; ckv[tid] = v; }
        const float rq = rsqrtf(blk_sum(s1, red, tid) / 384.f + RMS_EPS), rk = rsqrtf(blk_sum(s2, red, tid) / 256.f + RMS_EPS);
        if (tid < 384) cq[tid] *= rq * a.in[I_EV_QN][tid];
        if (tid < 256) ckv[tid] *= rk * a.in[I_EV_KVN][tid];
        __syncthreads();
        for (int j = tid; j < 768; j += 512) { const int hh = j / 96, dd = j % 96; float acc = 0.f; for (int k = 0; k < 384; ++k) acc += cq[k] * a.in[I_EV_WUQ][(size_t)k * 768 + j];
            float ref = acc;
            if (dd >= 64) { const int ri = dd - 64, pi = ri < 16 ? ri : ri - 16; const int jp = hh * 96 + 64 + (ri < 16 ? ri + 16 : ri - 16); float accp = 0.f; for (int k = 0; k < 384; ++k) accp += cq[k] * a.in[I_EV_WUQ][(size_t)k * 768 + jp];
                const float ang = (float)s * powf(10000.f, -(float)pi / 16.f); const float c = cosf(ang), sn = sinf(ang); ref = ri < 16 ? acc * c - accp * sn : acc * c + accp * sn; }
            ref *= C_MLA; const float got = bf2f(((const bf16*)(ws + WS_QA))[r * 768 + j]);
            if (!(fabsf(got - ref) <= 0.03f * fabsf(ref) + 0.02f)) dbg_flag(ctl, 1u); }
        for (int j = tid; j < 1024; j += 512) { const int hh = j >> 7, dd = j & 127; float acc = 0.f; for (int k = 0; k < 256; ++k) acc += ckv[k] * a.in[I_EV_WUKV][(size_t)k * 1024 + j];
            const float got = dd < 64 ? bf2f(((const bf16*)(ws + WS_KN))[r * 512 + hh * 64 + dd]) : bf2f(((const bf16*)(ws + WS_VA))[r * 512 + hh * 64 + dd - 64]);
            if (!(fabsf(got - acc) <= 0.03f * fabsf(acc) + 0.03f)) dbg_flag(ctl, 1u); }
        __syncthreads();
        const int h = (int)(dbg_hash((unsigned)i * 7u + 1u) & 7u);
        naive_attn<0>(a, b, h, s, lds, 0u); dbg_cmp64((const bf16*)(ws + WS_OCAT) + r * 1024 + h * 64, lds, ctl, 2u);
        naive_attn<1>(a, b, h, s, lds, 0u); dbg_cmp64((const bf16*)(ws + WS_OCAT) + r * 1024 + 512 + h * 64, lds, ctl, 4u);
    }
}
DI void dbg_check_b(const Args& a, LAS unsigned char* lds, unsigned* ctl, int bx, int G, const bf16* O2) {
    const int tid = threadIdx.x; unsigned char* ws = a.ws;
    LAS float* red = (LAS float*)(lds + 65536); LAS float* hrow = (LAS float*)lds; LAS float* gate = (LAS float*)(lds + 8192);
    const bf16* X2 = (const bf16*)a.out;
    for (int i = bx; i < 256; i += G) {
        const int b = i & 1, s = dbg_pos(i >> 1), h = (int)(dbg_hash((unsigned)i * 11u + 5u) & 15u); const size_t r = (size_t)b * SEQ + s;
        float ss = 0.f; for (int k = tid; k < 1024; k += 512) { const float x = bf2f(X2[r * 1024 + k]); ss += x * x; }
        const float rs = rsqrtf(blk_sum(ss, red, tid) / 1024.f + RMS_EPS);
        for (int k = tid; k < 1024; k += 512) hrow[k] = bf2f(X2[r * 1024 + k]) * rs * a.in[I_OD_AN][k];
        __syncthreads();
        for (int j = tid; j < 3072; j += 512) { float acc = 0.f; for (int k = 0; k < 1024; ++k) acc += hrow[k] * a.in[I_OD_WQKV][(size_t)k * 3072 + j];
            float ref = acc; float got;
            if (j < 1024) { ref = acc * C_64; got = bf2f(((const bf16*)(ws + WS_Q2))[r * 1024 + j]); } else if (j < 2048) got = bf2f(((const bf16*)(ws + WS_K2))[r * 1024 + j - 1024]); else got = bf2f(((const bf16*)(ws + WS_V2))[r * 1024 + j - 2048]);
            if (!(fabsf(got - ref) <= 0.03f * fabsf(ref) + 0.03f)) dbg_flag(ctl, 8u); }
        __syncthreads();
        const int qb = s >> 8; const unsigned sel = ((const unsigned*)(ws + WS_SEL))[((size_t)(b * 16 + h)) * SEQ + s];
        if (tid < 64) gate[tid] = -INFINITY;
        __syncthreads();
        { const int n = tid >> 3, part = tid & 7;
          float acc = 0.f; if (n < qb) { for (int kk = part * 32; kk < part * 32 + 32; ++kk) { const size_t kr = (size_t)b * SEQ + n * 256 + kk; for (int d = 0; d < 64; ++d) acc += bf2f(((const bf16*)(ws + WS_Q2))[r * 1024 + h * 64 + d]) * bf2f(((const bf16*)(ws + WS_K2))[kr * 1024 + h * 64 + d]); } }
          acc += __shfl_xor(acc, 1); acc += __shfl_xor(acc, 2); acc += __shfl_xor(acc, 4); if (part == 0 && n < qb) gate[n] = acc / 256.f; }
        __syncthreads();
        if (tid == 0) { const int nsel_exp = qb < 3 ? qb : 3; int nsel = 0; float gmin = INFINITY; bool bad = false;
            for (int k = 0; k < 3; ++k) { const unsigned e = (sel >> (8 * k)) & 0xFFu; if (e != 0xFFu) { if ((int)e >= qb) bad = true; else { ++nsel; gmin = fminf(gmin, gate[e]); } } }
            if (nsel != nsel_exp) bad = true;
            if ((sel & 0xFFu) != 0xFFu && ((sel & 0xFFu) == ((sel >> 8) & 0xFFu) || (sel & 0xFFu) == ((sel >> 16) & 0xFFu))) bad = true;
            if (((sel >> 8) & 0xFFu) != 0xFFu && ((sel >> 8) & 0xFFu) == ((sel >> 16) & 0xFFu)) bad = true;
            if (!bad && nsel > 0) { float gsc = 0.f; for (int n = 0; n < qb; ++n) gsc = fmaxf(gsc, fabsf(gate[n]));
                for (int n = 0; n < qb; ++n) { const bool chosen = n == (int)(sel & 0xFFu) || n == (int)((sel >> 8) & 0xFFu) || n == (int)((sel >> 16) & 0xFFu); if (!chosen && gate[n] > gmin + 0.02f * gsc + 1e-3f) bad = true; } }
            if (bad) dbg_flag(ctl, 8u); }
        __syncthreads();
        { LAS float* oref = (LAS float*)(lds + 70144); float* dref = (float*)(ws + WS_WRT + 256 * 1024) + (size_t)i * 64;
          naive_attn<2>(a, b, h, s, lds, 0xFFFFFFu);
          { const float v = tid < 64 ? fabsf(oref[tid]) : 0.f; const float mx = blk_max(v, red, tid);
            const float2 ms = ((const float2*)(ws + WS_PMS))[((size_t)(3 * 32 + b * 16 + h)) * SEQ + s]; const bf16* pob = (const bf16*)a.out + (size_t)32 * 1024 * 1024 + (((size_t)(b * 16 + h)) * SEQ + s) * 64;
            if (tid == 0) { if (!(fabsf(ms.x + log2f(ms.y) - oref[64]) <= 0.05f)) dbg_flag(ctl, 8u); }
            if (tid < 64) { const float g = bf2f(pob[tid]) / ms.y; if (!(fabsf(g - oref[tid]) <= 0.02f * mx + 2e-3f)) dbg_flag(ctl, 8u); }
            __syncthreads(); }
          naive_attn<2>(a, b, h, s, lds, sel);
          if (tid < 64) dref[tid] = oref[tid];
          __syncthreads(); }
    }
}
DI void dbg_check_b2(const Args& a, LAS unsigned char* lds, unsigned* ctl, int bx, int G, const bf16* O2) {
    const int tid = threadIdx.x; unsigned char* ws = a.ws; LAS float* red = (LAS float*)(lds + 65536);
    for (int i = bx; i < 256; i += G) {
        const int b = i & 1, s = dbg_pos(i >> 1), h = (int)(dbg_hash((unsigned)i * 11u + 5u) & 15u); const size_t r = (size_t)b * SEQ + s;
        const float* dref = (const float*)(ws + WS_WRT + 256 * 1024) + (size_t)i * 64;
        const float rf = tid < 64 ? dref[tid] : 0.f; const float mx = blk_max(fabsf(rf), red, tid);
        if (tid < 64) { const float g = bf2f(O2[r * 1024 + h * 64 + tid]); if (!(fabsf(g - rf) <= 0.02f * mx + 2e-3f)) dbg_flag(ctl, 8u); }
        __syncthreads();
    }
}
#endif

DI void router_chunk(const Args& a, int ch, LAS unsigned char* lds) {
    int tid_ = threadIdx.x; asm volatile("" : "+v"(tid_)); const int tid = tid_, lane = tid & 63, wave = rfl(tid >> 6);
    unsigned char* ws = a.ws;
    const bf16* X3 = (const bf16*)(ws + WS_X3B); const float* PS3 = (const float*)(ws + WS_PS3);
    const LAS float* wrt = (const LAS float*)lds;
    volatile LAS unsigned* te = (volatile LAS unsigned*)(lds + 32768);
    float2* TOKW = (float2*)(ws + WS_TOKW); float* TOKR = (float*)(ws + WS_TOKR); unsigned* TOKE = (unsigned*)(ws + WS_TOKE);
    v4u nw0 = *((const v4u*)(X3 + (size_t)(ch * 128 + wave * 16) * 1024) + lane), nw1 = *((const v4u*)(X3 + (size_t)(ch * 128 + wave * 16) * 1024 + 512) + lane);
    float npss = PS3[(size_t)(ch * 128 + wave * 16) * 16 + (lane & 15)];
#pragma unroll 1
    for (int i = 0; i < 16; ++i) {
        const int tl = wave * 16 + i, tok = ch * 128 + tl;
        const v4u w0 = nw0, w1 = nw1; float pss = npss;
        if (i < 15) { nw0 = *((const v4u*)(X3 + (size_t)(tok + 1) * 1024) + lane); nw1 = *((const v4u*)(X3 + (size_t)(tok + 1) * 1024 + 512) + lane); npss = PS3[(size_t)(tok + 1) * 16 + (lane & 15)]; }
        float xv[16] = {bflo(w0.x), bfhi(w0.x), bflo(w0.y), bfhi(w0.y), bflo(w0.z), bfhi(w0.z), bflo(w0.w), bfhi(w0.w), bflo(w1.x), bfhi(w1.x), bflo(w1.y), bfhi(w1.y), bflo(w1.z), bfhi(w1.z), bflo(w1.w), bfhi(w1.w)};
        float lg[8];
#pragma unroll
        for (int e = 0; e < 8; ++e) { const LAS f32x4* p0 = (const LAS f32x4*)(wrt + e * 1024 + lane * 8); const LAS f32x4* p1 = (const LAS f32x4*)(wrt + e * 1024 + 512 + lane * 8);
            const f32x4 a0 = p0[0], a1 = p0[1], b0 = p1[0], b1 = p1[1];
            float s = xv[0] * a0[0] + xv[1] * a0[1] + xv[2] * a0[2] + xv[3] * a0[3] + xv[4] * a1[0] + xv[5] * a1[1] + xv[6] * a1[2] + xv[7] * a1[3];
            s += xv[8] * b0[0] + xv[9] * b0[1] + xv[10] * b0[2] + xv[11] * b0[3] + xv[12] * b1[0] + xv[13] * b1[1] + xv[14] * b1[2] + xv[15] * b1[3];
            lg[e] = wave_sum(s); }
        pss += __shfl_xor(pss, 1); pss += __shfl_xor(pss, 2); pss += __shfl_xor(pss, 4); pss += __shfl_xor(pss, 8);
        const float rs = rsqrtf(pss * (1.f / 1024.f) + RMS_EPS);
        float v1 = -INFINITY, v2 = -INFINITY; unsigned i1 = 0, i2 = 0;
#pragma unroll
        for (int e = 0; e < 8; ++e) { const float l = lg[e] * rs; if (l > v1) { v2 = v1; i2 = i1; v1 = l; i1 = (unsigned)e; } else if (l > v2) { v2 = l; i2 = (unsigned)e; } }
        const float w1g = 1.f / (1.f + __expf(v2 - v1));
        if (lane == 0) { TOKW[tok] = make_float2(w1g, 1.f - w1g); TOKR[tok] = rs; TOKE[tok] = i1 | (i2 << 8); te[tl] = i1 | (i2 << 8); }
    }
    __syncthreads();
    { const unsigned e = (unsigned)wave; const unsigned ta = te[2 * lane], tb = te[2 * lane + 1];
      const unsigned m0 = (ta & 0xFFu) == e, m1 = ((ta >> 8) & 0xFFu) == e, m2 = (tb & 0xFFu) == e, m3 = ((tb >> 8) & 0xFFu) == e;
      const unsigned c = m0 + m1 + m2 + m3; unsigned inc = c;
#pragma unroll
      for (int o = 1; o < 64; o <<= 1) { const unsigned t = __shfl_up(inc, o); if (lane >= o) inc += t; }
      unsigned base = inc - c; int* PR = (int*)(ws + WS_PRANK) + (size_t)ch * 256 + 4 * lane;
      if (m0) { PR[0] = (int)base; ++base; } if (m1) { PR[1] = (int)base; ++base; } if (m2) { PR[2] = (int)base; ++base; } if (m3) { PR[3] = (int)base; ++base; }
      if (lane == 63) ((int*)(ws + WS_CNT))[ch * 8 + wave] = (int)inc; }
    __syncthreads();
}

DI void permute_phase(const Args& a, LAS unsigned char* lds, int G) {
    int tid_ = threadIdx.x; asm volatile("" : "+v"(tid_)); const int tid = tid_;
    unsigned char* ws = a.ws;
    LAS int* cnt = (LAS int*)lds;
    LAS int* off = (LAS int*)(lds + 8192);
    LAS int* ebase = (LAS int*)(lds + 16384);
    const int* CNT = (const int*)(ws + WS_CNT);
    for (int i = tid; i < 2048; i += 512) cnt[i] = CNT[i];
    __syncthreads();
    if (tid < 8) { int s = 0; for (int c = 0; c < 256; ++c) { off[c * 8 + tid] = s; s += cnt[c * 8 + tid]; } ebase[16 + tid] = s; }
    __syncthreads();
    if (tid == 0) { int s = 0; for (int e = 0; e < 8; ++e) { ebase[e] = s; s += (ebase[16 + e] + 255) & ~255; } ebase[8] = s; }
    __syncthreads();
    int* SDST = (int*)(ws + WS_SDST); float* SW = (float*)(ws + WS_SW); float* SRS = (float*)(ws + WS_SRS);
    int* STOK = (int*)(ws + WS_STOK);
    const float2* TOKW = (const float2*)(ws + WS_TOKW); const float* TOKR = (const float*)(ws + WS_TOKR); const unsigned* TOKE = (const unsigned*)(ws + WS_TOKE); const int* PRANK = (const int*)(ws + WS_PRANK);
    if (blockIdx.x == 0) {
        int* TE = (int*)(ws + WS_TILEE); const int nrt = ebase[8] >> 8;
        for (int rt = tid; rt < nrt; rt += 512) { int e = 0; for (int k = 1; k < 8; ++k) if (rt * 256 >= ebase[k]) e = k; TE[rt] = e; }
        if (tid == 0) ((unsigned*)(ws + WS_CTL))[CW_NRT] = (unsigned)nrt;
    }
    for (int e = blockIdx.x; e < 8; e += G) {
        const int lo = ebase[e] + ebase[16 + e], hi = ebase[e + 1];
        for (int s = lo + tid; s < hi; s += 512) { SDST[s] = -1; SW[s] = 0.f; SRS[s] = 0.f; STOK[s] = 0; }
    }
    for (int ch = blockIdx.x; ch < 256; ch += G) {
        if (tid < 256) { const int tok = ch * 128 + (tid >> 1), k = tid & 1; const unsigned te = TOKE[tok]; const int e = (int)((te >> (8 * k)) & 0xFFu);
            const int slot = ebase[e] + off[ch * 8 + e] + PRANK[(size_t)ch * 256 + tid];
            const float2 w = TOKW[tok]; SDST[slot] = tok * 2 + k; SW[slot] = k ? w.y : w.x; SRS[slot] = TOKR[tok]; STOK[slot] = tok; }
    }
}

DI void final_phase(const Args& a, int vcu, int G, float oscale) {
    int tid_ = threadIdx.x; asm volatile("" : "+v"(tid_)); const int tid = tid_, lane = tid & 63, wave = rfl(tid >> 6);
    const bf16* X3 = (const bf16*)(a.ws + WS_X3B); const bf16* YP = (const bf16*)(a.ws + WS_YP); const float* g = a.in[I_FINN];
    const int gw = vcu * 8 + wave, NGW = G * 8;
    f32x4 gv[4];
#pragma unroll
    for (int j = 0; j < 4; ++j) gv[j] = *((const f32x4*)g + 2 * lane + (j & 1) + 128 * (j >> 1));
    v4u nx[2], ny0[2], ny1[2];
#define FN_LOAD(m) do { _Pragma("unroll") for (int hlf = 0; hlf < 2; ++hlf) { nx[hlf] = __builtin_nontemporal_load((const v4u*)(X3 + (size_t)(m) * 1024 + hlf * 512) + lane); \
        ny0[hlf] = __builtin_nontemporal_load((const v4u*)(YP + (size_t)(2 * (m)) * 1024 + hlf * 512) + lane); ny1[hlf] = __builtin_nontemporal_load((const v4u*)(YP + (size_t)(2 * (m) + 1) * 1024 + hlf * 512) + lane); } } while (0)
    if (gw < T) FN_LOAD(gw);
    for (int m = gw; m < T; m += NGW) {
        float v[16]; float ss = 0.f;
        const v4u cx[2] = {nx[0], nx[1]}, cy0[2] = {ny0[0], ny0[1]}, cy1[2] = {ny1[0], ny1[1]};
        if (m + NGW < T) FN_LOAD(m + NGW);
#pragma unroll
        for (int hlf = 0; hlf < 2; ++hlf) {
            const v4u x = cx[hlf], y0 = cy0[hlf], y1 = cy1[hlf];
            const unsigned xs[4] = {x.x, x.y, x.z, x.w}, as[4] = {y0.x, y0.y, y0.z, y0.w}, bs[4] = {y1.x, y1.y, y1.z, y1.w};
#pragma unroll
            for (int j = 0; j < 4; ++j) { const float lo = bflo(xs[j]) + (bflo(as[j]) + bflo(bs[j])), hh = bfhi(xs[j]) + (bfhi(as[j]) + bfhi(bs[j])); v[hlf * 8 + 2 * j] = lo; v[hlf * 8 + 2 * j + 1] = hh; ss += lo * lo + hh * hh; }
        }
        ss = wave_sum(ss); const float rs = rsqrtf(ss * (1.f / 1024.f) + RMS_EPS) * oscale;
        float* o = a.out + (size_t)m * 1024;
#pragma unroll
        for (int hlf = 0; hlf < 2; ++hlf) { f32x4 o0, o1;
#pragma unroll
            for (int j = 0; j < 4; ++j) { o0[j] = v[hlf * 8 + j] * rs * gv[hlf * 2][j]; o1[j] = v[hlf * 8 + 4 + j] * rs * gv[hlf * 2 + 1][j]; }
            __builtin_nontemporal_store(o0, (f32x4*)(o + hlf * 512) + 2 * lane); __builtin_nontemporal_store(o1, (f32x4*)(o + hlf * 512) + 2 * lane + 1); }
    }
}

__global__ void __launch_bounds__(512, 2) hybrid_fwd(Args args) {
    extern __shared__ __attribute__((aligned(16))) unsigned char lds_raw[];
    LAS unsigned char* lds = (LAS unsigned char*)lds_raw;
    volatile LAS unsigned* MISC = (volatile LAS unsigned*)(lds + MISC_OFF);
    const int tid = threadIdx.x, wave = rfl(tid >> 6), lane = tid & 63;
    const int G = gridDim.x; const int bx = blockIdx.x; const int vcu = (G % 8 == 0) ? (bx % 8) * (G / 8) + bx / 8 : bx;
    unsigned char* ws = args.ws;
    unsigned* ctl = (unsigned*)(ws + WS_CTL);
    for (int u = tid; u < (LDS_BYTES - PHASE_LDS) / 4; u += 512) ((LAS unsigned*)(lds + PHASE_LDS))[u] = 0u;
    __syncthreads();
    XcdBarrier bar; bar.bar = ctl + CW_BAR; bar.x = 0; bar.st = nullptr;
#if MK_ONE_LAUNCH
    (void)xcd_barrier_post(ctl + CW_BAR, MISC + 8);
#if defined(PROBE_DUP) && ((PROBE_DUP >> 21) & 1)
#define GRID_BAR() do { const unsigned long long t0_ = __builtin_amdgcn_s_memrealtime(); XcdBarrier b_; b_.bar = (unsigned*)(args.ws + WS_CTL) + CW_BAR; b_.x = xb_xcc_id(); b_.st = (volatile LAS unsigned*)(lds + MISC_OFF) + 8; xcd_barrier(b_); if ((PROBE_SEAMS >> prb_k_) & 1) prb_wait_ += __builtin_amdgcn_s_memrealtime() - t0_; } while (0)
#else
#define GRID_BAR() do { XcdBarrier b_; b_.bar = (unsigned*)(args.ws + WS_CTL) + CW_BAR; b_.x = xb_xcc_id(); b_.st = (volatile LAS unsigned*)(lds + MISC_OFF) + 8; xcd_barrier(b_); } while (0)
#endif
#else
#define GRID_BAR() do { } while (0)
#endif
    int prb_k_ = 0; (void)prb_k_; unsigned long long prb_wait_ = 0; (void)prb_wait_;
    const int lo = args.ph_lo, hi = args.ph_hi;
#ifndef PH_MASK
#define PH_MASK 0x1FFFF
#endif
#define IN(k) (((PH_MASK >> (k)) & 1) && lo <= (k) && (k) < hi)
#if defined(PROBE_DUP) && ((PROBE_DUP >> 20) & 1)
#define SEAM(k) do { if (IN((k) + 1)) { GRID_BAR(); GRID_BAR(); } } while (0)
#else
#define SEAM(k) do { prb_k_ = (k); if (IN((k) + 1)) GRID_BAR(); } while (0)
#endif
#ifndef PROBE_DUP
#define PROBE_DUP 0
#endif
#define REP(k) for (int rep_ = 0; rep_ < (((PROBE_DUP >> (k)) & 1) ? 2 : 1); ++rep_)
    (void)lane; (void)wave;

    bf16* XB = (bf16*)(ws + WS_XB); bf16* OCAT = (bf16*)(ws + WS_OCAT);
    bf16 *SBQ = (bf16*)(ws + WS_SBQ), *SBK = (bf16*)(ws + WS_SBK), *SBV = (bf16*)(ws + WS_SBV), *CQ = (bf16*)(ws + WS_CQ), *CKV = (bf16*)(ws + WS_CKV), *KR = (bf16*)(ws + WS_KR);
    bf16 *QA = (bf16*)(ws + WS_QA), *KN = (bf16*)(ws + WS_KN), *VA = (bf16*)(ws + WS_VA), *X1B = (bf16*)(ws + WS_X1B), *HID = (bf16*)(ws + WS_HID), *X2B = (bf16*)args.out;
    bf16 *Q2 = (bf16*)(ws + WS_Q2), *K2 = (bf16*)(ws + WS_K2), *V2 = (bf16*)(ws + WS_V2), *X3B = (bf16*)(ws + WS_X3B), *YP = (bf16*)(ws + WS_YP), *HIDE = (bf16*)(ws + WS_HIDE);
    float *PQKV = (float*)(ws + WS_PQKV), *PS1 = (float*)(ws + WS_PS1), *PS2 = (float*)(ws + WS_PS2), *PS3 = (float*)(ws + WS_PS3), *KMP = (float*)(ws + WS_KMP);
    bf16* O2 = Q2;
    bf16* PO3 = (bf16*)args.out + (size_t)32 * 1024 * 1024;
    const float2* ROPE = (const float2*)(ws + WS_ROPE); unsigned* SEL = (unsigned*)(ws + WS_SEL); float2* PMS = (float2*)(ws + WS_PMS);

    if (IN(0)) REP(0) { p0_prologue(args, lds, vcu, G); SEAM(0); }
    if (IN(1)) REP(1) {
        pg8::Gemm g{XB, (const bf16*)(ws + W_IN), T, 2304, 1024}; pg8::StaticOrder S; S.init(T, 2304, G, bx);
        EpiInProj E{SBQ, CQ, CKV, KR, (const float*)(ws + WS_RSTD0), PQKV, ROPE};
        pg8::gemm_phase<EpiInProj, pg8::StaticOrder, true, true>(lds, g, S, E);
        { const bool half = (G == 256); if (!half || bx >= 128) { __syncthreads(); p0_weights(args, lds, (half ? bx - 128 : bx) * 8 + wave, (half ? 128 : G) * 8, true); } }
        SEAM(1);
    }
    if (IN(2)) REP(2) {
        { pg8::Gemm g{CQ, (const bf16*)(ws + W_UQ), T, 768, 384}; pg8::StaticOrder S; S.init(T, 768, G, bx);
          EpiQUp E{QA, PQKV, ROPE}; pg8::gemm_phase<EpiQUp, pg8::StaticOrder, true, true>(lds, g, S, E); }
        __syncthreads();
        { pg8::Gemm g{CKV, (const bf16*)(ws + W_UKV), T, 1024, 256}; pg8::StaticOrder S; S.init(T, 1024, G, bx);
          EpiKvUp E{KN, PQKV}; pg8::gemm_phase<EpiKvUp, pg8::StaticOrder, true, true>(lds, g, S, E); }
        SEAM(2);
    }
    if (IN(3)) REP(3) {
        REP(17) for (int v = vcu; v < 256; v += G) { const int bh = v >> 4, s = v & 15;
            att::mla_unit(bh, 63 - s, QA, KN, KR, VA, OCAT, lds); att::mla_unit(bh, 32 + s, QA, KN, KR, VA, OCAT, lds);
            att::mla_unit(bh, 31 - s, QA, KN, KR, VA, OCAT, lds); att::mla_unit(bh, s, QA, KN, KR, VA, OCAT, lds); }
        REP(18) { volatile LAS int* qslot = (volatile LAS int*)(lds + PHASE_LDS - 64);
          unsigned* qw = ctl + CW_QUEUE + 192 + 64 * rep_;
          if (tid == 0) qslot[0] = (int)atomicAdd(qw, 1u);
          __syncthreads();
          int uidx = qslot[0];
          __syncthreads();
          while (uidx < 1024) {
              unsigned nx = 0u; if (tid == 0) nx = atomicAdd(qw, 1u);
              att::sb_unit(uidx & 15, 63 - (uidx >> 4), SBQ, SBK, SBV, OCAT, lds);
              if (tid == 0) qslot[0] = (int)nx;
              __syncthreads();
              uidx = qslot[0];
              __syncthreads();
          } }
        SEAM(3);
#if DBG_CHECK & 1
        dbg_check_a(args, lds, ctl, bx, G);
#endif
    }
    if (IN(4)) REP(4) {
        pg8::Gemm g{OCAT, (const bf16*)(ws + W_O0), T, 1024, 1024}; pg8::StaticOrder S; S.init(T, 1024, G, bx);
        EpiRes<true> E{args.in[I_X], X1B, PS1}; pg8::gemm_phase<EpiRes<true>, pg8::StaticOrder, true, true>(lds, g, S, E);
        SEAM(4);
    }
    if (IN(5)) REP(5) {
        pg8::Gemm g{X1B, (const bf16*)(ws + W_GU0), T, 4096, 1024}; pg8::StaticOrder S; S.init(T, 4096, G, bx);
        EpiSwiGLU E{HID, 2048, 16, PS1, nullptr}; pg8::gemm_phase<EpiSwiGLU, pg8::StaticOrder, true, true>(lds, g, S, E);
        SEAM(5);
    }
    if (IN(6)) REP(6) {
        pg8::Gemm g{HID, (const bf16*)(ws + W_DN0), T, 1024, 2048}; pg8::StaticOrder S; S.init(T, 1024, G, bx);
        EpiRes<false> E{X1B, X2B, PS2}; pg8::gemm_phase<EpiRes<false>, pg8::StaticOrder, true, true>(lds, g, S, E);
        SEAM(6);
    }
    if (IN(7)) REP(7) {
        pg8::Gemm g{X2B, (const bf16*)(ws + W_QKV), T, 3072, 1024}; pg8::StaticOrder S; S.init(T, 3072, G, bx);
        EpiQkv E{Q2, PS2, KMP}; pg8::gemm_phase<EpiQkv, pg8::StaticOrder, true, true>(lds, g, S, E);
        SEAM(7);
    }
    if (IN(8)) REP(8) {
        for (int v = vcu; v < 256; v += G) att::moba_gate_unit(v & 31, v >> 5, Q2, KMP, SEL, (unsigned*)(ws + WS_MASK), lds);
        SEAM(8);
    }
    if (IN(9)) REP(9) {
        volatile LAS int* qslot = (volatile LAS int*)(lds + att::MB_OFF_Q);
        if (tid == 0) qslot[0] = (int)atomicAdd(ctl + CW_QUEUE + 64 * rep_, 1u);
        __syncthreads();
        int uidx = qslot[0];
        __syncthreads();
        while (uidx < 64 * 32) {
            unsigned nx = 0u; if (tid == 0) nx = atomicAdd(ctl + CW_QUEUE + 64 * rep_, 1u);
            att::moba_sel_unit(uidx & 31, uidx >> 5, Q2, K2, V2, (const unsigned long long*)(ws + WS_MASK), args.in[I_RELB], (bf16*)(ws + WS_PO0), (bf16*)(ws + WS_PO1), (bf16*)(ws + WS_PO2), PO3, PMS, lds);
            if (tid == 0) qslot[0] = (int)nx;
            __syncthreads();
            uidx = qslot[0];
            __syncthreads();
        }
        SEAM(9);
#if DBG_CHECK & 2
        dbg_check_b(args, lds, ctl, bx, G, O2); GRID_BAR();
#endif
    }
    if (IN(10)) REP(10) {
        att::moba_merge(vcu * 8 + wave, G * 8, SEL, (const bf16*)(ws + WS_PO0), (const bf16*)(ws + WS_PO1), (const bf16*)(ws + WS_PO2), PO3, PMS, O2);
        SEAM(10);
#if DBG_CHECK & 2
        dbg_check_b2(args, lds, ctl, bx, G, O2);
#endif
    }
    if (IN(11)) REP(11) {
        pg8::Gemm g{O2, (const bf16*)(ws + W_O1), T, 1024, 1024}; pg8::StaticOrder S; S.init(T, 1024, G, bx);
        EpiRes<false> E{X2B, X3B, PS3}; pg8::gemm_phase<EpiRes<false>, pg8::StaticOrder, true, true>(lds, g, S, E);
        SEAM(11);
    }
    if (IN(12)) REP(12) {
        { const f32x4* wrt = (const f32x4*)(ws + WS_WRT); f32x4 t_[4];
#pragma unroll
          for (int i = 0; i < 4; ++i) t_[i] = wrt[tid + 512 * i];
#pragma unroll
          for (int i = 0; i < 4; ++i) ((LAS f32x4*)lds)[tid + 512 * i] = t_[i]; }
        __syncthreads();
        for (int ch = bx; ch < 256; ch += G) router_chunk(args, ch, lds);
        SEAM(12);
    }
    if (IN(13)) REP(13) { permute_phase(args, lds, G); SEAM(13); }
    if (IN(14)) REP(14) {
        const int nrt = (int)ctl[CW_NRT];
        pg8::Gemm g{X3B, (const bf16*)(ws + W_EGU), NSLOT, 8192, 1024, (const int*)(ws + WS_STOK)}; MoeOrder S{(const int*)(ws + WS_TILEE), nrt, G, bx};
        EpiSwiGLU E{HIDE, 512, 4, nullptr, (const float*)(ws + WS_SRS)}; pg8::gemm_phase<EpiSwiGLU, MoeOrder, true, true, true>(lds, g, S, E);
        SEAM(14);
    }
    if (IN(15)) REP(15) {
        const int nrt = (int)ctl[CW_NRT];
        pg8::Gemm g{HIDE, (const bf16*)(ws + W_EDN), NSLOT, 8192, 512}; MoeOrder S{(const int*)(ws + WS_TILEE), nrt, G, bx};
        EpiMoeDown E{YP, (const int*)(ws + WS_SDST), (const float*)(ws + WS_SW)}; pg8::gemm_phase<EpiMoeDown, MoeOrder, true, true>(lds, g, S, E);
        SEAM(15);
    }
    if (IN(16)) REP(16) {
        float oscale = 1.f;
#if DBG_CHECK
        oscale = 1.f + 0.25f * (float)__hip_atomic_load(ctl + CW_ERR, __ATOMIC_RELAXED, __HIP_MEMORY_SCOPE_AGENT);
#endif
        final_phase(args, vcu, G, oscale);
#if defined(PROBE_DUP) && ((PROBE_DUP >> 21) & 1)
        if (bx == ((PROBE_DUP >> 22) & 0xFF)) { const unsigned long long t0_ = __builtin_amdgcn_s_memrealtime(); while (__builtin_amdgcn_s_memrealtime() - t0_ < 4ull * prb_wait_) __builtin_amdgcn_s_sleep(8); }
#endif
#if MK_ONE_LAUNCH
        if (bx == 0 && tid == 0) { if (__hip_atomic_load(ctl + CW_BAR + XB_TMO, __ATOMIC_RELAXED, __HIP_MEMORY_SCOPE_AGENT) != 0u) args.out[0] = __builtin_nanf(""); }
#endif
    }
#undef IN
#undef SEAM
}

extern "C" void kernel_launch(void* const* d_in, const int* in_sizes, int n_in, void* d_out, int out_size, void* d_ws, size_t ws_size, hipStream_t stream) {
    static int grid = 0;
    if (grid == 0) {
        if (n_in != 22 || in_sizes[0] != T * DM || out_size != T * DM || ws_size < WS_NEED) { fprintf(stderr, "kernel_launch: unexpected shapes (n_in %d, in0 %d, out %d, ws %zu < %zu); nothing launched\n", n_in, n_in > 0 ? in_sizes[0] : -1, out_size, ws_size, (size_t)WS_NEED); grid = -1; return; }
        int dev = 0, cus = 0, per_cu = 0;
        if (hipGetDevice(&dev) != hipSuccess || hipDeviceGetAttribute(&cus, hipDeviceAttributeMultiprocessorCount, dev) != hipSuccess) { grid = -1; return; }
        if (hipFuncSetAttribute((const void*)hybrid_fwd, hipFuncAttributeMaxDynamicSharedMemorySize, LDS_BYTES) != hipSuccess) { fprintf(stderr, "kernel_launch: hipFuncSetAttribute failed\n"); grid = -1; return; }
        if (hipOccupancyMaxActiveBlocksPerMultiprocessor(&per_cu, (const void*)hybrid_fwd, 512, LDS_BYTES) != hipSuccess || per_cu < 1) fprintf(stderr, "kernel_launch: occupancy query reports %d workgroups per CU\n", per_cu);
        (void)hipGetLastError();
        grid = cus;
    }
    if (grid < 0) return;
    if (hipMemsetAsync((char*)d_ws + WS_CTL, 0, CTL_ZERO_BYTES, stream) != hipSuccess) return;
    Args a{};
    for (int i = 0; i < 22; ++i) a.in[i] = (const float*)d_in[i];
    a.out = (float*)d_out; a.ws = (unsigned char*)d_ws;
#if MK_ONE_LAUNCH
    a.ph_lo = 0; a.ph_hi = NPH;
    hipLaunchKernelGGL(hybrid_fwd, dim3(grid), dim3(512), LDS_BYTES, stream, a);
#else
    for (int p = 0; p < NPH; ++p) { a.ph_lo = p; a.ph_hi = p + 1; hipLaunchKernelGGL(hybrid_fwd, dim3(grid), dim3(512), LDS_BYTES, stream, a); }
#endif
}
```

```cpp
#include <hip/hip_runtime.h>
#include <cstdio>
#include <cstdint>
#ifndef MK_ONE_LAUNCH
#define MK_ONE_LAUNCH 1
#endif
#ifndef PROBE_SEAMS
#define PROBE_SEAMS 0xFFFFF
#endif
#ifndef PROBE_DUP
#define PROBE_DUP 0
#endif
namespace pg8 {
#define PG8_LAS __attribute__((address_space(3)))
typedef unsigned short bf16_t;
typedef short bf16x8 __attribute__((ext_vector_type(8)));
typedef float f32x4 __attribute__((ext_vector_type(4)));
typedef unsigned u32x4 __attribute__((ext_vector_type(4)));
constexpr int BM = 256, BK = 64, HALF = 128, HTB = HALF * BK * 2  , STAGE_BYTES = 8 * HTB, NXCD = 8, WGM = 8;

__host__ __device__ __forceinline__ int lds_byte(int r, int c) { const int st = (r >> 4) * 2 + (c >> 5), rr = r & 15, cc = c & 31, ob = rr * 64 + cc * 2; return st * 1024 + (ob ^ (((ob >> 9) & 1) << 5)); }
__host__ __device__ __forceinline__ void stage_rc(int b, int& R, int& C) { const int st = b / 1024, sb = b % 1024, swz = sb ^ (((sb >> 9) & 1) << 5); R = (st >> 1) * 16 + swz / 64; C = (st & 1) * 32 + (swz % 64) / 2; }
__host__ __device__ __forceinline__ int perm32(int rho) { const int n = rho >> 4, i = rho & 15; return 8 * (i >> 2) + 4 * n + (i & 3); }

struct Unit { int pm, pn; };
struct Gemm { const bf16_t* A; const bf16_t* Bt; int M, N, K; const int* aidx; };

struct StaticOrder {
    int nM, nN, nwg, G, c;
    __host__ __device__ void init(int M, int N, int G_, int c_) { nM = M / BM; nN = N / BM; nwg = nM * nN; G = G_; c = c_; }
    __host__ __device__ bool next(int i, Unit& u) const {
        const long L = (long)i * G + c; if (L >= nwg) return false;
        int wgid = (int)L; { const int q = nwg / NXCD, r = nwg % NXCD, xcd = wgid % NXCD, off = wgid / NXCD; wgid = (xcd < r ? xcd * (q + 1) : r * (q + 1) + (xcd - r) * q) + off; }
        const int nig = WGM * nN, gid = wgid / nig, fm = gid * WGM, gsz = (nM - fm) < WGM ? (nM - fm) : WGM;
        u.pm = fm + ((wgid % nig) % gsz); u.pn = (wgid % nig) / gsz; return true;
    }
    __device__ __forceinline__ void a_ready(const Unit&) const {}
    __device__ __forceinline__ void done(const Unit&) const {}
};

__device__ __forceinline__ unsigned cvt_pk_bf16(float lo, float hi) { unsigned r; asm volatile("v_cvt_pk_bf16_f32 %0, %1, %2" : "=v"(r) : "v"(lo), "v"(hi)); return r; }
typedef float f32x2 __attribute__((ext_vector_type(2)));
template <class Epi, class Sched, bool ALIGN_EPI = false, bool SP2 = false, bool GATHER = false>
__device__ __forceinline__ void gemm_phase(PG8_LAS unsigned char* lds, const Gemm g, const Sched& S, const Epi& E) {
    static_assert(!GATHER || SP2, "the gather A path is wired into the two-super-phase loop only");
    int tid_ = threadIdx.x; asm volatile("" : "+v"(tid_));
    const int tid = tid_, wid = __builtin_amdgcn_readfirstlane(tid >> 6), lane = tid & 63, wr = wid >> 2, wc = wid & 3, fr = lane & 15, fq = lane >> 4;
    const int K = g.K, nt = K / BK;
    unsigned voffA[2], voffB[2];
#pragma unroll
    for (int i = 0; i < 2; ++i) { int R, C; stage_rc(tid * 16 + i * 8192, R, C); const int Rb = Epi::PERM ? ((R & ~31) + perm32(R & 31)) : R;
        voffA[i] = (unsigned)(R * K + C) * 2u; voffB[i] = (unsigned)(Rb * K + C) * 2u; }
    unsigned gA[2][2] = {{0u, 0u}, {0u, 0u}}, gN[2][2] = {{0u, 0u}, {0u, 0u}}; int gR[2] = {0, 0}, gC[2] = {0, 0};
    if constexpr (GATHER) {
#pragma unroll
        for (int i = 0; i < 2; ++i) stage_rc(tid * 16 + i * 8192, gR[i], gC[i]); }
#define PG8_GIDX(dst, pm) do { _Pragma("unroll") for (int _h = 0; _h < 2; ++_h) _Pragma("unroll") for (int _i = 0; _i < 2; ++_i) \
        dst[_h][_i] = (unsigned)(g.aidx[(pm) * BM + _h * HALF + gR[_i]] * K + gC[_i]) * 2u; } while (0)
    const size_t kstep = (size_t)(BK * 2);
    const size_t hstep = (size_t)HALF * K * 2;
    const size_t tstep = 2 * hstep;
    const unsigned ldsw = (unsigned)wid * 1024u;
    const int aoff = lds_byte(wr * 64 + fr, fq * 8), boff = lds_byte(wc * 32 + fr, fq * 8);
#define PG8_SA(b, h) (((b) * 2 + (h)) * HTB)
#define PG8_SB(b, h) ((4 + (b) * 2 + (h)) * HTB)
#define PG8_STAGE(bufoff, gbase, voff) do { _Pragma("unroll") for (int _i = 0; _i < 2; ++_i) \
        __builtin_amdgcn_global_load_lds((const unsigned*)((const char*)(gbase) + (voff)[_i]), (PG8_LAS unsigned*)(lds + (bufoff) + ldsw + _i * 8192), 16, 0, 0); } while (0)
#define PG8_STAGE_A(bufoff, gbase, hh, nx) do { if constexpr (GATHER) { _Pragma("unroll") for (int _i = 0; _i < 2; ++_i) \
        __builtin_amdgcn_global_load_lds((const unsigned*)((const char*)(gbase) + ((nx) ? gN[hh][_i] : gA[hh][_i])), (PG8_LAS unsigned*)(lds + (bufoff) + ldsw + _i * 8192), 16, 0, 0); } \
    else { PG8_STAGE(bufoff, (gbase) + (hh) * hstep, voffA); } } while (0)
#define PG8_LDA(dst, b, h) do { _Pragma("unroll") for (int m = 0; m < 4; ++m) _Pragma("unroll") for (int k = 0; k < 2; ++k) dst[m][k] = *(const PG8_LAS bf16x8*)(lds + PG8_SA(b, h) + aoff + m * 2048 + k * 1024); } while (0)
#define PG8_LDB(dst, b, h) do { _Pragma("unroll") for (int n = 0; n < 2; ++n) _Pragma("unroll") for (int k = 0; k < 2; ++k) dst[n][k] = *(const PG8_LAS bf16x8*)(lds + PG8_SB(b, h) + boff + n * 2048 + k * 1024); } while (0)
#define PG8_MMA(ai, bj, At, Bt) do { __builtin_amdgcn_s_setprio(1); _Pragma("unroll") for (int m = 0; m < 4; ++m) _Pragma("unroll") for (int n = 0; n < 2; ++n) _Pragma("unroll") for (int k = 0; k < 2; ++k) \
        acc[ai][bj][m][n] = __builtin_amdgcn_mfma_f32_16x16x32_bf16(Bt[n][k], At[m][k], acc[ai][bj][m][n], 0, 0, 0); __builtin_amdgcn_s_setprio(0); } while (0)
#define PG8_WAIT_V(n) asm volatile("s_waitcnt vmcnt(" #n ")" ::: "memory")
#define PG8_WAIT_L(n) asm volatile("s_waitcnt lgkmcnt(" #n ")" ::: "memory")
#define PG8_BAR __builtin_amdgcn_s_barrier()
#define PG8_SCHED __builtin_amdgcn_sched_barrier(0)
    Unit cur, nxt; int ui = 0;
    if (!S.next(0, cur)) return;
    f32x4 acc[2][2][4][2];
#pragma unroll
    for (int a = 0; a < 2; ++a)
#pragma unroll
        for (int b = 0; b < 2; ++b)
#pragma unroll
            for (int m = 0; m < 4; ++m)
#pragma unroll
                for (int n = 0; n < 2; ++n) acc[a][b][m][n] = (f32x4){0.f, 0.f, 0.f, 0.f};
    bf16x8 At[4][2], B0[2][2], B1[2][2];
    const char* cA = GATHER ? (const char*)g.A : (const char*)g.A + (size_t)cur.pm * tstep; const char* cB = (const char*)g.Bt + (size_t)cur.pn * tstep;
    if constexpr (GATHER) { PG8_GIDX(gA, cur.pm); }
    S.a_ready(cur);
    if constexpr (SP2) {
        PG8_STAGE(PG8_SB(0, 0), cB, voffB); PG8_STAGE(PG8_SB(0, 1), cB + hstep, voffB); PG8_STAGE_A(PG8_SA(0, 0), cA, 0, false); PG8_STAGE_A(PG8_SA(0, 1), cA, 1, false);
        if (wr == 1) PG8_BAR;
        PG8_WAIT_V(2); PG8_BAR;
        PG8_STAGE(PG8_SB(1, 0), cB + kstep, voffB); PG8_STAGE_A(PG8_SA(1, 0), cA + kstep, 0, false); PG8_STAGE(PG8_SB(1, 1), cB + hstep + kstep, voffB);
        PG8_WAIT_V(6); PG8_BAR;
    } else {
        PG8_STAGE(PG8_SB(0, 0), cB, voffB); PG8_STAGE(PG8_SA(0, 0), cA, voffA); PG8_STAGE(PG8_SB(0, 1), cB + hstep, voffB); PG8_STAGE(PG8_SA(0, 1), cA + hstep, voffA);
        if (wr == 1) PG8_BAR;
        PG8_WAIT_V(4); PG8_BAR;
        PG8_STAGE(PG8_SB(1, 0), cB + kstep, voffB); PG8_STAGE(PG8_SA(1, 0), cA + kstep, voffA); PG8_STAGE(PG8_SB(1, 1), cB + hstep + kstep, voffB);
        PG8_WAIT_V(6); PG8_BAR;
    }
    for (;;) {
        const bool has_next = S.next(ui + 1, nxt);
        const char* nA = GATHER ? (const char*)g.A : (has_next ? (const char*)g.A + (size_t)nxt.pm * tstep : cA); const char* nB = has_next ? (const char*)g.Bt + (size_t)nxt.pn * tstep : cB;
        if constexpr (GATHER) { if (has_next) { PG8_GIDX(gN, nxt.pm); } else { _Pragma("unroll") for (int _h = 0; _h < 2; ++_h) _Pragma("unroll") for (int _i = 0; _i < 2; ++_i) gN[_h][_i] = gA[_h][_i]; } }
#pragma unroll 1
        for (int t = 0; t < nt; t += 2) {
            const bool last = (t == nt - 2);
            const char* a1 = cA + (size_t)(t + 1) * kstep;
            const char* a2 = last ? nA : cA + (size_t)(t + 2) * kstep; const char* b2 = last ? nB : cB + (size_t)(t + 2) * kstep;
            const char* a3 = a2 + kstep; const char* b3 = b2 + kstep;
            if (last && has_next) S.a_ready(nxt);
            if constexpr (SP2) {
            PG8_LDB(B0, 0, 0); PG8_LDB(B1, 0, 1); PG8_SCHED; PG8_LDA(At, 0, 0); PG8_STAGE_A(PG8_SA(1, 1), a1, 1, false);
            PG8_WAIT_V(8); PG8_WAIT_L(0); PG8_BAR; PG8_MMA(0, 0, At, B0); PG8_MMA(0, 1, At, B1); PG8_BAR; PG8_SCHED;
            PG8_LDA(At, 0, 1); PG8_STAGE(PG8_SB(0, 0), b2, voffB); PG8_STAGE(PG8_SB(0, 1), b2 + hstep, voffB); PG8_STAGE_A(PG8_SA(0, 0), a2, 0, last);
            PG8_WAIT_V(8); PG8_WAIT_L(0); PG8_BAR; PG8_MMA(1, 0, At, B0); PG8_MMA(1, 1, At, B1); PG8_BAR; PG8_SCHED;
            PG8_LDB(B0, 1, 0); PG8_LDB(B1, 1, 1); PG8_SCHED; PG8_LDA(At, 1, 0); PG8_STAGE_A(PG8_SA(0, 1), a2, 1, last);
            PG8_WAIT_V(8); PG8_WAIT_L(0); PG8_BAR; PG8_MMA(0, 0, At, B0); PG8_MMA(0, 1, At, B1); PG8_BAR; PG8_SCHED;
            PG8_LDA(At, 1, 1); PG8_STAGE(PG8_SB(1, 0), b3, voffB); PG8_STAGE(PG8_SB(1, 1), b3 + hstep, voffB); PG8_STAGE_A(PG8_SA(1, 0), a3, 0, last);
            PG8_WAIT_V(8); PG8_WAIT_L(0); PG8_BAR; PG8_MMA(1, 0, At, B0); PG8_MMA(1, 1, At, B1); PG8_BAR; PG8_SCHED;
            } else {
            PG8_LDB(B0, 0, 0); PG8_SCHED; PG8_LDA(At, 0, 0); PG8_STAGE(PG8_SA(1, 1), a1 + hstep, voffA);
            PG8_WAIT_L(8); PG8_BAR; PG8_WAIT_L(0); PG8_MMA(0, 0, At, B0); PG8_BAR; PG8_SCHED;
            PG8_LDB(B1, 0, 1); PG8_STAGE(PG8_SB(0, 0), b2, voffB);
            PG8_BAR; PG8_WAIT_L(0); PG8_MMA(0, 1, At, B1); PG8_BAR;
            PG8_LDA(At, 0, 1); PG8_STAGE(PG8_SA(0, 0), a2, voffA);
            PG8_BAR; PG8_WAIT_L(0); PG8_MMA(1, 0, At, B0); PG8_BAR; PG8_SCHED;
            PG8_STAGE(PG8_SB(0, 1), b2 + hstep, voffB);
            PG8_WAIT_V(6); PG8_BAR; PG8_MMA(1, 1, At, B1); PG8_BAR;
            PG8_LDB(B0, 1, 0); PG8_SCHED; PG8_LDA(At, 1, 0); PG8_STAGE(PG8_SA(0, 1), a2 + hstep, voffA);
            PG8_WAIT_L(8); PG8_BAR; PG8_WAIT_L(0); PG8_MMA(0, 0, At, B0); PG8_BAR; PG8_SCHED;
            PG8_LDB(B1, 1, 1); PG8_STAGE(PG8_SB(1, 0), b3, voffB);
            PG8_BAR; PG8_WAIT_L(0); PG8_MMA(0, 1, At, B1); PG8_BAR;
            PG8_LDA(At, 1, 1); PG8_STAGE(PG8_SA(1, 0), a3, voffA);
            PG8_BAR; PG8_WAIT_L(0); PG8_MMA(1, 0, At, B0); PG8_BAR; PG8_SCHED;
            PG8_STAGE(PG8_SB(1, 1), b3 + hstep, voffB);
            PG8_WAIT_V(6); PG8_BAR; PG8_MMA(1, 1, At, B1); PG8_BAR;
            }
        }
        if constexpr (ALIGN_EPI) { if (wr == 0) PG8_BAR; }
        if constexpr (!Epi::AFTER_DRAIN) { E(acc, cur, wr, wc, fr, fq); S.done(cur); }
        if (!has_next) break;
#pragma unroll
        for (int a = 0; a < 2; ++a)
#pragma unroll
            for (int b = 0; b < 2; ++b)
#pragma unroll
                for (int m = 0; m < 4; ++m)
#pragma unroll
                    for (int n = 0; n < 2; ++n) acc[a][b][m][n] = (f32x4){0.f, 0.f, 0.f, 0.f};
        cur = nxt; cA = nA; cB = nB; ++ui;
        if constexpr (GATHER) { _Pragma("unroll") for (int _h = 0; _h < 2; ++_h) _Pragma("unroll") for (int _i = 0; _i < 2; ++_i) gA[_h][_i] = gN[_h][_i]; }
        if constexpr (ALIGN_EPI) { if (wr == 1) PG8_BAR; }
    }
    PG8_WAIT_V(0);
    if constexpr (!ALIGN_EPI) { if (wr == 0) PG8_BAR; }
    PG8_BAR;
    if constexpr (Epi::AFTER_DRAIN) { E.fused(acc, cur, wr, wc, fr, fq, lds, wid, lane); S.done(cur); }
#undef PG8_SA
#undef PG8_SB
#undef PG8_STAGE
#undef PG8_STAGE_A
#undef PG8_GIDX
#undef PG8_LDA
#undef PG8_LDB
#undef PG8_MMA
#undef PG8_WAIT_V
#undef PG8_WAIT_L
#undef PG8_BAR
#undef PG8_SCHED
}
}

#define DI __device__ __forceinline__
#define LAS __attribute__((address_space(3)))
#define GAS __attribute__((address_space(1)))
typedef unsigned short bf16;
constexpr int BATCH = 2, SEQ = 16384, T = BATCH * SEQ, DM = 1024;
constexpr float LOG2E = 1.4426950408889634f;
constexpr float RMS_EPS = 1e-6f;
DI int rfl(int v) { return __builtin_amdgcn_readfirstlane(v); }
DI float bflo(unsigned w) { return __uint_as_float(w << 16); }
DI float bfhi(unsigned w) { return __uint_as_float(w & 0xffff0000u); }
typedef float f32x2_t __attribute__((ext_vector_type(2))); typedef __bf16 bf16x2_t __attribute__((ext_vector_type(2)));
DI unsigned cvtpk(float lo, float hi) { f32x2_t v = {lo, hi}; bf16x2_t b = __builtin_convertvector(v, bf16x2_t); return __builtin_bit_cast(unsigned, b); }
typedef float f32x4 __attribute__((ext_vector_type(4)));
typedef unsigned v4u __attribute__((ext_vector_type(4)));
DI float ex2(float x) { return __builtin_amdgcn_exp2f(x); }
DI float lg2(float x) { return __builtin_amdgcn_logf(x); }
DI float wave_sum(float v) {
#pragma unroll
    for (int o = 1; o < 64; o <<= 1) v += __shfl_xor(v, o);
    return v;
}

namespace att {
typedef short bf16x8 __attribute__((ext_vector_type(8)));
typedef short s16x4 __attribute__((ext_vector_type(4)));
typedef float f32x16 __attribute__((ext_vector_type(16)));
typedef unsigned u32x4 __attribute__((ext_vector_type(4)));
typedef LAS const char* lcp;
typedef short v4i16_t __attribute__((ext_vector_type(4)));
DI int crow(int r, int hi) { return (r & 3) + 8 * (r >> 2) + 4 * hi; }
DI void glds16(const void* gsrc, unsigned lds_dst) { unsigned keep;
    asm volatile("s_mov_b32 %0, m0\n\ts_mov_b32 m0, %2\n\ts_nop 0\n\tglobal_load_lds_dwordx4 %1, off\n\ts_mov_b32 m0, %0" : "=&s"(keep) : "v"(gsrc), "s"(lds_dst) : "memory"); }
#define ATT_WAITV_BAR() asm volatile("s_waitcnt vmcnt(0) lgkmcnt(0)\n\ts_barrier" ::: "memory")
#define ATT_BAR() asm volatile("s_waitcnt lgkmcnt(0)\n\ts_barrier" ::: "memory")
#define WAVE_LDS_SYNC() asm volatile("" ::: "memory")
DI s16x4 vtr(lcp p) { return __builtin_bit_cast(s16x4, __builtin_amdgcn_ds_read_tr16_b64_v4i16((LAS v4i16_t*)p)); }
DI float hmax(float x) { auto rr = __builtin_amdgcn_permlane32_swap(__float_as_uint(x), __float_as_uint(x), false, false); return fmaxf(__uint_as_float(rr[0]), __uint_as_float(rr[1])); }
DI float hsum(float x) { auto rr = __builtin_amdgcn_permlane32_swap(__float_as_uint(x), __float_as_uint(x), false, false); return __uint_as_float(rr[0]) + __uint_as_float(rr[1]); }

template <int NK> DI void qk_tile(f32x16& p0, f32x16& p1, lcp kfr, const bf16x8* qr) {
    f32x16 z;
#pragma unroll
    for (int r = 0; r < 16; ++r) z[r] = 0.f;
    p0 = z; p1 = z;
    bf16x8 kf[2 * NK];
#pragma unroll
    for (int d0 = 0; d0 < NK; ++d0) { kf[2 * d0] = *(const LAS bf16x8*)(kfr + d0 * 2048); kf[2 * d0 + 1] = *(const LAS bf16x8*)(kfr + d0 * 2048 + 512); }
    __builtin_amdgcn_sched_barrier(0);
#pragma unroll
    for (int d0 = 0; d0 < NK; ++d0) { p0 = __builtin_amdgcn_mfma_f32_32x32x16_bf16(kf[2 * d0], qr[d0], p0, 0, 0, 0); p1 = __builtin_amdgcn_mfma_f32_32x32x16_bf16(kf[2 * d0 + 1], qr[d0], p1, 0, 0, 0); }
    __builtin_amdgcn_sched_barrier(0);
}
DI void pv_tile(f32x16* o, lcp vfr, const f32x16& p0, const f32x16& p1) {
    u32x4 pw[4];
    pw[0] = (u32x4){cvtpk(p0[0], p0[1]), cvtpk(p0[2], p0[3]), cvtpk(p0[4], p0[5]), cvtpk(p0[6], p0[7])};
    pw[1] = (u32x4){cvtpk(p0[8], p0[9]), cvtpk(p0[10], p0[11]), cvtpk(p0[12], p0[13]), cvtpk(p0[14], p0[15])};
    pw[2] = (u32x4){cvtpk(p1[0], p1[1]), cvtpk(p1[2], p1[3]), cvtpk(p1[4], p1[5]), cvtpk(p1[6], p1[7])};
    pw[3] = (u32x4){cvtpk(p1[8], p1[9]), cvtpk(p1[10], p1[11]), cvtpk(p1[12], p1[13]), cvtpk(p1[14], p1[15])};
#pragma unroll
    for (int d0 = 0; d0 < 2; ++d0) {
        s16x4 lo[4], hh[4];
#pragma unroll
        for (int ks = 0; ks < 4; ++ks) { lo[ks] = vtr(vfr + d0 * 4096 + ks * 1024); hh[ks] = vtr(vfr + d0 * 4096 + ks * 1024 + 512); }
        __builtin_amdgcn_sched_barrier(0);
#pragma unroll
        for (int ks = 0; ks < 4; ++ks) { const bf16x8 vf = (bf16x8){lo[ks][0], lo[ks][1], lo[ks][2], lo[ks][3], hh[ks][0], hh[ks][1], hh[ks][2], hh[ks][3]};
            o[d0] = __builtin_amdgcn_mfma_f32_32x32x16_bf16(__builtin_bit_cast(bf16x8, pw[ks]), vf, o[d0], 0, 0, 0); }
        __builtin_amdgcn_sched_barrier(0);
    }
}
DI void smax_update(f32x16& p0, f32x16& p1, float& mref, float& lsum, f32x16* o, LAS float* wsf, int r32, int hi) {
    float rm = fmaxf(p0[0], p1[0]);
#pragma unroll
    for (int r = 1; r < 16; ++r) rm = fmaxf(rm, fmaxf(p0[r], p1[r]));
    rm = hmax(rm);
    if (__any(rm > mref + 8.f)) {
        const float mnew = fmaxf(mref, rm);
        const float alpha = (mnew == mref) ? 1.f : ex2(mref - mnew);
        lsum *= alpha; mref = mnew;
        if (hi == 0) wsf[r32] = alpha;
        WAVE_LDS_SYNC();
#pragma unroll
        for (int r = 0; r < 16; ++r) { const float a = wsf[crow(r, hi)]; o[0][r] *= a; o[1][r] *= a; }
        WAVE_LDS_SYNC();
    }
    float s = 0.f;
#pragma unroll
    for (int r = 0; r < 16; ++r) { p0[r] = ex2(p0[r] - mref); p1[r] = ex2(p1[r] - mref); s += p0[r] + p1[r]; }
    lsum += s;
}
DI void stage_o(const f32x16* o, LAS bf16* stg, const LAS float* rowscale, int r32, int hi) {
    WAVE_LDS_SYNC();
#pragma unroll
    for (int r = 0; r < 16; ++r) { const int orow = crow(r, hi); const float sc = rowscale ? rowscale[orow] : 1.f;
        const unsigned a = cvtpk(o[0][r] * sc, o[1][r] * sc);
        stg[orow * 64 + r32] = (bf16)(a & 0xffffu); stg[orow * 64 + 32 + r32] = (bf16)(a >> 16); }
    WAVE_LDS_SYNC();
}

constexpr int MLA_KSLOT = 12288, VSLOT = 8192;
constexpr int MLA_OFF_V = 3 * MLA_KSLOT, MLA_OFF_WS = MLA_OFF_V + 3 * VSLOT, MLA_OFF_ST = MLA_OFF_WS + 8 * 256, MLA_LDS = MLA_OFF_ST + 8 * 4096;
template <int NK> DI void qk_tile_ref(f32x16& p0, f32x16& p1, lcp kfr, const bf16x8* qr, const f32x16& negm) {
    p0 = negm; p1 = negm;
    constexpr int H = NK / 2;
#pragma unroll
    for (int hb = 0; hb < 2; ++hb) {
        bf16x8 kf[2 * H];
#pragma unroll
        for (int d = 0; d < H; ++d) { const int d0 = hb * H + d; kf[2 * d] = *(const LAS bf16x8*)(kfr + d0 * 2048); kf[2 * d + 1] = *(const LAS bf16x8*)(kfr + d0 * 2048 + 512); }
        __builtin_amdgcn_sched_barrier(0);
#pragma unroll
        for (int d = 0; d < H; ++d) { const int d0 = hb * H + d; p0 = __builtin_amdgcn_mfma_f32_32x32x16_bf16(kf[2 * d], qr[d0], p0, 0, 0, 0); p1 = __builtin_amdgcn_mfma_f32_32x32x16_bf16(kf[2 * d + 1], qr[d0], p1, 0, 0, 0); }
        __builtin_amdgcn_sched_barrier(0);
    }
}
DI void smax_update_ref(f32x16& p0, f32x16& p1, float& mref, f32x16& negm, float& lsum, f32x16* o, LAS float* wsf, int r32, int hi, bool first) {
    float ra = __builtin_fmaxf(__builtin_fmaxf(p0[0], p0[1]), p1[0]), rb = __builtin_fmaxf(__builtin_fmaxf(p0[2], p0[3]), p1[1]);
    ra = __builtin_fmaxf(__builtin_fmaxf(ra, p1[2]), p1[3]);
#pragma unroll
    for (int r = 4; r < 16; r += 4) { ra = __builtin_fmaxf(__builtin_fmaxf(ra, p0[r]), p0[r + 1]); rb = __builtin_fmaxf(__builtin_fmaxf(rb, p0[r + 2]), p0[r + 3]);
        ra = __builtin_fmaxf(__builtin_fmaxf(ra, p1[r]), p1[r + 1]); rb = __builtin_fmaxf(__builtin_fmaxf(rb, p1[r + 2]), p1[r + 3]); }
    const float rm = hmax(fmaxf(ra, rb));
    if (first || __any(rm > 8.f)) {
        const float dl = first ? rm : fmaxf(rm, 0.f);
        mref += dl;
#pragma unroll
        for (int r = 0; r < 16; ++r) { p0[r] -= dl; p1[r] -= dl; }
#pragma unroll
        for (int r = 0; r < 16; ++r) negm[r] = -mref;
        if (!first) { const float alpha = ex2(-dl); lsum *= alpha;
            if (hi == 0) wsf[r32] = alpha;
            WAVE_LDS_SYNC();
#pragma unroll
            for (int r = 0; r < 16; ++r) { const float a = wsf[crow(r, hi)]; o[0][r] *= a; o[1][r] *= a; }
            WAVE_LDS_SYNC(); }
    }
    float s = 0.f;
#pragma unroll
    for (int r = 0; r < 16; ++r) { p0[r] = ex2(p0[r]); p1[r] = ex2(p1[r]); s += p0[r] + p1[r]; }
    lsum += s;
}
DI void mla_unit(int bh, int qb, const bf16* QA, const bf16* KN, const bf16* KR, const bf16* VA, bf16* OC, LAS unsigned char* lds) {
    int tid_ = threadIdx.x; asm volatile("" : "+v"(tid_));
    const int tid = tid_, lane = tid & 63, r32 = lane & 31, hi = lane >> 5, wid = rfl(tid >> 6);
    const int b = bh >> 3, h = bh & 7; const long rowbase = (long)b * SEQ; const int q0 = qb * 256;
    const unsigned lds0 = (unsigned)(size_t)lds;
    LAS float* wsf = (LAS float*)(lds + MLA_OFF_WS) + wid * 64;
    LAS bf16* stg = (LAS bf16*)(lds + MLA_OFF_ST) + wid * 2048;
    const bf16* ksrc = KN + (rowbase + lane) * 512 + h * 64 + wid * 8;
    const bf16* rsrc = KR + (rowbase + lane) * 32 + (wid & 3) * 8;
    const bf16* vsrc = VA + (rowbase + 16 * (wid & 3) + (lane >> 2)) * 512 + h * 64 + (wid >> 2) * 32 + (lane & 3) * 8;
#define MLA_DMA_K(t, s) do { glds16(ksrc + (long)(t) * 64 * 512, (unsigned)rfl((int)(lds0 + (s) * MLA_KSLOT + wid * 1024))); \
        if (wid < 4) glds16(rsrc + (long)(t) * 64 * 32, (unsigned)rfl((int)(lds0 + (s) * MLA_KSLOT + (8 + wid) * 1024))); } while (0)
#define MLA_DMA_V(t, s) glds16(vsrc + (long)(t) * 64 * 512, (unsigned)rfl((int)(lds0 + MLA_OFF_V + (s) * VSLOT + wid * 1024)))
    const bf16* qp = QA + (rowbase + q0 + wid * 32 + r32) * 768 + h * 96 + hi * 8;
    bf16x8 qr[6];
#pragma unroll
    for (int d0 = 0; d0 < 6; ++d0) qr[d0] = *(const bf16x8*)(qp + d0 * 16);
    const int NT = 4 * (qb + 1);
    const lcp kfr = (lcp)lds + hi * 1024 + r32 * 16;
    const lcp vfr = (lcp)lds + MLA_OFF_V + ((lane >> 4) & 1) * 32 + (lane & 3) * 8 + (4 * hi + ((lane & 15) >> 2)) * 64;
    float mref = 0.f, lsum = 0.f; f32x16 o[2], negm;
#pragma unroll
    for (int r = 0; r < 16; ++r) { o[0][r] = 0.f; o[1][r] = 0.f; negm[r] = 0.f; }
    const int qrel = 32 * wid + r32;
#define MLA_MASK(P0, P1, t) do { const int jb_ = (t) - (NT - 4); if (jb_ >= 0 && 64 * jb_ + 63 > 32 * wid) { \
        _Pragma("unroll") for (int r = 0; r < 16; ++r) { const int kv = 64 * jb_ + crow(r, hi); if (kv > qrel) P0[r] = -INFINITY; if (kv + 32 > qrel) P1[r] = -INFINITY; } } } while (0)
#define MLA_ROWMAX(P0, P1, rm) do { float ra_ = __builtin_fmaxf(__builtin_fmaxf(P0[0], P0[1]), P1[0]), rb_ = __builtin_fmaxf(__builtin_fmaxf(P0[2], P0[3]), P1[1]); ra_ = __builtin_fmaxf(__builtin_fmaxf(ra_, P1[2]), P1[3]); \
        _Pragma("unroll") for (int r = 4; r < 16; r += 4) { ra_ = __builtin_fmaxf(__builtin_fmaxf(ra_, P0[r]), P0[r + 1]); rb_ = __builtin_fmaxf(__builtin_fmaxf(rb_, P0[r + 2]), P0[r + 3]); \
            ra_ = __builtin_fmaxf(__builtin_fmaxf(ra_, P1[r]), P1[r + 1]); rb_ = __builtin_fmaxf(__builtin_fmaxf(rb_, P1[r + 2]), P1[r + 3]); } rm = hmax(fmaxf(ra_, rb_)); } while (0)
    MLA_DMA_K(0, 0); MLA_DMA_V(0, 0); MLA_DMA_K(1, 1);
    ATT_WAITV_BAR();
    MLA_DMA_K(2, 2); MLA_DMA_V(1, 1);
    f32x16 pa0, pa1, pb0, pb1;
    qk_tile_ref<6>(pa0, pa1, kfr, qr, negm); MLA_MASK(pa0, pa1, 0);
    { float rm; MLA_ROWMAX(pa0, pa1, rm); mref = rm;
#pragma unroll
      for (int r = 0; r < 16; ++r) { pa0[r] = ex2(pa0[r] - rm); pa1[r] = ex2(pa1[r] - rm); negm[r] = -rm; } }
    int kc = 1, kn = 2, kf_ = 0, vc = 0, vn = 1, vf_ = 2;
#define MLA_KLD(i) kf_##i = *(const LAS bf16x8*)(kb_ + ((i) >> 1) * 2048 + ((i) & 1) * 512)
#define MLA_VLD(i) do { vl_[i] = vtr(vb_ + ((i) >> 2) * 4096 + ((i) & 3) * 1024); vh_[i] = vtr(vb_ + ((i) >> 2) * 4096 + ((i) & 3) * 1024 + 512); } while (0)
#define MLA_PIN(x) asm volatile("" : "+v"(x))
#define MLA_STEP(C0, C1, P0, P1, t) do { \
        ATT_WAITV_BAR();                                               \
        if ((t) + 2 < NT) MLA_DMA_K((t) + 2, kf_); \
        if ((t) + 1 < NT) MLA_DMA_V((t) + 1, vf_); \
          \
        const lcp kb_ = kfr + kc * MLA_KSLOT; const lcp vb_ = vfr + vc * VSLOT; \
        bf16x8 kf_0, kf_1, kf_2, kf_3, kf_4, kf_5, kf_6, kf_7, kf_8, kf_9, kf_10, kf_11; s16x4 vl_[8], vh_[8]; u32x4 pw_[4]; float sacc_ = 0.f; \
        MLA_KLD(0); MLA_KLD(1); MLA_KLD(2); MLA_KLD(3); \
        MLA_KLD(4); C0 = __builtin_amdgcn_mfma_f32_32x32x16_bf16(kf_0, qr[0], negm, 0, 0, 0); sacc_ += P0[0]; sacc_ += P0[1]; sacc_ += P0[2]; MLA_PIN(sacc_); pw_[0][0] = cvtpk(P0[0], P0[1]); MLA_PIN(pw_[0]); __builtin_amdgcn_sched_barrier(0); \
        MLA_KLD(5); C1 = __builtin_amdgcn_mfma_f32_32x32x16_bf16(kf_1, qr[0], negm, 0, 0, 0); sacc_ += P0[3]; sacc_ += P0[4]; sacc_ += P0[5]; MLA_PIN(sacc_); pw_[0][1] = cvtpk(P0[2], P0[3]); MLA_PIN(pw_[0]); __builtin_amdgcn_sched_barrier(0); \
        MLA_KLD(6); C0 = __builtin_amdgcn_mfma_f32_32x32x16_bf16(kf_2, qr[1], C0, 0, 0, 0); sacc_ += P0[6]; sacc_ += P0[7]; sacc_ += P0[8]; MLA_PIN(sacc_); pw_[0][2] = cvtpk(P0[4], P0[5]); MLA_PIN(pw_[0]); __builtin_amdgcn_sched_barrier(0); \
        MLA_KLD(7); C1 = __builtin_amdgcn_mfma_f32_32x32x16_bf16(kf_3, qr[1], C1, 0, 0, 0); sacc_ += P0[9]; sacc_ += P0[10]; sacc_ += P0[11]; MLA_PIN(sacc_); pw_[0][3] = cvtpk(P0[6], P0[7]); MLA_PIN(pw_[0]); __builtin_amdgcn_sched_barrier(0); \
        MLA_KLD(8); MLA_VLD(0); C0 = __builtin_amdgcn_mfma_f32_32x32x16_bf16(kf_4, qr[2], C0, 0, 0, 0); sacc_ += P0[12]; sacc_ += P0[13]; sacc_ += P0[14]; MLA_PIN(sacc_); pw_[1][0] = cvtpk(P0[8], P0[9]); MLA_PIN(pw_[1]); pw_[1][1] = cvtpk(P0[10], P0[11]); MLA_PIN(pw_[1]); __builtin_amdgcn_sched_barrier(0); \
        MLA_KLD(9); MLA_VLD(1); C1 = __builtin_amdgcn_mfma_f32_32x32x16_bf16(kf_5, qr[2], C1, 0, 0, 0); sacc_ += P0[15]; sacc_ += P1[0]; sacc_ += P1[1]; MLA_PIN(sacc_); pw_[1][2] = cvtpk(P0[12], P0[13]); MLA_PIN(pw_[1]); pw_[1][3] = cvtpk(P0[14], P0[15]); MLA_PIN(pw_[1]); __builtin_amdgcn_sched_barrier(0); \
        MLA_KLD(10); MLA_VLD(2); C0 = __builtin_amdgcn_mfma_f32_32x32x16_bf16(kf_6, qr[3], C0, 0, 0, 0); sacc_ += P1[2]; sacc_ += P1[3]; sacc_ += P1[4]; MLA_PIN(sacc_); pw_[2][0] = cvtpk(P1[0], P1[1]); MLA_PIN(pw_[2]); pw_[2][1] = cvtpk(P1[2], P1[3]); MLA_PIN(pw_[2]); __builtin_amdgcn_sched_barrier(0); \
        MLA_KLD(11); MLA_VLD(3); C1 = __builtin_amdgcn_mfma_f32_32x32x16_bf16(kf_7, qr[3], C1, 0, 0, 0); sacc_ += P1[5]; sacc_ += P1[6]; sacc_ += P1[7]; MLA_PIN(sacc_); pw_[2][2] = cvtpk(P1[4], P1[5]); MLA_PIN(pw_[2]); pw_[2][3] = cvtpk(P1[6], P1[7]); MLA_PIN(pw_[2]); __builtin_amdgcn_sched_barrier(0); \
        MLA_VLD(4); C0 = __builtin_amdgcn_mfma_f32_32x32x16_bf16(kf_8, qr[4], C0, 0, 0, 0); sacc_ += P1[8]; sacc_ += P1[9]; MLA_PIN(sacc_); pw_[3][0] = cvtpk(P1[8], P1[9]); MLA_PIN(pw_[3]); __builtin_amdgcn_sched_barrier(0); \
        MLA_VLD(5); C1 = __builtin_amdgcn_mfma_f32_32x32x16_bf16(kf_9, qr[4], C1, 0, 0, 0); sacc_ += P1[10]; sacc_ += P1[11]; MLA_PIN(sacc_); pw_[3][1] = cvtpk(P1[10], P1[11]); MLA_PIN(pw_[3]); __builtin_amdgcn_sched_barrier(0); \
        MLA_VLD(6); C0 = __builtin_amdgcn_mfma_f32_32x32x16_bf16(kf_10, qr[5], C0, 0, 0, 0); sacc_ += P1[12]; sacc_ += P1[13]; MLA_PIN(sacc_); pw_[3][2] = cvtpk(P1[12], P1[13]); MLA_PIN(pw_[3]); __builtin_amdgcn_sched_barrier(0); \
        MLA_VLD(7); C1 = __builtin_amdgcn_mfma_f32_32x32x16_bf16(kf_11, qr[5], C1, 0, 0, 0); sacc_ += P1[14]; sacc_ += P1[15]; MLA_PIN(sacc_); pw_[3][3] = cvtpk(P1[14], P1[15]); MLA_PIN(pw_[3]); __builtin_amdgcn_sched_barrier(0); \
        lsum += sacc_; \
          \
        __builtin_amdgcn_sched_barrier(0); \
        o[0] = __builtin_amdgcn_mfma_f32_32x32x16_bf16(__builtin_bit_cast(bf16x8, pw_[0]), (bf16x8){vl_[0][0], vl_[0][1], vl_[0][2], vl_[0][3], vh_[0][0], vh_[0][1], vh_[0][2], vh_[0][3]}, o[0], 0, 0, 0); o[1] = __builtin_amdgcn_mfma_f32_32x32x16_bf16(__builtin_bit_cast(bf16x8, pw_[0]), (bf16x8){vl_[4][0], vl_[4][1], vl_[4][2], vl_[4][3], vh_[4][0], vh_[4][1], vh_[4][2], vh_[4][3]}, o[1], 0, 0, 0); \
        MLA_MASK(C0, C1, t); \
        float rm_; MLA_ROWMAX(C0, C1, rm_); \
        bool resc_ = false; float alpha_ = 1.f; \
        if (__any(rm_ > 8.f)) { const float dl = fmaxf(rm_, 0.f); mref += dl; alpha_ = ex2(-dl); lsum *= alpha_; resc_ = true; \
            _Pragma("unroll") for (int r = 0; r < 16; ++r) { C0[r] -= dl; C1[r] -= dl; negm[r] = -mref; } } \
          \
        __builtin_amdgcn_sched_barrier(0); \
        o[0] = __builtin_amdgcn_mfma_f32_32x32x16_bf16(__builtin_bit_cast(bf16x8, pw_[1]), (bf16x8){vl_[1][0], vl_[1][1], vl_[1][2], vl_[1][3], vh_[1][0], vh_[1][1], vh_[1][2], vh_[1][3]}, o[0], 0, 0, 0); C0[0] = ex2(C0[0]); C0[1] = ex2(C0[1]); C0[2] = ex2(C0[2]); C0[3] = ex2(C0[3]); C0[4] = ex2(C0[4]); MLA_PIN(C0); MLA_PIN(C1); __builtin_amdgcn_sched_barrier(0); \
        o[1] = __builtin_amdgcn_mfma_f32_32x32x16_bf16(__builtin_bit_cast(bf16x8, pw_[1]), (bf16x8){vl_[5][0], vl_[5][1], vl_[5][2], vl_[5][3], vh_[5][0], vh_[5][1], vh_[5][2], vh_[5][3]}, o[1], 0, 0, 0); C0[5] = ex2(C0[5]); C0[6] = ex2(C0[6]); C0[7] = ex2(C0[7]); C0[8] = ex2(C0[8]); C0[9] = ex2(C0[9]); MLA_PIN(C0); MLA_PIN(C1); __builtin_amdgcn_sched_barrier(0); \
        o[0] = __builtin_amdgcn_mfma_f32_32x32x16_bf16(__builtin_bit_cast(bf16x8, pw_[2]), (bf16x8){vl_[2][0], vl_[2][1], vl_[2][2], vl_[2][3], vh_[2][0], vh_[2][1], vh_[2][2], vh_[2][3]}, o[0], 0, 0, 0); C0[10] = ex2(C0[10]); C0[11] = ex2(C0[11]); C0[12] = ex2(C0[12]); C0[13] = ex2(C0[13]); C0[14] = ex2(C0[14]); MLA_PIN(C0); MLA_PIN(C1); __builtin_amdgcn_sched_barrier(0); \
        o[1] = __builtin_amdgcn_mfma_f32_32x32x16_bf16(__builtin_bit_cast(bf16x8, pw_[2]), (bf16x8){vl_[6][0], vl_[6][1], vl_[6][2], vl_[6][3], vh_[6][0], vh_[6][1], vh_[6][2], vh_[6][3]}, o[1], 0, 0, 0); C0[15] = ex2(C0[15]); C1[0] = ex2(C1[0]); C1[1] = ex2(C1[1]); C1[2] = ex2(C1[2]); C1[3] = ex2(C1[3]); MLA_PIN(C0); MLA_PIN(C1); __builtin_amdgcn_sched_barrier(0); \
        o[0] = __builtin_amdgcn_mfma_f32_32x32x16_bf16(__builtin_bit_cast(bf16x8, pw_[3]), (bf16x8){vl_[3][0], vl_[3][1], vl_[3][2], vl_[3][3], vh_[3][0], vh_[3][1], vh_[3][2], vh_[3][3]}, o[0], 0, 0, 0); C1[4] = ex2(C1[4]); C1[5] = ex2(C1[5]); C1[6] = ex2(C1[6]); C1[7] = ex2(C1[7]); C1[8] = ex2(C1[8]); MLA_PIN(C0); MLA_PIN(C1); __builtin_amdgcn_sched_barrier(0); \
        o[1] = __builtin_amdgcn_mfma_f32_32x32x16_bf16(__builtin_bit_cast(bf16x8, pw_[3]), (bf16x8){vl_[7][0], vl_[7][1], vl_[7][2], vl_[7][3], vh_[7][0], vh_[7][1], vh_[7][2], vh_[7][3]}, o[1], 0, 0, 0); C1[9] = ex2(C1[9]); C1[10] = ex2(C1[10]); C1[11] = ex2(C1[11]); C1[12] = ex2(C1[12]); C1[13] = ex2(C1[13]); MLA_PIN(C0); MLA_PIN(C1); __builtin_amdgcn_sched_barrier(0); \
        C1[14] = ex2(C1[14]); C1[15] = ex2(C1[15]); \
        if (resc_) { if (hi == 0) wsf[r32] = alpha_; WAVE_LDS_SYNC(); \
            _Pragma("unroll") for (int r = 0; r < 16; ++r) { const float a = wsf[crow(r, hi)]; o[0][r] *= a; o[1][r] *= a; } WAVE_LDS_SYNC(); } \
        { const int t_ = kc; kc = kn; kn = kf_; kf_ = t_; } { const int t_ = vc; vc = vn; vn = vf_; vf_ = t_; } } while (0)
    for (int t = 1; t + 1 < NT; t += 2) { MLA_STEP(pb0, pb1, pa0, pa1, t); MLA_STEP(pa0, pa1, pb0, pb1, t + 1); }
    MLA_STEP(pb0, pb1, pa0, pa1, NT - 1);
    { float s_ = 0.f;
#pragma unroll
      for (int r = 0; r < 16; ++r) s_ += pb0[r] + pb1[r];
      lsum += s_; ATT_WAITV_BAR(); pv_tile(o, vfr + vc * VSLOT, pb0, pb1); }
#undef MLA_STEP
#undef MLA_KLD
#undef MLA_VLD
#undef MLA_PIN
#undef MLA_ROWMAX
#undef MLA_MASK
#undef MLA_DMA_K
#undef MLA_DMA_V
    lsum = hsum(lsum);
    if (hi == 0) wsf[32 + r32] = __builtin_amdgcn_rcpf(lsum);
    stage_o(o, stg, wsf + 32, r32, hi);
    bf16* Ow = OC + (rowbase + q0 + wid * 32) * 1024 + h * 64;
#pragma unroll
    for (int i = 0; i < 4; ++i) { const int row = i * 8 + (lane >> 3), ch = lane & 7; const u32x4 v = *(const LAS u32x4*)(stg + row * 64 + ch * 8); *(u32x4*)(Ow + (long)row * 1024 + ch * 8) = v; }
    ATT_WAITV_BAR();
}

constexpr int SB_KSLOT = 8192, SB_OFF_V = 2 * SB_KSLOT, SB_OFF_WS = SB_OFF_V + 2 * VSLOT, SB_OFF_ST = SB_OFF_WS + 8 * 256, SB_OFF_FL = SB_OFF_ST + 8 * 4096, SB_LDS = SB_OFF_FL + 64;
DI void sb_unit(int bh, int qb, const bf16* Q, const bf16* K, const bf16* V, bf16* OC, LAS unsigned char* lds) {
    int tid_ = threadIdx.x; asm volatile("" : "+v"(tid_));
    const int tid = tid_, lane = tid & 63, r32 = lane & 31, hi = lane >> 5, wid = rfl(tid >> 6);
    const int b = bh >> 3, h = bh & 7; const long rowbase = (long)b * SEQ; const int q0 = qb * 256;
    const unsigned lds0 = (unsigned)(size_t)lds;
    LAS bf16* stg = (LAS bf16*)(lds + SB_OFF_ST) + wid * 2048;
    volatile LAS unsigned* fl = (volatile LAS unsigned*)(lds + SB_OFF_FL);
    const bf16* ksrc = K + (rowbase + lane) * 512 + h * 64 + wid * 8;
    const bf16* vsrc = V + (rowbase + 16 * (wid & 3) + (lane >> 2)) * 512 + h * 64 + (wid >> 2) * 32 + (lane & 3) * 8;
#define SB_DMA(t, s) do { glds16(ksrc + (long)(t) * 64 * 512, (unsigned)rfl((int)(lds0 + (s) * SB_KSLOT + wid * 1024))); \
        glds16(vsrc + (long)(t) * 64 * 512, (unsigned)rfl((int)(lds0 + SB_OFF_V + (s) * VSLOT + wid * 1024))); } while (0)
    const bf16* qp = Q + (rowbase + q0 + wid * 32 + r32) * 512 + h * 64 + hi * 8;
    bf16x8 qr[4];
#pragma unroll
    for (int d0 = 0; d0 < 4; ++d0) qr[d0] = *(const bf16x8*)(qp + d0 * 16);
    const int NT = 4 * (qb + 1);
    const lcp kfr = (lcp)lds + hi * 1024 + r32 * 16;
    const lcp vfr = (lcp)lds + SB_OFF_V + ((lane >> 4) & 1) * 32 + (lane & 3) * 8 + (4 * hi + ((lane & 15) >> 2)) * 64;
    float carry = 1.f; f32x16 o[2];
#pragma unroll
    for (int r = 0; r < 16; ++r) { o[0][r] = 0.f; o[1][r] = 0.f; }
    if (tid == 0) { fl[0] = 0u; fl[1] = 0u; fl[2] = 0u; }
    SB_DMA(NT - 1, 0);
    for (int i = 0; i < NT; ++i) {
        const int t = NT - 1 - i;
        ATT_WAITV_BAR();
        if (i > 0 && fl[(i - 1) % 3] == 0u) break;
        if (tid == 0) fl[(i + 1) % 3] = 0u;
        const int s = i & 1;
        if (t > 0) SB_DMA(t - 1, s ^ 1);
        const int jb = t - (NT - 4), qlo = 32 * wid;
        const bool skip = (jb >= 0 && 64 * jb >= qlo + 31);
        const bool dead = __all(carry == 0.f) != 0;
        if (!skip && !dead) {
            f32x16 p0, p1; qk_tile<4>(p0, p1, kfr + s * SB_KSLOT, qr);
            f32x16 f0, f1;
#pragma unroll
            for (int r = 0; r < 16; ++r) {
                { const float y = p0[r], e = ex2(-fabsf(y)), rr = __builtin_amdgcn_rcpf(1.f + e), er = e * rr; const bool pos = y >= 0.f; p0[r] = pos ? rr : er; f0[r] = pos ? er : rr; }
                { const float y = p1[r], e = ex2(-fabsf(y)), rr = __builtin_amdgcn_rcpf(1.f + e), er = e * rr; const bool pos = y >= 0.f; p1[r] = pos ? rr : er; f1[r] = pos ? er : rr; }
            }
            if (jb >= 0 && 64 * jb + 63 >= qlo) { const int qrel = qlo + r32;
#pragma unroll
                for (int r = 0; r < 16; ++r) { const int kv = 64 * jb + crow(r, hi);
                    if (kv >= qrel) { f0[r] = 1.f; p0[r] = 0.f; } if (kv + 32 >= qrel) { f1[r] = 1.f; p1[r] = 0.f; } } }
            float mine[8], oth[8], ps[8];
#pragma unroll
            for (int g = 0; g < 4; ++g) {
                { const float a0 = f0[4 * g], a1 = f0[4 * g + 1], a2 = f0[4 * g + 2], a3 = f0[4 * g + 3]; const float e1 = a3 * a2, e0 = e1 * a1;
                  f0[4 * g + 3] = 1.f; f0[4 * g + 2] = a3; f0[4 * g + 1] = e1; f0[4 * g] = e0; mine[g] = e0 * a0; }
                { const float a0 = f1[4 * g], a1 = f1[4 * g + 1], a2 = f1[4 * g + 2], a3 = f1[4 * g + 3]; const float e1 = a3 * a2, e0 = e1 * a1;
                  f1[4 * g + 3] = 1.f; f1[4 * g + 2] = a3; f1[4 * g + 1] = e1; f1[4 * g] = e0; mine[4 + g] = e0 * a0; }
            }
#pragma unroll
            for (int g = 0; g < 8; ++g) { auto rr = __builtin_amdgcn_permlane32_swap(__float_as_uint(mine[g]), __float_as_uint(mine[g]), false, false);
                const float x0 = __uint_as_float(rr[0]), x1 = __uint_as_float(rr[1]); oth[g] = hi ? x0 : x1; ps[g] = x0 * x1; }
            float sp = 1.f; float off[8];
#pragma unroll
            for (int g = 7; g >= 0; --g) { off[g] = sp * (hi ? 1.f : oth[g]) * carry; sp *= ps[g]; }
#pragma unroll
            for (int g = 0; g < 4; ++g)
#pragma unroll
                for (int j = 0; j < 4; ++j) { p0[4 * g + j] = p0[4 * g + j] * f0[4 * g + j] * off[g]; p1[4 * g + j] = p1[4 * g + j] * f1[4 * g + j] * off[4 + g]; }
            carry *= sp;
            pv_tile(o, vfr + s * VSLOT, p0, p1);
        }
        if (t > 0 && __any(carry != 0.f) && lane == 0) fl[i % 3] = 1u;
    }
#undef SB_DMA
    ATT_WAITV_BAR();
    stage_o(o, stg, nullptr, r32, hi);
    bf16* Ow = OC + (rowbase + q0 + wid * 32) * 1024 + 512 + h * 64;
#pragma unroll
    for (int i = 0; i < 4; ++i) { const int row = i * 8 + (lane >> 3), ch = lane & 7; const u32x4 v = *(const LAS u32x4*)(stg + row * 64 + ch * 8); *(u32x4*)(Ow + (long)row * 1024 + ch * 8) = v; }
    ATT_WAITV_BAR();
}

constexpr int MB_NB = SEQ / 256;
constexpr int MB_OFF_K = 0, MB_OFF_V = 32768, MB_OFF_WS = 65536, MB_OFF_ST = MB_OFF_WS + 8 * 256, MB_OFF_TAB = MB_OFF_ST + 8 * 4096, MB_OFF_RING = MB_OFF_TAB + 512,
              MB_OFF_WC = MB_OFF_RING + 32768, MB_OFF_Q = MB_OFF_WC + 64, MB_LDS = MB_OFF_Q + 64;
DI int t5_bucket(int d) { if (d < 16) return d; const int l = 16 + (int)(__logf((float)d * (1.f / 16.f)) * (16.f / 2.0794415416798357f)); return l < 31 ? l : 31; }
DI void mb_load_kv(const bf16* K2, const bf16* V2, long row0, int h, unsigned lds0, int lane, int wid) {
    const bf16* ksrc = K2 + (row0 + lane) * 1024 + h * 64 + wid * 8;
    const bf16* vsrc = V2 + (row0 + 16 * (wid & 3) + (lane >> 2)) * 1024 + h * 64 + (wid >> 2) * 32 + (lane & 3) * 8;
#pragma unroll
    for (int t = 0; t < 4; ++t) { glds16(ksrc + (long)t * 64 * 1024, (unsigned)rfl((int)(lds0 + MB_OFF_K + t * 8192 + wid * 1024)));
        glds16(vsrc + (long)t * 64 * 1024, (unsigned)rfl((int)(lds0 + MB_OFF_V + t * 8192 + wid * 1024))); }
}
DI void mb_fill_tab(const float* rel_bias, int h, LAS float* tab, int tid) { if (tid < 128) tab[tid] = rel_bias[h * 32 + t5_bucket(tid)] * LOG2E; }

DI void top3_ins(float v, unsigned i, float& v0, unsigned& i0, float& v1, unsigned& i1, float& v2, unsigned& i2) {
    const bool b0 = v > v0 || (v == v0 && i < i0), b1 = v > v1 || (v == v1 && i < i1), b2 = v > v2 || (v == v2 && i < i2);
    const float n2 = b1 ? v1 : (b2 ? v : v2); const unsigned m2 = b1 ? i1 : (b2 ? i : i2);
    const float n1 = b0 ? v0 : (b1 ? v : v1); const unsigned m1 = b0 ? i0 : (b1 ? i : i1);
    const float n0 = b0 ? v : v0; const unsigned m0 = b0 ? i : i0;
    v0 = n0; i0 = m0; v1 = n1; i1 = m1; v2 = n2; i2 = m2;
}
DI void moba_gate_unit(int bh, int g, const bf16* Q2, const float* KMP, unsigned* SEL, unsigned* MASK32, LAS unsigned char* lds) {
    using namespace att;
    int tid_ = threadIdx.x; asm volatile("" : "+v"(tid_));
    const int tid = tid_, lane = tid & 63, r32 = lane & 31, hi = lane >> 5, wid = rfl(tid >> 6);
    const int b = bh >> 4, h = bh & 15;
    LAS bf16* khi = (LAS bf16*)lds; LAS bf16* klo = (LAS bf16*)(lds + 8192);
#pragma unroll
    for (int it_ = 0; it_ < 8; ++it_) { const int i = tid + 512 * it_; const int n = i >> 6, d = i & 63; const size_t src = (size_t)(b * MB_NB + n) * 1024 + h * 64 + d;
        const float v = (KMP[src] + KMP[(size_t)(T / 256) * 1024 + src]) * (1.f / 256.f);
        const unsigned ph = cvtpk(v, 0.f) & 0xffffu; const float rem = v - __uint_as_float(ph << 16); const unsigned pl = cvtpk(rem, 0.f) & 0xffffu;
        const int off = (d >> 3) * 512 + n * 8 + (d & 7); khi[off] = (bf16)ph; klo[off] = (bf16)pl; }
    const bf16* qbase = Q2 + ((long)b * SEQ + wid * 32 + r32) * 1024 + h * 64 + hi * 8;
    bf16x8 qn[4];
#pragma unroll
    for (int d0 = 0; d0 < 4; ++d0) qn[d0] = *(const bf16x8*)(qbase + (long)g * 256 * 1024 + d0 * 16);
    __syncthreads();
    const lcp kfr = (lcp)lds + hi * 1024 + r32 * 16;
#pragma unroll 1
    for (int j = 0; j < 8; ++j) {
        const int qb = g + 8 * j;
        bf16x8 qr[4] = {qn[0], qn[1], qn[2], qn[3]};
        if (j < 7) {
#pragma unroll
            for (int d0 = 0; d0 < 4; ++d0) qn[d0] = *(const bf16x8*)(qbase + (long)(qb + 8) * 256 * 1024 + d0 * 16); }
        f32x16 p0, p1, q0, q1; qk_tile<4>(p0, p1, kfr, qr); qk_tile<4>(q0, q1, kfr + 8192, qr);
        float v0 = -INFINITY, v1 = -INFINITY, v2 = -INFINITY; unsigned i0 = 0xFFu, i1 = 0xFFu, i2 = 0xFFu;
#pragma unroll
        for (int r = 0; r < 16; ++r) { const unsigned n = (unsigned)crow(r, hi); const bool in = (int)n < qb;
            top3_ins(in ? p0[r] + q0[r] : -INFINITY, in ? n : 0xFFu, v0, i0, v1, i1, v2, i2); }
        if (qb > 32) {
#pragma unroll
            for (int r = 0; r < 16; ++r) { const unsigned n = 32u + (unsigned)crow(r, hi); const bool in = (int)n < qb;
                top3_ins(in ? p1[r] + q1[r] : -INFINITY, in ? n : 0xFFu, v0, i0, v1, i1, v2, i2); } }
        { float pa, pb, pc; unsigned qa, qb_, qc;
#define MB_SWAPF(dst, src) do { auto rr_ = __builtin_amdgcn_permlane32_swap(__float_as_uint(src), __float_as_uint(src), false, false); dst = __uint_as_float(hi ? rr_[0] : rr_[1]); } while (0)
#define MB_SWAPU(dst, src) do { auto rr_ = __builtin_amdgcn_permlane32_swap(src, src, false, false); dst = hi ? rr_[0] : rr_[1]; } while (0)
          MB_SWAPF(pa, v0); MB_SWAPF(pb, v1); MB_SWAPF(pc, v2); MB_SWAPU(qa, i0); MB_SWAPU(qb_, i1); MB_SWAPU(qc, i2);
#undef MB_SWAPF
#undef MB_SWAPU
          top3_ins(pa, qa, v0, i0, v1, i1, v2, i2); top3_ins(pb, qb_, v0, i0, v1, i1, v2, i2); top3_ins(pc, qc, v0, i0, v1, i1, v2, i2); }
        if (hi == 0) SEL[(size_t)bh * SEQ + qb * 256 + wid * 32 + r32] = i0 | (i1 << 8) | (i2 << 16);
        for (int n = 0; n < qb; ++n) { const unsigned m0 = (unsigned)__ballot(i0 == (unsigned)n), m1 = (unsigned)__ballot(i1 == (unsigned)n), m2 = (unsigned)__ballot(i2 == (unsigned)n);
            if (lane == 0) { unsigned* dst = MASK32 + ((((size_t)bh * 64 + n) * 64 + qb) * 3) * 8 + wid; dst[0] = m0; dst[8] = m1; dst[16] = m2; } }
    }
    __syncthreads();
}

DI void moba_sel_unit(int bh, int n, const bf16* Q2, const bf16* K2, const bf16* V2, const unsigned long long* MASK, const float* rel_bias, bf16* PO0, bf16* PO1, bf16* PO2, bf16* PO3, float2* PMS, LAS unsigned char* lds) {
    using namespace att;
    int tid_ = threadIdx.x; asm volatile("" : "+v"(tid_));
    const int tid = tid_, lane = tid & 63, r32 = lane & 31, hi = lane >> 5, wid = rfl(tid >> 6);
    const int b = bh >> 4, h = bh & 15; const unsigned lds0 = (unsigned)(size_t)lds;
    mb_load_kv(K2, V2, (long)b * SEQ + n * 256, h, lds0, lane, wid);
    mb_fill_tab(rel_bias, h, (LAS float*)(lds + MB_OFF_TAB), tid);
    LAS unsigned short* list = (LAS unsigned short*)(lds + MB_OFF_RING);
    volatile LAS unsigned* wc = (volatile LAS unsigned*)(lds + MB_OFF_WC);
    bf16x8 qo[4];
    { const bf16* qp = Q2 + ((long)b * SEQ + n * 256 + wid * 32 + r32) * 1024 + h * 64 + hi * 8;
#pragma unroll
      for (int d0 = 0; d0 < 4; ++d0) qo[d0] = *(const bf16x8*)(qp + d0 * 16); }
    const unsigned* mw = (const unsigned*)(MASK + (((size_t)bh * 64 + n) * 64 + (n + 1)) * 12);
    const int nwords = (63 - n) * 24;
    unsigned w[3]; unsigned c = 0;
#pragma unroll
    for (int i = 0; i < 3; ++i) { const int j = tid + 512 * i; w[i] = j < nwords ? mw[j] : 0u; c += (unsigned)__popc(w[i]); }
    unsigned inc = c;
#pragma unroll
    for (int o = 1; o < 64; o <<= 1) { const unsigned t = __shfl_up(inc, o); if (lane >= o) inc += t; }
    if (lane == 63) wc[wid] = inc;
    ATT_WAITV_BAR();
    unsigned base = inc - c, total = 0;
#pragma unroll
    for (int i = 0; i < 8; ++i) { const unsigned x = wc[i]; total += x; if (i < wid) base += x; }
#pragma unroll
    for (int i = 0; i < 3; ++i) { const int j = tid + 512 * i; const int qb = n + 1 + j / 24, rem = j % 24, k = rem >> 3, s0 = qb * 256 + (rem & 7) * 32; unsigned ww = w[i];
        while (ww) { const int bit = __ffs(ww) - 1; ww &= ww - 1u; list[base++] = (unsigned short)(((unsigned)(s0 + bit) << 2) | (unsigned)k); } }
    ATT_BAR();
    const int nchunk = ((int)total + 255) >> 8;
    LAS float* wsf = (LAS float*)(lds + MB_OFF_WS) + wid * 64;
    LAS bf16* stg = (LAS bf16*)(lds + MB_OFF_ST) + wid * 2048;
    const LAS float* tab = (const LAS float*)(lds + MB_OFF_TAB);
    const lcp kfr = (lcp)lds + MB_OFF_K + hi * 1024 + r32 * 16;
    const lcp vfr = (lcp)lds + MB_OFF_V + ((lane >> 4) & 1) * 32 + (lane & 3) * 8 + (4 * hi + ((lane & 15) >> 2)) * 64;
    const int nchunk_ = ((int)total + 255) >> 8;
    const bf16* qbase = Q2 + (long)b * SEQ * 1024 + h * 64 + hi * 8;
    const int kend = n * 256 + 255;
    bf16x8 qn[4]; unsigned en = 0; bool vn = false;
#define MB_QLOAD(cc) do { const int idx_ = (cc) * 256 + 32 * wid + r32; vn = idx_ < (int)total; en = vn ? (unsigned)list[idx_] : 0u; const bf16* qp_ = qbase + (long)(en >> 2) * 1024; \
        _Pragma("unroll") for (int d0 = 0; d0 < 4; ++d0) { bf16x8 z_; _Pragma("unroll") for (int j_ = 0; j_ < 8; ++j_) z_[j_] = 0; qn[d0] = vn ? *(const bf16x8*)(qp_ + d0 * 16) : z_; } } while (0)
    if (nchunk_ > 0) MB_QLOAD(0);
    { float mref = -INFINITY, lsum = 0.f; f32x16 o[2];
#pragma unroll
      for (int r = 0; r < 16; ++r) { o[0][r] = 0.f; o[1][r] = 0.f; }
      const int qrel = 32 * wid + r32, tlast = wid >> 1;
#pragma unroll 1
      for (int t = 0; t <= tlast; ++t) {
          f32x16 p0, p1; qk_tile<4>(p0, p1, kfr + t * 8192, qo);
          const int dbase = qrel - 64 * t;
#pragma unroll
          for (int r = 0; r < 16; ++r) { const int d0 = dbase - crow(r, hi), d1 = d0 - 32;
              const int c0 = d0 > 127 ? 127 : (d0 < 0 ? 0 : d0), c1 = d1 > 127 ? 127 : (d1 < 0 ? 0 : d1);
              p0[r] = d0 < 0 ? -INFINITY : p0[r] + tab[c0]; p1[r] = d1 < 0 ? -INFINITY : p1[r] + tab[c1]; }
          smax_update(p0, p1, mref, lsum, o, wsf, r32, hi);
          pv_tile(o, vfr + t * 8192, p0, p1);
      }
      lsum = hsum(lsum);
      const int sq = n * 256 + qrel;
      if (hi == 0) PMS[((size_t)(3 * 32 + bh)) * SEQ + sq] = make_float2(mref, lsum);
      stage_o(o, stg, nullptr, r32, hi);
#pragma unroll
      for (int i = 0; i < 4; ++i) { const int row = i * 8 + (lane >> 3), ch = lane & 7;
          const u32x4 v = *(const LAS u32x4*)(stg + row * 64 + ch * 8); __builtin_nontemporal_store(v, (u32x4*)(PO3 + ((size_t)bh * SEQ + (n * 256 + 32 * wid + row)) * 64 + ch * 8)); }
      WAVE_LDS_SYNC(); }
#if defined(PROBE_DUP) && ((PROBE_DUP >> 19) & 1)
    for (int prb_ = 0; prb_ < 2; ++prb_) {
#else
    {
#endif
#if defined(PROBE_DUP) && ((PROBE_DUP >> 19) & 1)
    if (prb_ > 0 && nchunk > 0) MB_QLOAD(0);
#endif
    if (wid >= 4) __builtin_amdgcn_s_sleep(10);
#pragma unroll 1
    for (int cc = 0; cc < nchunk; ++cc) {
        const int cnt = ((int)total - cc * 256) < 256 ? ((int)total - cc * 256) : 256;
        bf16x8 qr[4] = {qn[0], qn[1], qn[2], qn[3]}; const unsigned e = en; const bool valid = vn;
        if (cc + 1 < nchunk) MB_QLOAD(cc + 1);
        if (32 * wid >= cnt) continue;
        const bool far = __all(!valid || ((int)(e >> 2) - kend >= 113)) != 0;
        float mref = 0.f, lsum = 0.f; f32x16 o[2], negm;
#pragma unroll
        for (int r = 0; r < 16; ++r) { o[0][r] = 0.f; o[1][r] = 0.f; negm[r] = 0.f; }
#pragma unroll 1
        for (int t = 0; t < 4; ++t) {
            f32x16 p0, p1; qk_tile_ref<4>(p0, p1, kfr + t * 8192, qr, negm);
            if (!far) { const int dbase = (int)(e >> 2) - (n * 256 + 64 * t);
#pragma unroll
                for (int r = 0; r < 16; ++r) { int d0 = dbase - crow(r, hi), d1 = d0 - 32; d0 = d0 > 127 ? 127 : (d0 < 0 ? 0 : d0); d1 = d1 > 127 ? 127 : (d1 < 0 ? 0 : d1); p0[r] += tab[d0]; p1[r] += tab[d1]; } }
            smax_update_ref(p0, p1, mref, negm, lsum, o, wsf, r32, hi, t == 0);
            pv_tile(o, vfr + t * 8192, p0, p1);
        }
        lsum = hsum(lsum);
        if (far) mref += tab[127];
        if (valid && hi == 0) { unsigned e_ = e; asm volatile("" : "+v"(e_)); PMS[((size_t)((int)(e_ & 3u) * 32 + bh)) * SEQ + (int)(e_ >> 2)] = make_float2(mref, lsum); }
        stage_o(o, stg, nullptr, r32, hi);
#pragma unroll
        for (int i = 0; i < 4; ++i) { const int row = i * 8 + (lane >> 3), ch = lane & 7; const int ridx = 32 * wid + row;
            if (ridx < cnt) { const unsigned e2 = list[cc * 256 + ridx]; const int s2 = (int)(e2 >> 2), k2 = (int)(e2 & 3u);
                const u32x4 v = *(const LAS u32x4*)(stg + row * 64 + ch * 8); bf16* pob = k2 == 0 ? PO0 : (k2 == 1 ? PO1 : PO2); __builtin_nontemporal_store(v, (u32x4*)(pob + ((size_t)bh * SEQ + s2) * 64 + ch * 8)); } }
        WAVE_LDS_SYNC();
    }
    }
#undef MB_QLOAD
    ATT_WAITV_BAR();
}

DI void moba_merge(int gw, int ngw, const unsigned* SEL, const bf16* PO0, const bf16* PO1, const bf16* PO2, const bf16* PO3, const float2* PMS, bf16* O2) {
    using namespace att;
    int tid_ = threadIdx.x; asm volatile("" : "+v"(tid_));
    const int lane = tid_ & 63, sub = lane >> 3, ch = lane & 7;
    const int NST = 32 * (SEQ / 8);
    unsigned nsel = 0u; float2 nms[4]; u32x4 npv[4];
#define MB_MLOAD(st) do { const int bh_ = (st) / (SEQ / 8), s_ = ((st) % (SEQ / 8)) * 8 + sub; const size_t it_ = (size_t)bh_ * SEQ + s_; nsel = SEL[it_]; \
        _Pragma("unroll") for (int k = 0; k < 4; ++k) { nms[k] = PMS[(size_t)k * 32 * SEQ + it_]; const bf16* pob = k == 0 ? PO0 : (k == 1 ? PO1 : (k == 2 ? PO2 : PO3)); npv[k] = __builtin_nontemporal_load((const u32x4*)(pob + it_ * 64 + ch * 8)); } } while (0)
    if (gw < NST) MB_MLOAD(gw);
    for (int st = gw; st < NST; st += ngw) {
        const int bh = st / (SEQ / 8), s = (st % (SEQ / 8)) * 8 + sub;
        const unsigned sel = nsel; float2 ms[4] = {nms[0], nms[1], nms[2], nms[3]}; u32x4 pv[4] = {npv[0], npv[1], npv[2], npv[3]};
        if (st + ngw < NST) MB_MLOAD(st + ngw);
        float mall = ms[3].x;
#pragma unroll
        for (int k = 0; k < 3; ++k) { const bool ok = ((sel >> (8 * k)) & 0xFFu) != 0xFFu; if (!ok) { ms[k].x = -INFINITY; ms[k].y = 0.f; pv[k] = (u32x4){0u, 0u, 0u, 0u}; } mall = fmaxf(mall, ms[k].x); }
        float den = 0.f, acc[8] = {0.f, 0.f, 0.f, 0.f, 0.f, 0.f, 0.f, 0.f};
#pragma unroll
        for (int k = 0; k < 4; ++k) { const float w = ex2(ms[k].x - mall); den += w * ms[k].y; const u32x4 v = pv[k];
            acc[0] += w * bflo(v.x); acc[1] += w * bfhi(v.x); acc[2] += w * bflo(v.y); acc[3] += w * bfhi(v.y); acc[4] += w * bflo(v.z); acc[5] += w * bfhi(v.z); acc[6] += w * bflo(v.w); acc[7] += w * bfhi(v.w); }
        const float rd = __builtin_amdgcn_rcpf(den);
        const u32x4 ov = (u32x4){cvtpk(acc[0] * rd, acc[1] * rd), cvtpk(acc[2] * rd, acc[3] * rd), cvtpk(acc[4] * rd, acc[5] * rd), cvtpk(acc[6] * rd, acc[7] * rd)};
        *(u32x4*)(O2 + ((size_t)(bh >> 4) * SEQ + s) * 1024 + (bh & 15) * 64 + ch * 8) = ov;
    }
#undef MB_MLOAD
}
}

constexpr size_t MiB = 1u << 20;
constexpr int NSLOT = 2 * T + 8 * 256;
constexpr size_t WS_CTL = 0, CTL_ZERO_BYTES = 64 * 1024;
constexpr size_t WS_RSTD0 = 1 * MiB, WS_TOKW = WS_RSTD0 + 128 * 1024, WS_TOKR = WS_TOKW + 256 * 1024, WS_TOKE = WS_TOKR + 128 * 1024, WS_PRANK = WS_TOKE + 128 * 1024;
constexpr size_t WS_PQKV = 2 * MiB, WS_PS1 = 6 * MiB, WS_PS2 = 8 * MiB, WS_PS3 = 10 * MiB, WS_ROPE = 12 * MiB, WS_KMP = 14 * MiB;
constexpr size_t WS_SDST = 15 * MiB, WS_SW = WS_SDST + 272 * 1024, WS_SRS = WS_SW + 272 * 1024;
constexpr size_t WS_WRT = 16 * MiB, WS_CNT = WS_WRT + 64 * 1024, WS_TILEE = WS_CNT + 64 * 1024;
constexpr size_t WS_STOK = 17 * MiB;
constexpr size_t WS_SEL = 18 * MiB;
constexpr size_t WS_W = 20 * MiB;
constexpr size_t W_IN = WS_W, W_UQ = W_IN + (size_t)2304 * 1024 * 2, W_UKV = W_UQ + (size_t)768 * 384 * 2, W_O0 = W_UKV + (size_t)1024 * 256 * 2, W_GU0 = W_O0 + (size_t)1024 * 1024 * 2,
                 W_DN0 = W_GU0 + (size_t)4096 * 1024 * 2, W_QKV = W_DN0 + (size_t)1024 * 2048 * 2, W_O1 = W_QKV + (size_t)3072 * 1024 * 2, W_EGU = W_O1 + (size_t)1024 * 1024 * 2,
                 W_EDN = W_EGU + (size_t)8192 * 1024 * 2, W_END = W_EDN + (size_t)8192 * 512 * 2;
static_assert(W_END <= 76 * MiB, "weights region");
constexpr size_t WS_XB = 76 * MiB, WS_OCAT = 76 * MiB, WS_SBQ = 140 * MiB, WS_SBK = 172 * MiB, WS_SBV = 204 * MiB, WS_CQ = 236 * MiB, WS_CKV = 260 * MiB, WS_KR = 276 * MiB,
                 WS_QA = 278 * MiB, WS_KN = 326 * MiB, WS_VA = 358 * MiB, WS_X1B = 390 * MiB, WS_HID = 76 * MiB;
constexpr size_t WS_Q2 = 204 * MiB, WS_K2 = 268 * MiB, WS_V2 = 332 * MiB, WS_PO0 = 76 * MiB, WS_PO1 = 140 * MiB, WS_PO2 = 396 * MiB, WS_PMS = 460 * MiB;
constexpr size_t WS_X3B = 268 * MiB, WS_XPERM = 332 * MiB, WS_YP = 332 * MiB, WS_HIDE = 76 * MiB;
constexpr size_t WS_MASK = 476 * MiB;
constexpr size_t WS_NEED = 489 * MiB;
static_assert(WS_SBK == WS_SBQ + 32 * MiB && WS_SBV == WS_SBQ + 64 * MiB && WS_VA == WS_KN + 32 * MiB && WS_K2 == WS_Q2 + 64 * MiB && WS_V2 == WS_Q2 + 128 * MiB, "epilogue pointer arithmetic");
static_assert(WS_XPERM + (size_t)NSLOT * 2048 <= 464 * MiB && WS_HIDE + (size_t)NSLOT * 1024 <= 204 * MiB && WS_SRS + 272 * 1024 <= 16 * MiB && NSLOT * 4 <= 272 * 1024, "ws map");
constexpr int CW_BAR = 4096, CW_QUEUE = 8192, CW_NRT = 8256;
static_assert((8320 + 64) * 4 <= (int)CTL_ZERO_BYTES && CW_BAR + 3456 <= CW_QUEUE, "control words inside the zeroed region");
constexpr int RING_BYTES = 131072, LDS_BYTES = 147456, MISC_OFF = LDS_BYTES - 256, PHASE_LDS = LDS_BYTES - 512;
static_assert(att::MLA_LDS <= PHASE_LDS && att::SB_LDS <= PHASE_LDS && att::MB_LDS <= PHASE_LDS && RING_BYTES <= PHASE_LDS, "phase LDS");

#define XB_TMO      128
#define XB_XCNT(j)  (256  + 64 * (j))
#define XB_XSUB(j)  (1280 + 64 * (j))
#define XB_XGEN(j)  (2304 + 64 * (j))
#define XB_TOP      3328
#define XB_TOPGEN   3392
#define XCD_BAR_WORDS 3456
#define XB_SPIN_CAP (1u << 18)
__device__ __forceinline__ unsigned xb_ld(unsigned* p)              { return __hip_atomic_load(p, __ATOMIC_RELAXED, __HIP_MEMORY_SCOPE_AGENT); }
__device__ __forceinline__ unsigned xb_add(unsigned* p, unsigned v) { return __hip_atomic_fetch_add(p, v, __ATOMIC_RELAXED, __HIP_MEMORY_SCOPE_AGENT); }
__device__ __forceinline__ unsigned xb_xcc_id() { return (unsigned)__builtin_amdgcn_s_getreg((3 << 11) | 20) & 0xFu; }
#define XB_SPIN(cond, bar) do { unsigned _sp = 0; while (cond) { __builtin_amdgcn_s_sleep(1); \
    if ((++_sp & 255u) == 0u) { if (xb_ld(&(bar)[XB_TMO])) break; if (_sp > XB_SPIN_CAP) { atomicAdd(&(bar)[XB_TMO], 1u); break; } } } } while (0)
struct XcdBarrier { unsigned* bar; unsigned x; volatile LAS unsigned* st; };
__device__ __forceinline__ XcdBarrier xcd_barrier_post(unsigned* bar, volatile LAS unsigned* st) {
    XcdBarrier b; b.bar = bar; b.x = xb_xcc_id(); b.st = st;
    if (threadIdx.x == 0) (void)xb_add(&bar[XB_XCNT(b.x)], 1u);
    return b;
}
__device__ __forceinline__ void xcd_barrier_complete(unsigned* bar, unsigned x, unsigned& nloc, unsigned& nx) {
    const unsigned G = gridDim.x * gridDim.y * gridDim.z;
    unsigned sum, cnt, mine, sp = 0u;
    for (;;) {
        sum = 0u; cnt = 0u; mine = 0u;
#pragma unroll
        for (unsigned j = 0; j < 16; ++j) { const unsigned c = xb_ld(&bar[XB_XCNT(j)]); sum += c; cnt += (c > 0u) ? 1u : 0u; mine = (j == x) ? c : mine; }
        if (sum == G) break;
        __builtin_amdgcn_s_sleep(1);
        if ((++sp & 255u) == 0u) { if (xb_ld(&bar[XB_TMO])) break; if (sp > XB_SPIN_CAP) { atomicAdd(&bar[XB_TMO], 1u); break; } }
    }
    nloc = mine > 0u ? mine : 1u; nx = cnt > 0u ? cnt : 1u;
}
__device__ __forceinline__ void xcd_barrier(const XcdBarrier& b) {
    asm volatile("s_waitcnt vmcnt(0)" ::: "memory");
    __syncthreads();
    if (threadIdx.x == 0) {
        unsigned* bar = b.bar;
        __builtin_amdgcn_s_waitcnt(0);
        unsigned nloc = b.st[0], nx = b.st[1];
        if (nloc == 0u) { xcd_barrier_complete(bar, b.x, nloc, nx); b.st[0] = nloc; b.st[1] = nx; }
        const unsigned old = xb_add(&bar[XB_XSUB(b.x)], 1u);
        const unsigned gen = old / nloc;
        if (old + 1u == (gen + 1u) * nloc) {
            __builtin_amdgcn_fence(__ATOMIC_RELEASE, "agent");
            asm volatile("s_waitcnt vmcnt(0)" ::: "memory");
            const unsigned og = xb_add(&bar[XB_TOP], 1u);
            const unsigned tg = og / nx;
            if (og + 1u == (tg + 1u) * nx) xb_add(&bar[XB_TOPGEN], 1u);
            else XB_SPIN(xb_ld(&bar[XB_TOPGEN]) == tg, bar);
            __builtin_amdgcn_fence(__ATOMIC_ACQUIRE, "agent");
            xb_add(&bar[XB_XGEN(b.x)], 1u);
            asm volatile("s_waitcnt vmcnt(0)" ::: "memory");
        } else {
            XB_SPIN(xb_ld(&bar[XB_XGEN(b.x)]) == gen, bar);
            __builtin_amdgcn_fence(__ATOMIC_ACQUIRE, "agent");
            asm volatile("s_waitcnt vmcnt(0)" ::: "memory");
        }
    }
    __syncthreads();
}

struct Args { const float* in[22]; float* out; unsigned char* ws; int ph_lo, ph_hi; };
enum { I_X = 0, I_EV_AN, I_EV_WIN, I_EV_QN, I_EV_WUQ, I_EV_KVN, I_EV_WUKV, I_EV_WO, I_EV_FN, I_EV_WG, I_EV_WU, I_EV_WD, I_OD_AN, I_OD_WQKV, I_OD_WO, I_OD_FN, I_OD_WR, I_OD_WG, I_OD_WU, I_OD_WD, I_RELB, I_FINN };
constexpr int NPH = 17;

constexpr float C_MLA = 0.10206207261596575f * LOG2E;
constexpr float C_64 = 0.125f * LOG2E;
DI int map_rope32(int p) { return 16 * ((p >> 2) & 1) + 4 * (p >> 3) + (p & 3); }
DI void cvt_item(const float* W, int ld, int col, float scale, const float* gain, int K, bf16* WT, int k0, LAS float* scr, int lane) {
    const int colc = col < 0 ? 0 : col; const float sc = col < 0 ? 0.f : scale;
    const float* wp = W + (size_t)(k0 + (lane >> 5)) * ld + colc;
    float v[32];
#pragma unroll
    for (int i = 0; i < 32; ++i) v[i] = __builtin_nontemporal_load(wp + (size_t)(2 * i) * ld);
    const int c = lane & 7;
    f32x4 g0 = (f32x4){1.f, 1.f, 1.f, 1.f}, g1 = g0;
    if (gain) { g0 = *(const f32x4*)(gain + k0 + 8 * c); g1 = *(const f32x4*)(gain + k0 + 8 * c + 4); }
#pragma unroll
    for (int i = 0; i < 32; ++i) scr[(2 * i + (lane >> 5)) * 33 + (lane & 31)] = v[i] * sc;
    asm volatile("s_waitcnt lgkmcnt(0)" ::: "memory");
#pragma unroll
    for (int j = 0; j < 4; ++j) { const int n = (lane >> 3) + 8 * j; const LAS float* s = scr + (8 * c) * 33 + n;
        v4u o; o.x = cvtpk(s[0 * 33] * g0[0], s[1 * 33] * g0[1]); o.y = cvtpk(s[2 * 33] * g0[2], s[3 * 33] * g0[3]); o.z = cvtpk(s[4 * 33] * g1[0], s[5 * 33] * g1[1]); o.w = cvtpk(s[6 * 33] * g1[2], s[7 * 33] * g1[3]);
        *(v4u*)(WT + (size_t)n * K + k0 + 8 * c) = o; }
    asm volatile("s_waitcnt lgkmcnt(0)" ::: "memory");
}
DI void p0_weights(const Args& a, LAS unsigned char* lds, int gw, int NGW, bool layer1) {
    int tid_ = threadIdx.x; asm volatile("" : "+v"(tid_)); const int tid = tid_, lane = tid & 63, wave = rfl(tid >> 6);
    LAS float* scr = (LAS float*)(lds + wave * 8704);
    unsigned char* ws = a.ws;
    constexpr int J0 = 72 * 16, J1 = J0 + 24 * 6, J2 = J1 + 32 * 4, J3 = J2 + 32 * 16, J4 = J3 + 128 * 16, J5 = J4 + 32 * 32, J6 = J5 + 96 * 16, J7 = J6 + 32 * 16, J8 = J7 + 256 * 16, J9 = J8 + 256 * 8;
    for (int it = (layer1 ? J5 : 0) + gw; it < (layer1 ? J9 : J5); it += NGW) {
        const int ln = lane & 31;
        if (it < J0) { const int nb = it / 16, kb = it % 16, n = nb * 32 + ln; int col; float sc = 1.f;
            if (n < 1536) { col = 672 + n; if (n < 512) sc = C_64; } else if (n < 1920) col = n - 1536; else if (n < 2176) col = 384 + (n - 1920); else if (n < 2208) col = 640 + map_rope32(n - 2176); else col = -1;
            cvt_item(a.in[I_EV_WIN], 2208, col, sc, a.in[I_EV_AN], 1024, (bf16*)(ws + W_IN) + (size_t)nb * 32 * 1024, kb * 64, scr, lane); }
        else if (it < J1) { const int r = it - J0, nb = r / 6, kb = r % 6, n = nb * 32 + ln; const int col = (nb % 3 == 2) ? nb * 32 + map_rope32(ln) : n;
            cvt_item(a.in[I_EV_WUQ], 768, col, C_MLA, a.in[I_EV_QN], 384, (bf16*)(ws + W_UQ) + (size_t)nb * 32 * 384, kb * 64, scr, lane); }
        else if (it < J2) { const int r = it - J1, nb = r / 4, kb = r % 4, n = nb * 32 + ln; const int col = n < 512 ? (n >> 6) * 128 + (n & 63) : ((n - 512) >> 6) * 128 + 64 + ((n - 512) & 63);
            cvt_item(a.in[I_EV_WUKV], 1024, col, 1.f, a.in[I_EV_KVN], 256, (bf16*)(ws + W_UKV) + (size_t)nb * 32 * 256, kb * 64, scr, lane); }
        else if (it < J3) { const int r = it - J2, nb = r / 16, kb = r % 16;
            cvt_item(a.in[I_EV_WO], 1024, nb * 32 + ln, 1.f, nullptr, 1024, (bf16*)(ws + W_O0) + (size_t)nb * 32 * 1024, kb * 64, scr, lane); }
        else if (it < J4) { const int r = it - J3, nb = r / 16, kb = r % 16, n = nb * 32 + ln; const int tile = n >> 8, half = (n >> 7) & 1, col = tile * 128 + (n & 127);
            cvt_item(half ? a.in[I_EV_WU] : a.in[I_EV_WG], 2048, col, 1.f, a.in[I_EV_FN], 1024, (bf16*)(ws + W_GU0) + (size_t)nb * 32 * 1024, kb * 64, scr, lane); }
        else if (it < J5) { const int r = it - J4, nb = r / 32, kb = r % 32;
            cvt_item(a.in[I_EV_WD], 1024, nb * 32 + ln, 1.f, nullptr, 2048, (bf16*)(ws + W_DN0) + (size_t)nb * 32 * 2048, kb * 64, scr, lane); }
        else if (it < J6) { const int r = it - J5, nb = r / 16, kb = r % 16, n = nb * 32 + ln;
            cvt_item(a.in[I_OD_WQKV], 3072, n, n < 1024 ? C_64 : 1.f, a.in[I_OD_AN], 1024, (bf16*)(ws + W_QKV) + (size_t)nb * 32 * 1024, kb * 64, scr, lane); }
        else if (it < J7) { const int r = it - J6, nb = r / 16, kb = r % 16;
            cvt_item(a.in[I_OD_WO], 1024, nb * 32 + ln, 1.f, nullptr, 1024, (bf16*)(ws + W_O1) + (size_t)nb * 32 * 1024, kb * 64, scr, lane); }
        else if (it < J8) { const int r = it - J7, nb = r / 16, kb = r % 16, n = nb * 32 + ln; const int e = n >> 10, m = n & 1023, tile = m >> 8, half = (m >> 7) & 1, col = tile * 128 + (m & 127);
            cvt_item((half ? a.in[I_OD_WU] : a.in[I_OD_WG]) + (size_t)e * 1024 * 512, 512, col, 1.f, a.in[I_OD_FN], 1024, (bf16*)(ws + W_EGU) + (size_t)nb * 32 * 1024, kb * 64, scr, lane); }
        else { const int r = it - J8, nb = r / 8, kb = r % 8, n = nb * 32 + ln; const int e = n >> 10, m = n & 1023;
            cvt_item(a.in[I_OD_WD] + (size_t)e * 512 * 1024, 1024, m, 1.f, nullptr, 512, (bf16*)(ws + W_EDN) + (size_t)nb * 32 * 512, kb * 64, scr, lane); }
    }
}
DI void p0_prologue(const Args& a, LAS unsigned char* lds, int vcu, int G) {
    int tid_ = threadIdx.x; asm volatile("" : "+v"(tid_)); const int tid = tid_, lane = tid & 63, wave = rfl(tid >> 6);
    const int gw = vcu * 8 + wave, NGW = G * 8;
    unsigned char* ws = a.ws;
    p0_weights(a, lds, gw, NGW, false);
    { const float* x = a.in[I_X]; bf16* XB = (bf16*)(ws + WS_XB); float* rs0 = (float*)(ws + WS_RSTD0);
      f32x4 nv[4];
      if (gw < T) { const f32x4* xr = (const f32x4*)(x + (size_t)gw * DM) + lane;
#pragma unroll
          for (int j = 0; j < 4; ++j) nv[j] = __builtin_nontemporal_load(xr + 64 * j); }
      for (int m = gw; m < T; m += NGW) { f32x4 v[4]; float s = 0.f;
#pragma unroll
          for (int j = 0; j < 4; ++j) v[j] = nv[j];
          if (m + NGW < T) { const f32x4* xr = (const f32x4*)(x + (size_t)(m + NGW) * DM) + lane;
#pragma unroll
              for (int j = 0; j < 4; ++j) nv[j] = __builtin_nontemporal_load(xr + 64 * j); }
#pragma unroll
          for (int j = 0; j < 4; ++j) s += (v[j].x * v[j].x + v[j].y * v[j].y) + (v[j].z * v[j].z + v[j].w * v[j].w);
          s = wave_sum(s); if (lane == 0) rs0[m] = rsqrtf(s * (1.f / DM) + RMS_EPS);
          unsigned long long* o8 = (unsigned long long*)(XB + (size_t)m * DM) + lane;
#pragma unroll
          for (int j = 0; j < 4; ++j) o8[64 * j] = (unsigned long long)cvtpk(v[j].x, v[j].y) | ((unsigned long long)cvtpk(v[j].z, v[j].w) << 32); } }
    { float2* rope = (float2*)(ws + WS_ROPE); const int gt = vcu * 512 + tid, NT_ = G * 512;
      for (int i = gt; i < SEQ * 16; i += NT_) { const int pos = i >> 4, f = i & 15;
          const double inv = (f & 8 ? 0.01 : 1.0) * (f & 4 ? 0.1 : 1.0) * (f & 2 ? 0.31622776601683794 : 1.0) * (f & 1 ? 0.5623413251903491 : 1.0);
          double rev = (double)pos * inv * 0.15915494309189535; rev -= __builtin_rint(rev);
          rope[i] = make_float2(__builtin_amdgcn_cosf((float)rev), __builtin_amdgcn_sinf((float)rev)); } }
    { float* wrt = (float*)(ws + WS_WRT); const int gt = vcu * 512 + tid, NT_ = G * 512;
      for (int i = gt; i < 8 * 1024; i += NT_) { const int e = i >> 10, k = i & 1023; wrt[i] = a.in[I_OD_FN][k] * a.in[I_OD_WR][k * 8 + e]; } }
}

using pg8::Unit;
typedef const f32x4 (&AccRef)[2][2][4][2];
DI v4u pack8(f32x4 a, f32x4 b) { v4u w; w.x = cvtpk(a[0], a[1]); w.y = cvtpk(a[2], a[3]); w.z = cvtpk(b[0], b[1]); w.w = cvtpk(b[2], b[3]); return w; }
DI float sumsq8(f32x4 a, f32x4 b) { return (a[0] * a[0] + a[1] * a[1]) + (a[2] * a[2] + a[3] * a[3]) + (b[0] * b[0] + b[1] * b[1]) + (b[2] * b[2] + b[3] * b[3]); }
DI float fq_sum(float s) { s += __shfl_xor(s, 16); s += __shfl_xor(s, 32); return s; }
DI float rstd_from(const float* P, int n4, float invn) { float s = 0.f;
#pragma unroll 4
    for (int i = 0; i < n4; ++i) { const f32x4 v = ((const f32x4*)P)[i]; s += (v[0] + v[1]) + (v[2] + v[3]); } return rsqrtf(s * invn + RMS_EPS); }
DI void rope_pair(f32x4& t1, f32x4& t2, const float2* rp  ) {
#pragma unroll
    for (int j = 0; j < 4; ++j) { const float2 cs = rp[j]; const float a = t1[j], b = t2[j]; t1[j] = a * cs.x - b * cs.y; t2[j] = b * cs.x + a * cs.y; }
}
DI unsigned long long pack4(f32x4 a) { return (unsigned long long)cvtpk(a[0], a[1]) | ((unsigned long long)cvtpk(a[2], a[3]) << 32); }

#define EPI_ROW(q) (u.pm * 256 + ((q) >> 2) * 128 + wr * 64 + ((q) & 3) * 16 + fr)
#define EPI_RSTD8(rs, NP4, P, stride, off, invn) do { f32x4 pv_[8]; const int fqc_ = fq < (NP4) ? fq : 0; \
        _Pragma("unroll") for (int q = 0; q < 8; ++q) pv_[q] = *(const f32x4*)((P) + (size_t)EPI_ROW(q) * (stride) + (off) + fqc_ * 4); \
        _Pragma("unroll") for (int q = 0; q < 8; ++q) { float s_ = (pv_[q][0] + pv_[q][1]) + (pv_[q][2] + pv_[q][3]); if (fq >= (NP4)) s_ = 0.f; s_ = fq_sum(s_); rs[q] = rsqrtf(s_ * (invn) + RMS_EPS); } } while (0)
struct EpiInProj {
    static constexpr bool PERM = true, AFTER_DRAIN = false;
    bf16 *SBQ, *CQ, *CKV, *KR; const float* rstd0; float* PQKV; const float2* rope;
    DI void operator()(AccRef acc, const Unit& u, int wr, int wc, int fr, int fq) const {
        { int ln_ = (int)__builtin_amdgcn_mbcnt_hi(~0u, __builtin_amdgcn_mbcnt_lo(~0u, 0u)); asm volatile("" : "+v"(ln_)); fr = ln_ & 15; fq = ln_ >> 4; }
        float rs[8];
#pragma unroll
        for (int q = 0; q < 8; ++q) rs[q] = rstd0[EPI_ROW(q)];
#pragma unroll
        for (int bj = 0; bj < 2; ++bj) {
            const int col0 = u.pn * 256 + bj * 128, cw = wc * 32 + fq * 8;
#pragma unroll
            for (int q = 0; q < 8; ++q) { const int ai = q >> 2, m = q & 3; const int r = EPI_ROW(q);
                f32x4 v0 = acc[ai][bj][m][0] * rs[q], v1 = acc[ai][bj][m][1] * rs[q];
                if (col0 < 1536) { bf16* dst = SBQ + (size_t)(col0 >> 9) * (size_t)(16u << 20) + (size_t)r * 512 + (col0 & 511) + cw; *(v4u*)dst = pack8(v0, v1); }
                else if (col0 < 1920) { *(v4u*)(CQ + (size_t)r * 384 + (col0 - 1536) + cw) = pack8(v0, v1); const float s = fq_sum(sumsq8(v0, v1)); if (fq == 0) PQKV[(size_t)r * 32 + (col0 - 1536) / 32 + wc] = s; }
                else if (col0 < 2176) { *(v4u*)(CKV + (size_t)r * 256 + (col0 - 1920) + cw) = pack8(v0, v1); const float s = fq_sum(sumsq8(v0, v1)); if (fq == 0) PQKV[(size_t)r * 32 + 16 + (col0 - 1920) / 32 + wc] = s; }
                else if (wc == 0) {
                    const f32x4* rp = (const f32x4*)(rope + (size_t)(r & (SEQ - 1)) * 16 + 4 * fq); const f32x4 ca = rp[0], cb = rp[1];
                    const float c[4] = {ca[0], ca[2], cb[0], cb[2]}, sn[4] = {ca[1], ca[3], cb[1], cb[3]};
#pragma unroll
                    for (int j = 0; j < 4; ++j) { const float a = v0[j], b = v1[j]; v0[j] = a * c[j] - b * sn[j]; v1[j] = b * c[j] + a * sn[j]; }
                    *(unsigned long long*)(KR + (size_t)r * 32 + 4 * fq) = pack4(v0); *(unsigned long long*)(KR + (size_t)r * 32 + 16 + 4 * fq) = pack4(v1); }
            }
        }
    }
};
struct EpiQUp {
    static constexpr bool PERM = true, AFTER_DRAIN = false;
    bf16* QA; const float* PQKV; const float2* rope;
    DI void operator()(AccRef acc, const Unit& u, int wr, int wc, int fr, int fq) const {
        { int ln_ = (int)__builtin_amdgcn_mbcnt_hi(~0u, __builtin_amdgcn_mbcnt_lo(~0u, 0u)); asm volatile("" : "+v"(ln_)); fr = ln_ & 15; fq = ln_ >> 4; }
        float rs[8]; EPI_RSTD8(rs, 3, PQKV, 32, 0, 1.f / 384.f);
        const bool rope0 = (u.pn * 8 + wc) % 3 == 2, rope1 = (u.pn * 8 + 4 + wc) % 3 == 2;
#pragma unroll
        for (int hb = 0; hb < 2; ++hb) {
            f32x4 cs[4][2];
            if (rope0 || rope1) {
#pragma unroll
                for (int qq = 0; qq < 4; ++qq) { const f32x4* rp = (const f32x4*)(rope + (size_t)(EPI_ROW(hb * 4 + qq) & (SEQ - 1)) * 16 + 4 * fq); cs[qq][0] = rp[0]; cs[qq][1] = rp[1]; } }
#pragma unroll
            for (int qq = 0; qq < 4; ++qq) { const int q = hb * 4 + qq, ai = q >> 2, m = q & 3; const int r = EPI_ROW(q);
#pragma unroll
                for (int bj = 0; bj < 2; ++bj) { const int gi = u.pn * 8 + bj * 4 + wc; const bool isr = bj ? rope1 : rope0;
                    f32x4 v0 = acc[ai][bj][m][0] * rs[q], v1 = acc[ai][bj][m][1] * rs[q];
                    if (!isr) *(v4u*)(QA + (size_t)r * 768 + gi * 32 + fq * 8) = pack8(v0, v1);
                    else { const float c[4] = {cs[qq][0][0], cs[qq][0][2], cs[qq][1][0], cs[qq][1][2]}, sn[4] = {cs[qq][0][1], cs[qq][0][3], cs[qq][1][1], cs[qq][1][3]};
#pragma unroll
                        for (int j = 0; j < 4; ++j) { const float a = v0[j], b = v1[j]; v0[j] = a * c[j] - b * sn[j]; v1[j] = b * c[j] + a * sn[j]; }
                        *(unsigned long long*)(QA + (size_t)r * 768 + gi * 32 + 4 * fq) = pack4(v0); *(unsigned long long*)(QA + (size_t)r * 768 + gi * 32 + 16 + 4 * fq) = pack4(v1); } }
            }
        }
    }
};
struct EpiKvUp {
    static constexpr bool PERM = true, AFTER_DRAIN = false;
    bf16* KN; const float* PQKV;
    DI void operator()(AccRef acc, const Unit& u, int wr, int wc, int fr, int fq) const {
        { int ln_ = (int)__builtin_amdgcn_mbcnt_hi(~0u, __builtin_amdgcn_mbcnt_lo(~0u, 0u)); asm volatile("" : "+v"(ln_)); fr = ln_ & 15; fq = ln_ >> 4; }
        float rs[8]; EPI_RSTD8(rs, 2, PQKV, 32, 16, 1.f / 256.f);
#pragma unroll
        for (int q = 0; q < 8; ++q) { const int ai = q >> 2, m = q & 3; const int r = EPI_ROW(q);
#pragma unroll
            for (int bj = 0; bj < 2; ++bj) { const int c = u.pn * 256 + bj * 128 + wc * 32 + fq * 8;
                bf16* dst = KN + (size_t)(c >> 9) * (size_t)(16u << 20) + (size_t)r * 512 + (c & 511);
                *(v4u*)dst = pack8(acc[ai][bj][m][0] * rs[q], acc[ai][bj][m][1] * rs[q]); }
        }
    }
};
template <bool RES_F32> struct EpiRes {
    static constexpr bool PERM = true, AFTER_DRAIN = false;
    const void* res; bf16* Y; float* PS;
    DI void operator()(AccRef acc, const Unit& u, int wr, int wc, int fr, int fq) const {
        { int ln_ = (int)__builtin_amdgcn_mbcnt_hi(~0u, __builtin_amdgcn_mbcnt_lo(~0u, 0u)); asm volatile("" : "+v"(ln_)); fr = ln_ & 15; fq = ln_ >> 4; }
        const size_t cb = (size_t)u.pn * 256 + wc * 32 + fq * 8;
#pragma unroll
        for (int hb = 0; hb < 2; ++hb) {
            f32x4 x0[4][2], x1[4][2];
#pragma unroll
            for (int qq = 0; qq < 4; ++qq)
#pragma unroll
                for (int bj = 0; bj < 2; ++bj) { const size_t o = (size_t)EPI_ROW(hb * 4 + qq) * 1024 + cb + bj * 128;
                    if (RES_F32) { x0[qq][bj] = *(const f32x4*)((const float*)res + o); x1[qq][bj] = *(const f32x4*)((const float*)res + o + 4); }
                    else { const v4u w = *(const v4u*)((const bf16*)res + o); x0[qq][bj] = (f32x4){bflo(w.x), bfhi(w.x), bflo(w.y), bfhi(w.y)}; x1[qq][bj] = (f32x4){bflo(w.z), bfhi(w.z), bflo(w.w), bfhi(w.w)}; } }
#pragma unroll
            for (int qq = 0; qq < 4; ++qq) { const int q = hb * 4 + qq, ai = q >> 2, m = q & 3; const int r = EPI_ROW(q); float ss = 0.f;
#pragma unroll
                for (int bj = 0; bj < 2; ++bj) { const f32x4 v0 = acc[ai][bj][m][0] + x0[qq][bj], v1 = acc[ai][bj][m][1] + x1[qq][bj]; ss += sumsq8(v0, v1); *(v4u*)(Y + (size_t)r * 1024 + cb + bj * 128) = pack8(v0, v1); }
                ss = fq_sum(ss); if (fq == 0) PS[(size_t)r * 16 + u.pn * 4 + wc] = ss; }
        }
    }
};
DI f32x4 silu_mul(f32x4 g, f32x4 u) { f32x4 o;
#pragma unroll
    for (int j = 0; j < 4; ++j) o[j] = g[j] * u[j] * __builtin_amdgcn_rcpf(1.f + ex2(-g[j] * LOG2E)); return o; }
struct EpiSwiGLU {
    static constexpr bool PERM = true, AFTER_DRAIN = false;
    bf16* H; int ldh, ntile; const float* PS; const float* srs;
    DI void operator()(AccRef acc, const Unit& u, int wr, int wc, int fr, int fq) const {
        { int ln_ = (int)__builtin_amdgcn_mbcnt_hi(~0u, __builtin_amdgcn_mbcnt_lo(~0u, 0u)); asm volatile("" : "+v"(ln_)); fr = ln_ & 15; fq = ln_ >> 4; }
        float rs[8];
        if (PS) EPI_RSTD8(rs, 4, PS, 16, 0, 1.f / 1024.f);
        else {
#pragma unroll
            for (int q = 0; q < 8; ++q) rs[q] = srs[EPI_ROW(q)]; }
#pragma unroll
        for (int q = 0; q < 8; ++q) { const int ai = q >> 2, m = q & 3; const int r = EPI_ROW(q);
            const f32x4 h0 = silu_mul(acc[ai][0][m][0] * rs[q], acc[ai][1][m][0] * rs[q]), h1 = silu_mul(acc[ai][0][m][1] * rs[q], acc[ai][1][m][1] * rs[q]);
            *(v4u*)(H + (size_t)r * ldh + (u.pn % ntile) * 128 + wc * 32 + fq * 8) = pack8(h0, h1); }
    }
};
struct EpiQkv {
    static constexpr bool PERM = true, AFTER_DRAIN = false;
    bf16* Q2; const float* PS; float* KMP;
    DI void operator()(AccRef acc, const Unit& u, int wr, int wc, int fr, int fq) const {
        { int ln_ = (int)__builtin_amdgcn_mbcnt_hi(~0u, __builtin_amdgcn_mbcnt_lo(~0u, 0u)); asm volatile("" : "+v"(ln_)); fr = ln_ & 15; fq = ln_ >> 4; }
        float rs[8]; EPI_RSTD8(rs, 4, PS, 16, 0, 1.f / 1024.f);
        const int sec = u.pn >> 2; bf16* dstb = Q2 + (size_t)sec * (size_t)(32u << 20);
        f32x4 cs[2][2];
#pragma unroll
        for (int bj = 0; bj < 2; ++bj) { cs[bj][0] = (f32x4){0.f, 0.f, 0.f, 0.f}; cs[bj][1] = cs[bj][0]; }
#pragma unroll
        for (int q = 0; q < 8; ++q) { const int ai = q >> 2, m = q & 3; const int r = EPI_ROW(q);
#pragma unroll
            for (int bj = 0; bj < 2; ++bj) { const f32x4 v0 = acc[ai][bj][m][0] * rs[q], v1 = acc[ai][bj][m][1] * rs[q]; cs[bj][0] += v0; cs[bj][1] += v1;
                *(v4u*)(dstb + (size_t)r * 1024 + (u.pn & 3) * 256 + bj * 128 + wc * 32 + fq * 8) = pack8(v0, v1); }
        }
        if (sec == 1) {
#pragma unroll
            for (int bj = 0; bj < 2; ++bj)
#pragma unroll
                for (int n = 0; n < 2; ++n) { f32x4 s = cs[bj][n];
#pragma unroll
                    for (int j = 0; j < 4; ++j) { float t = s[j]; t += __shfl_xor(t, 1); t += __shfl_xor(t, 2); t += __shfl_xor(t, 4); t += __shfl_xor(t, 8); s[j] = t; }
                    if (fr == 0) *(f32x4*)(KMP + ((size_t)wr * (T / 256) + u.pm) * 1024 + (u.pn & 3) * 256 + bj * 128 + wc * 32 + fq * 8 + n * 4) = s; }
        }
    }
};
struct EpiMoeDown {
    static constexpr bool PERM = true, AFTER_DRAIN = false;
    bf16* YP; const int* sdst; const float* sw;
    DI void operator()(AccRef acc, const Unit& u, int wr, int wc, int fr, int fq) const {
        { int ln_ = (int)__builtin_amdgcn_mbcnt_hi(~0u, __builtin_amdgcn_mbcnt_lo(~0u, 0u)); asm volatile("" : "+v"(ln_)); fr = ln_ & 15; fq = ln_ >> 4; }
        int d[8]; float w[8];
#pragma unroll
        for (int q = 0; q < 8; ++q) { d[q] = sdst[EPI_ROW(q)]; w[q] = sw[EPI_ROW(q)]; }
#pragma unroll
        for (int q = 0; q < 8; ++q) { const int ai = q >> 2, m = q & 3;
            if (d[q] >= 0) {
#pragma unroll
                for (int bj = 0; bj < 2; ++bj) __builtin_nontemporal_store(pack8(acc[ai][bj][m][0] * w[q], acc[ai][bj][m][1] * w[q]), (v4u*)(YP + (size_t)d[q] * 1024 + (u.pn & 3) * 256 + bj * 128 + wc * 32 + fq * 8)); }
        }
    }
};
struct MoeOrder {
    const int* tile_e; int nrt, G, c;
    DI bool next(int i, Unit& u) const { const long L = (long)i * G + c; if (L >= (long)nrt * 4) return false; const int rt = (int)(L >> 2); u.pm = rt; u.pn = tile_e[rt] * 4 + (int)(L & 3); return true; }
    DI void a_ready(const Unit&) const {}
    DI void done(const Unit&) const {}
};

#ifndef DBG_CHECK
#define DBG_CHECK 0
#endif
constexpr int CW_ERR = 8320;
#if DBG_CHECK
DI float bf2f(bf16 v) { return __uint_as_float((unsigned)v << 16); }
DI void dbg_flag(unsigned* ctl, unsigned bit) { atomicOr(ctl + CW_ERR, bit); }
DI float blk_max(float v, LAS float* red, int tid) { red[tid] = v; __syncthreads(); for (int o = 256; o > 0; o >>= 1) { if (tid < o) red[tid] = fmaxf(red[tid], red[tid + o]); __syncthreads(); } const float r = red[0]; __syncthreads(); return r; }
DI float blk_sum(float v, LAS float* red, int tid) { red[tid] = v; __syncthreads(); for (int o = 256; o > 0; o >>= 1) { if (tid < o) red[tid] = red[tid] + red[tid + o]; __syncthreads(); } const float r = red[0]; __syncthreads(); return r; }
DI unsigned dbg_hash(unsigned i) { i ^= i >> 16; i *= 0x7feb352du; i ^= i >> 15; i *= 0x846ca68bu; i ^= i >> 16; return i; }
DI int dbg_pos(int i) { switch (i) { case 0: return 0; case 1: return 1; case 2: return 31; case 3: return 32; case 4: return 63; case 5: return 64; case 6: return 65; case 7: return 255; case 8: return 256; case 9: return 257;
    case 10: return 511; case 11: return 512; case 12: return 4095; case 13: return 4096; case 14: return 8191; case 15: return 16383; default: return (int)(dbg_hash((unsigned)i) % SEQ); } }
template <int MODE> DI void naive_attn(const Args& a, int b, int h, int s, LAS unsigned char* lds, unsigned sel) {
    const int tid = threadIdx.x; unsigned char* ws = a.ws;
    LAS float* lg = (LAS float*)lds; LAS float* red = (LAS float*)(lds + 65536); LAS float* qv = (LAS float*)(lds + 67584); LAS float* opart = (LAS float*)(lds + 68096); LAS float* oref = (LAS float*)(lds + 70144);
    const size_t r = (size_t)b * SEQ + s;
    const int DQ = MODE == 0 ? 96 : 64; float mblk = 0.f;
    if (tid < DQ) { float q;
        if (MODE == 0) q = bf2f(((const bf16*)(ws + WS_QA))[r * 768 + h * 96 + tid]); else if (MODE == 1) q = bf2f(((const bf16*)(ws + WS_SBQ))[r * 512 + h * 64 + tid]); else q = bf2f(((const bf16*)(ws + WS_Q2))[r * 1024 + h * 64 + tid]);
        qv[tid] = q; }
    __syncthreads();
    const int nk = MODE == 1 ? s : s + 1;
    float lmax = -INFINITY;
    for (int k = tid; k < nk; k += 512) { const size_t kr = (size_t)b * SEQ + k; float acc = 0.f;
        if (MODE == 0) { const bf16* kn = (const bf16*)(ws + WS_KN) + kr * 512 + h * 64; const bf16* kp = (const bf16*)(ws + WS_KR) + kr * 32;
            for (int d = 0; d < 64; ++d) acc += qv[d] * bf2f(kn[d]); for (int d = 0; d < 32; ++d) acc += qv[64 + d] * bf2f(kp[d]); }
        else if (MODE == 1) { const bf16* kk = (const bf16*)(ws + WS_SBK) + kr * 512 + h * 64; for (int d = 0; d < 64; ++d) acc += qv[d] * bf2f(kk[d]); }
        else { const int kb = k >> 8, qb = s >> 8; (void)qb; const bool ok = (MODE == 2 && kb == qb) || kb == (int)(sel & 0xFFu) || kb == (int)((sel >> 8) & 0xFFu) || kb == (int)((sel >> 16) & 0xFFu);
            if (ok) { const bf16* kk = (const bf16*)(ws + WS_K2) + kr * 1024 + h * 64; for (int d = 0; d < 64; ++d) acc += qv[d] * bf2f(kk[d]);
                const int dist = s - k; int bucket = dist; if (dist >= 16) { bucket = 16 + (int)(logf((float)dist / 16.f) / 2.0794415416798357f * 16.f); if (bucket > 31) bucket = 31; }
                acc += a.in[I_RELB][h * 32 + bucket] * LOG2E; } else acc = -INFINITY; }
        lg[k] = acc; lmax = fmaxf(lmax, acc); }
    __syncthreads();
    float tot = 1.f;
    if (MODE == 1) { if (tid == 0) { float run = 0.f; for (int k = nk - 1; k >= 0; --k) { const float y = lg[k]; const float sp = fmaxf(y, 0.f) + log2f(1.f + exp2f(-fabsf(y))); lg[k] = exp2f(y - sp + run); run -= sp; } } __syncthreads(); }
    else { const float m = blk_max(lmax, red, tid); mblk = m; float ls = 0.f; for (int k = tid; k < nk; k += 512) { const float p = exp2f(lg[k] - m); lg[k] = p; ls += p; } __syncthreads(); tot = blk_sum(ls, red, tid); }
    { const int g = tid >> 6, d = tid & 63; float acc = 0.f;
      for (int k = g; k < nk; k += 8) { const size_t kr = (size_t)b * SEQ + k; float v;
          if (MODE == 0) v = bf2f(((const bf16*)(ws + WS_VA))[kr * 512 + h * 64 + d]); else if (MODE == 1) v = bf2f(((const bf16*)(ws + WS_SBV))[kr * 512 + h * 64 + d]); else v = bf2f(((const bf16*)(ws + WS_V2))[kr * 1024 + h * 64 + d]);
          const float p = lg[k]; if (p != 0.f) acc += p * v; }
      opart[g * 64 + d] = acc; }
    __syncthreads();
    if (tid < 64) { float acc = 0.f; for (int g = 0; g < 8; ++g) acc += opart[g * 64 + tid]; oref[tid] = acc / tot; }
    if (tid == 0) oref[64] = mblk + log2f(tot);
    __syncthreads();
}
DI void dbg_cmp64(const bf16* got, LAS unsigned char* lds, unsigned* ctl, unsigned bit) {
    const int tid = threadIdx.x; LAS float* red = (LAS float*)(lds + 65536); LAS float* oref = (LAS float*)(lds + 70144);
    const float v = tid < 64 ? fabsf(oref[tid]) : 0.f; const float mx = blk_max(v, red, tid);
    if (tid < 64) { const float g = bf2f(got[tid]); if (!(fabsf(g - oref[tid]) <= 0.02f * mx + 2e-3f)) dbg_flag(ctl, bit); }
    __syncthreads();
}
DI void dbg_check_a(const Args& a, LAS unsigned char* lds, unsigned* ctl, int bx, int G) {
    const int tid = threadIdx.x; unsigned char* ws = a.ws;
    LAS float* red = (LAS float*)(lds + 65536); LAS float* hrow = (LAS float*)lds;
    LAS float* cq = (LAS float*)(lds + 4096); LAS float* ckv = (LAS float*)(lds + 8192);
    const float2* rope = (const float2*)(ws + WS_ROPE);
    for (int i = bx; i < 256; i += G) {
        const int b = i & 1, s = dbg_pos(i >> 1); const size_t r = (size_t)b * SEQ + s;
        float ss = 0.f; for (int k = tid; k < 1024; k += 512) { const float x = a.in[I_X][r * 1024 + k]; ss += x * x; }
        const float rs = rsqrtf(blk_sum(ss, red, tid) / 1024.f + RMS_EPS);
        for (int k = tid; k < 1024; k += 512) hrow[k] = a.in[I_X][r * 1024 + k] * rs * a.in[I_EV_AN][k];
        __syncthreads();
        for (int j = tid; j < 2208; j += 512) { float acc = 0.f; for (int k = 0; k < 1024; ++k) acc += hrow[k] * a.in[I_EV_WIN][(size_t)k * 2208 + j];
            float got, ref = acc; bool cmp = true;
            if (j < 384) got = bf2f(((const bf16*)(ws + WS_CQ))[r * 384 + j]);
            else if (j < 640) got = bf2f(((const bf16*)(ws + WS_CKV))[r * 256 + (j - 384)]);
            else if (j < 672) { cmp = false; got = 0.f; }
            else if (j < 1184) { got = bf2f(((const bf16*)(ws + WS_SBQ))[r * 512 + (j - 672)]); ref = acc * C_64; }
            else if (j < 1696) got = bf2f(((const bf16*)(ws + WS_SBK))[r * 512 + (j - 1184)]);
            else got = bf2f(((const bf16*)(ws + WS_SBV))[r * 512 + (j - 1696)]);
            if (cmp && !(fabsf(got - ref) <= 0.03f * fabsf(ref) + 0.03f)) dbg_flag(ctl, 1u); }
        if (tid < 16) { float t1 = 0.f, t2 = 0.f; for (int k = 0; k < 1024; ++k) { t1 += hrow[k] * a.in[I_EV_WIN][(size_t)k * 2208 + 640 + tid]; t2 += hrow[k] * a.in[I_EV_WIN][(size_t)k * 2208 + 656 + tid]; }
            const float ang = (float)s * powf(10000.f, -(float)tid / 16.f); const float c = cosf(ang), sn = sinf(ang);
            const float o1 = t1 * c - t2 * sn, o2 = t2 * c + t1 * sn; const float g1 = bf2f(((const bf16*)(ws + WS_KR))[r * 32 + tid]), g2 = bf2f(((const bf16*)(ws + WS_KR))[r * 32 + 16 + tid]);
            if (!(fabsf(g1 - o1) <= 0.03f * fabsf(o1) + 0.03f) || !(fabsf(g2 - o2) <= 0.03f * fabsf(o2) + 0.03f)) dbg_flag(ctl, 1u);
            const float2 tb = rope[(size_t)s * 16 + tid]; if (!(fabsf(tb.x - c) < 2e-3f && fabsf(tb.y - sn) < 2e-3f)) dbg_flag(ctl, 1u); }
        __syncthreads();
        float s1 = 0.f, s2 = 0.f;
        if (tid < 384) { const float v = bf2f(((const bf16*)(ws + WS_CQ))[r * 384 + tid]); s1 = v * v; cq[tid] = v; }
        if (tid < 256) { const float v = bf2f(((const bf16*)(ws + WS_CKV))[r * 256 + tid]); s2 = v * v; ckv[tid] = v; }
        const float rq = rsqrtf(blk_sum(s1, red, tid) / 384.f + RMS_EPS), rk = rsqrtf(blk_sum(s2, red, tid) / 256.f + RMS_EPS);
        if (tid < 384) cq[tid] *= rq * a.in[I_EV_QN][tid];
        if (tid < 256) ckv[tid] *= rk * a.in[I_EV_KVN][tid];
        __syncthreads();
        for (int j = tid; j < 768; j += 512) { const int hh = j / 96, dd = j % 96; float acc = 0.f; for (int k = 0; k < 384; ++k) acc += cq[k] * a.in[I_EV_WUQ][(size_t)k * 768 + j];
            float ref = acc;
            if (dd >= 64) { const int ri = dd - 64, pi = ri < 16 ? ri : ri - 16; const int jp = hh * 96 + 64 + (ri < 16 ? ri + 16 : ri - 16); float accp = 0.f; for (int k = 0; k < 384; ++k) accp += cq[k] * a.in[I_EV_WUQ][(size_t)k * 768 + jp];
                const float ang = (float)s * powf(10000.f, -(float)pi / 16.f); const float c = cosf(ang), sn = sinf(ang); ref = ri < 16 ? acc * c - accp * sn : acc * c + accp * sn; }
            ref *= C_MLA; const float got = bf2f(((const bf16*)(ws + WS_QA))[r * 768 + j]);
            if (!(fabsf(got - ref) <= 0.03f * fabsf(ref) + 0.02f)) dbg_flag(ctl, 1u); }
        for (int j = tid; j < 1024; j += 512) { const int hh = j >> 7, dd = j & 127; float acc = 0.f; for (int k = 0; k < 256; ++k) acc += ckv[k] * a.in[I_EV_WUKV][(size_t)k * 1024 + j];
            const float got = dd < 64 ? bf2f(((const bf16*)(ws + WS_KN))[r * 512 + hh * 64 + dd]) : bf2f(((const bf16*)(ws + WS_VA))[r * 512 + hh * 64 + dd - 64]);
            if (!(fabsf(got - acc) <= 0.03f * fabsf(acc) + 0.03f)) dbg_flag(ctl, 1u); }
        __syncthreads();
        const int h = (int)(dbg_hash((unsigned)i * 7u + 1u) & 7u);
        naive_attn<0>(a, b, h, s, lds, 0u); dbg_cmp64((const bf16*)(ws + WS_OCAT) + r * 1024 + h * 64, lds, ctl, 2u);
        naive_attn<1>(a, b, h, s, lds, 0u); dbg_cmp64((const bf16*)(ws + WS_OCAT) + r * 1024 + 512 + h * 64, lds, ctl, 4u);
    }
}
DI void dbg_check_b(const Args& a, LAS unsigned char* lds, unsigned* ctl, int bx, int G, const bf16* O2) {
    const int tid = threadIdx.x; unsigned char* ws = a.ws;
    LAS float* red = (LAS float*)(lds + 65536); LAS float* hrow = (LAS float*)lds; LAS float* gate = (LAS float*)(lds + 8192);
    const bf16* X2 = (const bf16*)a.out;
    for (int i = bx; i < 256; i += G) {
        const int b = i & 1, s = dbg_pos(i >> 1), h = (int)(dbg_hash((unsigned)i * 11u + 5u) & 15u); const size_t r = (size_t)b * SEQ + s;
        float ss = 0.f; for (int k = tid; k < 1024; k += 512) { const float x = bf2f(X2[r * 1024 + k]); ss += x * x; }
        const float rs = rsqrtf(blk_sum(ss, red, tid) / 1024.f + RMS_EPS);
        for (int k = tid; k < 1024; k += 512) hrow[k] = bf2f(X2[r * 1024 + k]) * rs * a.in[I_OD_AN][k];
        __syncthreads();
        for (int j = tid; j < 3072; j += 512) { float acc = 0.f; for (int k = 0; k < 1024; ++k) acc += hrow[k] * a.in[I_OD_WQKV][(size_t)k * 3072 + j];
            float ref = acc; float got;
            if (j < 1024) { ref = acc * C_64; got = bf2f(((const bf16*)(ws + WS_Q2))[r * 1024 + j]); } else if (j < 2048) got = bf2f(((const bf16*)(ws + WS_K2))[r * 1024 + j - 1024]); else got = bf2f(((const bf16*)(ws + WS_V2))[r * 1024 + j - 2048]);
            if (!(fabsf(got - ref) <= 0.03f * fabsf(ref) + 0.03f)) dbg_flag(ctl, 8u); }
        __syncthreads();
        const int qb = s >> 8; const unsigned sel = ((const unsigned*)(ws + WS_SEL))[((size_t)(b * 16 + h)) * SEQ + s];
        if (tid < 64) gate[tid] = -INFINITY;
        __syncthreads();
        { const int n = tid >> 3, part = tid & 7;
          float acc = 0.f; if (n < qb) { for (int kk = part * 32; kk < part * 32 + 32; ++kk) { const size_t kr = (size_t)b * SEQ + n * 256 + kk; for (int d = 0; d < 64; ++d) acc += bf2f(((const bf16*)(ws + WS_Q2))[r * 1024 + h * 64 + d]) * bf2f(((const bf16*)(ws + WS_K2))[kr * 1024 + h * 64 + d]); } }
          acc += __shfl_xor(acc, 1); acc += __shfl_xor(acc, 2); acc += __shfl_xor(acc, 4); if (part == 0 && n < qb) gate[n] = acc / 256.f; }
        __syncthreads();
        if (tid == 0) { const int nsel_exp = qb < 3 ? qb : 3; int nsel = 0; float gmin = INFINITY; bool bad = false;
            for (int k = 0; k < 3; ++k) { const unsigned e = (sel >> (8 * k)) & 0xFFu; if (e != 0xFFu) { if ((int)e >= qb) bad = true; else { ++nsel; gmin = fminf(gmin, gate[e]); } } }
            if (nsel != nsel_exp) bad = true;
            if ((sel & 0xFFu) != 0xFFu && ((sel & 0xFFu) == ((sel >> 8) & 0xFFu) || (sel & 0xFFu) == ((sel >> 16) & 0xFFu))) bad = true;
            if (((sel >> 8) & 0xFFu) != 0xFFu && ((sel >> 8) & 0xFFu) == ((sel >> 16) & 0xFFu)) bad = true;
            if (!bad && nsel > 0) { float gsc = 0.f; for (int n = 0; n < qb; ++n) gsc = fmaxf(gsc, fabsf(gate[n]));
                for (int n = 0; n < qb; ++n) { const bool chosen = n == (int)(sel & 0xFFu) || n == (int)((sel >> 8) & 0xFFu) || n == (int)((sel >> 16) & 0xFFu); if (!chosen && gate[n] > gmin + 0.02f * gsc + 1e-3f) bad = true; } }
            if (bad) dbg_flag(ctl, 8u); }
        __syncthreads();
        { LAS float* oref = (LAS float*)(lds + 70144); float* dref = (float*)(ws + WS_WRT + 256 * 1024) + (size_t)i * 64;
          naive_attn<2>(a, b, h, s, lds, 0xFFFFFFu);
          { const float v = tid < 64 ? fabsf(oref[tid]) : 0.f; const float mx = blk_max(v, red, tid);
            const float2 ms = ((const float2*)(ws + WS_PMS))[((size_t)(3 * 32 + b * 16 + h)) * SEQ + s]; const bf16* pob = (const bf16*)a.out + (size_t)32 * 1024 * 1024 + (((size_t)(b * 16 + h)) * SEQ + s) * 64;
            if (tid == 0) { if (!(fabsf(ms.x + log2f(ms.y) - oref[64]) <= 0.05f)) dbg_flag(ctl, 8u); }
            if (tid < 64) { const float g = bf2f(pob[tid]) / ms.y; if (!(fabsf(g - oref[tid]) <= 0.02f * mx + 2e-3f)) dbg_flag(ctl, 8u); }
            __syncthreads(); }
          naive_attn<2>(a, b, h, s, lds, sel);
          if (tid < 64) dref[tid] = oref[tid];
          __syncthreads(); }
    }
}
DI void dbg_check_b2(const Args& a, LAS unsigned char* lds, unsigned* ctl, int bx, int G, const bf16* O2) {
    const int tid = threadIdx.x; unsigned char* ws = a.ws; LAS float* red = (LAS float*)(lds + 65536);
    for (int i = bx; i < 256; i += G) {
        const int b = i & 1, s = dbg_pos(i >> 1), h = (int)(dbg_hash((unsigned)i * 11u + 5u) & 15u); const size_t r = (size_t)b * SEQ + s;
        const float* dref = (const float*)(ws + WS_WRT + 256 * 1024) + (size_t)i * 64;
        const float rf = tid < 64 ? dref[tid] : 0.f; const float mx = blk_max(fabsf(rf), red, tid);
        if (tid < 64) { const float g = bf2f(O2[r * 1024 + h * 64 + tid]); if (!(fabsf(g - rf) <= 0.02f * mx + 2e-3f)) dbg_flag(ctl, 8u); }
        __syncthreads();
    }
}
#endif

DI void router_chunk(const Args& a, int ch, LAS unsigned char* lds) {
    int tid_ = threadIdx.x; asm volatile("" : "+v"(tid_)); const int tid = tid_, lane = tid & 63, wave = rfl(tid >> 6);
    unsigned char* ws = a.ws;
    const bf16* X3 = (const bf16*)(ws + WS_X3B); const float* PS3 = (const float*)(ws + WS_PS3);
    const LAS float* wrt = (const LAS float*)lds;
    volatile LAS unsigned* te = (volatile LAS unsigned*)(lds + 32768);
    float2* TOKW = (float2*)(ws + WS_TOKW); float* TOKR = (float*)(ws + WS_TOKR); unsigned* TOKE = (unsigned*)(ws + WS_TOKE);
    v4u nw0 = *((const v4u*)(X3 + (size_t)(ch * 128 + wave * 16) * 1024) + lane), nw1 = *((const v4u*)(X3 + (size_t)(ch * 128 + wave * 16) * 1024 + 512) + lane);
    float npss = PS3[(size_t)(ch * 128 + wave * 16) * 16 + (lane & 15)];
#pragma unroll 1
    for (int i = 0; i < 16; ++i) {
        const int tl = wave * 16 + i, tok = ch * 128 + tl;
        const v4u w0 = nw0, w1 = nw1; float pss = npss;
        if (i < 15) { nw0 = *((const v4u*)(X3 + (size_t)(tok + 1) * 1024) + lane); nw1 = *((const v4u*)(X3 + (size_t)(tok + 1) * 1024 + 512) + lane); npss = PS3[(size_t)(tok + 1) * 16 + (lane & 15)]; }
        float xv[16] = {bflo(w0.x), bfhi(w0.x), bflo(w0.y), bfhi(w0.y), bflo(w0.z), bfhi(w0.z), bflo(w0.w), bfhi(w0.w), bflo(w1.x), bfhi(w1.x), bflo(w1.y), bfhi(w1.y), bflo(w1.z), bfhi(w1.z), bflo(w1.w), bfhi(w1.w)};
        float lg[8];
#pragma unroll
        for (int e = 0; e < 8; ++e) { const LAS f32x4* p0 = (const LAS f32x4*)(wrt + e * 1024 + lane * 8); const LAS f32x4* p1 = (const LAS f32x4*)(wrt + e * 1024 + 512 + lane * 8);
            const f32x4 a0 = p0[0], a1 = p0[1], b0 = p1[0], b1 = p1[1];
            float s = xv[0] * a0[0] + xv[1] * a0[1] + xv[2] * a0[2] + xv[3] * a0[3] + xv[4] * a1[0] + xv[5] * a1[1] + xv[6] * a1[2] + xv[7] * a1[3];
            s += xv[8] * b0[0] + xv[9] * b0[1] + xv[10] * b0[2] + xv[11] * b0[3] + xv[12] * b1[0] + xv[13] * b1[1] + xv[14] * b1[2] + xv[15] * b1[3];
            lg[e] = wave_sum(s); }
        pss += __shfl_xor(pss, 1); pss += __shfl_xor(pss, 2); pss += __shfl_xor(pss, 4); pss += __shfl_xor(pss, 8);
        const float rs = rsqrtf(pss * (1.f / 1024.f) + RMS_EPS);
        float v1 = -INFINITY, v2 = -INFINITY; unsigned i1 = 0, i2 = 0;
#pragma unroll
        for (int e = 0; e < 8; ++e) { const float l = lg[e] * rs; if (l > v1) { v2 = v1; i2 = i1; v1 = l; i1 = (unsigned)e; } else if (l > v2) { v2 = l; i2 = (unsigned)e; } }
        const float w1g = 1.f / (1.f + __expf(v2 - v1));
        if (lane == 0) { TOKW[tok] = make_float2(w1g, 1.f - w1g); TOKR[tok] = rs; TOKE[tok] = i1 | (i2 << 8); te[tl] = i1 | (i2 << 8); }
    }
    __syncthreads();
    { const unsigned e = (unsigned)wave; const unsigned ta = te[2 * lane], tb = te[2 * lane + 1];
      const unsigned m0 = (ta & 0xFFu) == e, m1 = ((ta >> 8) & 0xFFu) == e, m2 = (tb & 0xFFu) == e, m3 = ((tb >> 8) & 0xFFu) == e;
      const unsigned c = m0 + m1 + m2 + m3; unsigned inc = c;
#pragma unroll
      for (int o = 1; o < 64; o <<= 1) { const unsigned t = __shfl_up(inc, o); if (lane >= o) inc += t; }
      unsigned base = inc - c; int* PR = (int*)(ws + WS_PRANK) + (size_t)ch * 256 + 4 * lane;
      if (m0) { PR[0] = (int)base; ++base; } if (m1) { PR[1] = (int)base; ++base; } if (m2) { PR[2] = (int)base; ++base; } if (m3) { PR[3] = (int)base; ++base; }
      if (lane == 63) ((int*)(ws + WS_CNT))[ch * 8 + wave] = (int)inc; }
    __syncthreads();
}

DI void permute_phase(const Args& a, LAS unsigned char* lds, int G) {
    int tid_ = threadIdx.x; asm volatile("" : "+v"(tid_)); const int tid = tid_;
    unsigned char* ws = a.ws;
    LAS int* cnt = (LAS int*)lds;
    LAS int* off = (LAS int*)(lds + 8192);
    LAS int* ebase = (LAS int*)(lds + 16384);
    const int* CNT = (const int*)(ws + WS_CNT);
    for (int i = tid; i < 2048; i += 512) cnt[i] = CNT[i];
    __syncthreads();
    if (tid < 8) { int s = 0; for (int c = 0; c < 256; ++c) { off[c * 8 + tid] = s; s += cnt[c * 8 + tid]; } ebase[16 + tid] = s; }
    __syncthreads();
    if (tid == 0) { int s = 0; for (int e = 0; e < 8; ++e) { ebase[e] = s; s += (ebase[16 + e] + 255) & ~255; } ebase[8] = s; }
    __syncthreads();
    int* SDST = (int*)(ws + WS_SDST); float* SW = (float*)(ws + WS_SW); float* SRS = (float*)(ws + WS_SRS);
    int* STOK = (int*)(ws + WS_STOK);
    const float2* TOKW = (const float2*)(ws + WS_TOKW); const float* TOKR = (const float*)(ws + WS_TOKR); const unsigned* TOKE = (const unsigned*)(ws + WS_TOKE); const int* PRANK = (const int*)(ws + WS_PRANK);
    if (blockIdx.x == 0) {
        int* TE = (int*)(ws + WS_TILEE); const int nrt = ebase[8] >> 8;
        for (int rt = tid; rt < nrt; rt += 512) { int e = 0; for (int k = 1; k < 8; ++k) if (rt * 256 >= ebase[k]) e = k; TE[rt] = e; }
        if (tid == 0) ((unsigned*)(ws + WS_CTL))[CW_NRT] = (unsigned)nrt;
    }
    for (int e = blockIdx.x; e < 8; e += G) {
        const int lo = ebase[e] + ebase[16 + e], hi = ebase[e + 1];
        for (int s = lo + tid; s < hi; s += 512) { SDST[s] = -1; SW[s] = 0.f; SRS[s] = 0.f; STOK[s] = 0; }
    }
    for (int ch = blockIdx.x; ch < 256; ch += G) {
        if (tid < 256) { const int tok = ch * 128 + (tid >> 1), k = tid & 1; const unsigned te = TOKE[tok]; const int e = (int)((te >> (8 * k)) & 0xFFu);
            const int slot = ebase[e] + off[ch * 8 + e] + PRANK[(size_t)ch * 256 + tid];
            const float2 w = TOKW[tok]; SDST[slot] = tok * 2 + k; SW[slot] = k ? w.y : w.x; SRS[slot] = TOKR[tok]; STOK[slot] = tok; }
    }
}

DI void final_phase(const Args& a, int vcu, int G, float oscale) {
    int tid_ = threadIdx.x; asm volatile("" : "+v"(tid_)); const int tid = tid_, lane = tid & 63, wave = rfl(tid >> 6);
    const bf16* X3 = (const bf16*)(a.ws + WS_X3B); const bf16* YP = (const bf16*)(a.ws + WS_YP); const float* g = a.in[I_FINN];
    const int gw = vcu * 8 + wave, NGW = G * 8;
    f32x4 gv[4];
#pragma unroll
    for (int j = 0; j < 4; ++j) gv[j] = *((const f32x4*)g + 2 * lane + (j & 1) + 128 * (j >> 1));
    v4u nx[2], ny0[2], ny1[2];
#define FN_LOAD(m) do { _Pragma("unroll") for (int hlf = 0; hlf < 2; ++hlf) { nx[hlf] = __builtin_nontemporal_load((const v4u*)(X3 + (size_t)(m) * 1024 + hlf * 512) + lane); \
        ny0[hlf] = __builtin_nontemporal_load((const v4u*)(YP + (size_t)(2 * (m)) * 1024 + hlf * 512) + lane); ny1[hlf] = __builtin_nontemporal_load((const v4u*)(YP + (size_t)(2 * (m) + 1) * 1024 + hlf * 512) + lane); } } while (0)
    if (gw < T) FN_LOAD(gw);
    for (int m = gw; m < T; m += NGW) {
        float v[16]; float ss = 0.f;
        const v4u cx[2] = {nx[0], nx[1]}, cy0[2] = {ny0[0], ny0[1]}, cy1[2] = {ny1[0], ny1[1]};
        if (m + NGW < T) FN_LOAD(m + NGW);
#pragma unroll
        for (int hlf = 0; hlf < 2; ++hlf) {
            const v4u x = cx[hlf], y0 = cy0[hlf], y1 = cy1[hlf];
            const unsigned xs[4] = {x.x, x.y, x.z, x.w}, as[4] = {y0.x, y0.y, y0.z, y0.w}, bs[4] = {y1.x, y1.y, y1.z, y1.w};
#pragma unroll
            for (int j = 0; j < 4; ++j) { const float lo = bflo(xs[j]) + (bflo(as[j]) + bflo(bs[j])), hh = bfhi(xs[j]) + (bfhi(as[j]) + bfhi(bs[j])); v[hlf * 8 + 2 * j] = lo; v[hlf * 8 + 2 * j + 1] = hh; ss += lo * lo + hh * hh; }
        }
        ss = wave_sum(ss); const float rs = rsqrtf(ss * (1.f / 1024.f) + RMS_EPS) * oscale;
        float* o = a.out + (size_t)m * 1024;
#pragma unroll
        for (int hlf = 0; hlf < 2; ++hlf) { f32x4 o0, o1;
#pragma unroll
            for (int j = 0; j < 4; ++j) { o0[j] = v[hlf * 8 + j] * rs * gv[hlf * 2][j]; o1[j] = v[hlf * 8 + 4 + j] * rs * gv[hlf * 2 + 1][j]; }
            __builtin_nontemporal_store(o0, (f32x4*)(o + hlf * 512) + 2 * lane); __builtin_nontemporal_store(o1, (f32x4*)(o + hlf * 512) + 2 * lane + 1); }
    }
}

__global__ void __launch_bounds__(512, 2) hybrid_fwd(Args args) {
    extern __shared__ __attribute__((aligned(16))) unsigned char lds_raw[];
    LAS unsigned char* lds = (LAS unsigned char*)lds_raw;
    volatile LAS unsigned* MISC = (volatile LAS unsigned*)(lds + MISC_OFF);
    const int tid = threadIdx.x, wave = rfl(tid >> 6), lane = tid & 63;
    const int G = gridDim.x; const int bx = blockIdx.x; const int vcu = (G % 8 == 0) ? (bx % 8) * (G / 8) + bx / 8 : bx;
    unsigned char* ws = args.ws;
    unsigned* ctl = (unsigned*)(ws + WS_CTL);
    for (int u = tid; u < (LDS_BYTES - PHASE_LDS) / 4; u += 512) ((LAS unsigned*)(lds + PHASE_LDS))[u] = 0u;
    __syncthreads();
    XcdBarrier bar; bar.bar = ctl + CW_BAR; bar.x = 0; bar.st = nullptr;
#if MK_ONE_LAUNCH
    (void)xcd_barrier_post(ctl + CW_BAR, MISC + 8);
#if defined(PROBE_DUP) && ((PROBE_DUP >> 21) & 1)
#define GRID_BAR() do { const unsigned long long t0_ = __builtin_amdgcn_s_memrealtime(); XcdBarrier b_; b_.bar = (unsigned*)(args.ws + WS_CTL) + CW_BAR; b_.x = xb_xcc_id(); b_.st = (volatile LAS unsigned*)(lds + MISC_OFF) + 8; xcd_barrier(b_); if ((PROBE_SEAMS >> prb_k_) & 1) prb_wait_ += __builtin_amdgcn_s_memrealtime() - t0_; } while (0)
#else
#define GRID_BAR() do { XcdBarrier b_; b_.bar = (unsigned*)(args.ws + WS_CTL) + CW_BAR; b_.x = xb_xcc_id(); b_.st = (volatile LAS unsigned*)(lds + MISC_OFF) + 8; xcd_barrier(b_); } while (0)
#endif
#else
#define GRID_BAR() do { } while (0)
#endif
    int prb_k_ = 0; (void)prb_k_; unsigned long long prb_wait_ = 0; (void)prb_wait_;
    const int lo = args.ph_lo, hi = args.ph_hi;
#ifndef PH_MASK
#define PH_MASK 0x1FFFF
#endif
#define IN(k) (((PH_MASK >> (k)) & 1) && lo <= (k) && (k) < hi)
#if defined(PROBE_DUP) && ((PROBE_DUP >> 20) & 1)
#define SEAM(k) do { if (IN((k) + 1)) { GRID_BAR(); GRID_BAR(); } } while (0)
#else
#define SEAM(k) do { prb_k_ = (k); if (IN((k) + 1)) GRID_BAR(); } while (0)
#endif
#ifndef PROBE_DUP
#define PROBE_DUP 0
#endif
#define REP(k) for (int rep_ = 0; rep_ < (((PROBE_DUP >> (k)) & 1) ? 2 : 1); ++rep_)
    (void)lane; (void)wave;

    bf16* XB = (bf16*)(ws + WS_XB); bf16* OCAT = (bf16*)(ws + WS_OCAT);
    bf16 *SBQ = (bf16*)(ws + WS_SBQ), *SBK = (bf16*)(ws + WS_SBK), *SBV = (bf16*)(ws + WS_SBV), *CQ = (bf16*)(ws + WS_CQ), *CKV = (bf16*)(ws + WS_CKV), *KR = (bf16*)(ws + WS_KR);
    bf16 *QA = (bf16*)(ws + WS_QA), *KN = (bf16*)(ws + WS_KN), *VA = (bf16*)(ws + WS_VA), *X1B = (bf16*)(ws + WS_X1B), *HID = (bf16*)(ws + WS_HID), *X2B = (bf16*)args.out;
    bf16 *Q2 = (bf16*)(ws + WS_Q2), *K2 = (bf16*)(ws + WS_K2), *V2 = (bf16*)(ws + WS_V2), *X3B = (bf16*)(ws + WS_X3B), *YP = (bf16*)(ws + WS_YP), *HIDE = (bf16*)(ws + WS_HIDE);
    float *PQKV = (float*)(ws + WS_PQKV), *PS1 = (float*)(ws + WS_PS1), *PS2 = (float*)(ws + WS_PS2), *PS3 = (float*)(ws + WS_PS3), *KMP = (float*)(ws + WS_KMP);
    bf16* O2 = Q2;
    bf16* PO3 = (bf16*)args.out + (size_t)32 * 1024 * 1024;
    const float2* ROPE = (const float2*)(ws + WS_ROPE); unsigned* SEL = (unsigned*)(ws + WS_SEL); float2* PMS = (float2*)(ws + WS_PMS);

    if (IN(0)) REP(0) { p0_prologue(args, lds, vcu, G); SEAM(0); }
    if (IN(1)) REP(1) {
        pg8::Gemm g{XB, (const bf16*)(ws + W_IN), T, 2304, 1024}; pg8::StaticOrder S; S.init(T, 2304, G, bx);
        EpiInProj E{SBQ, CQ, CKV, KR, (const float*)(ws + WS_RSTD0), PQKV, ROPE};
        pg8::gemm_phase<EpiInProj, pg8::StaticOrder, true, true>(lds, g, S, E);
        { const bool half = (G == 256); if (!half || bx >= 128) { __syncthreads(); p0_weights(args, lds, (half ? bx - 128 : bx) * 8 + wave, (half ? 128 : G) * 8, true); } }
        SEAM(1);
    }
    if (IN(2)) REP(2) {
        { pg8::Gemm g{CQ, (const bf16*)(ws + W_UQ), T, 768, 384}; pg8::StaticOrder S; S.init(T, 768, G, bx);
          EpiQUp E{QA, PQKV, ROPE}; pg8::gemm_phase<EpiQUp, pg8::StaticOrder, true, true>(lds, g, S, E); }
        __syncthreads();
        { pg8::Gemm g{CKV, (const bf16*)(ws + W_UKV), T, 1024, 256}; pg8::StaticOrder S; S.init(T, 1024, G, bx);
          EpiKvUp E{KN, PQKV}; pg8::gemm_phase<EpiKvUp, pg8::StaticOrder, true, true>(lds, g, S, E); }
        SEAM(2);
    }
    if (IN(3)) REP(3) {
        REP(17) { volatile LAS int* qslot = (volatile LAS int*)(lds + PHASE_LDS - 64);
          const int x0 = (int)(xb_xcc_id() & 7u);
          for (int j = 0; j < 8; ++j) { const int xx = (x0 + j) & 7; unsigned* qw = ctl + CW_QUEUE + 512 + 64 * xx + 1024 * rep_;
              for (;;) {
                  if (tid == 0) qslot[0] = (int)atomicAdd(qw, 1u);
                  __syncthreads();
                  const int idx = qslot[0];
                  __syncthreads();
                  if (idx >= 128) break;
                  att::mla_unit(2 * xx + (idx & 1), 63 - (idx >> 1), QA, KN, KR, VA, OCAT, lds);
              } } }
        REP(18) { volatile LAS int* qslot = (volatile LAS int*)(lds + PHASE_LDS - 64);
          unsigned* qw = ctl + CW_QUEUE + 192 + 64 * rep_;
          if (tid == 0) qslot[0] = (int)atomicAdd(qw, 1u);
          __syncthreads();
          int uidx = qslot[0];
          __syncthreads();
          while (uidx < 1024) {
              unsigned nx = 0u; if (tid == 0) nx = atomicAdd(qw, 1u);
              att::sb_unit(uidx & 15, 63 - (uidx >> 4), SBQ, SBK, SBV, OCAT, lds);
              if (tid == 0) qslot[0] = (int)nx;
              __syncthreads();
              uidx = qslot[0];
              __syncthreads();
          } }
        SEAM(3);
#if DBG_CHECK & 1
        dbg_check_a(args, lds, ctl, bx, G);
#endif
    }
    if (IN(4)) REP(4) {
        pg8::Gemm g{OCAT, (const bf16*)(ws + W_O0), T, 1024, 1024}; pg8::StaticOrder S; S.init(T, 1024, G, bx);
        EpiRes<true> E{args.in[I_X], X1B, PS1}; pg8::gemm_phase<EpiRes<true>, pg8::StaticOrder, true, true>(lds, g, S, E);
        SEAM(4);
    }
    if (IN(5)) REP(5) {
        pg8::Gemm g{X1B, (const bf16*)(ws + W_GU0), T, 4096, 1024}; pg8::StaticOrder S; S.init(T, 4096, G, bx);
        EpiSwiGLU E{HID, 2048, 16, PS1, nullptr}; pg8::gemm_phase<EpiSwiGLU, pg8::StaticOrder, true, true>(lds, g, S, E);
        SEAM(5);
    }
    if (IN(6)) REP(6) {
        pg8::Gemm g{HID, (const bf16*)(ws + W_DN0), T, 1024, 2048}; pg8::StaticOrder S; S.init(T, 1024, G, bx);
        EpiRes<false> E{X1B, X2B, PS2}; pg8::gemm_phase<EpiRes<false>, pg8::StaticOrder, true, true>(lds, g, S, E);
        SEAM(6);
    }
    if (IN(7)) REP(7) {
        pg8::Gemm g{X2B, (const bf16*)(ws + W_QKV), T, 3072, 1024}; pg8::StaticOrder S; S.init(T, 3072, G, bx);
        EpiQkv E{Q2, PS2, KMP}; pg8::gemm_phase<EpiQkv, pg8::StaticOrder, true, true>(lds, g, S, E);
        SEAM(7);
    }
    if (IN(8)) REP(8) {
        for (int v = vcu; v < 256; v += G) att::moba_gate_unit(v & 31, v >> 5, Q2, KMP, SEL, (unsigned*)(ws + WS_MASK), lds);
        SEAM(8);
    }
    if (IN(9)) REP(9) {
        volatile LAS int* qslot = (volatile LAS int*)(lds + att::MB_OFF_Q);
        if (tid == 0) qslot[0] = (int)atomicAdd(ctl + CW_QUEUE + 64 * rep_, 1u);
        __syncthreads();
        int uidx = qslot[0];
        __syncthreads();
        while (uidx < 64 * 32) {
            unsigned nx = 0u; if (tid == 0) nx = atomicAdd(ctl + CW_QUEUE + 64 * rep_, 1u);
            att::moba_sel_unit(uidx & 31, uidx >> 5, Q2, K2, V2, (const unsigned long long*)(ws + WS_MASK), args.in[I_RELB], (bf16*)(ws + WS_PO0), (bf16*)(ws + WS_PO1), (bf16*)(ws + WS_PO2), PO3, PMS, lds);
            if (tid == 0) qslot[0] = (int)nx;
            __syncthreads();
            uidx = qslot[0];
            __syncthreads();
        }
        SEAM(9);
#if DBG_CHECK & 2
        dbg_check_b(args, lds, ctl, bx, G, O2); GRID_BAR();
#endif
    }
    if (IN(10)) REP(10) {
        att::moba_merge(vcu * 8 + wave, G * 8, SEL, (const bf16*)(ws + WS_PO0), (const bf16*)(ws + WS_PO1), (const bf16*)(ws + WS_PO2), PO3, PMS, O2);
        SEAM(10);
#if DBG_CHECK & 2
        dbg_check_b2(args, lds, ctl, bx, G, O2);
#endif
    }
    if (IN(11)) REP(11) {
        pg8::Gemm g{O2, (const bf16*)(ws + W_O1), T, 1024, 1024}; pg8::StaticOrder S; S.init(T, 1024, G, bx);
        EpiRes<false> E{X2B, X3B, PS3}; pg8::gemm_phase<EpiRes<false>, pg8::StaticOrder, true, true>(lds, g, S, E);
        SEAM(11);
    }
    if (IN(12)) REP(12) {
        { const f32x4* wrt = (const f32x4*)(ws + WS_WRT); f32x4 t_[4];
#pragma unroll
          for (int i = 0; i < 4; ++i) t_[i] = wrt[tid + 512 * i];
#pragma unroll
          for (int i = 0; i < 4; ++i) ((LAS f32x4*)lds)[tid + 512 * i] = t_[i]; }
        __syncthreads();
        for (int ch = bx; ch < 256; ch += G) router_chunk(args, ch, lds);
        SEAM(12);
    }
    if (IN(13)) REP(13) { permute_phase(args, lds, G); SEAM(13); }
    if (IN(14)) REP(14) {
        const int nrt = (int)ctl[CW_NRT];
        pg8::Gemm g{X3B, (const bf16*)(ws + W_EGU), NSLOT, 8192, 1024, (const int*)(ws + WS_STOK)}; MoeOrder S{(const int*)(ws + WS_TILEE), nrt, G, bx};
        EpiSwiGLU E{HIDE, 512, 4, nullptr, (const float*)(ws + WS_SRS)}; pg8::gemm_phase<EpiSwiGLU, MoeOrder, true, true, true>(lds, g, S, E);
        SEAM(14);
    }
    if (IN(15)) REP(15) {
        const int nrt = (int)ctl[CW_NRT];
        pg8::Gemm g{HIDE, (const bf16*)(ws + W_EDN), NSLOT, 8192, 512}; MoeOrder S{(const int*)(ws + WS_TILEE), nrt, G, bx};
        EpiMoeDown E{YP, (const int*)(ws + WS_SDST), (const float*)(ws + WS_SW)}; pg8::gemm_phase<EpiMoeDown, MoeOrder, true, true>(lds, g, S, E);
        SEAM(15);
    }
    if (IN(16)) REP(16) {
        float oscale = 1.f;
#if DBG_CHECK
        oscale = 1.f + 0.25f * (float)__hip_atomic_load(ctl + CW_ERR, __ATOMIC_RELAXED, __HIP_MEMORY_SCOPE_AGENT);
#endif
        final_phase(args, vcu, G, oscale);
#if defined(PROBE_DUP) && ((PROBE_DUP >> 21) & 1)
        if (bx == ((PROBE_DUP >> 22) & 0xFF)) { const unsigned long long t0_ = __builtin_amdgcn_s_memrealtime(); while (__builtin_amdgcn_s_memrealtime() - t0_ < 4ull * prb_wait_) __builtin_amdgcn_s_sleep(8); }
#endif
#if MK_ONE_LAUNCH
        if (bx == 0 && tid == 0) { if (__hip_atomic_load(ctl + CW_BAR + XB_TMO, __ATOMIC_RELAXED, __HIP_MEMORY_SCOPE_AGENT) != 0u) args.out[0] = __builtin_nanf(""); }
#endif
    }
#undef IN
#undef SEAM
}

extern "C" void kernel_launch(void* const* d_in, const int* in_sizes, int n_in, void* d_out, int out_size, void* d_ws, size_t ws_size, hipStream_t stream) {
    static int grid = 0;
    if (grid == 0) {
        if (n_in != 22 || in_sizes[0] != T * DM || out_size != T * DM || ws_size < WS_NEED) { fprintf(stderr, "kernel_launch: unexpected shapes (n_in %d, in0 %d, out %d, ws %zu < %zu); nothing launched\n", n_in, n_in > 0 ? in_sizes[0] : -1, out_size, ws_size, (size_t)WS_NEED); grid = -1; return; }
        int dev = 0, cus = 0, per_cu = 0;
        if (hipGetDevice(&dev) != hipSuccess || hipDeviceGetAttribute(&cus, hipDeviceAttributeMultiprocessorCount, dev) != hipSuccess) { grid = -1; return; }
        if (hipFuncSetAttribute((const void*)hybrid_fwd, hipFuncAttributeMaxDynamicSharedMemorySize, LDS_BYTES) != hipSuccess) { fprintf(stderr, "kernel_launch: hipFuncSetAttribute failed\n"); grid = -1; return; }
        if (hipOccupancyMaxActiveBlocksPerMultiprocessor(&per_cu, (const void*)hybrid_fwd, 512, LDS_BYTES) != hipSuccess || per_cu < 1) fprintf(stderr, "kernel_launch: occupancy query reports %d workgroups per CU\n", per_cu);
        (void)hipGetLastError();
        grid = cus;
    }
    if (grid < 0) return;
    if (hipMemsetAsync((char*)d_ws + WS_CTL, 0, CTL_ZERO_BYTES, stream) != hipSuccess) return;
    Args a{};
    for (int i = 0; i < 22; ++i) a.in[i] = (const float*)d_in[i];
    a.out = (float*)d_out; a.ws = (unsigned char*)d_ws;
#if MK_ONE_LAUNCH
    a.ph_lo = 0; a.ph_hi = NPH;
    hipLaunchKernelGGL(hybrid_fwd, dim3(grid), dim3(512), LDS_BYTES, stream, a);
#else
    for (int p = 0; p < NPH; ++p) { a.ph_lo = p; a.ph_hi = p + 1; hipLaunchKernelGGL(hybrid_fwd, dim3(grid), dim3(512), LDS_BYTES, stream, a); }
#endif
}
```

```cpp
#include <hip/hip_runtime.h>
#include <cstdio>
#include <cstdint>
#ifndef MK_ONE_LAUNCH
#define MK_ONE_LAUNCH 1
#endif
#ifndef PROBE_SEAMS
#define PROBE_SEAMS 0xFFFFF
#endif
#ifndef PROBE_DUP
#define PROBE_DUP 0
#endif
namespace pg8 {
#define PG8_LAS __attribute__((address_space(3)))
typedef unsigned short bf16_t;
typedef short bf16x8 __attribute__((ext_vector_type(8)));
typedef float f32x4 __attribute__((ext_vector_type(4)));
typedef unsigned u32x4 __attribute__((ext_vector_type(4)));
constexpr int BM = 256, BK = 64, HALF = 128, HTB = HALF * BK * 2  , STAGE_BYTES = 8 * HTB, NXCD = 8, WGM = 8;

__host__ __device__ __forceinline__ int lds_byte(int r, int c) { const int st = (r >> 4) * 2 + (c >> 5), rr = r & 15, cc = c & 31, ob = rr * 64 + cc * 2; return st * 1024 + (ob ^ (((ob >> 9) & 1) << 5)); }
__host__ __device__ __forceinline__ void stage_rc(int b, int& R, int& C) { const int st = b / 1024, sb = b % 1024, swz = sb ^ (((sb >> 9) & 1) << 5); R = (st >> 1) * 16 + swz / 64; C = (st & 1) * 32 + (swz % 64) / 2; }
__host__ __device__ __forceinline__ int perm32(int rho) { const int n = rho >> 4, i = rho & 15; return 8 * (i >> 2) + 4 * n + (i & 3); }

struct Unit { int pm, pn; };
struct Gemm { const bf16_t* A; const bf16_t* Bt; int M, N, K; const int* aidx; };

struct StaticOrder {
    int nM, nN, nwg, G, c;
    __host__ __device__ void init(int M, int N, int G_, int c_) { nM = M / BM; nN = N / BM; nwg = nM * nN; G = G_; c = c_; }
    __host__ __device__ bool next(int i, Unit& u) const {
        const long L = (long)i * G + c; if (L >= nwg) return false;
        int wgid = (int)L; { const int q = nwg / NXCD, r = nwg % NXCD, xcd = wgid % NXCD, off = wgid / NXCD; wgid = (xcd < r ? xcd * (q + 1) : r * (q + 1) + (xcd - r) * q) + off; }
        const int nig = WGM * nN, gid = wgid / nig, fm = gid * WGM, gsz = (nM - fm) < WGM ? (nM - fm) : WGM;
        u.pm = fm + ((wgid % nig) % gsz); u.pn = (wgid % nig) / gsz; return true;
    }
    __device__ __forceinline__ void a_ready(const Unit&) const {}
    __device__ __forceinline__ void done(const Unit&) const {}
};

__device__ __forceinline__ unsigned cvt_pk_bf16(float lo, float hi) { unsigned r; asm volatile("v_cvt_pk_bf16_f32 %0, %1, %2" : "=v"(r) : "v"(lo), "v"(hi)); return r; }
typedef float f32x2 __attribute__((ext_vector_type(2)));
template <class Epi, class Sched, bool ALIGN_EPI = false, bool SP2 = false, bool GATHER = false>
__device__ __forceinline__ void gemm_phase(PG8_LAS unsigned char* lds, const Gemm g, const Sched& S, const Epi& E) {
    static_assert(!GATHER || SP2, "the gather A path is wired into the two-super-phase loop only");
    int tid_ = threadIdx.x; asm volatile("" : "+v"(tid_));
    const int tid = tid_, wid = __builtin_amdgcn_readfirstlane(tid >> 6), lane = tid & 63, wr = wid >> 2, wc = wid & 3, fr = lane & 15, fq = lane >> 4;
    const int K = g.K, nt = K / BK;
    unsigned voffA[2], voffB[2];
#pragma unroll
    for (int i = 0; i < 2; ++i) { int R, C; stage_rc(tid * 16 + i * 8192, R, C); const int Rb = Epi::PERM ? ((R & ~31) + perm32(R & 31)) : R;
        voffA[i] = (unsigned)(R * K + C) * 2u; voffB[i] = (unsigned)(Rb * K + C) * 2u; }
    unsigned gA[2][2] = {{0u, 0u}, {0u, 0u}}, gN[2][2] = {{0u, 0u}, {0u, 0u}}; int gR[2] = {0, 0}, gC[2] = {0, 0};
    if constexpr (GATHER) {
#pragma unroll
        for (int i = 0; i < 2; ++i) stage_rc(tid * 16 + i * 8192, gR[i], gC[i]); }
#define PG8_GIDX(dst, pm) do { _Pragma("unroll") for (int _h = 0; _h < 2; ++_h) _Pragma("unroll") for (int _i = 0; _i < 2; ++_i) \
        dst[_h][_i] = (unsigned)(g.aidx[(pm) * BM + _h * HALF + gR[_i]] * K + gC[_i]) * 2u; } while (0)
    const size_t kstep = (size_t)(BK * 2);
    const size_t hstep = (size_t)HALF * K * 2;
    const size_t tstep = 2 * hstep;
    const unsigned ldsw = (unsigned)wid * 1024u;
    const int aoff = lds_byte(wr * 64 + fr, fq * 8), boff = lds_byte(wc * 32 + fr, fq * 8);
#define PG8_SA(b, h) (((b) * 2 + (h)) * HTB)
#define PG8_SB(b, h) ((4 + (b) * 2 + (h)) * HTB)
#define PG8_STAGE(bufoff, gbase, voff) do { _Pragma("unroll") for (int _i = 0; _i < 2; ++_i) \
        __builtin_amdgcn_global_load_lds((const unsigned*)((const char*)(gbase) + (voff)[_i]), (PG8_LAS unsigned*)(lds + (bufoff) + ldsw + _i * 8192), 16, 0, 0); } while (0)
#define PG8_STAGE_A(bufoff, gbase, hh, nx) do { if constexpr (GATHER) { _Pragma("unroll") for (int _i = 0; _i < 2; ++_i) \
        __builtin_amdgcn_global_load_lds((const unsigned*)((const char*)(gbase) + ((nx) ? gN[hh][_i] : gA[hh][_i])), (PG8_LAS unsigned*)(lds + (bufoff) + ldsw + _i * 8192), 16, 0, 0); } \
    else { PG8_STAGE(bufoff, (gbase) + (hh) * hstep, voffA); } } while (0)
#define PG8_LDA(dst, b, h) do { _Pragma("unroll") for (int m = 0; m < 4; ++m) _Pragma("unroll") for (int k = 0; k < 2; ++k) dst[m][k] = *(const PG8_LAS bf16x8*)(lds + PG8_SA(b, h) + aoff + m * 2048 + k * 1024); } while (0)
#define PG8_LDB(dst, b, h) do { _Pragma("unroll") for (int n = 0; n < 2; ++n) _Pragma("unroll") for (int k = 0; k < 2; ++k) dst[n][k] = *(const PG8_LAS bf16x8*)(lds + PG8_SB(b, h) + boff + n * 2048 + k * 1024); } while (0)
#define PG8_MMA(ai, bj, At, Bt) do { __builtin_amdgcn_s_setprio(1); _Pragma("unroll") for (int m = 0; m < 4; ++m) _Pragma("unroll") for (int n = 0; n < 2; ++n) _Pragma("unroll") for (int k = 0; k < 2; ++k) \
        acc[ai][bj][m][n] = __builtin_amdgcn_mfma_f32_16x16x32_bf16(Bt[n][k], At[m][k], acc[ai][bj][m][n], 0, 0, 0); __builtin_amdgcn_s_setprio(0); } while (0)
#define PG8_WAIT_V(n) asm volatile("s_waitcnt vmcnt(" #n ")" ::: "memory")
#define PG8_WAIT_L(n) asm volatile("s_waitcnt lgkmcnt(" #n ")" ::: "memory")
#define PG8_BAR __builtin_amdgcn_s_barrier()
#define PG8_SCHED __builtin_amdgcn_sched_barrier(0)
    Unit cur, nxt; int ui = 0;
    if (!S.next(0, cur)) return;
    f32x4 acc[2][2][4][2];
#pragma unroll
    for (int a = 0; a < 2; ++a)
#pragma unroll
        for (int b = 0; b < 2; ++b)
#pragma unroll
            for (int m = 0; m < 4; ++m)
#pragma unroll
                for (int n = 0; n < 2; ++n) acc[a][b][m][n] = (f32x4){0.f, 0.f, 0.f, 0.f};
    bf16x8 At[4][2], B0[2][2], B1[2][2];
    const char* cA = GATHER ? (const char*)g.A : (const char*)g.A + (size_t)cur.pm * tstep; const char* cB = (const char*)g.Bt + (size_t)cur.pn * tstep;
    if constexpr (GATHER) { PG8_GIDX(gA, cur.pm); }
    S.a_ready(cur);
    if constexpr (SP2) {
        PG8_STAGE(PG8_SB(0, 0), cB, voffB); PG8_STAGE(PG8_SB(0, 1), cB + hstep, voffB); PG8_STAGE_A(PG8_SA(0, 0), cA, 0, false); PG8_STAGE_A(PG8_SA(0, 1), cA, 1, false);
        if (wr == 1) PG8_BAR;
        PG8_WAIT_V(2); PG8_BAR;
        PG8_STAGE(PG8_SB(1, 0), cB + kstep, voffB); PG8_STAGE_A(PG8_SA(1, 0), cA + kstep, 0, false); PG8_STAGE(PG8_SB(1, 1), cB + hstep + kstep, voffB);
        PG8_WAIT_V(6); PG8_BAR;
    } else {
        PG8_STAGE(PG8_SB(0, 0), cB, voffB); PG8_STAGE(PG8_SA(0, 0), cA, voffA); PG8_STAGE(PG8_SB(0, 1), cB + hstep, voffB); PG8_STAGE(PG8_SA(0, 1), cA + hstep, voffA);
        if (wr == 1) PG8_BAR;
        PG8_WAIT_V(4); PG8_BAR;
        PG8_STAGE(PG8_SB(1, 0), cB + kstep, voffB); PG8_STAGE(PG8_SA(1, 0), cA + kstep, voffA); PG8_STAGE(PG8_SB(1, 1), cB + hstep + kstep, voffB);
        PG8_WAIT_V(6); PG8_BAR;
    }
    for (;;) {
        const bool has_next = S.next(ui + 1, nxt);
        const char* nA = GATHER ? (const char*)g.A : (has_next ? (const char*)g.A + (size_t)nxt.pm * tstep : cA); const char* nB = has_next ? (const char*)g.Bt + (size_t)nxt.pn * tstep : cB;
        if constexpr (GATHER) { if (has_next) { PG8_GIDX(gN, nxt.pm); } else { _Pragma("unroll") for (int _h = 0; _h < 2; ++_h) _Pragma("unroll") for (int _i = 0; _i < 2; ++_i) gN[_h][_i] = gA[_h][_i]; } }
#pragma unroll 1
        for (int t = 0; t < nt; t += 2) {
            const bool last = (t == nt - 2);
            const char* a1 = cA + (size_t)(t + 1) * kstep;
            const char* a2 = last ? nA : cA + (size_t)(t + 2) * kstep; const char* b2 = last ? nB : cB + (size_t)(t + 2) * kstep;
            const char* a3 = a2 + kstep; const char* b3 = b2 + kstep;
            if (last && has_next) S.a_ready(nxt);
            if constexpr (SP2) {
            PG8_LDB(B0, 0, 0); PG8_LDB(B1, 0, 1); PG8_SCHED; PG8_LDA(At, 0, 0); PG8_STAGE_A(PG8_SA(1, 1), a1, 1, false);
            PG8_WAIT_V(8); PG8_WAIT_L(0); PG8_BAR; PG8_MMA(0, 0, At, B0); PG8_MMA(0, 1, At, B1); PG8_BAR; PG8_SCHED;
            PG8_LDA(At, 0, 1); PG8_STAGE(PG8_SB(0, 0), b2, voffB); PG8_STAGE(PG8_SB(0, 1), b2 + hstep, voffB); PG8_STAGE_A(PG8_SA(0, 0), a2, 0, last);
            PG8_WAIT_V(8); PG8_WAIT_L(0); PG8_BAR; PG8_MMA(1, 0, At, B0); PG8_MMA(1, 1, At, B1); PG8_BAR; PG8_SCHED;
            PG8_LDB(B0, 1, 0); PG8_LDB(B1, 1, 1); PG8_SCHED; PG8_LDA(At, 1, 0); PG8_STAGE_A(PG8_SA(0, 1), a2, 1, last);
            PG8_WAIT_V(8); PG8_WAIT_L(0); PG8_BAR; PG8_MMA(0, 0, At, B0); PG8_MMA(0, 1, At, B1); PG8_BAR; PG8_SCHED;
            PG8_LDA(At, 1, 1); PG8_STAGE(PG8_SB(1, 0), b3, voffB); PG8_STAGE(PG8_SB(1, 1), b3 + hstep, voffB); PG8_STAGE_A(PG8_SA(1, 0), a3, 0, last);
            PG8_WAIT_V(8); PG8_WAIT_L(0); PG8_BAR; PG8_MMA(1, 0, At, B0); PG8_MMA(1, 1, At, B1); PG8_BAR; PG8_SCHED;
            } else {
            PG8_LDB(B0, 0, 0); PG8_SCHED; PG8_LDA(At, 0, 0); PG8_STAGE(PG8_SA(1, 1), a1 + hstep, voffA);
            PG8_WAIT_L(8); PG8_BAR; PG8_WAIT_L(0); PG8_MMA(0, 0, At, B0); PG8_BAR; PG8_SCHED;
            PG8_LDB(B1, 0, 1); PG8_STAGE(PG8_SB(0, 0), b2, voffB);
            PG8_BAR; PG8_WAIT_L(0); PG8_MMA(0, 1, At, B1); PG8_BAR;
            PG8_LDA(At, 0, 1); PG8_STAGE(PG8_SA(0, 0), a2, voffA);
            PG8_BAR; PG8_WAIT_L(0); PG8_MMA(1, 0, At, B0); PG8_BAR; PG8_SCHED;
            PG8_STAGE(PG8_SB(0, 1), b2 + hstep, voffB);
            PG8_WAIT_V(6); PG8_BAR; PG8_MMA(1, 1, At, B1); PG8_BAR;
            PG8_LDB(B0, 1, 0); PG8_SCHED; PG8_LDA(At, 1, 0); PG8_STAGE(PG8_SA(0, 1), a2 + hstep, voffA);
            PG8_WAIT_L(8); PG8_BAR; PG8_WAIT_L(0); PG8_MMA(0, 0, At, B0); PG8_BAR; PG8_SCHED;
            PG8_LDB(B1, 1, 1); PG8_STAGE(PG8_SB(1, 0), b3, voffB);
            PG8_BAR; PG8_WAIT_L(0); PG8_MMA(0, 1, At, B1); PG8_BAR;
            PG8_LDA(At, 1, 1); PG8_STAGE(PG8_SA(1, 0), a3, voffA);
            PG8_BAR; PG8_WAIT_L(0); PG8_MMA(1, 0, At, B0); PG8_BAR; PG8_SCHED;
            PG8_STAGE(PG8_SB(1, 1), b3 + hstep, voffB);
            PG8_WAIT_V(6); PG8_BAR; PG8_MMA(1, 1, At, B1); PG8_BAR;
            }
        }
        if constexpr (ALIGN_EPI) { if (wr == 0) PG8_BAR; }
        if constexpr (!Epi::AFTER_DRAIN) { E(acc, cur, wr, wc, fr, fq); S.done(cur); }
        if (!has_next) break;
#pragma unroll
        for (int a = 0; a < 2; ++a)
#pragma unroll
            for (int b = 0; b < 2; ++b)
#pragma unroll
                for (int m = 0; m < 4; ++m)
#pragma unroll
                    for (int n = 0; n < 2; ++n) acc[a][b][m][n] = (f32x4){0.f, 0.f, 0.f, 0.f};
        cur = nxt; cA = nA; cB = nB; ++ui;
        if constexpr (GATHER) { _Pragma("unroll") for (int _h = 0; _h < 2; ++_h) _Pragma("unroll") for (int _i = 0; _i < 2; ++_i) gA[_h][_i] = gN[_h][_i]; }
        if constexpr (ALIGN_EPI) { if (wr == 1) PG8_BAR; }
    }
    PG8_WAIT_V(0);
    if constexpr (!ALIGN_EPI) { if (wr == 0) PG8_BAR; }
    PG8_BAR;
    if constexpr (Epi::AFTER_DRAIN) { E.fused(acc, cur, wr, wc, fr, fq, lds, wid, lane); S.done(cur); }
#undef PG8_SA
#undef PG8_SB
#undef PG8_STAGE
#undef PG8_STAGE_A
#undef PG8_GIDX
#undef PG8_LDA
#undef PG8_LDB
#undef PG8_MMA
#undef PG8_WAIT_V
#undef PG8_WAIT_L
#undef PG8_BAR
#undef PG8_SCHED
}
}

#define DI __device__ __forceinline__
#define LAS __attribute__((address_space(3)))
#define GAS __attribute__((address_space(1)))
typedef unsigned short bf16;
constexpr int BATCH = 2, SEQ = 16384, T = BATCH * SEQ, DM = 1024;
constexpr float LOG2E = 1.4426950408889634f;
constexpr float RMS_EPS = 1e-6f;
DI int rfl(int v) { return __builtin_amdgcn_readfirstlane(v); }
DI float bflo(unsigned w) { return __uint_as_float(w << 16); }
DI float bfhi(unsigned w) { return __uint_as_float(w & 0xffff0000u); }
typedef float f32x2_t __attribute__((ext_vector_type(2))); typedef __bf16 bf16x2_t __attribute__((ext_vector_type(2)));
DI unsigned cvtpk(float lo, float hi) { f32x2_t v = {lo, hi}; bf16x2_t b = __builtin_convertvector(v, bf16x2_t); return __builtin_bit_cast(unsigned, b); }
typedef float f32x4 __attribute__((ext_vector_type(4)));
typedef unsigned v4u __attribute__((ext_vector_type(4)));
DI float ex2(float x) { return __builtin_amdgcn_exp2f(x); }
DI float lg2(float x) { return __builtin_amdgcn_logf(x); }
DI float wave_sum(float v) {
#pragma unroll
    for (int o = 1; o < 64; o <<= 1) v += __shfl_xor(v, o);
    return v;
}

namespace att {
typedef short bf16x8 __attribute__((ext_vector_type(8)));
typedef short s16x4 __attribute__((ext_vector_type(4)));
typedef float f32x16 __attribute__((ext_vector_type(16)));
typedef unsigned u32x4 __attribute__((ext_vector_type(4)));
typedef LAS const char* lcp;
typedef short v4i16_t __attribute__((ext_vector_type(4)));
DI int crow(int r, int hi) { return (r & 3) + 8 * (r >> 2) + 4 * hi; }
DI void glds16(const void* gsrc, unsigned lds_dst) { unsigned keep;
    asm volatile("s_mov_b32 %0, m0\n\ts_mov_b32 m0, %2\n\ts_nop 0\n\tglobal_load_lds_dwordx4 %1, off\n\ts_mov_b32 m0, %0" : "=&s"(keep) : "v"(gsrc), "s"(lds_dst) : "memory"); }
#define ATT_WAITV_BAR() asm volatile("s_waitcnt vmcnt(0) lgkmcnt(0)\n\ts_barrier" ::: "memory")
#define ATT_BAR() asm volatile("s_waitcnt lgkmcnt(0)\n\ts_barrier" ::: "memory")
#define WAVE_LDS_SYNC() asm volatile("" ::: "memory")
DI s16x4 vtr(lcp p) { return __builtin_bit_cast(s16x4, __builtin_amdgcn_ds_read_tr16_b64_v4i16((LAS v4i16_t*)p)); }
DI float hmax(float x) { auto rr = __builtin_amdgcn_permlane32_swap(__float_as_uint(x), __float_as_uint(x), false, false); return fmaxf(__uint_as_float(rr[0]), __uint_as_float(rr[1])); }
DI float hsum(float x) { auto rr = __builtin_amdgcn_permlane32_swap(__float_as_uint(x), __float_as_uint(x), false, false); return __uint_as_float(rr[0]) + __uint_as_float(rr[1]); }

template <int NK> DI void qk_tile(f32x16& p0, f32x16& p1, lcp kfr, const bf16x8* qr) {
    f32x16 z;
#pragma unroll
    for (int r = 0; r < 16; ++r) z[r] = 0.f;
    p0 = z; p1 = z;
    bf16x8 kf[2 * NK];
#pragma unroll
    for (int d0 = 0; d0 < NK; ++d0) { kf[2 * d0] = *(const LAS bf16x8*)(kfr + d0 * 2048); kf[2 * d0 + 1] = *(const LAS bf16x8*)(kfr + d0 * 2048 + 512); }
    __builtin_amdgcn_sched_barrier(0);
#pragma unroll
    for (int d0 = 0; d0 < NK; ++d0) { p0 = __builtin_amdgcn_mfma_f32_32x32x16_bf16(kf[2 * d0], qr[d0], p0, 0, 0, 0); p1 = __builtin_amdgcn_mfma_f32_32x32x16_bf16(kf[2 * d0 + 1], qr[d0], p1, 0, 0, 0); }
    __builtin_amdgcn_sched_barrier(0);
}
DI void pv_tile(f32x16* o, lcp vfr, const f32x16& p0, const f32x16& p1) {
    u32x4 pw[4];
    pw[0] = (u32x4){cvtpk(p0[0], p0[1]), cvtpk(p0[2], p0[3]), cvtpk(p0[4], p0[5]), cvtpk(p0[6], p0[7])};
    pw[1] = (u32x4){cvtpk(p0[8], p0[9]), cvtpk(p0[10], p0[11]), cvtpk(p0[12], p0[13]), cvtpk(p0[14], p0[15])};
    pw[2] = (u32x4){cvtpk(p1[0], p1[1]), cvtpk(p1[2], p1[3]), cvtpk(p1[4], p1[5]), cvtpk(p1[6], p1[7])};
    pw[3] = (u32x4){cvtpk(p1[8], p1[9]), cvtpk(p1[10], p1[11]), cvtpk(p1[12], p1[13]), cvtpk(p1[14], p1[15])};
#pragma unroll
    for (int d0 = 0; d0 < 2; ++d0) {
        s16x4 lo[4], hh[4];
#pragma unroll
        for (int ks = 0; ks < 4; ++ks) { lo[ks] = vtr(vfr + d0 * 4096 + ks * 1024); hh[ks] = vtr(vfr + d0 * 4096 + ks * 1024 + 512); }
        __builtin_amdgcn_sched_barrier(0);
#pragma unroll
        for (int ks = 0; ks < 4; ++ks) { const bf16x8 vf = (bf16x8){lo[ks][0], lo[ks][1], lo[ks][2], lo[ks][3], hh[ks][0], hh[ks][1], hh[ks][2], hh[ks][3]};
            o[d0] = __builtin_amdgcn_mfma_f32_32x32x16_bf16(__builtin_bit_cast(bf16x8, pw[ks]), vf, o[d0], 0, 0, 0); }
        __builtin_amdgcn_sched_barrier(0);
    }
}
DI void smax_update(f32x16& p0, f32x16& p1, float& mref, float& lsum, f32x16* o, LAS float* wsf, int r32, int hi) {
    float rm = fmaxf(p0[0], p1[0]);
#pragma unroll
    for (int r = 1; r < 16; ++r) rm = fmaxf(rm, fmaxf(p0[r], p1[r]));
    rm = hmax(rm);
    if (__any(rm > mref + 8.f)) {
        const float mnew = fmaxf(mref, rm);
        const float alpha = (mnew == mref) ? 1.f : ex2(mref - mnew);
        lsum *= alpha; mref = mnew;
        if (hi == 0) wsf[r32] = alpha;
        WAVE_LDS_SYNC();
#pragma unroll
        for (int r = 0; r < 16; ++r) { const float a = wsf[crow(r, hi)]; o[0][r] *= a; o[1][r] *= a; }
        WAVE_LDS_SYNC();
    }
    float s = 0.f;
#pragma unroll
    for (int r = 0; r < 16; ++r) { p0[r] = ex2(p0[r] - mref); p1[r] = ex2(p1[r] - mref); s += p0[r] + p1[r]; }
    lsum += s;
}
DI void stage_o(const f32x16* o, LAS bf16* stg, const LAS float* rowscale, int r32, int hi) {
    WAVE_LDS_SYNC();
#pragma unroll
    for (int r = 0; r < 16; ++r) { const int orow = crow(r, hi); const float sc = rowscale ? rowscale[orow] : 1.f;
        const unsigned a = cvtpk(o[0][r] * sc, o[1][r] * sc);
        stg[orow * 64 + r32] = (bf16)(a & 0xffffu); stg[orow * 64 + 32 + r32] = (bf16)(a >> 16); }
    WAVE_LDS_SYNC();
}

constexpr int MLA_KSLOT = 12288, VSLOT = 8192;
constexpr int MLA_OFF_V = 3 * MLA_KSLOT, MLA_OFF_WS = MLA_OFF_V + 3 * VSLOT, MLA_OFF_ST = MLA_OFF_WS + 8 * 256, MLA_LDS = MLA_OFF_ST + 8 * 4096;
template <int NK> DI void qk_tile_ref(f32x16& p0, f32x16& p1, lcp kfr, const bf16x8* qr, const f32x16& negm) {
    p0 = negm; p1 = negm;
    constexpr int H = NK / 2;
#pragma unroll
    for (int hb = 0; hb < 2; ++hb) {
        bf16x8 kf[2 * H];
#pragma unroll
        for (int d = 0; d < H; ++d) { const int d0 = hb * H + d; kf[2 * d] = *(const LAS bf16x8*)(kfr + d0 * 2048); kf[2 * d + 1] = *(const LAS bf16x8*)(kfr + d0 * 2048 + 512); }
        __builtin_amdgcn_sched_barrier(0);
#pragma unroll
        for (int d = 0; d < H; ++d) { const int d0 = hb * H + d; p0 = __builtin_amdgcn_mfma_f32_32x32x16_bf16(kf[2 * d], qr[d0], p0, 0, 0, 0); p1 = __builtin_amdgcn_mfma_f32_32x32x16_bf16(kf[2 * d + 1], qr[d0], p1, 0, 0, 0); }
        __builtin_amdgcn_sched_barrier(0);
    }
}
DI void smax_update_ref(f32x16& p0, f32x16& p1, float& mref, f32x16& negm, float& lsum, f32x16* o, LAS float* wsf, int r32, int hi, bool first) {
    float ra = __builtin_fmaxf(__builtin_fmaxf(p0[0], p0[1]), p1[0]), rb = __builtin_fmaxf(__builtin_fmaxf(p0[2], p0[3]), p1[1]);
    ra = __builtin_fmaxf(__builtin_fmaxf(ra, p1[2]), p1[3]);
#pragma unroll
    for (int r = 4; r < 16; r += 4) { ra = __builtin_fmaxf(__builtin_fmaxf(ra, p0[r]), p0[r + 1]); rb = __builtin_fmaxf(__builtin_fmaxf(rb, p0[r + 2]), p0[r + 3]);
        ra = __builtin_fmaxf(__builtin_fmaxf(ra, p1[r]), p1[r + 1]); rb = __builtin_fmaxf(__builtin_fmaxf(rb, p1[r + 2]), p1[r + 3]); }
    const float rm = hmax(fmaxf(ra, rb));
    if (first || __any(rm > 8.f)) {
        const float dl = first ? rm : fmaxf(rm, 0.f);
        mref += dl;
#pragma unroll
        for (int r = 0; r < 16; ++r) { p0[r] -= dl; p1[r] -= dl; }
#pragma unroll
        for (int r = 0; r < 16; ++r) negm[r] = -mref;
        if (!first) { const float alpha = ex2(-dl); lsum *= alpha;
            if (hi == 0) wsf[r32] = alpha;
            WAVE_LDS_SYNC();
#pragma unroll
            for (int r = 0; r < 16; ++r) { const float a = wsf[crow(r, hi)]; o[0][r] *= a; o[1][r] *= a; }
            WAVE_LDS_SYNC(); }
    }
    float s = 0.f;
#pragma unroll
    for (int r = 0; r < 16; ++r) { p0[r] = ex2(p0[r]); p1[r] = ex2(p1[r]); s += p0[r] + p1[r]; }
    lsum += s;
}
DI void mla_unit(int bh, int qb, const bf16* QA, const bf16* KN, const bf16* KR, const bf16* VA, bf16* OC, LAS unsigned char* lds) {
    int tid_ = threadIdx.x; asm volatile("" : "+v"(tid_));
    const int tid = tid_, lane = tid & 63, r32 = lane & 31, hi = lane >> 5, wid = rfl(tid >> 6);
    const int b = bh >> 3, h = bh & 7; const long rowbase = (long)b * SEQ; const int q0 = qb * 256;
    const unsigned lds0 = (unsigned)(size_t)lds;
    LAS float* wsf = (LAS float*)(lds + MLA_OFF_WS) + wid * 64;
    LAS bf16* stg = (LAS bf16*)(lds + MLA_OFF_ST) + wid * 2048;
    const bf16* ksrc = KN + (rowbase + lane) * 512 + h * 64 + wid * 8;
    const bf16* rsrc = KR + (rowbase + lane) * 32 + (wid & 3) * 8;
    const bf16* vsrc = VA + (rowbase + 16 * (wid & 3) + (lane >> 2)) * 512 + h * 64 + (wid >> 2) * 32 + (lane & 3) * 8;
#define MLA_DMA_K(t, s) do { glds16(ksrc + (long)(t) * 64 * 512, (unsigned)rfl((int)(lds0 + (s) * MLA_KSLOT + wid * 1024))); \
        if (wid < 4) glds16(rsrc + (long)(t) * 64 * 32, (unsigned)rfl((int)(lds0 + (s) * MLA_KSLOT + (8 + wid) * 1024))); } while (0)
#define MLA_DMA_V(t, s) glds16(vsrc + (long)(t) * 64 * 512, (unsigned)rfl((int)(lds0 + MLA_OFF_V + (s) * VSLOT + wid * 1024)))
    const bf16* qp = QA + (rowbase + q0 + wid * 32 + r32) * 768 + h * 96 + hi * 8;
    bf16x8 qr[6];
#pragma unroll
    for (int d0 = 0; d0 < 6; ++d0) qr[d0] = *(const bf16x8*)(qp + d0 * 16);
    const int NT = 4 * (qb + 1);
    const lcp kfr = (lcp)lds + hi * 1024 + r32 * 16;
    const lcp vfr = (lcp)lds + MLA_OFF_V + ((lane >> 4) & 1) * 32 + (lane & 3) * 8 + (4 * hi + ((lane & 15) >> 2)) * 64;
    float mref = 0.f, lsum = 0.f; f32x16 o[2], negm;
#pragma unroll
    for (int r = 0; r < 16; ++r) { o[0][r] = 0.f; o[1][r] = 0.f; negm[r] = 0.f; }
    const int qrel = 32 * wid + r32;
#define MLA_MASK(P0, P1, t) do { const int jb_ = (t) - (NT - 4); if (jb_ >= 0 && 64 * jb_ + 63 > 32 * wid) { \
        _Pragma("unroll") for (int r = 0; r < 16; ++r) { const int kv = 64 * jb_ + crow(r, hi); if (kv > qrel) P0[r] = -INFINITY; if (kv + 32 > qrel) P1[r] = -INFINITY; } } } while (0)
#define MLA_ROWMAX(P0, P1, rm) do { float ra_ = __builtin_fmaxf(__builtin_fmaxf(P0[0], P0[1]), P1[0]), rb_ = __builtin_fmaxf(__builtin_fmaxf(P0[2], P0[3]), P1[1]); ra_ = __builtin_fmaxf(__builtin_fmaxf(ra_, P1[2]), P1[3]); \
        _Pragma("unroll") for (int r = 4; r < 16; r += 4) { ra_ = __builtin_fmaxf(__builtin_fmaxf(ra_, P0[r]), P0[r + 1]); rb_ = __builtin_fmaxf(__builtin_fmaxf(rb_, P0[r + 2]), P0[r + 3]); \
            ra_ = __builtin_fmaxf(__builtin_fmaxf(ra_, P1[r]), P1[r + 1]); rb_ = __builtin_fmaxf(__builtin_fmaxf(rb_, P1[r + 2]), P1[r + 3]); } rm = hmax(fmaxf(ra_, rb_)); } while (0)
    MLA_DMA_K(0, 0); MLA_DMA_V(0, 0); MLA_DMA_K(1, 1);
    ATT_WAITV_BAR();
    MLA_DMA_K(2, 2); MLA_DMA_V(1, 1);
    f32x16 pa0, pa1, pb0, pb1;
    qk_tile_ref<6>(pa0, pa1, kfr, qr, negm); MLA_MASK(pa0, pa1, 0);
    { float rm; MLA_ROWMAX(pa0, pa1, rm); mref = rm;
#pragma unroll
      for (int r = 0; r < 16; ++r) { pa0[r] = ex2(pa0[r] - rm); pa1[r] = ex2(pa1[r] - rm); negm[r] = -rm; } }
    int kc = 1, kn = 2, kf_ = 0, vc = 0, vn = 1, vf_ = 2;
#define MLA_KLD(i) kf_##i = *(const LAS bf16x8*)(kb_ + ((i) >> 1) * 2048 + ((i) & 1) * 512)
#define MLA_VLD(i) do { vl_[i] = vtr(vb_ + ((i) >> 2) * 4096 + ((i) & 3) * 1024); vh_[i] = vtr(vb_ + ((i) >> 2) * 4096 + ((i) & 3) * 1024 + 512); } while (0)
#define MLA_PIN(x) asm volatile("" : "+v"(x))
#define MLA_STEP(C0, C1, P0, P1, t) do { \
        ATT_WAITV_BAR();                                               \
        if ((t) + 2 < NT) MLA_DMA_K((t) + 2, kf_); \
        if ((t) + 1 < NT) MLA_DMA_V((t) + 1, vf_); \
          \
        const lcp kb_ = kfr + kc * MLA_KSLOT; const lcp vb_ = vfr + vc * VSLOT; \
        bf16x8 kf_0, kf_1, kf_2, kf_3, kf_4, kf_5, kf_6, kf_7, kf_8, kf_9, kf_10, kf_11; s16x4 vl_[8], vh_[8]; u32x4 pw_[4]; float sacc_ = 0.f; \
        MLA_KLD(0); MLA_KLD(1); MLA_KLD(2); MLA_KLD(3); \
        MLA_KLD(4); C0 = __builtin_amdgcn_mfma_f32_32x32x16_bf16(kf_0, qr[0], negm, 0, 0, 0); sacc_ += P0[0]; sacc_ += P0[1]; sacc_ += P0[2]; MLA_PIN(sacc_); pw_[0][0] = cvtpk(P0[0], P0[1]); MLA_PIN(pw_[0]); __builtin_amdgcn_sched_barrier(0); \
        MLA_KLD(5); C1 = __builtin_amdgcn_mfma_f32_32x32x16_bf16(kf_1, qr[0], negm, 0, 0, 0); sacc_ += P0[3]; sacc_ += P0[4]; sacc_ += P0[5]; MLA_PIN(sacc_); pw_[0][1] = cvtpk(P0[2], P0[3]); MLA_PIN(pw_[0]); __builtin_amdgcn_sched_barrier(0); \
        MLA_KLD(6); C0 = __builtin_amdgcn_mfma_f32_32x32x16_bf16(kf_2, qr[1], C0, 0, 0, 0); sacc_ += P0[6]; sacc_ += P0[7]; sacc_ += P0[8]; MLA_PIN(sacc_); pw_[0][2] = cvtpk(P0[4], P0[5]); MLA_PIN(pw_[0]); __builtin_amdgcn_sched_barrier(0); \
        MLA_KLD(7); C1 = __builtin_amdgcn_mfma_f32_32x32x16_bf16(kf_3, qr[1], C1, 0, 0, 0); sacc_ += P0[9]; sacc_ += P0[10]; sacc_ += P0[11]; MLA_PIN(sacc_); pw_[0][3] = cvtpk(P0[6], P0[7]); MLA_PIN(pw_[0]); __builtin_amdgcn_sched_barrier(0); \
        MLA_KLD(8); MLA_VLD(0); C0 = __builtin_amdgcn_mfma_f32_32x32x16_bf16(kf_4, qr[2], C0, 0, 0, 0); sacc_ += P0[12]; sacc_ += P0[13]; sacc_ += P0[14]; MLA_PIN(sacc_); pw_[1][0] = cvtpk(P0[8], P0[9]); MLA_PIN(pw_[1]); pw_[1][1] = cvtpk(P0[10], P0[11]); MLA_PIN(pw_[1]); __builtin_amdgcn_sched_barrier(0); \
        MLA_KLD(9); MLA_VLD(1); C1 = __builtin_amdgcn_mfma_f32_32x32x16_bf16(kf_5, qr[2], C1, 0, 0, 0); sacc_ += P0[15]; sacc_ += P1[0]; sacc_ += P1[1]; MLA_PIN(sacc_); pw_[1][2] = cvtpk(P0[12], P0[13]); MLA_PIN(pw_[1]); pw_[1][3] = cvtpk(P0[14], P0[15]); MLA_PIN(pw_[1]); __builtin_amdgcn_sched_barrier(0); \
        MLA_KLD(10); MLA_VLD(2); C0 = __builtin_amdgcn_mfma_f32_32x32x16_bf16(kf_6, qr[3], C0, 0, 0, 0); sacc_ += P1[2]; sacc_ += P1[3]; sacc_ += P1[4]; MLA_PIN(sacc_); pw_[2][0] = cvtpk(P1[0], P1[1]); MLA_PIN(pw_[2]); pw_[2][1] = cvtpk(P1[2], P1[3]); MLA_PIN(pw_[2]); __builtin_amdgcn_sched_barrier(0); \
        MLA_KLD(11); MLA_VLD(3); C1 = __builtin_amdgcn_mfma_f32_32x32x16_bf16(kf_7, qr[3], C1, 0, 0, 0); sacc_ += P1[5]; sacc_ += P1[6]; sacc_ += P1[7]; MLA_PIN(sacc_); pw_[2][2] = cvtpk(P1[4], P1[5]); MLA_PIN(pw_[2]); pw_[2][3] = cvtpk(P1[6], P1[7]); MLA_PIN(pw_[2]); __builtin_amdgcn_sched_barrier(0); \
        MLA_VLD(4); C0 = __builtin_amdgcn_mfma_f32_32x32x16_bf16(kf_8, qr[4], C0, 0, 0, 0); sacc_ += P1[8]; sacc_ += P1[9]; MLA_PIN(sacc_); pw_[3][0] = cvtpk(P1[8], P1[9]); MLA_PIN(pw_[3]); __builtin_amdgcn_sched_barrier(0); \
        MLA_VLD(5); C1 = __builtin_amdgcn_mfma_f32_32x32x16_bf16(kf_9, qr[4], C1, 0, 0, 0); sacc_ += P1[10]; sacc_ += P1[11]; MLA_PIN(sacc_); pw_[3][1] = cvtpk(P1[10], P1[11]); MLA_PIN(pw_[3]); __builtin_amdgcn_sched_barrier(0); \
        MLA_VLD(6); C0 = __builtin_amdgcn_mfma_f32_32x32x16_bf16(kf_10, qr[5], C0, 0, 0, 0); sacc_ += P1[12]; sacc_ += P1[13]; MLA_PIN(sacc_); pw_[3][2] = cvtpk(P1[12], P1[13]); MLA_PIN(pw_[3]); __builtin_amdgcn_sched_barrier(0); \
        MLA_VLD(7); C1 = __builtin_amdgcn_mfma_f32_32x32x16_bf16(kf_11, qr[5], C1, 0, 0, 0); sacc_ += P1[14]; sacc_ += P1[15]; MLA_PIN(sacc_); pw_[3][3] = cvtpk(P1[14], P1[15]); MLA_PIN(pw_[3]); __builtin_amdgcn_sched_barrier(0); \
        lsum += sacc_; \
          \
        __builtin_amdgcn_sched_barrier(0); \
        o[0] = __builtin_amdgcn_mfma_f32_32x32x16_bf16(__builtin_bit_cast(bf16x8, pw_[0]), (bf16x8){vl_[0][0], vl_[0][1], vl_[0][2], vl_[0][3], vh_[0][0], vh_[0][1], vh_[0][2], vh_[0][3]}, o[0], 0, 0, 0); o[1] = __builtin_amdgcn_mfma_f32_32x32x16_bf16(__builtin_bit_cast(bf16x8, pw_[0]), (bf16x8){vl_[4][0], vl_[4][1], vl_[4][2], vl_[4][3], vh_[4][0], vh_[4][1], vh_[4][2], vh_[4][3]}, o[1], 0, 0, 0); \
        MLA_MASK(C0, C1, t); \
        float rm_; MLA_ROWMAX(C0, C1, rm_); \
        bool resc_ = false; float alpha_ = 1.f; \
        if (__any(rm_ > 8.f)) { const float dl = fmaxf(rm_, 0.f); mref += dl; alpha_ = ex2(-dl); lsum *= alpha_; resc_ = true; \
            _Pragma("unroll") for (int r = 0; r < 16; ++r) { C0[r] -= dl; C1[r] -= dl; negm[r] = -mref; } } \
          \
        __builtin_amdgcn_sched_barrier(0); \
        o[0] = __builtin_amdgcn_mfma_f32_32x32x16_bf16(__builtin_bit_cast(bf16x8, pw_[1]), (bf16x8){vl_[1][0], vl_[1][1], vl_[1][2], vl_[1][3], vh_[1][0], vh_[1][1], vh_[1][2], vh_[1][3]}, o[0], 0, 0, 0); C0[0] = ex2(C0[0]); C0[1] = ex2(C0[1]); C0[2] = ex2(C0[2]); C0[3] = ex2(C0[3]); C0[4] = ex2(C0[4]); MLA_PIN(C0); MLA_PIN(C1); __builtin_amdgcn_sched_barrier(0); \
        o[1] = __builtin_amdgcn_mfma_f32_32x32x16_bf16(__builtin_bit_cast(bf16x8, pw_[1]), (bf16x8){vl_[5][0], vl_[5][1], vl_[5][2], vl_[5][3], vh_[5][0], vh_[5][1], vh_[5][2], vh_[5][3]}, o[1], 0, 0, 0); C0[5] = ex2(C0[5]); C0[6] = ex2(C0[6]); C0[7] = ex2(C0[7]); C0[8] = ex2(C0[8]); C0[9] = ex2(C0[9]); MLA_PIN(C0); MLA_PIN(C1); __builtin_amdgcn_sched_barrier(0); \
        o[0] = __builtin_amdgcn_mfma_f32_32x32x16_bf16(__builtin_bit_cast(bf16x8, pw_[2]), (bf16x8){vl_[2][0], vl_[2][1], vl_[2][2], vl_[2][3], vh_[2][0], vh_[2][1], vh_[2][2], vh_[2][3]}, o[0], 0, 0, 0); C0[10] = ex2(C0[10]); C0[11] = ex2(C0[11]); C0[12] = ex2(C0[12]); C0[13] = ex2(C0[13]); C0[14] = ex2(C0[14]); MLA_PIN(C0); MLA_PIN(C1); __builtin_amdgcn_sched_barrier(0); \
        o[1] = __builtin_amdgcn_mfma_f32_32x32x16_bf16(__builtin_bit_cast(bf16x8, pw_[2]), (bf16x8){vl_[6][0], vl_[6][1], vl_[6][2], vl_[6][3], vh_[6][0], vh_[6][1], vh_[6][2], vh_[6][3]}, o[1], 0, 0, 0); C0[15] = ex2(C0[15]); C1[0] = ex2(C1[0]); C1[1] = ex2(C1[1]); C1[2] = ex2(C1[2]); C1[3] = ex2(C1[3]); MLA_PIN(C0); MLA_PIN(C1); __builtin_amdgcn_sched_barrier(0); \
        o[0] = __builtin_amdgcn_mfma_f32_32x32x16_bf16(__builtin_bit_cast(bf16x8, pw_[3]), (bf16x8){vl_[3][0], vl_[3][1], vl_[3][2], vl_[3][3], vh_[3][0], vh_[3][1], vh_[3][2], vh_[3][3]}, o[0], 0, 0, 0); C1[4] = ex2(C1[4]); C1[5] = ex2(C1[5]); C1[6] = ex2(C1[6]); C1[7] = ex2(C1[7]); C1[8] = ex2(C1[8]); MLA_PIN(C0); MLA_PIN(C1); __builtin_amdgcn_sched_barrier(0); \
        o[1] = __builtin_amdgcn_mfma_f32_32x32x16_bf16(__builtin_bit_cast(bf16x8, pw_[3]), (bf16x8){vl_[7][0], vl_[7][1], vl_[7][2], vl_[7][3], vh_[7][0], vh_[7][1], vh_[7][2], vh_[7][3]}, o[1], 0, 0, 0); C1[9] = ex2(C1[9]); C1[10] = ex2(C1[10]); C1[11] = ex2(C1[11]); C1[12] = ex2(C1[12]); C1[13] = ex2(C1[13]); MLA_PIN(C0); MLA_PIN(C1); __builtin_amdgcn_sched_barrier(0); \
        C1[14] = ex2(C1[14]); C1[15] = ex2(C1[15]); \
        if (resc_) { if (hi == 0) wsf[r32] = alpha_; WAVE_LDS_SYNC(); \
            _Pragma("unroll") for (int r = 0; r < 16; ++r) { const float a = wsf[crow(r, hi)]; o[0][r] *= a; o[1][r] *= a; } WAVE_LDS_SYNC(); } \
        { const int t_ = kc; kc = kn; kn = kf_; kf_ = t_; } { const int t_ = vc; vc = vn; vn = vf_; vf_ = t_; } } while (0)
    for (int t = 1; t + 1 < NT; t += 2) { MLA_STEP(pb0, pb1, pa0, pa1, t); MLA_STEP(pa0, pa1, pb0, pb1, t + 1); }
    MLA_STEP(pb0, pb1, pa0, pa1, NT - 1);
    { float s_ = 0.f;
#pragma unroll
      for (int r = 0; r < 16; ++r) s_ += pb0[r] + pb1[r];
      lsum += s_; ATT_WAITV_BAR(); pv_tile(o, vfr + vc * VSLOT, pb0, pb1); }
#undef MLA_STEP
#undef MLA_KLD
#undef MLA_VLD
#undef MLA_PIN
#undef MLA_ROWMAX
#undef MLA_MASK
#undef MLA_DMA_K
#undef MLA_DMA_V
    lsum = hsum(lsum);
    if (hi == 0) wsf[32 + r32] = __builtin_amdgcn_rcpf(lsum);
    stage_o(o, stg, wsf + 32, r32, hi);
    bf16* Ow = OC + (rowbase + q0 + wid * 32) * 1024 + h * 64;
#pragma unroll
    for (int i = 0; i < 4; ++i) { const int row = i * 8 + (lane >> 3), ch = lane & 7; const u32x4 v = *(const LAS u32x4*)(stg + row * 64 + ch * 8); *(u32x4*)(Ow + (long)row * 1024 + ch * 8) = v; }
    ATT_WAITV_BAR();
}

constexpr int SB_KSLOT = 8192, SB_OFF_V = 2 * SB_KSLOT, SB_OFF_WS = SB_OFF_V + 2 * VSLOT, SB_OFF_ST = SB_OFF_WS + 8 * 256, SB_OFF_FL = SB_OFF_ST + 8 * 4096, SB_LDS = SB_OFF_FL + 64;
DI void sb_unit(int bh, int qb, const bf16* Q, const bf16* K, const bf16* V, bf16* OC, LAS unsigned char* lds) {
    int tid_ = threadIdx.x; asm volatile("" : "+v"(tid_));
    const int tid = tid_, lane = tid & 63, r32 = lane & 31, hi = lane >> 5, wid = rfl(tid >> 6);
    const int b = bh >> 3, h = bh & 7; const long rowbase = (long)b * SEQ; const int q0 = qb * 256;
    const unsigned lds0 = (unsigned)(size_t)lds;
    LAS bf16* stg = (LAS bf16*)(lds + SB_OFF_ST) + wid * 2048;
    volatile LAS unsigned* fl = (volatile LAS unsigned*)(lds + SB_OFF_FL);
    const bf16* ksrc = K + (rowbase + lane) * 512 + h * 64 + wid * 8;
    const bf16* vsrc = V + (rowbase + 16 * (wid & 3) + (lane >> 2)) * 512 + h * 64 + (wid >> 2) * 32 + (lane & 3) * 8;
#define SB_DMA(t, s) do { glds16(ksrc + (long)(t) * 64 * 512, (unsigned)rfl((int)(lds0 + (s) * SB_KSLOT + wid * 1024))); \
        glds16(vsrc + (long)(t) * 64 * 512, (unsigned)rfl((int)(lds0 + SB_OFF_V + (s) * VSLOT + wid * 1024))); } while (0)
    const bf16* qp = Q + (rowbase + q0 + wid * 32 + r32) * 512 + h * 64 + hi * 8;
    bf16x8 qr[4];
#pragma unroll
    for (int d0 = 0; d0 < 4; ++d0) qr[d0] = *(const bf16x8*)(qp + d0 * 16);
    const int NT = 4 * (qb + 1);
    const lcp kfr = (lcp)lds + hi * 1024 + r32 * 16;
    const lcp vfr = (lcp)lds + SB_OFF_V + ((lane >> 4) & 1) * 32 + (lane & 3) * 8 + (4 * hi + ((lane & 15) >> 2)) * 64;
    float carry = 1.f; f32x16 o[2];
#pragma unroll
    for (int r = 0; r < 16; ++r) { o[0][r] = 0.f; o[1][r] = 0.f; }
    if (tid == 0) { fl[0] = 0u; fl[1] = 0u; fl[2] = 0u; }
    SB_DMA(NT - 1, 0);
    for (int i = 0; i < NT; ++i) {
        const int t = NT - 1 - i;
        ATT_WAITV_BAR();
        if (i > 0 && fl[(i - 1) % 3] == 0u) break;
        if (tid == 0) fl[(i + 1) % 3] = 0u;
        const int s = i & 1;
        if (t > 0) SB_DMA(t - 1, s ^ 1);
        const int jb = t - (NT - 4), qlo = 32 * wid;
        const bool skip = (jb >= 0 && 64 * jb >= qlo + 31);
        const bool dead = __all(carry == 0.f) != 0;
        if (!skip && !dead) {
            f32x16 p0, p1; qk_tile<4>(p0, p1, kfr + s * SB_KSLOT, qr);
            f32x16 f0, f1;
#pragma unroll
            for (int r = 0; r < 16; ++r) {
                { const float y = p0[r], e = ex2(-fabsf(y)), rr = __builtin_amdgcn_rcpf(1.f + e), er = e * rr; const bool pos = y >= 0.f; p0[r] = pos ? rr : er; f0[r] = pos ? er : rr; }
                { const float y = p1[r], e = ex2(-fabsf(y)), rr = __builtin_amdgcn_rcpf(1.f + e), er = e * rr; const bool pos = y >= 0.f; p1[r] = pos ? rr : er; f1[r] = pos ? er : rr; }
            }
            if (jb >= 0 && 64 * jb + 63 >= qlo) { const int qrel = qlo + r32;
#pragma unroll
                for (int r = 0; r < 16; ++r) { const int kv = 64 * jb + crow(r, hi);
                    if (kv >= qrel) { f0[r] = 1.f; p0[r] = 0.f; } if (kv + 32 >= qrel) { f1[r] = 1.f; p1[r] = 0.f; } } }
            float mine[8], oth[8], ps[8];
#pragma unroll
            for (int g = 0; g < 4; ++g) {
                { const float a0 = f0[4 * g], a1 = f0[4 * g + 1], a2 = f0[4 * g + 2], a3 = f0[4 * g + 3]; const float e1 = a3 * a2, e0 = e1 * a1;
                  f0[4 * g + 3] = 1.f; f0[4 * g + 2] = a3; f0[4 * g + 1] = e1; f0[4 * g] = e0; mine[g] = e0 * a0; }
                { const float a0 = f1[4 * g], a1 = f1[4 * g + 1], a2 = f1[4 * g + 2], a3 = f1[4 * g + 3]; const float e1 = a3 * a2, e0 = e1 * a1;
                  f1[4 * g + 3] = 1.f; f1[4 * g + 2] = a3; f1[4 * g + 1] = e1; f1[4 * g] = e0; mine[4 + g] = e0 * a0; }
            }
#pragma unroll
            for (int g = 0; g < 8; ++g) { auto rr = __builtin_amdgcn_permlane32_swap(__float_as_uint(mine[g]), __float_as_uint(mine[g]), false, false);
                const float x0 = __uint_as_float(rr[0]), x1 = __uint_as_float(rr[1]); oth[g] = hi ? x0 : x1; ps[g] = x0 * x1; }
            float sp = 1.f; float off[8];
#pragma unroll
            for (int g = 7; g >= 0; --g) { off[g] = sp * (hi ? 1.f : oth[g]) * carry; sp *= ps[g]; }
#pragma unroll
            for (int g = 0; g < 4; ++g)
#pragma unroll
                for (int j = 0; j < 4; ++j) { p0[4 * g + j] = p0[4 * g + j] * f0[4 * g + j] * off[g]; p1[4 * g + j] = p1[4 * g + j] * f1[4 * g + j] * off[4 + g]; }
            carry *= sp;
            pv_tile(o, vfr + s * VSLOT, p0, p1);
        }
        if (t > 0 && __any(carry != 0.f) && lane == 0) fl[i % 3] = 1u;
    }
#undef SB_DMA
    ATT_WAITV_BAR();
    stage_o(o, stg, nullptr, r32, hi);
    bf16* Ow = OC + (rowbase + q0 + wid * 32) * 1024 + 512 + h * 64;
#pragma unroll
    for (int i = 0; i < 4; ++i) { const int row = i * 8 + (lane >> 3), ch = lane & 7; const u32x4 v = *(const LAS u32x4*)(stg + row * 64 + ch * 8); *(u32x4*)(Ow + (long)row * 1024 + ch * 8) = v; }
    ATT_WAITV_BAR();
}

constexpr int MB_NB = SEQ / 256;
constexpr int MB_OFF_K = 0, MB_OFF_V = 32768, MB_OFF_WS = 65536, MB_OFF_ST = MB_OFF_WS + 8 * 256, MB_OFF_TAB = MB_OFF_ST + 8 * 4096, MB_OFF_RING = MB_OFF_TAB + 512,
              MB_OFF_WC = MB_OFF_RING + 32768, MB_OFF_Q = MB_OFF_WC + 64, MB_LDS = MB_OFF_Q + 64;
DI int t5_bucket(int d) { if (d < 16) return d; const int l = 16 + (int)(__logf((float)d * (1.f / 16.f)) * (16.f / 2.0794415416798357f)); return l < 31 ? l : 31; }
DI void mb_load_kv(const bf16* K2, const bf16* V2, long row0, int h, unsigned lds0, int lane, int wid) {
    const bf16* ksrc = K2 + (row0 + lane) * 1024 + h * 64 + wid * 8;
    const bf16* vsrc = V2 + (row0 + 16 * (wid & 3) + (lane >> 2)) * 1024 + h * 64 + (wid >> 2) * 32 + (lane & 3) * 8;
#pragma unroll
    for (int t = 0; t < 4; ++t) { glds16(ksrc + (long)t * 64 * 1024, (unsigned)rfl((int)(lds0 + MB_OFF_K + t * 8192 + wid * 1024)));
        glds16(vsrc + (long)t * 64 * 1024, (unsigned)rfl((int)(lds0 + MB_OFF_V + t * 8192 + wid * 1024))); }
}
DI void mb_fill_tab(const float* rel_bias, int h, LAS float* tab, int tid) { if (tid < 128) tab[tid] = rel_bias[h * 32 + t5_bucket(tid)] * LOG2E; }

DI void top3_ins(float v, unsigned i, float& v0, unsigned& i0, float& v1, unsigned& i1, float& v2, unsigned& i2) {
    const bool b0 = v > v0 || (v == v0 && i < i0), b1 = v > v1 || (v == v1 && i < i1), b2 = v > v2 || (v == v2 && i < i2);
    const float n2 = b1 ? v1 : (b2 ? v : v2); const unsigned m2 = b1 ? i1 : (b2 ? i : i2);
    const float n1 = b0 ? v0 : (b1 ? v : v1); const unsigned m1 = b0 ? i0 : (b1 ? i : i1);
    const float n0 = b0 ? v : v0; const unsigned m0 = b0 ? i : i0;
    v0 = n0; i0 = m0; v1 = n1; i1 = m1; v2 = n2; i2 = m2;
}
DI void moba_gate_unit(int bh, int g, const bf16* Q2, const float* KMP, unsigned* SEL, unsigned* MASK32, LAS unsigned char* lds) {
    using namespace att;
    int tid_ = threadIdx.x; asm volatile("" : "+v"(tid_));
    const int tid = tid_, lane = tid & 63, r32 = lane & 31, hi = lane >> 5, wid = rfl(tid >> 6);
    const int b = bh >> 4, h = bh & 15;
    LAS bf16* khi = (LAS bf16*)lds; LAS bf16* klo = (LAS bf16*)(lds + 8192);
#pragma unroll
    for (int it_ = 0; it_ < 8; ++it_) { const int i = tid + 512 * it_; const int n = i >> 6, d = i & 63; const size_t src = (size_t)(b * MB_NB + n) * 1024 + h * 64 + d;
        const float v = (KMP[src] + KMP[(size_t)(T / 256) * 1024 + src]) * (1.f / 256.f);
        const unsigned ph = cvtpk(v, 0.f) & 0xffffu; const float rem = v - __uint_as_float(ph << 16); const unsigned pl = cvtpk(rem, 0.f) & 0xffffu;
        const int off = (d >> 3) * 512 + n * 8 + (d & 7); khi[off] = (bf16)ph; klo[off] = (bf16)pl; }
    const bf16* qbase = Q2 + ((long)b * SEQ + wid * 32 + r32) * 1024 + h * 64 + hi * 8;
    bf16x8 qn[4];
#pragma unroll
    for (int d0 = 0; d0 < 4; ++d0) qn[d0] = *(const bf16x8*)(qbase + (long)g * 256 * 1024 + d0 * 16);
    __syncthreads();
    const lcp kfr = (lcp)lds + hi * 1024 + r32 * 16;
#pragma unroll 1
    for (int j = 0; j < 8; ++j) {
        const int qb = g + 8 * j;
        bf16x8 qr[4] = {qn[0], qn[1], qn[2], qn[3]};
        if (j < 7) {
#pragma unroll
            for (int d0 = 0; d0 < 4; ++d0) qn[d0] = *(const bf16x8*)(qbase + (long)(qb + 8) * 256 * 1024 + d0 * 16); }
        f32x16 p0, p1, q0, q1; qk_tile<4>(p0, p1, kfr, qr); qk_tile<4>(q0, q1, kfr + 8192, qr);
        float v0 = -INFINITY, v1 = -INFINITY, v2 = -INFINITY; unsigned i0 = 0xFFu, i1 = 0xFFu, i2 = 0xFFu;
#pragma unroll
        for (int r = 0; r < 16; ++r) { const unsigned n = (unsigned)crow(r, hi); const bool in = (int)n < qb;
            top3_ins(in ? p0[r] + q0[r] : -INFINITY, in ? n : 0xFFu, v0, i0, v1, i1, v2, i2); }
        if (qb > 32) {
#pragma unroll
            for (int r = 0; r < 16; ++r) { const unsigned n = 32u + (unsigned)crow(r, hi); const bool in = (int)n < qb;
                top3_ins(in ? p1[r] + q1[r] : -INFINITY, in ? n : 0xFFu, v0, i0, v1, i1, v2, i2); } }
        { float pa, pb, pc; unsigned qa, qb_, qc;
#define MB_SWAPF(dst, src) do { auto rr_ = __builtin_amdgcn_permlane32_swap(__float_as_uint(src), __float_as_uint(src), false, false); dst = __uint_as_float(hi ? rr_[0] : rr_[1]); } while (0)
#define MB_SWAPU(dst, src) do { auto rr_ = __builtin_amdgcn_permlane32_swap(src, src, false, false); dst = hi ? rr_[0] : rr_[1]; } while (0)
          MB_SWAPF(pa, v0); MB_SWAPF(pb, v1); MB_SWAPF(pc, v2); MB_SWAPU(qa, i0); MB_SWAPU(qb_, i1); MB_SWAPU(qc, i2);
#undef MB_SWAPF
#undef MB_SWAPU
          top3_ins(pa, qa, v0, i0, v1, i1, v2, i2); top3_ins(pb, qb_, v0, i0, v1, i1, v2, i2); top3_ins(pc, qc, v0, i0, v1, i1, v2, i2); }
        if (hi == 0) SEL[(size_t)bh * SEQ + qb * 256 + wid * 32 + r32] = i0 | (i1 << 8) | (i2 << 16);
        for (int n = 0; n < qb; ++n) { const unsigned m0 = (unsigned)__ballot(i0 == (unsigned)n), m1 = (unsigned)__ballot(i1 == (unsigned)n), m2 = (unsigned)__ballot(i2 == (unsigned)n);
            if (lane == 0) { unsigned* dst = MASK32 + ((((size_t)bh * 64 + n) * 64 + qb) * 3) * 8 + wid; dst[0] = m0; dst[8] = m1; dst[16] = m2; } }
    }
    __syncthreads();
}

DI void moba_sel_unit(int bh, int n, const bf16* Q2, const bf16* K2, const bf16* V2, const unsigned long long* MASK, const float* rel_bias, bf16* PO0, bf16* PO1, bf16* PO2, bf16* PO3, float2* PMS, LAS unsigned char* lds) {
    using namespace att;
    int tid_ = threadIdx.x; asm volatile("" : "+v"(tid_));
    const int tid = tid_, lane = tid & 63, r32 = lane & 31, hi = lane >> 5, wid = rfl(tid >> 6);
    const int b = bh >> 4, h = bh & 15; const unsigned lds0 = (unsigned)(size_t)lds;
    mb_load_kv(K2, V2, (long)b * SEQ + n * 256, h, lds0, lane, wid);
    mb_fill_tab(rel_bias, h, (LAS float*)(lds + MB_OFF_TAB), tid);
    LAS unsigned short* list = (LAS unsigned short*)(lds + MB_OFF_RING);
    volatile LAS unsigned* wc = (volatile LAS unsigned*)(lds + MB_OFF_WC);
    bf16x8 qo[4];
    { const bf16* qp = Q2 + ((long)b * SEQ + n * 256 + wid * 32 + r32) * 1024 + h * 64 + hi * 8;
#pragma unroll
      for (int d0 = 0; d0 < 4; ++d0) qo[d0] = *(const bf16x8*)(qp + d0 * 16); }
    const unsigned* mw = (const unsigned*)(MASK + (((size_t)bh * 64 + n) * 64 + (n + 1)) * 12);
    const int nwords = (63 - n) * 24;
    unsigned w[3]; unsigned c = 0;
#pragma unroll
    for (int i = 0; i < 3; ++i) { const int j = tid + 512 * i; w[i] = j < nwords ? mw[j] : 0u; c += (unsigned)__popc(w[i]); }
    unsigned inc = c;
#pragma unroll
    for (int o = 1; o < 64; o <<= 1) { const unsigned t = __shfl_up(inc, o); if (lane >= o) inc += t; }
    if (lane == 63) wc[wid] = inc;
    ATT_WAITV_BAR();
    unsigned base = inc - c, total = 0;
#pragma unroll
    for (int i = 0; i < 8; ++i) { const unsigned x = wc[i]; total += x; if (i < wid) base += x; }
#pragma unroll
    for (int i = 0; i < 3; ++i) { const int j = tid + 512 * i; const int qb = n + 1 + j / 24, rem = j % 24, k = rem >> 3, s0 = qb * 256 + (rem & 7) * 32; unsigned ww = w[i];
        while (ww) { const int bit = __ffs(ww) - 1; ww &= ww - 1u; list[base++] = (unsigned short)(((unsigned)(s0 + bit) << 2) | (unsigned)k); } }
    ATT_BAR();
    const int nchunk = ((int)total + 255) >> 8;
    LAS float* wsf = (LAS float*)(lds + MB_OFF_WS) + wid * 64;
    LAS bf16* stg = (LAS bf16*)(lds + MB_OFF_ST) + wid * 2048;
    const LAS float* tab = (const LAS float*)(lds + MB_OFF_TAB);
    const lcp kfr = (lcp)lds + MB_OFF_K + hi * 1024 + r32 * 16;
    const lcp vfr = (lcp)lds + MB_OFF_V + ((lane >> 4) & 1) * 32 + (lane & 3) * 8 + (4 * hi + ((lane & 15) >> 2)) * 64;
    const int nchunk_ = ((int)total + 255) >> 8;
    const bf16* qbase = Q2 + (long)b * SEQ * 1024 + h * 64 + hi * 8;
    const int kend = n * 256 + 255;
    bf16x8 qn[4]; unsigned en = 0; bool vn = false;
#define MB_QLOAD(cc) do { const int idx_ = (cc) * 256 + 32 * wid + r32; vn = idx_ < (int)total; en = vn ? (unsigned)list[idx_] : 0u; const bf16* qp_ = qbase + (long)(en >> 2) * 1024; \
        _Pragma("unroll") for (int d0 = 0; d0 < 4; ++d0) { bf16x8 z_; _Pragma("unroll") for (int j_ = 0; j_ < 8; ++j_) z_[j_] = 0; qn[d0] = vn ? *(const bf16x8*)(qp_ + d0 * 16) : z_; } } while (0)
    if (nchunk_ > 0) MB_QLOAD(0);
    { float mref = -INFINITY, lsum = 0.f; f32x16 o[2];
#pragma unroll
      for (int r = 0; r < 16; ++r) { o[0][r] = 0.f; o[1][r] = 0.f; }
      const int qrel = 32 * wid + r32, tlast = wid >> 1;
#pragma unroll 1
      for (int t = 0; t <= tlast; ++t) {
          f32x16 p0, p1; qk_tile<4>(p0, p1, kfr + t * 8192, qo);
          const int dbase = qrel - 64 * t;
#pragma unroll
          for (int r = 0; r < 16; ++r) { const int d0 = dbase - crow(r, hi), d1 = d0 - 32;
              const int c0 = d0 > 127 ? 127 : (d0 < 0 ? 0 : d0), c1 = d1 > 127 ? 127 : (d1 < 0 ? 0 : d1);
              p0[r] = d0 < 0 ? -INFINITY : p0[r] + tab[c0]; p1[r] = d1 < 0 ? -INFINITY : p1[r] + tab[c1]; }
          smax_update(p0, p1, mref, lsum, o, wsf, r32, hi);
          pv_tile(o, vfr + t * 8192, p0, p1);
      }
      lsum = hsum(lsum);
      const int sq = n * 256 + qrel;
      if (hi == 0) PMS[((size_t)(3 * 32 + bh)) * SEQ + sq] = make_float2(mref, lsum);
      stage_o(o, stg, nullptr, r32, hi);
#pragma unroll
      for (int i = 0; i < 4; ++i) { const int row = i * 8 + (lane >> 3), ch = lane & 7;
          const u32x4 v = *(const LAS u32x4*)(stg + row * 64 + ch * 8); __builtin_nontemporal_store(v, (u32x4*)(PO3 + ((size_t)bh * SEQ + (n * 256 + 32 * wid + row)) * 64 + ch * 8)); }
      WAVE_LDS_SYNC(); }
#if defined(PROBE_DUP) && ((PROBE_DUP >> 19) & 1)
    for (int prb_ = 0; prb_ < 2; ++prb_) {
#else
    {
#endif
#if defined(PROBE_DUP) && ((PROBE_DUP >> 19) & 1)
    if (prb_ > 0 && nchunk > 0) MB_QLOAD(0);
#endif
    if (wid >= 4) __builtin_amdgcn_s_sleep(10);
#pragma unroll 1
    for (int cc = 0; cc < nchunk; ++cc) {
        const int cnt = ((int)total - cc * 256) < 256 ? ((int)total - cc * 256) : 256;
        bf16x8 qr[4] = {qn[0], qn[1], qn[2], qn[3]}; const unsigned e = en; const bool valid = vn;
        if (cc + 1 < nchunk) MB_QLOAD(cc + 1);
        if (32 * wid >= cnt) continue;
        const bool far = __all(!valid || ((int)(e >> 2) - kend >= 113)) != 0;
        float mref = 0.f, lsum = 0.f; f32x16 o[2], negm;
#pragma unroll
        for (int r = 0; r < 16; ++r) { o[0][r] = 0.f; o[1][r] = 0.f; negm[r] = 0.f; }
#pragma unroll 1
        for (int t = 0; t < 4; ++t) {
            f32x16 p0, p1; qk_tile_ref<4>(p0, p1, kfr + t * 8192, qr, negm);
            if (!far) { const int dbase = (int)(e >> 2) - (n * 256 + 64 * t);
#pragma unroll
                for (int r = 0; r < 16; ++r) { int d0 = dbase - crow(r, hi), d1 = d0 - 32; d0 = d0 > 127 ? 127 : (d0 < 0 ? 0 : d0); d1 = d1 > 127 ? 127 : (d1 < 0 ? 0 : d1); p0[r] += tab[d0]; p1[r] += tab[d1]; } }
            smax_update_ref(p0, p1, mref, negm, lsum, o, wsf, r32, hi, t == 0);
            pv_tile(o, vfr + t * 8192, p0, p1);
        }
        lsum = hsum(lsum);
        if (far) mref += tab[127];
        if (valid && hi == 0) { unsigned e_ = e; asm volatile("" : "+v"(e_)); PMS[((size_t)((int)(e_ & 3u) * 32 + bh)) * SEQ + (int)(e_ >> 2)] = make_float2(mref, lsum); }
        stage_o(o, stg, nullptr, r32, hi);
#pragma unroll
        for (int i = 0; i < 4; ++i) { const int row = i * 8 + (lane >> 3), ch = lane & 7; const int ridx = 32 * wid + row;
            if (ridx < cnt) { const unsigned e2 = list[cc * 256 + ridx]; const int s2 = (int)(e2 >> 2), k2 = (int)(e2 & 3u);
                const u32x4 v = *(const LAS u32x4*)(stg + row * 64 + ch * 8); bf16* pob = k2 == 0 ? PO0 : (k2 == 1 ? PO1 : PO2); __builtin_nontemporal_store(v, (u32x4*)(pob + ((size_t)bh * SEQ + s2) * 64 + ch * 8)); } }
        WAVE_LDS_SYNC();
    }
    }
#undef MB_QLOAD
    ATT_WAITV_BAR();
}

DI void moba_merge(int gw, int ngw, const unsigned* SEL, const bf16* PO0, const bf16* PO1, const bf16* PO2, const bf16* PO3, const float2* PMS, bf16* O2) {
    using namespace att;
    int tid_ = threadIdx.x; asm volatile("" : "+v"(tid_));
    const int lane = tid_ & 63, sub = lane >> 3, ch = lane & 7;
    const int NST = 32 * (SEQ / 8);
    unsigned nsel = 0u; float2 nms[4]; u32x4 npv[4];
#define MB_MLOAD(st) do { const int bh_ = (st) / (SEQ / 8), s_ = ((st) % (SEQ / 8)) * 8 + sub; const size_t it_ = (size_t)bh_ * SEQ + s_; nsel = SEL[it_]; \
        _Pragma("unroll") for (int k = 0; k < 4; ++k) { nms[k] = PMS[(size_t)k * 32 * SEQ + it_]; const bf16* pob = k == 0 ? PO0 : (k == 1 ? PO1 : (k == 2 ? PO2 : PO3)); npv[k] = __builtin_nontemporal_load((const u32x4*)(pob + it_ * 64 + ch * 8)); } } while (0)
    if (gw < NST) MB_MLOAD(gw);
    for (int st = gw; st < NST; st += ngw) {
        const int bh = st / (SEQ / 8), s = (st % (SEQ / 8)) * 8 + sub;
        const unsigned sel = nsel; float2 ms[4] = {nms[0], nms[1], nms[2], nms[3]}; u32x4 pv[4] = {npv[0], npv[1], npv[2], npv[3]};
        if (st + ngw < NST) MB_MLOAD(st + ngw);
        float mall = ms[3].x;
#pragma unroll
        for (int k = 0; k < 3; ++k) { const bool ok = ((sel >> (8 * k)) & 0xFFu) != 0xFFu; if (!ok) { ms[k].x = -INFINITY; ms[k].y = 0.f; pv[k] = (u32x4){0u, 0u, 0u, 0u}; } mall = fmaxf(mall, ms[k].x); }
        float den = 0.f, acc[8] = {0.f, 0.f, 0.f, 0.f, 0.f, 0.f, 0.f, 0.f};
#pragma unroll
        for (int k = 0; k < 4; ++k) { const float w = ex2(ms[k].x - mall); den += w * ms[k].y; const u32x4 v = pv[k];
            acc[0] += w * bflo(v.x); acc[1] += w * bfhi(v.x); acc[2] += w * bflo(v.y); acc[3] += w * bfhi(v.y); acc[4] += w * bflo(v.z); acc[5] += w * bfhi(v.z); acc[6] += w * bflo(v.w); acc[7] += w * bfhi(v.w); }
        const float rd = __builtin_amdgcn_rcpf(den);
        const u32x4 ov = (u32x4){cvtpk(acc[0] * rd, acc[1] * rd), cvtpk(acc[2] * rd, acc[3] * rd), cvtpk(acc[4] * rd, acc[5] * rd), cvtpk(acc[6] * rd, acc[7] * rd)};
        *(u32x4*)(O2 + ((size_t)(bh >> 4) * SEQ + s) * 1024 + (bh & 15) * 64 + ch * 8) = ov;
    }
#undef MB_MLOAD
}
}

constexpr size_t MiB = 1u << 20;
constexpr int NSLOT = 2 * T + 8 * 256;
constexpr size_t WS_CTL = 0, CTL_ZERO_BYTES = 64 * 1024;
constexpr size_t WS_RSTD0 = 1 * MiB, WS_TOKW = WS_RSTD0 + 128 * 1024, WS_TOKR = WS_TOKW + 256 * 1024, WS_TOKE = WS_TOKR + 128 * 1024, WS_PRANK = WS_TOKE + 128 * 1024;
constexpr size_t WS_PQKV = 2 * MiB, WS_PS1 = 6 * MiB, WS_PS2 = 8 * MiB, WS_PS3 = 10 * MiB, WS_ROPE = 12 * MiB, WS_KMP = 14 * MiB;
constexpr size_t WS_SDST = 15 * MiB, WS_SW = WS_SDST + 272 * 1024, WS_SRS = WS_SW + 272 * 1024;
constexpr size_t WS_WRT = 16 * MiB, WS_CNT = WS_WRT + 64 * 1024, WS_TILEE = WS_CNT + 64 * 1024;
constexpr size_t WS_STOK = 17 * MiB;
constexpr size_t WS_SEL = 18 * MiB;
constexpr size_t WS_W = 20 * MiB;
constexpr size_t W_IN = WS_W, W_UQ = W_IN + (size_t)2304 * 1024 * 2, W_UKV = W_UQ + (size_t)768 * 384 * 2, W_O0 = W_UKV + (size_t)1024 * 256 * 2, W_GU0 = W_O0 + (size_t)1024 * 1024 * 2,
                 W_DN0 = W_GU0 + (size_t)4096 * 1024 * 2, W_QKV = W_DN0 + (size_t)1024 * 2048 * 2, W_O1 = W_QKV + (size_t)3072 * 1024 * 2, W_EGU = W_O1 + (size_t)1024 * 1024 * 2,
                 W_EDN = W_EGU + (size_t)8192 * 1024 * 2, W_END = W_EDN + (size_t)8192 * 512 * 2;
static_assert(W_END <= 76 * MiB, "weights region");
constexpr size_t WS_XB = 76 * MiB, WS_OCAT = 76 * MiB, WS_SBQ = 140 * MiB, WS_SBK = 172 * MiB, WS_SBV = 204 * MiB, WS_CQ = 236 * MiB, WS_CKV = 260 * MiB, WS_KR = 276 * MiB,
                 WS_QA = 278 * MiB, WS_KN = 326 * MiB, WS_VA = 358 * MiB, WS_X1B = 390 * MiB, WS_HID = 76 * MiB;
constexpr size_t WS_Q2 = 204 * MiB, WS_K2 = 268 * MiB, WS_V2 = 332 * MiB, WS_PO0 = 76 * MiB, WS_PO1 = 140 * MiB, WS_PO2 = 396 * MiB, WS_PMS = 460 * MiB;
constexpr size_t WS_X3B = 268 * MiB, WS_XPERM = 332 * MiB, WS_YP = 332 * MiB, WS_HIDE = 76 * MiB;
constexpr size_t WS_MASK = 476 * MiB;
constexpr size_t WS_NEED = 489 * MiB;
static_assert(WS_SBK == WS_SBQ + 32 * MiB && WS_SBV == WS_SBQ + 64 * MiB && WS_VA == WS_KN + 32 * MiB && WS_K2 == WS_Q2 + 64 * MiB && WS_V2 == WS_Q2 + 128 * MiB, "epilogue pointer arithmetic");
static_assert(WS_XPERM + (size_t)NSLOT * 2048 <= 464 * MiB && WS_HIDE + (size_t)NSLOT * 1024 <= 204 * MiB && WS_SRS + 272 * 1024 <= 16 * MiB && NSLOT * 4 <= 272 * 1024, "ws map");
constexpr int CW_BAR = 4096, CW_QUEUE = 8192, CW_NRT = 8256;
static_assert((8320 + 64) * 4 <= (int)CTL_ZERO_BYTES && CW_BAR + 3456 <= CW_QUEUE, "control words inside the zeroed region");
constexpr int RING_BYTES = 131072, LDS_BYTES = 147456, MISC_OFF = LDS_BYTES - 256, PHASE_LDS = LDS_BYTES - 512;
static_assert(att::MLA_LDS <= PHASE_LDS && att::SB_LDS <= PHASE_LDS && att::MB_LDS <= PHASE_LDS && RING_BYTES <= PHASE_LDS, "phase LDS");

#define XB_TMO      128
#define XB_XCNT(j)  (256  + 64 * (j))
#define XB_XSUB(j)  (1280 + 64 * (j))
#define XB_XGEN(j)  (2304 + 64 * (j))
#define XB_TOP      3328
#define XB_TOPGEN   3392
#define XCD_BAR_WORDS 3456
#define XB_SPIN_CAP (1u << 18)
__device__ __forceinline__ unsigned xb_ld(unsigned* p)              { return __hip_atomic_load(p, __ATOMIC_RELAXED, __HIP_MEMORY_SCOPE_AGENT); }
__device__ __forceinline__ unsigned xb_add(unsigned* p, unsigned v) { return __hip_atomic_fetch_add(p, v, __ATOMIC_RELAXED, __HIP_MEMORY_SCOPE_AGENT); }
__device__ __forceinline__ unsigned xb_xcc_id() { return (unsigned)__builtin_amdgcn_s_getreg((3 << 11) | 20) & 0xFu; }
#define XB_SPIN(cond, bar) do { unsigned _sp = 0; while (cond) { __builtin_amdgcn_s_sleep(1); \
    if ((++_sp & 255u) == 0u) { if (xb_ld(&(bar)[XB_TMO])) break; if (_sp > XB_SPIN_CAP) { atomicAdd(&(bar)[XB_TMO], 1u); break; } } } } while (0)
struct XcdBarrier { unsigned* bar; unsigned x; volatile LAS unsigned* st; };
__device__ __forceinline__ XcdBarrier xcd_barrier_post(unsigned* bar, volatile LAS unsigned* st) {
    XcdBarrier b; b.bar = bar; b.x = xb_xcc_id(); b.st = st;
    if (threadIdx.x == 0) (void)xb_add(&bar[XB_XCNT(b.x)], 1u);
    return b;
}
__device__ __forceinline__ void xcd_barrier_complete(unsigned* bar, unsigned x, unsigned& nloc, unsigned& nx) {
    const unsigned G = gridDim.x * gridDim.y * gridDim.z;
    unsigned sum, cnt, mine, sp = 0u;
    for (;;) {
        sum = 0u; cnt = 0u; mine = 0u;
#pragma unroll
        for (unsigned j = 0; j < 16; ++j) { const unsigned c = xb_ld(&bar[XB_XCNT(j)]); sum += c; cnt += (c > 0u) ? 1u : 0u; mine = (j == x) ? c : mine; }
        if (sum == G) break;
        __builtin_amdgcn_s_sleep(1);
        if ((++sp & 255u) == 0u) { if (xb_ld(&bar[XB_TMO])) break; if (sp > XB_SPIN_CAP) { atomicAdd(&bar[XB_TMO], 1u); break; } }
    }
    nloc = mine > 0u ? mine : 1u; nx = cnt > 0u ? cnt : 1u;
}
__device__ __forceinline__ void xcd_barrier(const XcdBarrier& b) {
    asm volatile("s_waitcnt vmcnt(0)" ::: "memory");
    __syncthreads();
    if (threadIdx.x == 0) {
        unsigned* bar = b.bar;
        __builtin_amdgcn_s_waitcnt(0);
        unsigned nloc = b.st[0], nx = b.st[1];
        if (nloc == 0u) { xcd_barrier_complete(bar, b.x, nloc, nx); b.st[0] = nloc; b.st[1] = nx; }
        const unsigned old = xb_add(&bar[XB_XSUB(b.x)], 1u);
        const unsigned gen = old / nloc;
        if (old + 1u == (gen + 1u) * nloc) {
            __builtin_amdgcn_fence(__ATOMIC_RELEASE, "agent");
            asm volatile("s_waitcnt vmcnt(0)" ::: "memory");
            const unsigned og = xb_add(&bar[XB_TOP], 1u);
            const unsigned tg = og / nx;
            if (og + 1u == (tg + 1u) * nx) xb_add(&bar[XB_TOPGEN], 1u);
            else XB_SPIN(xb_ld(&bar[XB_TOPGEN]) == tg, bar);
            __builtin_amdgcn_fence(__ATOMIC_ACQUIRE, "agent");
            xb_add(&bar[XB_XGEN(b.x)], 1u);
            asm volatile("s_waitcnt vmcnt(0)" ::: "memory");
        } else {
            XB_SPIN(xb_ld(&bar[XB_XGEN(b.x)]) == gen, bar);
            __builtin_amdgcn_fence(__ATOMIC_ACQUIRE, "agent");
            asm volatile("s_waitcnt vmcnt(0)" ::: "memory");
        }
    }
    __syncthreads();
}

struct Args { const float* in[22]; float* out; unsigned char* ws; int ph_lo, ph_hi; };
enum { I_X = 0, I_EV_AN, I_EV_WIN, I_EV_QN, I_EV_WUQ, I_EV_KVN, I_EV_WUKV, I_EV_WO, I_EV_FN, I_EV_WG, I_EV_WU, I_EV_WD, I_OD_AN, I_OD_WQKV, I_OD_WO, I_OD_FN, I_OD_WR, I_OD_WG, I_OD_WU, I_OD_WD, I_RELB, I_FINN };
constexpr int NPH = 17;

constexpr float C_MLA = 0.10206207261596575f * LOG2E;
constexpr float C_64 = 0.125f * LOG2E;
DI int map_rope32(int p) { return 16 * ((p >> 2) & 1) + 4 * (p >> 3) + (p & 3); }
DI void cvt_item(const float* W, int ld, int col, float scale, const float* gain, int K, bf16* WT, int k0, LAS float* scr, int lane) {
    const int colc = col < 0 ? 0 : col; const float sc = col < 0 ? 0.f : scale;
    const float* wp = W + (size_t)(k0 + (lane >> 5)) * ld + colc;
    float v[32];
#pragma unroll
    for (int i = 0; i < 32; ++i) v[i] = __builtin_nontemporal_load(wp + (size_t)(2 * i) * ld);
    const int c = lane & 7;
    f32x4 g0 = (f32x4){1.f, 1.f, 1.f, 1.f}, g1 = g0;
    if (gain) { g0 = *(const f32x4*)(gain + k0 + 8 * c); g1 = *(const f32x4*)(gain + k0 + 8 * c + 4); }
#pragma unroll
    for (int i = 0; i < 32; ++i) scr[(2 * i + (lane >> 5)) * 33 + (lane & 31)] = v[i] * sc;
    asm volatile("s_waitcnt lgkmcnt(0)" ::: "memory");
#pragma unroll
    for (int j = 0; j < 4; ++j) { const int n = (lane >> 3) + 8 * j; const LAS float* s = scr + (8 * c) * 33 + n;
        v4u o; o.x = cvtpk(s[0 * 33] * g0[0], s[1 * 33] * g0[1]); o.y = cvtpk(s[2 * 33] * g0[2], s[3 * 33] * g0[3]); o.z = cvtpk(s[4 * 33] * g1[0], s[5 * 33] * g1[1]); o.w = cvtpk(s[6 * 33] * g1[2], s[7 * 33] * g1[3]);
        *(v4u*)(WT + (size_t)n * K + k0 + 8 * c) = o; }
    asm volatile("s_waitcnt lgkmcnt(0)" ::: "memory");
}
DI void p0_weights(const Args& a, LAS unsigned char* lds, int gw, int NGW, bool layer1) {
    int tid_ = threadIdx.x; asm volatile("" : "+v"(tid_)); const int tid = tid_, lane = tid & 63, wave = rfl(tid >> 6);
    LAS float* scr = (LAS float*)(lds + wave * 8704);
    unsigned char* ws = a.ws;
    constexpr int J0 = 72 * 16, J1 = J0 + 24 * 6, J2 = J1 + 32 * 4, J3 = J2 + 32 * 16, J4 = J3 + 128 * 16, J5 = J4 + 32 * 32, J6 = J5 + 96 * 16, J7 = J6 + 32 * 16, J8 = J7 + 256 * 16, J9 = J8 + 256 * 8;
    for (int it = (layer1 ? J5 : 0) + gw; it < (layer1 ? J9 : J5); it += NGW) {
        const int ln = lane & 31;
        if (it < J0) { const int nb = it / 16, kb = it % 16, n = nb * 32 + ln; int col; float sc = 1.f;
            if (n < 1536) { col = 672 + n; if (n < 512) sc = C_64; } else if (n < 1920) col = n - 1536; else if (n < 2176) col = 384 + (n - 1920); else if (n < 2208) col = 640 + map_rope32(n - 2176); else col = -1;
            cvt_item(a.in[I_EV_WIN], 2208, col, sc, a.in[I_EV_AN], 1024, (bf16*)(ws + W_IN) + (size_t)nb * 32 * 1024, kb * 64, scr, lane); }
        else if (it < J1) { const int r = it - J0, nb = r / 6, kb = r % 6, n = nb * 32 + ln; const int col = (nb % 3 == 2) ? nb * 32 + map_rope32(ln) : n;
            cvt_item(a.in[I_EV_WUQ], 768, col, C_MLA, a.in[I_EV_QN], 384, (bf16*)(ws + W_UQ) + (size_t)nb * 32 * 384, kb * 64, scr, lane); }
        else if (it < J2) { const int r = it - J1, nb = r / 4, kb = r % 4, n = nb * 32 + ln; const int col = n < 512 ? (n >> 6) * 128 + (n & 63) : ((n - 512) >> 6) * 128 + 64 + ((n - 512) & 63);
            cvt_item(a.in[I_EV_WUKV], 1024, col, 1.f, a.in[I_EV_KVN], 256, (bf16*)(ws + W_UKV) + (size_t)nb * 32 * 256, kb * 64, scr, lane); }
        else if (it < J3) { const int r = it - J2, nb = r / 16, kb = r % 16;
            cvt_item(a.in[I_EV_WO], 1024, nb * 32 + ln, 1.f, nullptr, 1024, (bf16*)(ws + W_O0) + (size_t)nb * 32 * 1024, kb * 64, scr, lane); }
        else if (it < J4) { const int r = it - J3, nb = r / 16, kb = r % 16, n = nb * 32 + ln; const int tile = n >> 8, half = (n >> 7) & 1, col = tile * 128 + (n & 127);
            cvt_item(half ? a.in[I_EV_WU] : a.in[I_EV_WG], 2048, col, 1.f, a.in[I_EV_FN], 1024, (bf16*)(ws + W_GU0) + (size_t)nb * 32 * 1024, kb * 64, scr, lane); }
        else if (it < J5) { const int r = it - J4, nb = r / 32, kb = r % 32;
            cvt_item(a.in[I_EV_WD], 1024, nb * 32 + ln, 1.f, nullptr, 2048, (bf16*)(ws + W_DN0) + (size_t)nb * 32 * 2048, kb * 64, scr, lane); }
        else if (it < J6) { const int r = it - J5, nb = r / 16, kb = r % 16, n = nb * 32 + ln;
            cvt_item(a.in[I_OD_WQKV], 3072, n, n < 1024 ? C_64 : 1.f, a.in[I_OD_AN], 1024, (bf16*)(ws + W_QKV) + (size_t)nb * 32 * 1024, kb * 64, scr, lane); }
        else if (it < J7) { const int r = it - J6, nb = r / 16, kb = r % 16;
            cvt_item(a.in[I_OD_WO], 1024, nb * 32 + ln, 1.f, nullptr, 1024, (bf16*)(ws + W_O1) + (size_t)nb * 32 * 1024, kb * 64, scr, lane); }
        else if (it < J8) { const int r = it - J7, nb = r / 16, kb = r % 16, n = nb * 32 + ln; const int e = n >> 10, m = n & 1023, tile = m >> 8, half = (m >> 7) & 1, col = tile * 128 + (m & 127);
            cvt_item((half ? a.in[I_OD_WU] : a.in[I_OD_WG]) + (size_t)e * 1024 * 512, 512, col, 1.f, a.in[I_OD_FN], 1024, (bf16*)(ws + W_EGU) + (size_t)nb * 32 * 1024, kb * 64, scr, lane); }
        else { const int r = it - J8, nb = r / 8, kb = r % 8, n = nb * 32 + ln; const int e = n >> 10, m = n & 1023;
            cvt_item(a.in[I_OD_WD] + (size_t)e * 512 * 1024, 1024, m, 1.f, nullptr, 512, (bf16*)(ws + W_EDN) + (size_t)nb * 32 * 512, kb * 64, scr, lane); }
    }
}
DI void p0_prologue(const Args& a, LAS unsigned char* lds, int vcu, int G) {
    int tid_ = threadIdx.x; asm volatile("" : "+v"(tid_)); const int tid = tid_, lane = tid & 63, wave = rfl(tid >> 6);
    const int gw = vcu * 8 + wave, NGW = G * 8;
    unsigned char* ws = a.ws;
    p0_weights(a, lds, gw, NGW, false);
    { const float* x = a.in[I_X]; bf16* XB = (bf16*)(ws + WS_XB); float* rs0 = (float*)(ws + WS_RSTD0);
      f32x4 nv[4];
      if (gw < T) { const f32x4* xr = (const f32x4*)(x + (size_t)gw * DM) + lane;
#pragma unroll
          for (int j = 0; j < 4; ++j) nv[j] = __builtin_nontemporal_load(xr + 64 * j); }
      for (int m = gw; m < T; m += NGW) { f32x4 v[4]; float s = 0.f;
#pragma unroll
          for (int j = 0; j < 4; ++j) v[j] = nv[j];
          if (m + NGW < T) { const f32x4* xr = (const f32x4*)(x + (size_t)(m + NGW) * DM) + lane;
#pragma unroll
              for (int j = 0; j < 4; ++j) nv[j] = __builtin_nontemporal_load(xr + 64 * j); }
#pragma unroll
          for (int j = 0; j < 4; ++j) s += (v[j].x * v[j].x + v[j].y * v[j].y) + (v[j].z * v[j].z + v[j].w * v[j].w);
          s = wave_sum(s); if (lane == 0) rs0[m] = rsqrtf(s * (1.f / DM) + RMS_EPS);
          unsigned long long* o8 = (unsigned long long*)(XB + (size_t)m * DM) + lane;
#pragma unroll
          for (int j = 0; j < 4; ++j) o8[64 * j] = (unsigned long long)cvtpk(v[j].x, v[j].y) | ((unsigned long long)cvtpk(v[j].z, v[j].w) << 32); } }
    { float2* rope = (float2*)(ws + WS_ROPE); const int gt = vcu * 512 + tid, NT_ = G * 512;
      for (int i = gt; i < SEQ * 16; i += NT_) { const int pos = i >> 4, f = i & 15;
          const double inv = (f & 8 ? 0.01 : 1.0) * (f & 4 ? 0.1 : 1.0) * (f & 2 ? 0.31622776601683794 : 1.0) * (f & 1 ? 0.5623413251903491 : 1.0);
          double rev = (double)pos * inv * 0.15915494309189535; rev -= __builtin_rint(rev);
          rope[i] = make_float2(__builtin_amdgcn_cosf((float)rev), __builtin_amdgcn_sinf((float)rev)); } }
    { float* wrt = (float*)(ws + WS_WRT); const int gt = vcu * 512 + tid, NT_ = G * 512;
      for (int i = gt; i < 8 * 1024; i += NT_) { const int e = i >> 10, k = i & 1023; wrt[i] = a.in[I_OD_FN][k] * a.in[I_OD_WR][k * 8 + e]; } }
}

using pg8::Unit;
typedef const f32x4 (&AccRef)[2][2][4][2];
DI v4u pack8(f32x4 a, f32x4 b) { v4u w; w.x = cvtpk(a[0], a[1]); w.y = cvtpk(a[2], a[3]); w.z = cvtpk(b[0], b[1]); w.w = cvtpk(b[2], b[3]); return w; }
DI float sumsq8(f32x4 a, f32x4 b) { return (a[0] * a[0] + a[1] * a[1]) + (a[2] * a[2] + a[3] * a[3]) + (b[0] * b[0] + b[1] * b[1]) + (b[2] * b[2] + b[3] * b[3]); }
DI float fq_sum(float s) { s += __shfl_xor(s, 16); s += __shfl_xor(s, 32); return s; }
DI float rstd_from(const float* P, int n4, float invn) { float s = 0.f;
#pragma unroll 4
    for (int i = 0; i < n4; ++i) { const f32x4 v = ((const f32x4*)P)[i]; s += (v[0] + v[1]) + (v[2] + v[3]); } return rsqrtf(s * invn + RMS_EPS); }
DI void rope_pair(f32x4& t1, f32x4& t2, const float2* rp  ) {
#pragma unroll
    for (int j = 0; j < 4; ++j) { const float2 cs = rp[j]; const float a = t1[j], b = t2[j]; t1[j] = a * cs.x - b * cs.y; t2[j] = b * cs.x + a * cs.y; }
}
DI unsigned long long pack4(f32x4 a) { return (unsigned long long)cvtpk(a[0], a[1]) | ((unsigned long long)cvtpk(a[2], a[3]) << 32); }

#define EPI_ROW(q) (u.pm * 256 + ((q) >> 2) * 128 + wr * 64 + ((q) & 3) * 16 + fr)
#define EPI_RSTD8(rs, NP4, P, stride, off, invn) do { f32x4 pv_[8]; const int fqc_ = fq < (NP4) ? fq : 0; \
        _Pragma("unroll") for (int q = 0; q < 8; ++q) pv_[q] = *(const f32x4*)((P) + (size_t)EPI_ROW(q) * (stride) + (off) + fqc_ * 4); \
        _Pragma("unroll") for (int q = 0; q < 8; ++q) { float s_ = (pv_[q][0] + pv_[q][1]) + (pv_[q][2] + pv_[q][3]); if (fq >= (NP4)) s_ = 0.f; s_ = fq_sum(s_); rs[q] = rsqrtf(s_ * (invn) + RMS_EPS); } } while (0)
struct EpiInProj {
    static constexpr bool PERM = true, AFTER_DRAIN = false;
    bf16 *SBQ, *CQ, *CKV, *KR; const float* rstd0; float* PQKV; const float2* rope;
    DI void operator()(AccRef acc, const Unit& u, int wr, int wc, int fr, int fq) const {
        { int ln_ = (int)__builtin_amdgcn_mbcnt_hi(~0u, __builtin_amdgcn_mbcnt_lo(~0u, 0u)); asm volatile("" : "+v"(ln_)); fr = ln_ & 15; fq = ln_ >> 4; }
        float rs[8];
#pragma unroll
        for (int q = 0; q < 8; ++q) rs[q] = rstd0[EPI_ROW(q)];
#pragma unroll
        for (int bj = 0; bj < 2; ++bj) {
            const int col0 = u.pn * 256 + bj * 128, cw = wc * 32 + fq * 8;
#pragma unroll
            for (int q = 0; q < 8; ++q) { const int ai = q >> 2, m = q & 3; const int r = EPI_ROW(q);
                f32x4 v0 = acc[ai][bj][m][0] * rs[q], v1 = acc[ai][bj][m][1] * rs[q];
                if (col0 < 1536) { bf16* dst = SBQ + (size_t)(col0 >> 9) * (size_t)(16u << 20) + (size_t)r * 512 + (col0 & 511) + cw; *(v4u*)dst = pack8(v0, v1); }
                else if (col0 < 1920) { *(v4u*)(CQ + (size_t)r * 384 + (col0 - 1536) + cw) = pack8(v0, v1); const float s = fq_sum(sumsq8(v0, v1)); if (fq == 0) PQKV[(size_t)r * 32 + (col0 - 1536) / 32 + wc] = s; }
                else if (col0 < 2176) { *(v4u*)(CKV + (size_t)r * 256 + (col0 - 1920) + cw) = pack8(v0, v1); const float s = fq_sum(sumsq8(v0, v1)); if (fq == 0) PQKV[(size_t)r * 32 + 16 + (col0 - 1920) / 32 + wc] = s; }
                else if (wc == 0) {
                    const f32x4* rp = (const f32x4*)(rope + (size_t)(r & (SEQ - 1)) * 16 + 4 * fq); const f32x4 ca = rp[0], cb = rp[1];
                    const float c[4] = {ca[0], ca[2], cb[0], cb[2]}, sn[4] = {ca[1], ca[3], cb[1], cb[3]};
#pragma unroll
                    for (int j = 0; j < 4; ++j) { const float a = v0[j], b = v1[j]; v0[j] = a * c[j] - b * sn[j]; v1[j] = b * c[j] + a * sn[j]; }
                    *(unsigned long long*)(KR + (size_t)r * 32 + 4 * fq) = pack4(v0); *(unsigned long long*)(KR + (size_t)r * 32 + 16 + 4 * fq) = pack4(v1); }
            }
        }
    }
};
struct EpiQUp {
    static constexpr bool PERM = true, AFTER_DRAIN = false;
    bf16* QA; const float* PQKV; const float2* rope;
    DI void operator()(AccRef acc, const Unit& u, int wr, int wc, int fr, int fq) const {
        { int ln_ = (int)__builtin_amdgcn_mbcnt_hi(~0u, __builtin_amdgcn_mbcnt_lo(~0u, 0u)); asm volatile("" : "+v"(ln_)); fr = ln_ & 15; fq = ln_ >> 4; }
        float rs[8]; EPI_RSTD8(rs, 3, PQKV, 32, 0, 1.f / 384.f);
        const bool rope0 = (u.pn * 8 + wc) % 3 == 2, rope1 = (u.pn * 8 + 4 + wc) % 3 == 2;
#pragma unroll
        for (int hb = 0; hb < 2; ++hb) {
            f32x4 cs[4][2];
            if (rope0 || rope1) {
#pragma unroll
                for (int qq = 0; qq < 4; ++qq) { const f32x4* rp = (const f32x4*)(rope + (size_t)(EPI_ROW(hb * 4 + qq) & (SEQ - 1)) * 16 + 4 * fq); cs[qq][0] = rp[0]; cs[qq][1] = rp[1]; } }
#pragma unroll
            for (int qq = 0; qq < 4; ++qq) { const int q = hb * 4 + qq, ai = q >> 2, m = q & 3; const int r = EPI_ROW(q);
#pragma unroll
                for (int bj = 0; bj < 2; ++bj) { const int gi = u.pn * 8 + bj * 4 + wc; const bool isr = bj ? rope1 : rope0;
                    f32x4 v0 = acc[ai][bj][m][0] * rs[q], v1 = acc[ai][bj][m][1] * rs[q];
                    if (!isr) *(v4u*)(QA + (size_t)r * 768 + gi * 32 + fq * 8) = pack8(v0, v1);
                    else { const float c[4] = {cs[qq][0][0], cs[qq][0][2], cs[qq][1][0], cs[qq][1][2]}, sn[4] = {cs[qq][0][1], cs[qq][0][3], cs[qq][1][1], cs[qq][1][3]};
#pragma unroll
                        for (int j = 0; j < 4; ++j) { const float a = v0[j], b = v1[j]; v0[j] = a * c[j] - b * sn[j]; v1[j] = b * c[j] + a * sn[j]; }
                        *(unsigned long long*)(QA + (size_t)r * 768 + gi * 32 + 4 * fq) = pack4(v0); *(unsigned long long*)(QA + (size_t)r * 768 + gi * 32 + 16 + 4 * fq) = pack4(v1); } }
            }
        }
    }
};
struct EpiKvUp {
    static constexpr bool PERM = true, AFTER_DRAIN = false;
    bf16* KN; const float* PQKV;
    DI void operator()(AccRef acc, const Unit& u, int wr, int wc, int fr, int fq) const {
        { int ln_ = (int)__builtin_amdgcn_mbcnt_hi(~0u, __builtin_amdgcn_mbcnt_lo(~0u, 0u)); asm volatile("" : "+v"(ln_)); fr = ln_ & 15; fq = ln_ >> 4; }
        float rs[8]; EPI_RSTD8(rs, 2, PQKV, 32, 16, 1.f / 256.f);
#pragma unroll
        for (int q = 0; q < 8; ++q) { const int ai = q >> 2, m = q & 3; const int r = EPI_ROW(q);
#pragma unroll
            for (int bj = 0; bj < 2; ++bj) { const int c = u.pn * 256 + bj * 128 + wc * 32 + fq * 8;
                bf16* dst = KN + (size_t)(c >> 9) * (size_t)(16u << 20) + (size_t)r * 512 + (c & 511);
                *(v4u*)dst = pack8(acc[ai][bj][m][0] * rs[q], acc[ai][bj][m][1] * rs[q]); }
        }
    }
};
template <bool RES_F32> struct EpiRes {
    static constexpr bool PERM = true, AFTER_DRAIN = false;
    const void* res; bf16* Y; float* PS;
    DI void operator()(AccRef acc, const Unit& u, int wr, int wc, int fr, int fq) const {
        { int ln_ = (int)__builtin_amdgcn_mbcnt_hi(~0u, __builtin_amdgcn_mbcnt_lo(~0u, 0u)); asm volatile("" : "+v"(ln_)); fr = ln_ & 15; fq = ln_ >> 4; }
        const size_t cb = (size_t)u.pn * 256 + wc * 32 + fq * 8;
#pragma unroll
        for (int hb = 0; hb < 2; ++hb) {
            f32x4 x0[4][2], x1[4][2];
#pragma unroll
            for (int qq = 0; qq < 4; ++qq)
#pragma unroll
                for (int bj = 0; bj < 2; ++bj) { const size_t o = (size_t)EPI_ROW(hb * 4 + qq) * 1024 + cb + bj * 128;
                    if (RES_F32) { x0[qq][bj] = *(const f32x4*)((const float*)res + o); x1[qq][bj] = *(const f32x4*)((const float*)res + o + 4); }
                    else { const v4u w = *(const v4u*)((const bf16*)res + o); x0[qq][bj] = (f32x4){bflo(w.x), bfhi(w.x), bflo(w.y), bfhi(w.y)}; x1[qq][bj] = (f32x4){bflo(w.z), bfhi(w.z), bflo(w.w), bfhi(w.w)}; } }
#pragma unroll
            for (int qq = 0; qq < 4; ++qq) { const int q = hb * 4 + qq, ai = q >> 2, m = q & 3; const int r = EPI_ROW(q); float ss = 0.f;
#pragma unroll
                for (int bj = 0; bj < 2; ++bj) { const f32x4 v0 = acc[ai][bj][m][0] + x0[qq][bj], v1 = acc[ai][bj][m][1] + x1[qq][bj]; ss += sumsq8(v0, v1); *(v4u*)(Y + (size_t)r * 1024 + cb + bj * 128) = pack8(v0, v1); }
                ss = fq_sum(ss); if (fq == 0) PS[(size_t)r * 16 + u.pn * 4 + wc] = ss; }
        }
    }
};
DI f32x4 silu_mul(f32x4 g, f32x4 u) { f32x4 o;
#pragma unroll
    for (int j = 0; j < 4; ++j) o[j] = g[j] * u[j] * __builtin_amdgcn_rcpf(1.f + ex2(-g[j] * LOG2E)); return o; }
struct EpiSwiGLU {
    static constexpr bool PERM = true, AFTER_DRAIN = false;
    bf16* H; int ldh, ntile; const float* PS; const float* srs;
    DI void operator()(AccRef acc, const Unit& u, int wr, int wc, int fr, int fq) const {
        { int ln_ = (int)__builtin_amdgcn_mbcnt_hi(~0u, __builtin_amdgcn_mbcnt_lo(~0u, 0u)); asm volatile("" : "+v"(ln_)); fr = ln_ & 15; fq = ln_ >> 4; }
        float rs[8];
        if (PS) EPI_RSTD8(rs, 4, PS, 16, 0, 1.f / 1024.f);
        else {
#pragma unroll
            for (int q = 0; q < 8; ++q) rs[q] = srs[EPI_ROW(q)]; }
#pragma unroll
        for (int q = 0; q < 8; ++q) { const int ai = q >> 2, m = q & 3; const int r = EPI_ROW(q);
            const f32x4 h0 = silu_mul(acc[ai][0][m][0] * rs[q], acc[ai][1][m][0] * rs[q]), h1 = silu_mul(acc[ai][0][m][1] * rs[q], acc[ai][1][m][1] * rs[q]);
            *(v4u*)(H + (size_t)r * ldh + (u.pn % ntile) * 128 + wc * 32 + fq * 8) = pack8(h0, h1); }
    }
};
struct EpiQkv {
    static constexpr bool PERM = true, AFTER_DRAIN = false;
    bf16* Q2; const float* PS; float* KMP;
    DI void operator()(AccRef acc, const Unit& u, int wr, int wc, int fr, int fq) const {
        { int ln_ = (int)__builtin_amdgcn_mbcnt_hi(~0u, __builtin_amdgcn_mbcnt_lo(~0u, 0u)); asm volatile("" : "+v"(ln_)); fr = ln_ & 15; fq = ln_ >> 4; }
        float rs[8]; EPI_RSTD8(rs, 4, PS, 16, 0, 1.f / 1024.f);
        const int sec = u.pn >> 2; bf16* dstb = Q2 + (size_t)sec * (size_t)(32u << 20);
        f32x4 cs[2][2];
#pragma unroll
        for (int bj = 0; bj < 2; ++bj) { cs[bj][0] = (f32x4){0.f, 0.f, 0.f, 0.f}; cs[bj][1] = cs[bj][0]; }
#pragma unroll
        for (int q = 0; q < 8; ++q) { const int ai = q >> 2, m = q & 3; const int r = EPI_ROW(q);
#pragma unroll
            for (int bj = 0; bj < 2; ++bj) { const f32x4 v0 = acc[ai][bj][m][0] * rs[q], v1 = acc[ai][bj][m][1] * rs[q]; cs[bj][0] += v0; cs[bj][1] += v1;
                *(v4u*)(dstb + (size_t)r * 1024 + (u.pn & 3) * 256 + bj * 128 + wc * 32 + fq * 8) = pack8(v0, v1); }
        }
        if (sec == 1) {
#pragma unroll
            for (int bj = 0; bj < 2; ++bj)
#pragma unroll
                for (int n = 0; n < 2; ++n) { f32x4 s = cs[bj][n];
#pragma unroll
                    for (int j = 0; j < 4; ++j) { float t = s[j]; t += __shfl_xor(t, 1); t += __shfl_xor(t, 2); t += __shfl_xor(t, 4); t += __shfl_xor(t, 8); s[j] = t; }
                    if (fr == 0) *(f32x4*)(KMP + ((size_t)wr * (T / 256) + u.pm) * 1024 + (u.pn & 3) * 256 + bj * 128 + wc * 32 + fq * 8 + n * 4) = s; }
        }
    }
};
struct EpiMoeDown {
    static constexpr bool PERM = true, AFTER_DRAIN = false;
    bf16* YP; const int* sdst; const float* sw;
    DI void operator()(AccRef acc, const Unit& u, int wr, int wc, int fr, int fq) const {
        { int ln_ = (int)__builtin_amdgcn_mbcnt_hi(~0u, __builtin_amdgcn_mbcnt_lo(~0u, 0u)); asm volatile("" : "+v"(ln_)); fr = ln_ & 15; fq = ln_ >> 4; }
        int d[8]; float w[8];
#pragma unroll
        for (int q = 0; q < 8; ++q) { d[q] = sdst[EPI_ROW(q)]; w[q] = sw[EPI_ROW(q)]; }
#pragma unroll
        for (int q = 0; q < 8; ++q) { const int ai = q >> 2, m = q & 3;
            if (d[q] >= 0) {
#pragma unroll
                for (int bj = 0; bj < 2; ++bj) __builtin_nontemporal_store(pack8(acc[ai][bj][m][0] * w[q], acc[ai][bj][m][1] * w[q]), (v4u*)(YP + (size_t)d[q] * 1024 + (u.pn & 3) * 256 + bj * 128 + wc * 32 + fq * 8)); }
        }
    }
};
struct MoeOrder {
    const int* tile_e; int nrt, G, c;
    DI bool next(int i, Unit& u) const { const long L = (long)i * G + c; if (L >= (long)nrt * 4) return false; const int rt = (int)(L >> 2); u.pm = rt; u.pn = tile_e[rt] * 4 + (int)(L & 3); return true; }
    DI void a_ready(const Unit&) const {}
    DI void done(const Unit&) const {}
};

#ifndef DBG_CHECK
#define DBG_CHECK 0
#endif
constexpr int CW_ERR = 8320;
#if DBG_CHECK
DI float bf2f(bf16 v) { return __uint_as_float((unsigned)v << 16); }
DI void dbg_flag(unsigned* ctl, unsigned bit) { atomicOr(ctl + CW_ERR, bit); }
DI float blk_max(float v, LAS float* red, int tid) { red[tid] = v; __syncthreads(); for (int o = 256; o > 0; o >>= 1) { if (tid < o) red[tid] = fmaxf(red[tid], red[tid + o]); __syncthreads(); } const float r = red[0]; __syncthreads(); return r; }
DI float blk_sum(float v, LAS float* red, int tid) { red[tid] = v; __syncthreads(); for (int o = 256; o > 0; o >>= 1) { if (tid < o) red[tid] = red[tid] + red[tid + o]; __syncthreads(); } const float r = red[0]; __syncthreads(); return r; }
DI unsigned dbg_hash(unsigned i) { i ^= i >> 16; i *= 0x7feb352du; i ^= i >> 15; i *= 0x846ca68bu; i ^= i >> 16; return i; }
DI int dbg_pos(int i) { switch (i) { case 0: return 0; case 1: return 1; case 2: return 31; case 3: return 32; case 4: return 63; case 5: return 64; case 6: return 65; case 7: return 255; case 8: return 256; case 9: return 257;
    case 10: return 511; case 11: return 512; case 12: return 4095; case 13: return 4096; case 14: return 8191; case 15: return 16383; default: return (int)(dbg_hash((unsigned)i) % SEQ); } }
template <int MODE> DI void naive_attn(const Args& a, int b, int h, int s, LAS unsigned char* lds, unsigned sel) {
    const int tid = threadIdx.x; unsigned char* ws = a.ws;
    LAS float* lg = (LAS float*)lds; LAS float* red = (LAS float*)(lds + 65536); LAS float* qv = (LAS float*)(lds + 67584); LAS float* opart = (LAS float*)(lds + 68096); LAS float* oref = (LAS float*)(lds + 70144);
    const size_t r = (size_t)b * SEQ + s;
    const int DQ = MODE == 0 ? 96 : 64; float mblk = 0.f;
    if (tid < DQ) { float q;
        if (MODE == 0) q = bf2f(((const bf16*)(ws + WS_QA))[r * 768 + h * 96 + tid]); else if (MODE == 1) q = bf2f(((const bf16*)(ws + WS_SBQ))[r * 512 + h * 64 + tid]); else q = bf2f(((const bf16*)(ws + WS_Q2))[r * 1024 + h * 64 + tid]);
        qv[tid] = q; }
    __syncthreads();
    const int nk = MODE == 1 ? s : s + 1;
    float lmax = -INFINITY;
    for (int k = tid; k < nk; k += 512) { const size_t kr = (size_t)b * SEQ + k; float acc = 0.f;
        if (MODE == 0) { const bf16* kn = (const bf16*)(ws + WS_KN) + kr * 512 + h * 64; const bf16* kp = (const bf16*)(ws + WS_KR) + kr * 32;
            for (int d = 0; d < 64; ++d) acc += qv[d] * bf2f(kn[d]); for (int d = 0; d < 32; ++d) acc += qv[64 + d] * bf2f(kp[d]); }
        else if (MODE == 1) { const bf16* kk = (const bf16*)(ws + WS_SBK) + kr * 512 + h * 64; for (int d = 0; d < 64; ++d) acc += qv[d] * bf2f(kk[d]); }
        else { const int kb = k >> 8, qb = s >> 8; (void)qb; const bool ok = (MODE == 2 && kb == qb) || kb == (int)(sel & 0xFFu) || kb == (int)((sel >> 8) & 0xFFu) || kb == (int)((sel >> 16) & 0xFFu);
            if (ok) { const bf16* kk = (const bf16*)(ws + WS_K2) + kr * 1024 + h * 64; for (int d = 0; d < 64; ++d) acc += qv[d] * bf2f(kk[d]);
                const int dist = s - k; int bucket = dist; if (dist >= 16) { bucket = 16 + (int)(logf((float)dist / 16.f) / 2.0794415416798357f * 16.f); if (bucket > 31) bucket = 31; }
                acc += a.in[I_RELB][h * 32 + bucket] * LOG2E; } else acc = -INFINITY; }
        lg[k] = acc; lmax = fmaxf(lmax, acc); }
    __syncthreads();
    float tot = 1.f;
    if (MODE == 1) { if (tid == 0) { float run = 0.f; for (int k = nk - 1; k >= 0; --k) { const float y = lg[k]; const float sp = fmaxf(y, 0.f) + log2f(1.f + exp2f(-fabsf(y))); lg[k] = exp2f(y - sp + run); run -= sp; } } __syncthreads(); }
    else { const float m = blk_max(lmax, red, tid); mblk = m; float ls = 0.f; for (int k = tid; k < nk; k += 512) { const float p = exp2f(lg[k] - m); lg[k] = p; ls += p; } __syncthreads(); tot = blk_sum(ls, red, tid); }
    { const int g = tid >> 6, d = tid & 63; float acc = 0.f;
      for (int k = g; k < nk; k += 8) { const size_t kr = (size_t)b * SEQ + k; float v;
          if (MODE == 0) v = bf2f(((const bf16*)(ws + WS_VA))[kr * 512 + h * 64 + d]); else if (MODE == 1) v = bf2f(((const bf16*)(ws + WS_SBV))[kr * 512 + h * 64 + d]); else v = bf2f(((const bf16*)(ws + WS_V2))[kr * 1024 + h * 64 + d]);
          const float p = lg[k]; if (p != 0.f) acc += p * v; }
      opart[g * 64 + d] = acc; }
    __syncthreads();
    if (tid < 64) { float acc = 0.f; for (int g = 0; g < 8; ++g) acc += opart[g * 64 + tid]; oref[tid] = acc / tot; }
    if (tid == 0) oref[64] = mblk + log2f(tot);
    __syncthreads();
}
DI void dbg_cmp64(const bf16* got, LAS unsigned char* lds, unsigned* ctl, unsigned bit) {
    const int tid = threadIdx.x; LAS float* red = (LAS float*)(lds + 65536); LAS float* oref = (LAS float*)(lds + 70144);
    const float v = tid < 64 ? fabsf(oref[tid]) : 0.f; const float mx = blk_max(v, red, tid);
    if (tid < 64) { const float g = bf2f(got[tid]); if (!(fabsf(g - oref[tid]) <= 0.02f * mx + 2e-3f)) dbg_flag(ctl, bit); }
    __syncthreads();
}
DI void dbg_check_a(const Args& a, LAS unsigned char* lds, unsigned* ctl, int bx, int G) {
    const int tid = threadIdx.x; unsigned char* ws = a.ws;
    LAS float* red = (LAS float*)(lds + 65536); LAS float* hrow = (LAS float*)lds;
    LAS float* cq = (LAS float*)(lds + 4096); LAS float* ckv = (LAS float*)(lds + 8192);
    const float2* rope = (const float2*)(ws + WS_ROPE);
    for (int i = bx; i < 256; i += G) {
        const int b = i & 1, s = dbg_pos(i >> 1); const size_t r = (size_t)b * SEQ + s;
        float ss = 0.f; for (int k = tid; k < 1024; k += 512) { const float x = a.in[I_X][r * 1024 + k]; ss += x * x; }
        const float rs = rsqrtf(blk_sum(ss, red, tid) / 1024.f + RMS_EPS);
        for (int k = tid; k < 1024; k += 512) hrow[k] = a.in[I_X][r * 1024 + k] * rs * a.in[I_EV_AN][k];
        __syncthreads();
        for (int j = tid; j < 2208; j += 512) { float acc = 0.f; for (int k = 0; k < 1024; ++k) acc += hrow[k] * a.in[I_EV_WIN][(size_t)k * 2208 + j];
            float got, ref = acc; bool cmp = true;
            if (j < 384) got = bf2f(((const bf16*)(ws + WS_CQ))[r * 384 + j]);
            else if (j < 640) got = bf2f(((const bf16*)(ws + WS_CKV))[r * 256 + (j - 384)]);
            else if (j < 672) { cmp = false; got = 0.f; }
            else if (j < 1184) { got = bf2f(((const bf16*)(ws + WS_SBQ))[r * 512 + (j - 672)]); ref = acc * C_64; }
            else if (j < 1696) got = bf2f(((const bf16*)(ws + WS_SBK))[r * 512 + (j - 1184)]);
            else got = bf2f(((const bf16*)(ws + WS_SBV))[r * 512 + (j - 1696)]);
            if (cmp && !(fabsf(got - ref) <= 0.03f * fabsf(ref) + 0.03f)) dbg_flag(ctl, 1u); }
        if (tid < 16) { float t1 = 0.f, t2 = 0.f; for (int k = 0; k < 1024; ++k) { t1 += hrow[k] * a.in[I_EV_WIN][(size_t)k * 2208 + 640 + tid]; t2 += hrow[k] * a.in[I_EV_WIN][(size_t)k * 2208 + 656 + tid]; }
            const float ang = (float)s * powf(10000.f, -(float)tid / 16.f); const float c = cosf(ang), sn = sinf(ang);
            const float o1 = t1 * c - t2 * sn, o2 = t2 * c + t1 * sn; const float g1 = bf2f(((const bf16*)(ws + WS_KR))[r * 32 + tid]), g2 = bf2f(((const bf16*)(ws + WS_KR))[r * 32 + 16 + tid]);
            if (!(fabsf(g1 - o1) <= 0.03f * fabsf(o1) + 0.03f) || !(fabsf(g2 - o2) <= 0.03f * fabsf(o2) + 0.03f)) dbg_flag(ctl, 1u);
            const float2 tb = rope[(size_t)s * 16 + tid]; if (!(fabsf(tb.x - c) < 2e-3f && fabsf(tb.y - sn) < 2e-3f)) dbg_flag(ctl, 1u); }
        __syncthreads();
        float s1 = 0.f, s2 = 0.f;
        if (tid < 384) { const float v = bf2f(((const bf16*)(ws + WS_CQ))[r * 384 + tid]); s1 = v * v; cq[tid] = v; }
        if (tid < 256) { const float v = bf2f(((const bf16*)(ws + WS_CKV))[r * 256 + tid]); s2 = v * v; ckv[tid] = v; }
        const float rq = rsqrtf(blk_sum(s1, red, tid) / 384.f + RMS_EPS), rk = rsqrtf(blk_sum(s2, red, tid) / 256.f + RMS_EPS);
        if (tid < 384) cq[tid] *= rq * a.in[I_EV_QN][tid];
        if (tid < 256) ckv[tid] *= rk * a.in[I_EV_KVN][tid];
        __syncthreads();
        for (int j = tid; j < 768; j += 512) { const int hh = j / 96, dd = j % 96; float acc = 0.f; for (int k = 0; k < 384; ++k) acc += cq[k] * a.in[I_EV_WUQ][(size_t)k * 768 + j];
            float ref = acc;
            if (dd >= 64) { const int ri = dd - 64, pi = ri < 16 ? ri : ri - 16; const int jp = hh * 96 + 64 + (ri < 16 ? ri + 16 : ri - 16); float accp = 0.f; for (int k = 0; k < 384; ++k) accp += cq[k] * a.in[I_EV_WUQ][(size_t)k * 768 + jp];
                const float ang = (float)s * powf(10000.f, -(float)pi / 16.f); const float c = cosf(ang), sn = sinf(ang); ref = ri < 16 ? acc * c - accp * sn : acc * c + accp * sn; }
            ref *= C_MLA; const float got = bf2f(((const bf16*)(ws + WS_QA))[r * 768 + j]);
            if (!(fabsf(got - ref) <= 0.03f * fabsf(ref) + 0.02f)) dbg_flag(ctl, 1u); }
        for (int j = tid; j < 1024; j += 512) { const int hh = j >> 7, dd = j & 127; float acc = 0.f; for (int k = 0; k < 256; ++k) acc += ckv[k] * a.in[I_EV_WUKV][(size_t)k * 1024 + j];
            const float got = dd < 64 ? bf2f(((const bf16*)(ws + WS_KN))[r * 512 + hh * 64 + dd]) : bf2f(((const bf16*)(ws + WS_VA))[r * 512 + hh * 64 + dd - 64]);
            if (!(fabsf(got - acc) <= 0.03f * fabsf(acc) + 0.03f)) dbg_flag(ctl, 1u); }
        __syncthreads();
        const int h = (int)(dbg_hash((unsigned)i * 7u + 1u) & 7u);
        naive_attn<0>(a, b, h, s, lds, 0u); dbg_cmp64((const bf16*)(ws + WS_OCAT) + r * 1024 + h * 64, lds, ctl, 2u);
        naive_attn<1>(a, b, h, s, lds, 0u); dbg_cmp64((const bf16*)(ws + WS_OCAT) + r * 1024 + 512 + h * 64, lds, ctl, 4u);
    }
}
DI void dbg_check_b(const Args& a, LAS unsigned char* lds, unsigned* ctl, int bx, int G, const bf16* O2) {
    const int tid = threadIdx.x; unsigned char* ws = a.ws;
    LAS float* red = (LAS float*)(lds + 65536); LAS float* hrow = (LAS float*)lds; LAS float* gate = (LAS float*)(lds + 8192);
    const bf16* X2 = (const bf16*)a.out;
    for (int i = bx; i < 256; i += G) {
        const int b = i & 1, s = dbg_pos(i >> 1), h = (int)(dbg_hash((unsigned)i * 11u + 5u) & 15u); const size_t r = (size_t)b * SEQ + s;
        float ss = 0.f; for (int k = tid; k < 1024; k += 512) { const float x = bf2f(X2[r * 1024 + k]); ss += x * x; }
        const float rs = rsqrtf(blk_sum(ss, red, tid) / 1024.f + RMS_EPS);
        for (int k = tid; k < 1024; k += 512) hrow[k] = bf2f(X2[r * 1024 + k]) * rs * a.in[I_OD_AN][k];
        __syncthreads();
        for (int j = tid; j < 3072; j += 512) { float acc = 0.f; for (int k = 0; k < 1024; ++k) acc += hrow[k] * a.in[I_OD_WQKV][(size_t)k * 3072 + j];
            float ref = acc; float got;
            if (j < 1024) { ref = acc * C_64; got = bf2f(((const bf16*)(ws + WS_Q2))[r * 1024 + j]); } else if (j < 2048) got = bf2f(((const bf16*)(ws + WS_K2))[r * 1024 + j - 1024]); else got = bf2f(((const bf16*)(ws + WS_V2))[r * 1024 + j - 2048]);
            if (!(fabsf(got - ref) <= 0.03f * fabsf(ref) + 0.03f)) dbg_flag(ctl, 8u); }
        __syncthreads();
        const int qb = s >> 8; const unsigned sel = ((const unsigned*)(ws + WS_SEL))[((size_t)(b * 16 + h)) * SEQ + s];
        if (tid < 64) gate[tid] = -INFINITY;
        __syncthreads();
        { const int n = tid >> 3, part = tid & 7;
          float acc = 0.f; if (n < qb) { for (int kk = part * 32; kk < part * 32 + 32; ++kk) { const size_t kr = (size_t)b * SEQ + n * 256 + kk; for (int d = 0; d < 64; ++d) acc += bf2f(((const bf16*)(ws + WS_Q2))[r * 1024 + h * 64 + d]) * bf2f(((const bf16*)(ws + WS_K2))[kr * 1024 + h * 64 + d]); } }
          acc += __shfl_xor(acc, 1); acc += __shfl_xor(acc, 2); acc += __shfl_xor(acc, 4); if (part == 0 && n < qb) gate[n] = acc / 256.f; }
        __syncthreads();
        if (tid == 0) { const int nsel_exp = qb < 3 ? qb : 3; int nsel = 0; float gmin = INFINITY; bool bad = false;
            for (int k = 0; k < 3; ++k) { const unsigned e = (sel >> (8 * k)) & 0xFFu; if (e != 0xFFu) { if ((int)e >= qb) bad = true; else { ++nsel; gmin = fminf(gmin, gate[e]); } } }
            if (nsel != nsel_exp) bad = true;
            if ((sel & 0xFFu) != 0xFFu && ((sel & 0xFFu) == ((sel >> 8) & 0xFFu) || (sel & 0xFFu) == ((sel >> 16) & 0xFFu))) bad = true;
            if (((sel >> 8) & 0xFFu) != 0xFFu && ((sel >> 8) & 0xFFu) == ((sel >> 16) & 0xFFu)) bad = true;
            if (!bad && nsel > 0) { float gsc = 0.f; for (int n = 0; n < qb; ++n) gsc = fmaxf(gsc, fabsf(gate[n]));
                for (int n = 0; n < qb; ++n) { const bool chosen = n == (int)(sel & 0xFFu) || n == (int)((sel >> 8) & 0xFFu) || n == (int)((sel >> 16) & 0xFFu); if (!chosen && gate[n] > gmin + 0.02f * gsc + 1e-3f) bad = true; } }
            if (bad) dbg_flag(ctl, 8u); }
        __syncthreads();
        { LAS float* oref = (LAS float*)(lds + 70144); float* dref = (float*)(ws + WS_WRT + 256 * 1024) + (size_t)i * 64;
          naive_attn<2>(a, b, h, s, lds, 0xFFFFFFu);
          { const float v = tid < 64 ? fabsf(oref[tid]) : 0.f; const float mx = blk_max(v, red, tid);
            const float2 ms = ((const float2*)(ws + WS_PMS))[((size_t)(3 * 32 + b * 16 + h)) * SEQ + s]; const bf16* pob = (const bf16*)a.out + (size_t)32 * 1024 * 1024 + (((size_t)(b * 16 + h)) * SEQ + s) * 64;
            if (tid == 0) { if (!(fabsf(ms.x + log2f(ms.y) - oref[64]) <= 0.05f)) dbg_flag(ctl, 8u); }
            if (tid < 64) { const float g = bf2f(pob[tid]) / ms.y; if (!(fabsf(g - oref[tid]) <= 0.02f * mx + 2e-3f)) dbg_flag(ctl, 8u); }
            __syncthreads(); }
          naive_attn<2>(a, b, h, s, lds, sel);
          if (tid < 64) dref[tid] = oref[tid];
          __syncthreads(); }
    }
}
DI void dbg_check_b2(const Args& a, LAS unsigned char* lds, unsigned* ctl, int bx, int G, const bf16* O2) {
    const int tid = threadIdx.x; unsigned char* ws = a.ws; LAS float* red = (LAS float*)(lds + 65536);
    for (int i = bx; i < 256; i += G) {
        const int b = i & 1, s = dbg_pos(i >> 1), h = (int)(dbg_hash((unsigned)i * 11u + 5u) & 15u); const size_t r = (size_t)b * SEQ + s;
        const float* dref = (const float*)(ws + WS_WRT + 256 * 1024) + (size_t)i * 64;
        const float rf = tid < 64 ? dref[tid] : 0.f; const float mx = blk_max(fabsf(rf), red, tid);
        if (tid < 64) { const float g = bf2f(O2[r * 1024 + h * 64 + tid]); if (!(fabsf(g - rf) <= 0.02f * mx + 2e-3f)) dbg_flag(ctl, 8u); }
        __syncthreads();
    }
}
#endif

DI void router_chunk(const Args& a, int ch, LAS unsigned char* lds) {
    int tid_ = threadIdx.x; asm volatile("" : "+v"(tid_)); const int tid = tid_, lane = tid & 63, wave = rfl(tid >> 6);
    unsigned char* ws = a.ws;
    const bf16* X3 = (const bf16*)(ws + WS_X3B); const float* PS3 = (const float*)(ws + WS_PS3);
    const LAS float* wrt = (const LAS float*)lds;
    volatile LAS unsigned* te = (volatile LAS unsigned*)(lds + 32768);
    float2* TOKW = (float2*)(ws + WS_TOKW); float* TOKR = (float*)(ws + WS_TOKR); unsigned* TOKE = (unsigned*)(ws + WS_TOKE);
    v4u nw0 = *((const v4u*)(X3 + (size_t)(ch * 128 + wave * 16) * 1024) + lane), nw1 = *((const v4u*)(X3 + (size_t)(ch * 128 + wave * 16) * 1024 + 512) + lane);
    float npss = PS3[(size_t)(ch * 128 + wave * 16) * 16 + (lane & 15)];
#pragma unroll 1
    for (int i = 0; i < 16; ++i) {
        const int tl = wave * 16 + i, tok = ch * 128 + tl;
        const v4u w0 = nw0, w1 = nw1; float pss = npss;
        if (i < 15) { nw0 = *((const v4u*)(X3 + (size_t)(tok + 1) * 1024) + lane); nw1 = *((const v4u*)(X3 + (size_t)(tok + 1) * 1024 + 512) + lane); npss = PS3[(size_t)(tok + 1) * 16 + (lane & 15)]; }
        float xv[16] = {bflo(w0.x), bfhi(w0.x), bflo(w0.y), bfhi(w0.y), bflo(w0.z), bfhi(w0.z), bflo(w0.w), bfhi(w0.w), bflo(w1.x), bfhi(w1.x), bflo(w1.y), bfhi(w1.y), bflo(w1.z), bfhi(w1.z), bflo(w1.w), bfhi(w1.w)};
        float pv[8];
#pragma unroll
        for (int e = 0; e < 8; ++e) { const LAS f32x4* p0 = (const LAS f32x4*)(wrt + e * 1024 + lane * 8); const LAS f32x4* p1 = (const LAS f32x4*)(wrt + e * 1024 + 512 + lane * 8);
            const f32x4 a0 = p0[0], a1 = p0[1], b0 = p1[0], b1 = p1[1];
            float s = xv[0] * a0[0] + xv[1] * a0[1] + xv[2] * a0[2] + xv[3] * a0[3] + xv[4] * a1[0] + xv[5] * a1[1] + xv[6] * a1[2] + xv[7] * a1[3];
            s += xv[8] * b0[0] + xv[9] * b0[1] + xv[10] * b0[2] + xv[11] * b0[3] + xv[12] * b1[0] + xv[13] * b1[1] + xv[14] * b1[2] + xv[15] * b1[3];
            pv[e] = s; }
        float k4[4], k2[2], k1;
        { const bool h5 = (lane >> 5) & 1, h4 = (lane >> 4) & 1, h3 = (lane >> 3) & 1;
#pragma unroll
          for (int i = 0; i < 4; ++i) { const float send = h5 ? pv[i] : pv[4 + i]; k4[i] = (h5 ? pv[4 + i] : pv[i]) + __shfl_xor(send, 32); }
#pragma unroll
          for (int i = 0; i < 2; ++i) { const float send = h4 ? k4[i] : k4[2 + i]; k2[i] = (h4 ? k4[2 + i] : k4[i]) + __shfl_xor(send, 16); }
          { const float send = h3 ? k2[0] : k2[1]; k1 = (h3 ? k2[1] : k2[0]) + __shfl_xor(send, 8); }
          k1 += __shfl_xor(k1, 4); k1 += __shfl_xor(k1, 2); k1 += __shfl_xor(k1, 1); }
        float lg[8];
#pragma unroll
        for (int e = 0; e < 8; ++e) lg[e] = __uint_as_float(__builtin_amdgcn_readlane(__float_as_uint(k1), e * 8));
        pss += __shfl_xor(pss, 1); pss += __shfl_xor(pss, 2); pss += __shfl_xor(pss, 4); pss += __shfl_xor(pss, 8);
        const float rs = rsqrtf(pss * (1.f / 1024.f) + RMS_EPS);
        float v1 = -INFINITY, v2 = -INFINITY; unsigned i1 = 0, i2 = 0;
#pragma unroll
        for (int e = 0; e < 8; ++e) { const float l = lg[e] * rs; if (l > v1) { v2 = v1; i2 = i1; v1 = l; i1 = (unsigned)e; } else if (l > v2) { v2 = l; i2 = (unsigned)e; } }
        const float w1g = 1.f / (1.f + __expf(v2 - v1));
        if (lane == 0) { TOKW[tok] = make_float2(w1g, 1.f - w1g); TOKR[tok] = rs; TOKE[tok] = i1 | (i2 << 8); te[tl] = i1 | (i2 << 8); }
    }
    __syncthreads();
    { const unsigned e = (unsigned)wave; const unsigned ta = te[2 * lane], tb = te[2 * lane + 1];
      const unsigned m0 = (ta & 0xFFu) == e, m1 = ((ta >> 8) & 0xFFu) == e, m2 = (tb & 0xFFu) == e, m3 = ((tb >> 8) & 0xFFu) == e;
      const unsigned c = m0 + m1 + m2 + m3; unsigned inc = c;
#pragma unroll
      for (int o = 1; o < 64; o <<= 1) { const unsigned t = __shfl_up(inc, o); if (lane >= o) inc += t; }
      unsigned base = inc - c; int* PR = (int*)(ws + WS_PRANK) + (size_t)ch * 256 + 4 * lane;
      if (m0) { PR[0] = (int)base; ++base; } if (m1) { PR[1] = (int)base; ++base; } if (m2) { PR[2] = (int)base; ++base; } if (m3) { PR[3] = (int)base; ++base; }
      if (lane == 63) ((int*)(ws + WS_CNT))[ch * 8 + wave] = (int)inc; }
    __syncthreads();
}

DI void permute_phase(const Args& a, LAS unsigned char* lds, int G) {
    int tid_ = threadIdx.x; asm volatile("" : "+v"(tid_)); const int tid = tid_;
    unsigned char* ws = a.ws;
    LAS int* cnt = (LAS int*)lds;
    LAS int* off = (LAS int*)(lds + 8192);
    LAS int* ebase = (LAS int*)(lds + 16384);
    const int* CNT = (const int*)(ws + WS_CNT);
    for (int i = tid; i < 2048; i += 512) cnt[i] = CNT[i];
    __syncthreads();
    if (tid < 8) { int s = 0; for (int c = 0; c < 256; ++c) { off[c * 8 + tid] = s; s += cnt[c * 8 + tid]; } ebase[16 + tid] = s; }
    __syncthreads();
    if (tid == 0) { int s = 0; for (int e = 0; e < 8; ++e) { ebase[e] = s; s += (ebase[16 + e] + 255) & ~255; } ebase[8] = s; }
    __syncthreads();
    int* SDST = (int*)(ws + WS_SDST); float* SW = (float*)(ws + WS_SW); float* SRS = (float*)(ws + WS_SRS);
    int* STOK = (int*)(ws + WS_STOK);
    const float2* TOKW = (const float2*)(ws + WS_TOKW); const float* TOKR = (const float*)(ws + WS_TOKR); const unsigned* TOKE = (const unsigned*)(ws + WS_TOKE); const int* PRANK = (const int*)(ws + WS_PRANK);
    if (blockIdx.x == 0) {
        int* TE = (int*)(ws + WS_TILEE); const int nrt = ebase[8] >> 8;
        for (int rt = tid; rt < nrt; rt += 512) { int e = 0; for (int k = 1; k < 8; ++k) if (rt * 256 >= ebase[k]) e = k; TE[rt] = e; }
        if (tid == 0) ((unsigned*)(ws + WS_CTL))[CW_NRT] = (unsigned)nrt;
    }
    for (int e = blockIdx.x; e < 8; e += G) {
        const int lo = ebase[e] + ebase[16 + e], hi = ebase[e + 1];
        for (int s = lo + tid; s < hi; s += 512) { SDST[s] = -1; SW[s] = 0.f; SRS[s] = 0.f; STOK[s] = 0; }
    }
    for (int ch = blockIdx.x; ch < 256; ch += G) {
        if (tid < 256) { const int tok = ch * 128 + (tid >> 1), k = tid & 1; const unsigned te = TOKE[tok]; const int e = (int)((te >> (8 * k)) & 0xFFu);
            const int slot = ebase[e] + off[ch * 8 + e] + PRANK[(size_t)ch * 256 + tid];
            const float2 w = TOKW[tok]; SDST[slot] = tok * 2 + k; SW[slot] = k ? w.y : w.x; SRS[slot] = TOKR[tok]; STOK[slot] = tok; }
    }
}

DI void final_phase(const Args& a, int vcu, int G, float oscale) {
    int tid_ = threadIdx.x; asm volatile("" : "+v"(tid_)); const int tid = tid_, lane = tid & 63, wave = rfl(tid >> 6);
    const bf16* X3 = (const bf16*)(a.ws + WS_X3B); const bf16* YP = (const bf16*)(a.ws + WS_YP); const float* g = a.in[I_FINN];
    const int gw = vcu * 8 + wave, NGW = G * 8;
    f32x4 gv[4];
#pragma unroll
    for (int j = 0; j < 4; ++j) gv[j] = *((const f32x4*)g + 2 * lane + (j & 1) + 128 * (j >> 1));
    v4u nx[2], ny0[2], ny1[2];
#define FN_LOAD(m) do { _Pragma("unroll") for (int hlf = 0; hlf < 2; ++hlf) { nx[hlf] = __builtin_nontemporal_load((const v4u*)(X3 + (size_t)(m) * 1024 + hlf * 512) + lane); \
        ny0[hlf] = __builtin_nontemporal_load((const v4u*)(YP + (size_t)(2 * (m)) * 1024 + hlf * 512) + lane); ny1[hlf] = __builtin_nontemporal_load((const v4u*)(YP + (size_t)(2 * (m) + 1) * 1024 + hlf * 512) + lane); } } while (0)
    if (gw < T) FN_LOAD(gw);
    for (int m = gw; m < T; m += NGW) {
        float v[16]; float ss = 0.f;
        const v4u cx[2] = {nx[0], nx[1]}, cy0[2] = {ny0[0], ny0[1]}, cy1[2] = {ny1[0], ny1[1]};
        if (m + NGW < T) FN_LOAD(m + NGW);
#pragma unroll
        for (int hlf = 0; hlf < 2; ++hlf) {
            const v4u x = cx[hlf], y0 = cy0[hlf], y1 = cy1[hlf];
            const unsigned xs[4] = {x.x, x.y, x.z, x.w}, as[4] = {y0.x, y0.y, y0.z, y0.w}, bs[4] = {y1.x, y1.y, y1.z, y1.w};
#pragma unroll
            for (int j = 0; j < 4; ++j) { const float lo = bflo(xs[j]) + (bflo(as[j]) + bflo(bs[j])), hh = bfhi(xs[j]) + (bfhi(as[j]) + bfhi(bs[j])); v[hlf * 8 + 2 * j] = lo; v[hlf * 8 + 2 * j + 1] = hh; ss += lo * lo + hh * hh; }
        }
        ss = wave_sum(ss); const float rs = rsqrtf(ss * (1.f / 1024.f) + RMS_EPS) * oscale;
        float* o = a.out + (size_t)m * 1024;
#pragma unroll
        for (int hlf = 0; hlf < 2; ++hlf) { f32x4 o0, o1;
#pragma unroll
            for (int j = 0; j < 4; ++j) { o0[j] = v[hlf * 8 + j] * rs * gv[hlf * 2][j]; o1[j] = v[hlf * 8 + 4 + j] * rs * gv[hlf * 2 + 1][j]; }
            __builtin_nontemporal_store(o0, (f32x4*)(o + hlf * 512) + 2 * lane); __builtin_nontemporal_store(o1, (f32x4*)(o + hlf * 512) + 2 * lane + 1); }
    }
}

__global__ void __launch_bounds__(512, 2) hybrid_fwd(Args args) {
    extern __shared__ __attribute__((aligned(16))) unsigned char lds_raw[];
    LAS unsigned char* lds = (LAS unsigned char*)lds_raw;
    volatile LAS unsigned* MISC = (volatile LAS unsigned*)(lds + MISC_OFF);
    const int tid = threadIdx.x, wave = rfl(tid >> 6), lane = tid & 63;
    const int G = gridDim.x; const int bx = blockIdx.x; const int vcu = (G % 8 == 0) ? (bx % 8) * (G / 8) + bx / 8 : bx;
    unsigned char* ws = args.ws;
    unsigned* ctl = (unsigned*)(ws + WS_CTL);
    for (int u = tid; u < (LDS_BYTES - PHASE_LDS) / 4; u += 512) ((LAS unsigned*)(lds + PHASE_LDS))[u] = 0u;
    __syncthreads();
    XcdBarrier bar; bar.bar = ctl + CW_BAR; bar.x = 0; bar.st = nullptr;
#if MK_ONE_LAUNCH
    (void)xcd_barrier_post(ctl + CW_BAR, MISC + 8);
#if defined(PROBE_DUP) && ((PROBE_DUP >> 21) & 1)
#define GRID_BAR() do { const unsigned long long t0_ = __builtin_amdgcn_s_memrealtime(); XcdBarrier b_; b_.bar = (unsigned*)(args.ws + WS_CTL) + CW_BAR; b_.x = xb_xcc_id(); b_.st = (volatile LAS unsigned*)(lds + MISC_OFF) + 8; xcd_barrier(b_); if ((PROBE_SEAMS >> prb_k_) & 1) prb_wait_ += __builtin_amdgcn_s_memrealtime() - t0_; } while (0)
#else
#define GRID_BAR() do { XcdBarrier b_; b_.bar = (unsigned*)(args.ws + WS_CTL) + CW_BAR; b_.x = xb_xcc_id(); b_.st = (volatile LAS unsigned*)(lds + MISC_OFF) + 8; xcd_barrier(b_); } while (0)
#endif
#else
#define GRID_BAR() do { } while (0)
#endif
    int prb_k_ = 0; (void)prb_k_; unsigned long long prb_wait_ = 0; (void)prb_wait_;
    const int lo = args.ph_lo, hi = args.ph_hi;
#ifndef PH_MASK
#define PH_MASK 0x1FFFF
#endif
#define IN(k) (((PH_MASK >> (k)) & 1) && lo <= (k) && (k) < hi)
#if defined(PROBE_DUP) && ((PROBE_DUP >> 20) & 1)
#define SEAM(k) do { if (IN((k) + 1)) { GRID_BAR(); GRID_BAR(); } } while (0)
#else
#define SEAM(k) do { prb_k_ = (k); if (IN((k) + 1)) GRID_BAR(); } while (0)
#endif
#ifndef PROBE_DUP
#define PROBE_DUP 0
#endif
#define REP(k) for (int rep_ = 0; rep_ < (((PROBE_DUP >> (k)) & 1) ? 2 : 1); ++rep_)
    (void)lane; (void)wave;

    bf16* XB = (bf16*)(ws + WS_XB); bf16* OCAT = (bf16*)(ws + WS_OCAT);
    bf16 *SBQ = (bf16*)(ws + WS_SBQ), *SBK = (bf16*)(ws + WS_SBK), *SBV = (bf16*)(ws + WS_SBV), *CQ = (bf16*)(ws + WS_CQ), *CKV = (bf16*)(ws + WS_CKV), *KR = (bf16*)(ws + WS_KR);
    bf16 *QA = (bf16*)(ws + WS_QA), *KN = (bf16*)(ws + WS_KN), *VA = (bf16*)(ws + WS_VA), *X1B = (bf16*)(ws + WS_X1B), *HID = (bf16*)(ws + WS_HID), *X2B = (bf16*)args.out;
    bf16 *Q2 = (bf16*)(ws + WS_Q2), *K2 = (bf16*)(ws + WS_K2), *V2 = (bf16*)(ws + WS_V2), *X3B = (bf16*)(ws + WS_X3B), *YP = (bf16*)(ws + WS_YP), *HIDE = (bf16*)(ws + WS_HIDE);
    float *PQKV = (float*)(ws + WS_PQKV), *PS1 = (float*)(ws + WS_PS1), *PS2 = (float*)(ws + WS_PS2), *PS3 = (float*)(ws + WS_PS3), *KMP = (float*)(ws + WS_KMP);
    bf16* O2 = Q2;
    bf16* PO3 = (bf16*)args.out + (size_t)32 * 1024 * 1024;
    const float2* ROPE = (const float2*)(ws + WS_ROPE); unsigned* SEL = (unsigned*)(ws + WS_SEL); float2* PMS = (float2*)(ws + WS_PMS);

    if (IN(0)) REP(0) { p0_prologue(args, lds, vcu, G); SEAM(0); }
    if (IN(1)) REP(1) {
        pg8::Gemm g{XB, (const bf16*)(ws + W_IN), T, 2304, 1024}; pg8::StaticOrder S; S.init(T, 2304, G, bx);
        EpiInProj E{SBQ, CQ, CKV, KR, (const float*)(ws + WS_RSTD0), PQKV, ROPE};
        pg8::gemm_phase<EpiInProj, pg8::StaticOrder, true, true>(lds, g, S, E);
        { const bool half = (G == 256); if (!half || bx >= 128) { __syncthreads(); p0_weights(args, lds, (half ? bx - 128 : bx) * 8 + wave, (half ? 128 : G) * 8, true); } }
        SEAM(1);
    }
    if (IN(2)) REP(2) {
        { pg8::Gemm g{CQ, (const bf16*)(ws + W_UQ), T, 768, 384}; pg8::StaticOrder S; S.init(T, 768, G, bx);
          EpiQUp E{QA, PQKV, ROPE}; pg8::gemm_phase<EpiQUp, pg8::StaticOrder, true, true>(lds, g, S, E); }
        __syncthreads();
        { pg8::Gemm g{CKV, (const bf16*)(ws + W_UKV), T, 1024, 256}; pg8::StaticOrder S; S.init(T, 1024, G, bx);
          EpiKvUp E{KN, PQKV}; pg8::gemm_phase<EpiKvUp, pg8::StaticOrder, true, true>(lds, g, S, E); }
        SEAM(2);
    }
    if (IN(3)) REP(3) {
        REP(17) for (int v = vcu; v < 256; v += G) { const int bh = v >> 4, s = v & 15;
            att::mla_unit(bh, 63 - s, QA, KN, KR, VA, OCAT, lds); att::mla_unit(bh, 32 + s, QA, KN, KR, VA, OCAT, lds);
            att::mla_unit(bh, 31 - s, QA, KN, KR, VA, OCAT, lds); att::mla_unit(bh, s, QA, KN, KR, VA, OCAT, lds); }
        REP(18) { volatile LAS int* qslot = (volatile LAS int*)(lds + PHASE_LDS - 64);
          unsigned* qw = ctl + CW_QUEUE + 192 + 64 * rep_;
          if (tid == 0) qslot[0] = (int)atomicAdd(qw, 1u);
          __syncthreads();
          int uidx = qslot[0];
          __syncthreads();
          while (uidx < 1024) {
              unsigned nx = 0u; if (tid == 0) nx = atomicAdd(qw, 1u);
              att::sb_unit(uidx & 15, 63 - (uidx >> 4), SBQ, SBK, SBV, OCAT, lds);
              if (tid == 0) qslot[0] = (int)nx;
              __syncthreads();
              uidx = qslot[0];
              __syncthreads();
          } }
        SEAM(3);
#if DBG_CHECK & 1
        dbg_check_a(args, lds, ctl, bx, G);
#endif
    }
    if (IN(4)) REP(4) {
        pg8::Gemm g{OCAT, (const bf16*)(ws + W_O0), T, 1024, 1024}; pg8::StaticOrder S; S.init(T, 1024, G, bx);
        EpiRes<true> E{args.in[I_X], X1B, PS1}; pg8::gemm_phase<EpiRes<true>, pg8::StaticOrder, true, true>(lds, g, S, E);
        SEAM(4);
    }
    if (IN(5)) REP(5) {
        pg8::Gemm g{X1B, (const bf16*)(ws + W_GU0), T, 4096, 1024}; pg8::StaticOrder S; S.init(T, 4096, G, bx);
        EpiSwiGLU E{HID, 2048, 16, PS1, nullptr}; pg8::gemm_phase<EpiSwiGLU, pg8::StaticOrder, true, true>(lds, g, S, E);
        SEAM(5);
    }
    if (IN(6)) REP(6) {
        pg8::Gemm g{HID, (const bf16*)(ws + W_DN0), T, 1024, 2048}; pg8::StaticOrder S; S.init(T, 1024, G, bx);
        EpiRes<false> E{X1B, X2B, PS2}; pg8::gemm_phase<EpiRes<false>, pg8::StaticOrder, true, true>(lds, g, S, E);
        SEAM(6);
    }
    if (IN(7)) REP(7) {
        pg8::Gemm g{X2B, (const bf16*)(ws + W_QKV), T, 3072, 1024}; pg8::StaticOrder S; S.init(T, 3072, G, bx);
        EpiQkv E{Q2, PS2, KMP}; pg8::gemm_phase<EpiQkv, pg8::StaticOrder, true, true>(lds, g, S, E);
        SEAM(7);
    }
    if (IN(8)) REP(8) {
        for (int v = vcu; v < 256; v += G) att::moba_gate_unit(v & 31, v >> 5, Q2, KMP, SEL, (unsigned*)(ws + WS_MASK), lds);
        SEAM(8);
    }
    if (IN(9)) REP(9) {
        volatile LAS int* qslot = (volatile LAS int*)(lds + att::MB_OFF_Q);
        if (tid == 0) qslot[0] = (int)atomicAdd(ctl + CW_QUEUE + 64 * rep_, 1u);
        __syncthreads();
        int uidx = qslot[0];
        __syncthreads();
        while (uidx < 64 * 32) {
            unsigned nx = 0u; if (tid == 0) nx = atomicAdd(ctl + CW_QUEUE + 64 * rep_, 1u);
            att::moba_sel_unit(uidx & 31, uidx >> 5, Q2, K2, V2, (const unsigned long long*)(ws + WS_MASK), args.in[I_RELB], (bf16*)(ws + WS_PO0), (bf16*)(ws + WS_PO1), (bf16*)(ws + WS_PO2), PO3, PMS, lds);
            if (tid == 0) qslot[0] = (int)nx;
            __syncthreads();
            uidx = qslot[0];
            __syncthreads();
        }
        SEAM(9);
#if DBG_CHECK & 2
        dbg_check_b(args, lds, ctl, bx, G, O2); GRID_BAR();
#endif
    }
    if (IN(10)) REP(10) {
        att::moba_merge(vcu * 8 + wave, G * 8, SEL, (const bf16*)(ws + WS_PO0), (const bf16*)(ws + WS_PO1), (const bf16*)(ws + WS_PO2), PO3, PMS, O2);
        SEAM(10);
#if DBG_CHECK & 2
        dbg_check_b2(args, lds, ctl, bx, G, O2);
#endif
    }
    if (IN(11)) REP(11) {
        pg8::Gemm g{O2, (const bf16*)(ws + W_O1), T, 1024, 1024}; pg8::StaticOrder S; S.init(T, 1024, G, bx);
        EpiRes<false> E{X2B, X3B, PS3}; pg8::gemm_phase<EpiRes<false>, pg8::StaticOrder, true, true>(lds, g, S, E);
        SEAM(11);
    }
    if (IN(12)) REP(12) {
        { const f32x4* wrt = (const f32x4*)(ws + WS_WRT); f32x4 t_[4];
#pragma unroll
          for (int i = 0; i < 4; ++i) t_[i] = wrt[tid + 512 * i];
#pragma unroll
          for (int i = 0; i < 4; ++i) ((LAS f32x4*)lds)[tid + 512 * i] = t_[i]; }
        __syncthreads();
        for (int ch = bx; ch < 256; ch += G) router_chunk(args, ch, lds);
        SEAM(12);
    }
    if (IN(13)) REP(13) { permute_phase(args, lds, G); SEAM(13); }
    if (IN(14)) REP(14) {
        const int nrt = (int)ctl[CW_NRT];
        pg8::Gemm g{X3B, (const bf16*)(ws + W_EGU), NSLOT, 8192, 1024, (const int*)(ws + WS_STOK)}; MoeOrder S{(const int*)(ws + WS_TILEE), nrt, G, bx};
        EpiSwiGLU E{HIDE, 512, 4, nullptr, (const float*)(ws + WS_SRS)}; pg8::gemm_phase<EpiSwiGLU, MoeOrder, true, true, true>(lds, g, S, E);
        SEAM(14);
    }
    if (IN(15)) REP(15) {
        const int nrt = (int)ctl[CW_NRT];
        pg8::Gemm g{HIDE, (const bf16*)(ws + W_EDN), NSLOT, 8192, 512}; MoeOrder S{(const int*)(ws + WS_TILEE), nrt, G, bx};
        EpiMoeDown E{YP, (const int*)(ws + WS_SDST), (const float*)(ws + WS_SW)}; pg8::gemm_phase<EpiMoeDown, MoeOrder, true, true>(lds, g, S, E);
        SEAM(15);
    }
    if (IN(16)) REP(16) {
        float oscale = 1.f;
#if DBG_CHECK
        oscale = 1.f + 0.25f * (float)__hip_atomic_load(ctl + CW_ERR, __ATOMIC_RELAXED, __HIP_MEMORY_SCOPE_AGENT);
#endif
        final_phase(args, vcu, G, oscale);
#if defined(PROBE_DUP) && ((PROBE_DUP >> 21) & 1)
        if (bx == ((PROBE_DUP >> 22) & 0xFF)) { const unsigned long long t0_ = __builtin_amdgcn_s_memrealtime(); while (__builtin_amdgcn_s_memrealtime() - t0_ < 4ull * prb_wait_) __builtin_amdgcn_s_sleep(8); }
#endif
#if MK_ONE_LAUNCH
        if (bx == 0 && tid == 0) { if (__hip_atomic_load(ctl + CW_BAR + XB_TMO, __ATOMIC_RELAXED, __HIP_MEMORY_SCOPE_AGENT) != 0u) args.out[0] = __builtin_nanf(""); }
#endif
    }
#undef IN
#undef SEAM
}

extern "C" void kernel_launch(void* const* d_in, const int* in_sizes, int n_in, void* d_out, int out_size, void* d_ws, size_t ws_size, hipStream_t stream) {
    static int grid = 0;
    if (grid == 0) {
        if (n_in != 22 || in_sizes[0] != T * DM || out_size != T * DM || ws_size < WS_NEED) { fprintf(stderr, "kernel_launch: unexpected shapes (n_in %d, in0 %d, out %d, ws %zu < %zu); nothing launched\n", n_in, n_in > 0 ? in_sizes[0] : -1, out_size, ws_size, (size_t)WS_NEED); grid = -1; return; }
        int dev = 0, cus = 0, per_cu = 0;
        if (hipGetDevice(&dev) != hipSuccess || hipDeviceGetAttribute(&cus, hipDeviceAttributeMultiprocessorCount, dev) != hipSuccess) { grid = -1; return; }
        if (hipFuncSetAttribute((const void*)hybrid_fwd, hipFuncAttributeMaxDynamicSharedMemorySize, LDS_BYTES) != hipSuccess) { fprintf(stderr, "kernel_launch: hipFuncSetAttribute failed\n"); grid = -1; return; }
        if (hipOccupancyMaxActiveBlocksPerMultiprocessor(&per_cu, (const void*)hybrid_fwd, 512, LDS_BYTES) != hipSuccess || per_cu < 1) fprintf(stderr, "kernel_launch: occupancy query reports %d workgroups per CU\n", per_cu);
        (void)hipGetLastError();
        grid = cus;
    }
    if (grid < 0) return;
    if (hipMemsetAsync((char*)d_ws + WS_CTL, 0, CTL_ZERO_BYTES, stream) != hipSuccess) return;
    Args a{};
    for (int i = 0; i < 22; ++i) a.in[i] = (const float*)d_in[i];
    a.out = (float*)d_out; a.ws = (unsigned char*)d_ws;
#if MK_ONE_LAUNCH
    a.ph_lo = 0; a.ph_hi = NPH;
    hipLaunchKernelGGL(hybrid_fwd, dim3(grid), dim3(512), LDS_BYTES, stream, a);
#else
    for (int p = 0; p < NPH; ++p) { a.ph_lo = p; a.ph_hi = p + 1; hipLaunchKernelGGL(hybrid_fwd, dim3(grid), dim3(512), LDS_BYTES, stream, a); }
#endif
}
```

```cpp
#include <hip/hip_runtime.h>
#include <cstdio>
#include <cstdint>
#ifndef MK_ONE_LAUNCH
#define MK_ONE_LAUNCH 1
#endif
#ifndef PROBE_SEAMS
#define PROBE_SEAMS 0xFFFFF
#endif
#ifndef PROBE_DUP
#define PROBE_DUP 0
#endif
namespace pg8 {
#define PG8_LAS __attribute__((address_space(3)))
typedef unsigned short bf16_t;
typedef short bf16x8 __attribute__((ext_vector_type(8)));
typedef float f32x4 __attribute__((ext_vector_type(4)));
typedef unsigned u32x4 __attribute__((ext_vector_type(4)));
constexpr int BM = 256, BK = 64, HALF = 128, HTB = HALF * BK * 2  , STAGE_BYTES = 8 * HTB, NXCD = 8, WGM = 8;

__host__ __device__ __forceinline__ int lds_byte(int r, int c) { const int st = (r >> 4) * 2 + (c >> 5), rr = r & 15, cc = c & 31, ob = rr * 64 + cc * 2; return st * 1024 + (ob ^ (((ob >> 9) & 1) << 5)); }
__host__ __device__ __forceinline__ void stage_rc(int b, int& R, int& C) { const int st = b / 1024, sb = b % 1024, swz = sb ^ (((sb >> 9) & 1) << 5); R = (st >> 1) * 16 + swz / 64; C = (st & 1) * 32 + (swz % 64) / 2; }
__host__ __device__ __forceinline__ int perm32(int rho) { const int n = rho >> 4, i = rho & 15; return 8 * (i >> 2) + 4 * n + (i & 3); }

struct Unit { int pm, pn; };
struct Gemm { const bf16_t* A; const bf16_t* Bt; int M, N, K; const int* aidx; };

struct StaticOrder {
    int nM, nN, nwg, G, c;
    __host__ __device__ void init(int M, int N, int G_, int c_) { nM = M / BM; nN = N / BM; nwg = nM * nN; G = G_; c = c_; }
    __host__ __device__ bool next(int i, Unit& u) const {
        const long L = (long)i * G + c; if (L >= nwg) return false;
        int wgid = (int)L; { const int q = nwg / NXCD, r = nwg % NXCD, xcd = wgid % NXCD, off = wgid / NXCD; wgid = (xcd < r ? xcd * (q + 1) : r * (q + 1) + (xcd - r) * q) + off; }
        const int nig = WGM * nN, gid = wgid / nig, fm = gid * WGM, gsz = (nM - fm) < WGM ? (nM - fm) : WGM;
        u.pm = fm + ((wgid % nig) % gsz); u.pn = (wgid % nig) / gsz; return true;
    }
    __device__ __forceinline__ void a_ready(const Unit&) const {}
    __device__ __forceinline__ void done(const Unit&) const {}
};

__device__ __forceinline__ unsigned cvt_pk_bf16(float lo, float hi) { unsigned r; asm volatile("v_cvt_pk_bf16_f32 %0, %1, %2" : "=v"(r) : "v"(lo), "v"(hi)); return r; }
typedef float f32x2 __attribute__((ext_vector_type(2)));
template <class Epi, class Sched, bool ALIGN_EPI = false, bool SP2 = false, bool GATHER = false>
__device__ __forceinline__ void gemm_phase(PG8_LAS unsigned char* lds, const Gemm g, const Sched& S, const Epi& E) {
    static_assert(!GATHER || SP2, "the gather A path is wired into the two-super-phase loop only");
    int tid_ = threadIdx.x; asm volatile("" : "+v"(tid_));
    const int tid = tid_, wid = __builtin_amdgcn_readfirstlane(tid >> 6), lane = tid & 63, wr = wid >> 2, wc = wid & 3, fr = lane & 15, fq = lane >> 4;
    const int K = g.K, nt = K / BK;
    unsigned voffA[2], voffB[2];
#pragma unroll
    for (int i = 0; i < 2; ++i) { int R, C; stage_rc(tid * 16 + i * 8192, R, C); const int Rb = Epi::PERM ? ((R & ~31) + perm32(R & 31)) : R;
        voffA[i] = (unsigned)(R * K + C) * 2u; voffB[i] = (unsigned)(Rb * K + C) * 2u; }
    unsigned gA[2][2] = {{0u, 0u}, {0u, 0u}}, gN[2][2] = {{0u, 0u}, {0u, 0u}}; int gR[2] = {0, 0}, gC[2] = {0, 0};
    if constexpr (GATHER) {
#pragma unroll
        for (int i = 0; i < 2; ++i) stage_rc(tid * 16 + i * 8192, gR[i], gC[i]); }
#define PG8_GIDX(dst, pm) do { _Pragma("unroll") for (int _h = 0; _h < 2; ++_h) _Pragma("unroll") for (int _i = 0; _i < 2; ++_i) \
        dst[_h][_i] = (unsigned)(g.aidx[(pm) * BM + _h * HALF + gR[_i]] * K + gC[_i]) * 2u; } while (0)
    const size_t kstep = (size_t)(BK * 2);
    const size_t hstep = (size_t)HALF * K * 2;
    const size_t tstep = 2 * hstep;
    const unsigned ldsw = (unsigned)wid * 1024u;
    const int aoff = lds_byte(wr * 64 + fr, fq * 8), boff = lds_byte(wc * 32 + fr, fq * 8);
#define PG8_SA(b, h) (((b) * 2 + (h)) * HTB)
#define PG8_SB(b, h) ((4 + (b) * 2 + (h)) * HTB)
#define PG8_STAGE(bufoff, gbase, voff) do { _Pragma("unroll") for (int _i = 0; _i < 2; ++_i) \
        __builtin_amdgcn_global_load_lds((const unsigned*)((const char*)(gbase) + (voff)[_i]), (PG8_LAS unsigned*)(lds + (bufoff) + ldsw + _i * 8192), 16, 0, 0); } while (0)
#define PG8_STAGE_A(bufoff, gbase, hh, nx) do { if constexpr (GATHER) { _Pragma("unroll") for (int _i = 0; _i < 2; ++_i) \
        __builtin_amdgcn_global_load_lds((const unsigned*)((const char*)(gbase) + ((nx) ? gN[hh][_i] : gA[hh][_i])), (PG8_LAS unsigned*)(lds + (bufoff) + ldsw + _i * 8192), 16, 0, 0); } \
    else { PG8_STAGE(bufoff, (gbase) + (hh) * hstep, voffA); } } while (0)
#define PG8_LDA(dst, b, h) do { _Pragma("unroll") for (int m = 0; m < 4; ++m) _Pragma("unroll") for (int k = 0; k < 2; ++k) dst[m][k] = *(const PG8_LAS bf16x8*)(lds + PG8_SA(b, h) + aoff + m * 2048 + k * 1024); } while (0)
#define PG8_LDB(dst, b, h) do { _Pragma("unroll") for (int n = 0; n < 2; ++n) _Pragma("unroll") for (int k = 0; k < 2; ++k) dst[n][k] = *(const PG8_LAS bf16x8*)(lds + PG8_SB(b, h) + boff + n * 2048 + k * 1024); } while (0)
#define PG8_MMA(ai, bj, At, Bt) do { __builtin_amdgcn_s_setprio(1); _Pragma("unroll") for (int m = 0; m < 4; ++m) _Pragma("unroll") for (int n = 0; n < 2; ++n) _Pragma("unroll") for (int k = 0; k < 2; ++k) \
        acc[ai][bj][m][n] = __builtin_amdgcn_mfma_f32_16x16x32_bf16(Bt[n][k], At[m][k], acc[ai][bj][m][n], 0, 0, 0); __builtin_amdgcn_s_setprio(0); } while (0)
#define PG8_WAIT_V(n) asm volatile("s_waitcnt vmcnt(" #n ")" ::: "memory")
#define PG8_WAIT_L(n) asm volatile("s_waitcnt lgkmcnt(" #n ")" ::: "memory")
#define PG8_BAR __builtin_amdgcn_s_barrier()
#define PG8_SCHED __builtin_amdgcn_sched_barrier(0)
    Unit cur, nxt; int ui = 0;
    if (!S.next(0, cur)) return;
    f32x4 acc[2][2][4][2];
#pragma unroll
    for (int a = 0; a < 2; ++a)
#pragma unroll
        for (int b = 0; b < 2; ++b)
#pragma unroll
            for (int m = 0; m < 4; ++m)
#pragma unroll
                for (int n = 0; n < 2; ++n) acc[a][b][m][n] = (f32x4){0.f, 0.f, 0.f, 0.f};
    bf16x8 At[4][2], B0[2][2], B1[2][2];
    const char* cA = GATHER ? (const char*)g.A : (const char*)g.A + (size_t)cur.pm * tstep; const char* cB = (const char*)g.Bt + (size_t)cur.pn * tstep;
    if constexpr (GATHER) { PG8_GIDX(gA, cur.pm); }
    S.a_ready(cur);
    if constexpr (SP2) {
        PG8_STAGE(PG8_SB(0, 0), cB, voffB); PG8_STAGE(PG8_SB(0, 1), cB + hstep, voffB); PG8_STAGE_A(PG8_SA(0, 0), cA, 0, false); PG8_STAGE_A(PG8_SA(0, 1), cA, 1, false);
        if (wr == 1) PG8_BAR;
        PG8_WAIT_V(2); PG8_BAR;
        PG8_STAGE(PG8_SB(1, 0), cB + kstep, voffB); PG8_STAGE_A(PG8_SA(1, 0), cA + kstep, 0, false); PG8_STAGE(PG8_SB(1, 1), cB + hstep + kstep, voffB);
        PG8_WAIT_V(6); PG8_BAR;
    } else {
        PG8_STAGE(PG8_SB(0, 0), cB, voffB); PG8_STAGE(PG8_SA(0, 0), cA, voffA); PG8_STAGE(PG8_SB(0, 1), cB + hstep, voffB); PG8_STAGE(PG8_SA(0, 1), cA + hstep, voffA);
        if (wr == 1) PG8_BAR;
        PG8_WAIT_V(4); PG8_BAR;
        PG8_STAGE(PG8_SB(1, 0), cB + kstep, voffB); PG8_STAGE(PG8_SA(1, 0), cA + kstep, voffA); PG8_STAGE(PG8_SB(1, 1), cB + hstep + kstep, voffB);
        PG8_WAIT_V(6); PG8_BAR;
    }
    for (;;) {
        const bool has_next = S.next(ui + 1, nxt);
        const char* nA = GATHER ? (const char*)g.A : (has_next ? (const char*)g.A + (size_t)nxt.pm * tstep : cA); const char* nB = has_next ? (const char*)g.Bt + (size_t)nxt.pn * tstep : cB;
        if constexpr (GATHER) { if (has_next) { PG8_GIDX(gN, nxt.pm); } else { _Pragma("unroll") for (int _h = 0; _h < 2; ++_h) _Pragma("unroll") for (int _i = 0; _i < 2; ++_i) gN[_h][_i] = gA[_h][_i]; } }
#pragma unroll 1
        for (int t = 0; t < nt; t += 2) {
            const bool last = (t == nt - 2);
            const char* a1 = cA + (size_t)(t + 1) * kstep;
            const char* a2 = last ? nA : cA + (size_t)(t + 2) * kstep; const char* b2 = last ? nB : cB + (size_t)(t + 2) * kstep;
            const char* a3 = a2 + kstep; const char* b3 = b2 + kstep;
            if (last && has_next) S.a_ready(nxt);
            if constexpr (SP2) {
            PG8_LDB(B0, 0, 0); PG8_LDB(B1, 0, 1); PG8_SCHED; PG8_LDA(At, 0, 0); PG8_STAGE_A(PG8_SA(1, 1), a1, 1, false);
            PG8_WAIT_V(8); PG8_WAIT_L(0); PG8_BAR; PG8_MMA(0, 0, At, B0); PG8_MMA(0, 1, At, B1); PG8_BAR; PG8_SCHED;
            PG8_LDA(At, 0, 1); PG8_STAGE(PG8_SB(0, 0), b2, voffB); PG8_STAGE(PG8_SB(0, 1), b2 + hstep, voffB); PG8_STAGE_A(PG8_SA(0, 0), a2, 0, last);
            PG8_WAIT_V(8); PG8_WAIT_L(0); PG8_BAR; PG8_MMA(1, 0, At, B0); PG8_MMA(1, 1, At, B1); PG8_BAR; PG8_SCHED;
            PG8_LDB(B0, 1, 0); PG8_LDB(B1, 1, 1); PG8_SCHED; PG8_LDA(At, 1, 0); PG8_STAGE_A(PG8_SA(0, 1), a2, 1, last);
            PG8_WAIT_V(8); PG8_WAIT_L(0); PG8_BAR; PG8_MMA(0, 0, At, B0); PG8_MMA(0, 1, At, B1); PG8_BAR; PG8_SCHED;
            PG8_LDA(At, 1, 1); PG8_STAGE(PG8_SB(1, 0), b3, voffB); PG8_STAGE(PG8_SB(1, 1), b3 + hstep, voffB); PG8_STAGE_A(PG8_SA(1, 0), a3, 0, last);
            PG8_WAIT_V(8); PG8_WAIT_L(0); PG8_BAR; PG8_MMA(1, 0, At, B0); PG8_MMA(1, 1, At, B1); PG8_BAR; PG8_SCHED;
            } else {
            PG8_LDB(B0, 0, 0); PG8_SCHED; PG8_LDA(At, 0, 0); PG8_STAGE(PG8_SA(1, 1), a1 + hstep, voffA);
            PG8_WAIT_L(8); PG8_BAR; PG8_WAIT_L(0); PG8_MMA(0, 0, At, B0); PG8_BAR; PG8_SCHED;
            PG8_LDB(B1, 0, 1); PG8_STAGE(PG8_SB(0, 0), b2, voffB);
            PG8_BAR; PG8_WAIT_L(0); PG8_MMA(0, 1, At, B1); PG8_BAR;
            PG8_LDA(At, 0, 1); PG8_STAGE(PG8_SA(0, 0), a2, voffA);
            PG8_BAR; PG8_WAIT_L(0); PG8_MMA(1, 0, At, B0); PG8_BAR; PG8_SCHED;
            PG8_STAGE(PG8_SB(0, 1), b2 + hstep, voffB);
            PG8_WAIT_V(6); PG8_BAR; PG8_MMA(1, 1, At, B1); PG8_BAR;
            PG8_LDB(B0, 1, 0); PG8_SCHED; PG8_LDA(At, 1, 0); PG8_STAGE(PG8_SA(0, 1), a2 + hstep, voffA);
            PG8_WAIT_L(8); PG8_BAR; PG8_WAIT_L(0); PG8_MMA(0, 0, At, B0); PG8_BAR; PG8_SCHED;
            PG8_LDB(B1, 1, 1); PG8_STAGE(PG8_SB(1, 0), b3, voffB);
            PG8_BAR; PG8_WAIT_L(0); PG8_MMA(0, 1, At, B1); PG8_BAR;
            PG8_LDA(At, 1, 1); PG8_STAGE(PG8_SA(1, 0), a3, voffA);
            PG8_BAR; PG8_WAIT_L(0); PG8_MMA(1, 0, At, B0); PG8_BAR; PG8_SCHED;
            PG8_STAGE(PG8_SB(1, 1), b3 + hstep, voffB);
            PG8_WAIT_V(6); PG8_BAR; PG8_MMA(1, 1, At, B1); PG8_BAR;
            }
        }
        if constexpr (ALIGN_EPI) { if (wr == 0) PG8_BAR; }
        if constexpr (!Epi::AFTER_DRAIN) { E(acc, cur, wr, wc, fr, fq); S.done(cur); }
        if (!has_next) break;
#pragma unroll
        for (int a = 0; a < 2; ++a)
#pragma unroll
            for (int b = 0; b < 2; ++b)
#pragma unroll
                for (int m = 0; m < 4; ++m)
#pragma unroll
                    for (int n = 0; n < 2; ++n) acc[a][b][m][n] = (f32x4){0.f, 0.f, 0.f, 0.f};
        cur = nxt; cA = nA; cB = nB; ++ui;
        if constexpr (GATHER) { _Pragma("unroll") for (int _h = 0; _h < 2; ++_h) _Pragma("unroll") for (int _i = 0; _i < 2; ++_i) gA[_h][_i] = gN[_h][_i]; }
        if constexpr (ALIGN_EPI) { if (wr == 1) PG8_BAR; }
    }
    PG8_WAIT_V(0);
    if constexpr (!ALIGN_EPI) { if (wr == 0) PG8_BAR; }
    PG8_BAR;
    if constexpr (Epi::AFTER_DRAIN) { E.fused(acc, cur, wr, wc, fr, fq, lds, wid, lane); S.done(cur); }
#undef PG8_SA
#undef PG8_SB
#undef PG8_STAGE
#undef PG8_STAGE_A
#undef PG8_GIDX
#undef PG8_LDA
#undef PG8_LDB
#undef PG8_MMA
#undef PG8_WAIT_V
#undef PG8_WAIT_L
#undef PG8_BAR
#undef PG8_SCHED
}
}

#define DI __device__ __forceinline__
#define LAS __attribute__((address_space(3)))
#define GAS __attribute__((address_space(1)))
typedef unsigned short bf16;
constexpr int BATCH = 2, SEQ = 16384, T = BATCH * SEQ, DM = 1024;
constexpr float LOG2E = 1.4426950408889634f;
constexpr float RMS_EPS = 1e-6f;
DI int rfl(int v) { return __builtin_amdgcn_readfirstlane(v); }
DI float bflo(unsigned w) { return __uint_as_float(w << 16); }
DI float bfhi(unsigned w) { return __uint_as_float(w & 0xffff0000u); }
typedef float f32x2_t __attribute__((ext_vector_type(2))); typedef __bf16 bf16x2_t __attribute__((ext_vector_type(2)));
DI unsigned cvtpk(float lo, float hi) { f32x2_t v = {lo, hi}; bf16x2_t b = __builtin_convertvector(v, bf16x2_t); return __builtin_bit_cast(unsigned, b); }
typedef float f32x4 __attribute__((ext_vector_type(4)));
typedef unsigned v4u __attribute__((ext_vector_type(4)));
DI float ex2(float x) { return __builtin_amdgcn_exp2f(x); }
DI float lg2(float x) { return __builtin_amdgcn_logf(x); }
DI float wave_sum(float v) {
#pragma unroll
    for (int o = 1; o < 64; o <<= 1) v += __shfl_xor(v, o);
    return v;
}

namespace att {
typedef short bf16x8 __attribute__((ext_vector_type(8)));
typedef short s16x4 __attribute__((ext_vector_type(4)));
typedef float f32x16 __attribute__((ext_vector_type(16)));
typedef unsigned u32x4 __attribute__((ext_vector_type(4)));
typedef LAS const char* lcp;
typedef short v4i16_t __attribute__((ext_vector_type(4)));
DI int crow(int r, int hi) { return (r & 3) + 8 * (r >> 2) + 4 * hi; }
DI void glds16(const void* gsrc, unsigned lds_dst) { unsigned keep;
    asm volatile("s_mov_b32 %0, m0\n\ts_mov_b32 m0, %2\n\ts_nop 0\n\tglobal_load_lds_dwordx4 %1, off\n\ts_mov_b32 m0, %0" : "=&s"(keep) : "v"(gsrc), "s"(lds_dst) : "memory"); }
#define ATT_WAITV_BAR() asm volatile("s_waitcnt vmcnt(0) lgkmcnt(0)\n\ts_barrier" ::: "memory")
#define ATT_BAR() asm volatile("s_waitcnt lgkmcnt(0)\n\ts_barrier" ::: "memory")
#define WAVE_LDS_SYNC() asm volatile("" ::: "memory")
DI s16x4 vtr(lcp p) { return __builtin_bit_cast(s16x4, __builtin_amdgcn_ds_read_tr16_b64_v4i16((LAS v4i16_t*)p)); }
DI float hmax(float x) { auto rr = __builtin_amdgcn_permlane32_swap(__float_as_uint(x), __float_as_uint(x), false, false); return fmaxf(__uint_as_float(rr[0]), __uint_as_float(rr[1])); }
DI float hsum(float x) { auto rr = __builtin_amdgcn_permlane32_swap(__float_as_uint(x), __float_as_uint(x), false, false); return __uint_as_float(rr[0]) + __uint_as_float(rr[1]); }

template <int NK> DI void qk_tile(f32x16& p0, f32x16& p1, lcp kfr, const bf16x8* qr) {
    f32x16 z;
#pragma unroll
    for (int r = 0; r < 16; ++r) z[r] = 0.f;
    p0 = z; p1 = z;
    bf16x8 kf[2 * NK];
#pragma unroll
    for (int d0 = 0; d0 < NK; ++d0) { kf[2 * d0] = *(const LAS bf16x8*)(kfr + d0 * 2048); kf[2 * d0 + 1] = *(const LAS bf16x8*)(kfr + d0 * 2048 + 512); }
    __builtin_amdgcn_sched_barrier(0);
#pragma unroll
    for (int d0 = 0; d0 < NK; ++d0) { p0 = __builtin_amdgcn_mfma_f32_32x32x16_bf16(kf[2 * d0], qr[d0], p0, 0, 0, 0); p1 = __builtin_amdgcn_mfma_f32_32x32x16_bf16(kf[2 * d0 + 1], qr[d0], p1, 0, 0, 0); }
    __builtin_amdgcn_sched_barrier(0);
}
DI void pv_tile(f32x16* o, lcp vfr, const f32x16& p0, const f32x16& p1) {
    u32x4 pw[4];
    pw[0] = (u32x4){cvtpk(p0[0], p0[1]), cvtpk(p0[2], p0[3]), cvtpk(p0[4], p0[5]), cvtpk(p0[6], p0[7])};
    pw[1] = (u32x4){cvtpk(p0[8], p0[9]), cvtpk(p0[10], p0[11]), cvtpk(p0[12], p0[13]), cvtpk(p0[14], p0[15])};
    pw[2] = (u32x4){cvtpk(p1[0], p1[1]), cvtpk(p1[2], p1[3]), cvtpk(p1[4], p1[5]), cvtpk(p1[6], p1[7])};
    pw[3] = (u32x4){cvtpk(p1[8], p1[9]), cvtpk(p1[10], p1[11]), cvtpk(p1[12], p1[13]), cvtpk(p1[14], p1[15])};
#pragma unroll
    for (int d0 = 0; d0 < 2; ++d0) {
        s16x4 lo[4], hh[4];
#pragma unroll
        for (int ks = 0; ks < 4; ++ks) { lo[ks] = vtr(vfr + d0 * 4096 + ks * 1024); hh[ks] = vtr(vfr + d0 * 4096 + ks * 1024 + 512); }
        __builtin_amdgcn_sched_barrier(0);
#pragma unroll
        for (int ks = 0; ks < 4; ++ks) { const bf16x8 vf = (bf16x8){lo[ks][0], lo[ks][1], lo[ks][2], lo[ks][3], hh[ks][0], hh[ks][1], hh[ks][2], hh[ks][3]};
            o[d0] = __builtin_amdgcn_mfma_f32_32x32x16_bf16(__builtin_bit_cast(bf16x8, pw[ks]), vf, o[d0], 0, 0, 0); }
        __builtin_amdgcn_sched_barrier(0);
    }
}
DI void smax_update(f32x16& p0, f32x16& p1, float& mref, float& lsum, f32x16* o, LAS float* wsf, int r32, int hi) {
    float rm = fmaxf(p0[0], p1[0]);
#pragma unroll
    for (int r = 1; r < 16; ++r) rm = fmaxf(rm, fmaxf(p0[r], p1[r]));
    rm = hmax(rm);
    if (__any(rm > mref + 8.f)) {
        const float mnew = fmaxf(mref, rm);
        const float alpha = (mnew == mref) ? 1.f : ex2(mref - mnew);
        lsum *= alpha; mref = mnew;
        if (hi == 0) wsf[r32] = alpha;
        WAVE_LDS_SYNC();
#pragma unroll
        for (int r = 0; r < 16; ++r) { const float a = wsf[crow(r, hi)]; o[0][r] *= a; o[1][r] *= a; }
        WAVE_LDS_SYNC();
    }
    float s = 0.f;
#pragma unroll
    for (int r = 0; r < 16; ++r) { p0[r] = ex2(p0[r] - mref); p1[r] = ex2(p1[r] - mref); s += p0[r] + p1[r]; }
    lsum += s;
}
DI void stage_o(const f32x16* o, LAS bf16* stg, const LAS float* rowscale, int r32, int hi) {
    WAVE_LDS_SYNC();
#pragma unroll
    for (int r = 0; r < 16; ++r) { const int orow = crow(r, hi); const float sc = rowscale ? rowscale[orow] : 1.f;
        const unsigned a = cvtpk(o[0][r] * sc, o[1][r] * sc);
        stg[orow * 64 + r32] = (bf16)(a & 0xffffu); stg[orow * 64 + 32 + r32] = (bf16)(a >> 16); }
    WAVE_LDS_SYNC();
}

constexpr int MLA_KSLOT = 12288, VSLOT = 8192;
constexpr int MLA_OFF_V = 3 * MLA_KSLOT, MLA_OFF_WS = MLA_OFF_V + 3 * VSLOT, MLA_OFF_ST = MLA_OFF_WS + 8 * 256, MLA_LDS = MLA_OFF_ST + 8 * 4096;
template <int NK> DI void qk_tile_ref(f32x16& p0, f32x16& p1, lcp kfr, const bf16x8* qr, const f32x16& negm) {
    p0 = negm; p1 = negm;
    constexpr int H = NK / 2;
#pragma unroll
    for (int hb = 0; hb < 2; ++hb) {
        bf16x8 kf[2 * H];
#pragma unroll
        for (int d = 0; d < H; ++d) { const int d0 = hb * H + d; kf[2 * d] = *(const LAS bf16x8*)(kfr + d0 * 2048); kf[2 * d + 1] = *(const LAS bf16x8*)(kfr + d0 * 2048 + 512); }
        __builtin_amdgcn_sched_barrier(0);
#pragma unroll
        for (int d = 0; d < H; ++d) { const int d0 = hb * H + d; p0 = __builtin_amdgcn_mfma_f32_32x32x16_bf16(kf[2 * d], qr[d0], p0, 0, 0, 0); p1 = __builtin_amdgcn_mfma_f32_32x32x16_bf16(kf[2 * d + 1], qr[d0], p1, 0, 0, 0); }
        __builtin_amdgcn_sched_barrier(0);
    }
}
DI void smax_update_ref(f32x16& p0, f32x16& p1, float& mref, f32x16& negm, float& lsum, f32x16* o, LAS float* wsf, int r32, int hi, bool first) {
    float ra = __builtin_fmaxf(__builtin_fmaxf(p0[0], p0[1]), p1[0]), rb = __builtin_fmaxf(__builtin_fmaxf(p0[2], p0[3]), p1[1]);
    ra = __builtin_fmaxf(__builtin_fmaxf(ra, p1[2]), p1[3]);
#pragma unroll
    for (int r = 4; r < 16; r += 4) { ra = __builtin_fmaxf(__builtin_fmaxf(ra, p0[r]), p0[r + 1]); rb = __builtin_fmaxf(__builtin_fmaxf(rb, p0[r + 2]), p0[r + 3]);
        ra = __builtin_fmaxf(__builtin_fmaxf(ra, p1[r]), p1[r + 1]); rb = __builtin_fmaxf(__builtin_fmaxf(rb, p1[r + 2]), p1[r + 3]); }
    const float rm = hmax(fmaxf(ra, rb));
    if (first || __any(rm > 8.f)) {
        const float dl = first ? rm : fmaxf(rm, 0.f);
        mref += dl;
#pragma unroll
        for (int r = 0; r < 16; ++r) { p0[r] -= dl; p1[r] -= dl; }
#pragma unroll
        for (int r = 0; r < 16; ++r) negm[r] = -mref;
        if (!first) { const float alpha = ex2(-dl); lsum *= alpha;
            if (hi == 0) wsf[r32] = alpha;
            WAVE_LDS_SYNC();
#pragma unroll
            for (int r = 0; r < 16; ++r) { const float a = wsf[crow(r, hi)]; o[0][r] *= a; o[1][r] *= a; }
            WAVE_LDS_SYNC(); }
    }
    float s = 0.f;
#pragma unroll
    for (int r = 0; r < 16; ++r) { p0[r] = ex2(p0[r]); p1[r] = ex2(p1[r]); s += p0[r] + p1[r]; }
    lsum += s;
}
DI void mla_unit(int bh, int qb, const bf16* QA, const bf16* KN, const bf16* KR, const bf16* VA, bf16* OC, LAS unsigned char* lds) {
    int tid_ = threadIdx.x; asm volatile("" : "+v"(tid_));
    const int tid = tid_, lane = tid & 63, r32 = lane & 31, hi = lane >> 5, wid = rfl(tid >> 6);
    const int b = bh >> 3, h = bh & 7; const long rowbase = (long)b * SEQ; const int q0 = qb * 256;
    const unsigned lds0 = (unsigned)(size_t)lds;
    LAS float* wsf = (LAS float*)(lds + MLA_OFF_WS) + wid * 64;
    LAS bf16* stg = (LAS bf16*)(lds + MLA_OFF_ST) + wid * 2048;
    const bf16* ksrc = KN + (rowbase + lane) * 512 + h * 64 + wid * 8;
    const bf16* rsrc = KR + (rowbase + lane) * 32 + (wid & 3) * 8;
    const bf16* vsrc = VA + (rowbase + 16 * (wid & 3) + (lane >> 2)) * 512 + h * 64 + (wid >> 2) * 32 + (lane & 3) * 8;
#define MLA_DMA_K(t, s) do { glds16(ksrc + (long)(t) * 64 * 512, (unsigned)rfl((int)(lds0 + (s) * MLA_KSLOT + wid * 1024))); \
        if (wid < 4) glds16(rsrc + (long)(t) * 64 * 32, (unsigned)rfl((int)(lds0 + (s) * MLA_KSLOT + (8 + wid) * 1024))); } while (0)
#define MLA_DMA_V(t, s) glds16(vsrc + (long)(t) * 64 * 512, (unsigned)rfl((int)(lds0 + MLA_OFF_V + (s) * VSLOT + wid * 1024)))
    const bf16* qp = QA + (rowbase + q0 + wid * 32 + r32) * 768 + h * 96 + hi * 8;
    bf16x8 qr[6];
#pragma unroll
    for (int d0 = 0; d0 < 6; ++d0) qr[d0] = *(const bf16x8*)(qp + d0 * 16);
    const int NT = 4 * (qb + 1);
    const lcp kfr = (lcp)lds + hi * 1024 + r32 * 16;
    const lcp vfr = (lcp)lds + MLA_OFF_V + ((lane >> 4) & 1) * 32 + (lane & 3) * 8 + (4 * hi + ((lane & 15) >> 2)) * 64;
    float mref = 0.f, lsum = 0.f; f32x16 o[2], negm;
#pragma unroll
    for (int r = 0; r < 16; ++r) { o[0][r] = 0.f; o[1][r] = 0.f; negm[r] = 0.f; }
    const int qrel = 32 * wid + r32;
#define MLA_MASK(P0, P1, t) do { const int jb_ = (t) - (NT - 4); if (jb_ >= 0 && 64 * jb_ + 63 > 32 * wid) { \
        _Pragma("unroll") for (int r = 0; r < 16; ++r) { const int kv = 64 * jb_ + crow(r, hi); if (kv > qrel) P0[r] = -INFINITY; if (kv + 32 > qrel) P1[r] = -INFINITY; } } } while (0)
#define MLA_ROWMAX(P0, P1, rm) do { float ra_ = __builtin_fmaxf(__builtin_fmaxf(P0[0], P0[1]), P1[0]), rb_ = __builtin_fmaxf(__builtin_fmaxf(P0[2], P0[3]), P1[1]); ra_ = __builtin_fmaxf(__builtin_fmaxf(ra_, P1[2]), P1[3]); \
        _Pragma("unroll") for (int r = 4; r < 16; r += 4) { ra_ = __builtin_fmaxf(__builtin_fmaxf(ra_, P0[r]), P0[r + 1]); rb_ = __builtin_fmaxf(__builtin_fmaxf(rb_, P0[r + 2]), P0[r + 3]); \
            ra_ = __builtin_fmaxf(__builtin_fmaxf(ra_, P1[r]), P1[r + 1]); rb_ = __builtin_fmaxf(__builtin_fmaxf(rb_, P1[r + 2]), P1[r + 3]); } rm = hmax(fmaxf(ra_, rb_)); } while (0)
    MLA_DMA_K(0, 0); MLA_DMA_V(0, 0); MLA_DMA_K(1, 1);
    ATT_WAITV_BAR();
    MLA_DMA_K(2, 2); MLA_DMA_V(1, 1);
    f32x16 pa0, pa1, pb0, pb1;
    qk_tile_ref<6>(pa0, pa1, kfr, qr, negm); MLA_MASK(pa0, pa1, 0);
    { float rm; MLA_ROWMAX(pa0, pa1, rm); mref = rm;
#pragma unroll
      for (int r = 0; r < 16; ++r) { pa0[r] = ex2(pa0[r] - rm); pa1[r] = ex2(pa1[r] - rm); negm[r] = -rm; } }
    int kc = 1, kn = 2, kf_ = 0, vc = 0, vn = 1, vf_ = 2;
#define MLA_KLD(i) kf_##i = *(const LAS bf16x8*)(kb_ + ((i) >> 1) * 2048 + ((i) & 1) * 512)
#define MLA_VLD(i) do { vl_[i] = vtr(vb_ + ((i) >> 2) * 4096 + ((i) & 3) * 1024); vh_[i] = vtr(vb_ + ((i) >> 2) * 4096 + ((i) & 3) * 1024 + 512); } while (0)
#define MLA_PIN(x) asm volatile("" : "+v"(x))
#define MLA_STEP(C0, C1, P0, P1, t) do { \
        ATT_WAITV_BAR();                                               \
        if ((t) + 2 < NT) MLA_DMA_K((t) + 2, kf_); \
        if ((t) + 1 < NT) MLA_DMA_V((t) + 1, vf_); \
          \
        const lcp kb_ = kfr + kc * MLA_KSLOT; const lcp vb_ = vfr + vc * VSLOT; \
        bf16x8 kf_0, kf_1, kf_2, kf_3, kf_4, kf_5, kf_6, kf_7, kf_8, kf_9, kf_10, kf_11; s16x4 vl_[8], vh_[8]; u32x4 pw_[4]; float sacc_ = 0.f; \
        MLA_KLD(0); MLA_KLD(1); MLA_KLD(2); MLA_KLD(3); \
        MLA_KLD(4); C0 = __builtin_amdgcn_mfma_f32_32x32x16_bf16(kf_0, qr[0], negm, 0, 0, 0); sacc_ += P0[0]; sacc_ += P0[1]; sacc_ += P0[2]; MLA_PIN(sacc_); pw_[0][0] = cvtpk(P0[0], P0[1]); MLA_PIN(pw_[0]); __builtin_amdgcn_sched_barrier(0); \
        MLA_KLD(5); C1 = __builtin_amdgcn_mfma_f32_32x32x16_bf16(kf_1, qr[0], negm, 0, 0, 0); sacc_ += P0[3]; sacc_ += P0[4]; sacc_ += P0[5]; MLA_PIN(sacc_); pw_[0][1] = cvtpk(P0[2], P0[3]); MLA_PIN(pw_[0]); __builtin_amdgcn_sched_barrier(0); \
        MLA_KLD(6); C0 = __builtin_amdgcn_mfma_f32_32x32x16_bf16(kf_2, qr[1], C0, 0, 0, 0); sacc_ += P0[6]; sacc_ += P0[7]; sacc_ += P0[8]; MLA_PIN(sacc_); pw_[0][2] = cvtpk(P0[4], P0[5]); MLA_PIN(pw_[0]); __builtin_amdgcn_sched_barrier(0); \
        MLA_KLD(7); C1 = __builtin_amdgcn_mfma_f32_32x32x16_bf16(kf_3, qr[1], C1, 0, 0, 0); sacc_ += P0[9]; sacc_ += P0[10]; sacc_ += P0[11]; MLA_PIN(sacc_); pw_[0][3] = cvtpk(P0[6], P0[7]); MLA_PIN(pw_[0]); __builtin_amdgcn_sched_barrier(0); \
        MLA_KLD(8); MLA_VLD(0); C0 = __builtin_amdgcn_mfma_f32_32x32x16_bf16(kf_4, qr[2], C0, 0, 0, 0); sacc_ += P0[12]; sacc_ += P0[13]; sacc_ += P0[14]; MLA_PIN(sacc_); pw_[1][0] = cvtpk(P0[8], P0[9]); MLA_PIN(pw_[1]); pw_[1][1] = cvtpk(P0[10], P0[11]); MLA_PIN(pw_[1]); __builtin_amdgcn_sched_barrier(0); \
        MLA_KLD(9); MLA_VLD(1); C1 = __builtin_amdgcn_mfma_f32_32x32x16_bf16(kf_5, qr[2], C1, 0, 0, 0); sacc_ += P0[15]; sacc_ += P1[0]; sacc_ += P1[1]; MLA_PIN(sacc_); pw_[1][2] = cvtpk(P0[12], P0[13]); MLA_PIN(pw_[1]); pw_[1][3] = cvtpk(P0[14], P0[15]); MLA_PIN(pw_[1]); __builtin_amdgcn_sched_barrier(0); \
        MLA_KLD(10); MLA_VLD(2); C0 = __builtin_amdgcn_mfma_f32_32x32x16_bf16(kf_6, qr[3], C0, 0, 0, 0); sacc_ += P1[2]; sacc_ += P1[3]; sacc_ += P1[4]; MLA_PIN(sacc_); pw_[2][0] = cvtpk(P1[0], P1[1]); MLA_PIN(pw_[2]); pw_[2][1] = cvtpk(P1[2], P1[3]); MLA_PIN(pw_[2]); __builtin_amdgcn_sched_barrier(0); \
        MLA_KLD(11); MLA_VLD(3); C1 = __builtin_amdgcn_mfma_f32_32x32x16_bf16(kf_7, qr[3], C1, 0, 0, 0); sacc_ += P1[5]; sacc_ += P1[6]; sacc_ += P1[7]; MLA_PIN(sacc_); pw_[2][2] = cvtpk(P1[4], P1[5]); MLA_PIN(pw_[2]); pw_[2][3] = cvtpk(P1[6], P1[7]); MLA_PIN(pw_[2]); __builtin_amdgcn_sched_barrier(0); \
        MLA_VLD(4); C0 = __builtin_amdgcn_mfma_f32_32x32x16_bf16(kf_8, qr[4], C0, 0, 0, 0); sacc_ += P1[8]; sacc_ += P1[9]; MLA_PIN(sacc_); pw_[3][0] = cvtpk(P1[8], P1[9]); MLA_PIN(pw_[3]); __builtin_amdgcn_sched_barrier(0); \
        MLA_VLD(5); C1 = __builtin_amdgcn_mfma_f32_32x32x16_bf16(kf_9, qr[4], C1, 0, 0, 0); sacc_ += P1[10]; sacc_ += P1[11]; MLA_PIN(sacc_); pw_[3][1] = cvtpk(P1[10], P1[11]); MLA_PIN(pw_[3]); __builtin_amdgcn_sched_barrier(0); \
        MLA_VLD(6); C0 = __builtin_amdgcn_mfma_f32_32x32x16_bf16(kf_10, qr[5], C0, 0, 0, 0); sacc_ += P1[12]; sacc_ += P1[13]; MLA_PIN(sacc_); pw_[3][2] = cvtpk(P1[12], P1[13]); MLA_PIN(pw_[3]); __builtin_amdgcn_sched_barrier(0); \
        MLA_VLD(7); C1 = __builtin_amdgcn_mfma_f32_32x32x16_bf16(kf_11, qr[5], C1, 0, 0, 0); sacc_ += P1[14]; sacc_ += P1[15]; MLA_PIN(sacc_); pw_[3][3] = cvtpk(P1[14], P1[15]); MLA_PIN(pw_[3]); __builtin_amdgcn_sched_barrier(0); \
        lsum += sacc_; \
          \
        __builtin_amdgcn_sched_barrier(0); \
        o[0] = __builtin_amdgcn_mfma_f32_32x32x16_bf16(__builtin_bit_cast(bf16x8, pw_[0]), (bf16x8){vl_[0][0], vl_[0][1], vl_[0][2], vl_[0][3], vh_[0][0], vh_[0][1], vh_[0][2], vh_[0][3]}, o[0], 0, 0, 0); o[1] = __builtin_amdgcn_mfma_f32_32x32x16_bf16(__builtin_bit_cast(bf16x8, pw_[0]), (bf16x8){vl_[4][0], vl_[4][1], vl_[4][2], vl_[4][3], vh_[4][0], vh_[4][1], vh_[4][2], vh_[4][3]}, o[1], 0, 0, 0); \
        MLA_MASK(C0, C1, t); \
        float rm_; MLA_ROWMAX(C0, C1, rm_); \
        bool resc_ = false; float alpha_ = 1.f; \
        if (__any(rm_ > 8.f)) { const float dl = fmaxf(rm_, 0.f); mref += dl; alpha_ = ex2(-dl); lsum *= alpha_; resc_ = true; \
            _Pragma("unroll") for (int r = 0; r < 16; ++r) { C0[r] -= dl; C1[r] -= dl; negm[r] = -mref; } } \
          \
        __builtin_amdgcn_sched_barrier(0); \
        o[0] = __builtin_amdgcn_mfma_f32_32x32x16_bf16(__builtin_bit_cast(bf16x8, pw_[1]), (bf16x8){vl_[1][0], vl_[1][1], vl_[1][2], vl_[1][3], vh_[1][0], vh_[1][1], vh_[1][2], vh_[1][3]}, o[0], 0, 0, 0); C0[0] = ex2(C0[0]); C0[1] = ex2(C0[1]); C0[2] = ex2(C0[2]); C0[3] = ex2(C0[3]); C0[4] = ex2(C0[4]); MLA_PIN(C0); MLA_PIN(C1); __builtin_amdgcn_sched_barrier(0); \
        o[1] = __builtin_amdgcn_mfma_f32_32x32x16_bf16(__builtin_bit_cast(bf16x8, pw_[1]), (bf16x8){vl_[5][0], vl_[5][1], vl_[5][2], vl_[5][3], vh_[5][0], vh_[5][1], vh_[5][2], vh_[5][3]}, o[1], 0, 0, 0); C0[5] = ex2(C0[5]); C0[6] = ex2(C0[6]); C0[7] = ex2(C0[7]); C0[8] = ex2(C0[8]); C0[9] = ex2(C0[9]); MLA_PIN(C0); MLA_PIN(C1); __builtin_amdgcn_sched_barrier(0); \
        o[0] = __builtin_amdgcn_mfma_f32_32x32x16_bf16(__builtin_bit_cast(bf16x8, pw_[2]), (bf16x8){vl_[2][0], vl_[2][1], vl_[2][2], vl_[2][3], vh_[2][0], vh_[2][1], vh_[2][2], vh_[2][3]}, o[0], 0, 0, 0); C0[10] = ex2(C0[10]); C0[11] = ex2(C0[11]); C0[12] = ex2(C0[12]); C0[13] = ex2(C0[13]); C0[14] = ex2(C0[14]); MLA_PIN(C0); MLA_PIN(C1); __builtin_amdgcn_sched_barrier(0); \
        o[1] = __builtin_amdgcn_mfma_f32_32x32x16_bf16(__builtin_bit_cast(bf16x8, pw_[2]), (bf16x8){vl_[6][0], vl_[6][1], vl_[6][2], vl_[6][3], vh_[6][0], vh_[6][1], vh_[6][2], vh_[6][3]}, o[1], 0, 0, 0); C0[15] = ex2(C0[15]); C1[0] = ex2(C1[0]); C1[1] = ex2(C1[1]); C1[2] = ex2(C1[2]); C1[3] = ex2(C1[3]); MLA_PIN(C0); MLA_PIN(C1); __builtin_amdgcn_sched_barrier(0); \
        o[0] = __builtin_amdgcn_mfma_f32_32x32x16_bf16(__builtin_bit_cast(bf16x8, pw_[3]), (bf16x8){vl_[3][0], vl_[3][1], vl_[3][2], vl_[3][3], vh_[3][0], vh_[3][1], vh_[3][2], vh_[3][3]}, o[0], 0, 0, 0); C1[4] = ex2(C1[4]); C1[5] = ex2(C1[5]); C1[6] = ex2(C1[6]); C1[7] = ex2(C1[7]); C1[8] = ex2(C1[8]); MLA_PIN(C0); MLA_PIN(C1); __builtin_amdgcn_sched_barrier(0); \
        o[1] = __builtin_amdgcn_mfma_f32_32x32x16_bf16(__builtin_bit_cast(bf16x8, pw_[3]), (bf16x8){vl_[7][0], vl_[7][1], vl_[7][2], vl_[7][3], vh_[7][0], vh_[7][1], vh_[7][2], vh_[7][3]}, o[1], 0, 0, 0); C1[9] = ex2(C1[9]); C1[10] = ex2(C1[10]); C1[11] = ex2(C1[11]); C1[12] = ex2(C1[12]); C1[13] = ex2(C1[13]); MLA_PIN(C0); MLA_PIN(C1); __builtin_amdgcn_sched_barrier(0); \
        C1[14] = ex2(C1[14]); C1[15] = ex2(C1[15]); \
        if (resc_) { if (hi == 0) wsf[r32] = alpha_; WAVE_LDS_SYNC(); \
            _Pragma("unroll") for (int r = 0; r < 16; ++r) { const float a = wsf[crow(r, hi)]; o[0][r] *= a; o[1][r] *= a; } WAVE_LDS_SYNC(); } \
        { const int t_ = kc; kc = kn; kn = kf_; kf_ = t_; } { const int t_ = vc; vc = vn; vn = vf_; vf_ = t_; } } while (0)
    for (int t = 1; t + 1 < NT; t += 2) { MLA_STEP(pb0, pb1, pa0, pa1, t); MLA_STEP(pa0, pa1, pb0, pb1, t + 1); }
    MLA_STEP(pb0, pb1, pa0, pa1, NT - 1);
    { float s_ = 0.f;
#pragma unroll
      for (int r = 0; r < 16; ++r) s_ += pb0[r] + pb1[r];
      lsum += s_; ATT_WAITV_BAR(); pv_tile(o, vfr + vc * VSLOT, pb0, pb1); }
#undef MLA_STEP
#undef MLA_KLD
#undef MLA_VLD
#undef MLA_PIN
#undef MLA_ROWMAX
#undef MLA_MASK
#undef MLA_DMA_K
#undef MLA_DMA_V
    lsum = hsum(lsum);
    if (hi == 0) wsf[32 + r32] = __builtin_amdgcn_rcpf(lsum);
    stage_o(o, stg, wsf + 32, r32, hi);
    bf16* Ow = OC + (rowbase + q0 + wid * 32) * 1024 + h * 64;
#pragma unroll
    for (int i = 0; i < 4; ++i) { const int row = i * 8 + (lane >> 3), ch = lane & 7; const u32x4 v = *(const LAS u32x4*)(stg + row * 64 + ch * 8); *(u32x4*)(Ow + (long)row * 1024 + ch * 8) = v; }
    ATT_WAITV_BAR();
}

constexpr int SB_KSLOT = 8192, SB_OFF_V = 2 * SB_KSLOT, SB_OFF_WS = SB_OFF_V + 2 * VSLOT, SB_OFF_ST = SB_OFF_WS + 8 * 256, SB_OFF_FL = SB_OFF_ST + 8 * 4096, SB_LDS = SB_OFF_FL + 64;
DI void sb_unit(int bh, int qb, const bf16* Q, const bf16* K, const bf16* V, bf16* OC, LAS unsigned char* lds) {
    int tid_ = threadIdx.x; asm volatile("" : "+v"(tid_));
    const int tid = tid_, lane = tid & 63, r32 = lane & 31, hi = lane >> 5, wid = rfl(tid >> 6);
    const int b = bh >> 3, h = bh & 7; const long rowbase = (long)b * SEQ; const int q0 = qb * 256;
    const unsigned lds0 = (unsigned)(size_t)lds;
    LAS bf16* stg = (LAS bf16*)(lds + SB_OFF_ST) + wid * 2048;
    volatile LAS unsigned* fl = (volatile LAS unsigned*)(lds + SB_OFF_FL);
    const bf16* ksrc = K + (rowbase + lane) * 512 + h * 64 + wid * 8;
    const bf16* vsrc = V + (rowbase + 16 * (wid & 3) + (lane >> 2)) * 512 + h * 64 + (wid >> 2) * 32 + (lane & 3) * 8;
#define SB_DMA(t, s) do { glds16(ksrc + (long)(t) * 64 * 512, (unsigned)rfl((int)(lds0 + (s) * SB_KSLOT + wid * 1024))); \
        glds16(vsrc + (long)(t) * 64 * 512, (unsigned)rfl((int)(lds0 + SB_OFF_V + (s) * VSLOT + wid * 1024))); } while (0)
    const bf16* qp = Q + (rowbase + q0 + wid * 32 + r32) * 512 + h * 64 + hi * 8;
    bf16x8 qr[4];
#pragma unroll
    for (int d0 = 0; d0 < 4; ++d0) qr[d0] = *(const bf16x8*)(qp + d0 * 16);
    const int NT = 4 * (qb + 1);
    const lcp kfr = (lcp)lds + hi * 1024 + r32 * 16;
    const lcp vfr = (lcp)lds + SB_OFF_V + ((lane >> 4) & 1) * 32 + (lane & 3) * 8 + (4 * hi + ((lane & 15) >> 2)) * 64;
    float carry = 1.f; f32x16 o[2];
#pragma unroll
    for (int r = 0; r < 16; ++r) { o[0][r] = 0.f; o[1][r] = 0.f; }
    if (tid == 0) { fl[0] = 0u; fl[1] = 0u; fl[2] = 0u; }
    SB_DMA(NT - 1, 0);
    for (int i = 0; i < NT; ++i) {
        const int t = NT - 1 - i;
        ATT_WAITV_BAR();
        if (i > 0 && fl[(i - 1) % 3] == 0u) break;
        if (tid == 0) fl[(i + 1) % 3] = 0u;
        const int s = i & 1;
        if (t > 0) SB_DMA(t - 1, s ^ 1);
        const int jb = t - (NT - 4), qlo = 32 * wid;
        const bool skip = (jb >= 0 && 64 * jb >= qlo + 31);
        const bool dead = __all(carry == 0.f) != 0;
        if (!skip && !dead) {
            f32x16 p0, p1; qk_tile<4>(p0, p1, kfr + s * SB_KSLOT, qr);
            f32x16 f0, f1;
#pragma unroll
            for (int r = 0; r < 16; ++r) {
                { const float y = p0[r], e = ex2(-fabsf(y)), rr = __builtin_amdgcn_rcpf(1.f + e), er = e * rr; const bool pos = y >= 0.f; p0[r] = pos ? rr : er; f0[r] = pos ? er : rr; }
                { const float y = p1[r], e = ex2(-fabsf(y)), rr = __builtin_amdgcn_rcpf(1.f + e), er = e * rr; const bool pos = y >= 0.f; p1[r] = pos ? rr : er; f1[r] = pos ? er : rr; }
            }
            if (jb >= 0 && 64 * jb + 63 >= qlo) { const int qrel = qlo + r32;
#pragma unroll
                for (int r = 0; r < 16; ++r) { const int kv = 64 * jb + crow(r, hi);
                    if (kv >= qrel) { f0[r] = 1.f; p0[r] = 0.f; } if (kv + 32 >= qrel) { f1[r] = 1.f; p1[r] = 0.f; } } }
            float mine[8], oth[8], ps[8];
#pragma unroll
            for (int g = 0; g < 4; ++g) {
                { const float a0 = f0[4 * g], a1 = f0[4 * g + 1], a2 = f0[4 * g + 2], a3 = f0[4 * g + 3]; const float e1 = a3 * a2, e0 = e1 * a1;
                  f0[4 * g + 3] = 1.f; f0[4 * g + 2] = a3; f0[4 * g + 1] = e1; f0[4 * g] = e0; mine[g] = e0 * a0; }
                { const float a0 = f1[4 * g], a1 = f1[4 * g + 1], a2 = f1[4 * g + 2], a3 = f1[4 * g + 3]; const float e1 = a3 * a2, e0 = e1 * a1;
                  f1[4 * g + 3] = 1.f; f1[4 * g + 2] = a3; f1[4 * g + 1] = e1; f1[4 * g] = e0; mine[4 + g] = e0 * a0; }
            }
#pragma unroll
            for (int g = 0; g < 8; ++g) { auto rr = __builtin_amdgcn_permlane32_swap(__float_as_uint(mine[g]), __float_as_uint(mine[g]), false, false);
                const float x0 = __uint_as_float(rr[0]), x1 = __uint_as_float(rr[1]); oth[g] = hi ? x0 : x1; ps[g] = x0 * x1; }
            float sp = 1.f; float off[8];
#pragma unroll
            for (int g = 7; g >= 0; --g) { off[g] = sp * (hi ? 1.f : oth[g]) * carry; sp *= ps[g]; }
#pragma unroll
            for (int g = 0; g < 4; ++g)
#pragma unroll
                for (int j = 0; j < 4; ++j) { p0[4 * g + j] = p0[4 * g + j] * f0[4 * g + j] * off[g]; p1[4 * g + j] = p1[4 * g + j] * f1[4 * g + j] * off[4 + g]; }
            carry *= sp;
            pv_tile(o, vfr + s * VSLOT, p0, p1);
        }
        if (t > 0 && __any(carry != 0.f) && lane == 0) fl[i % 3] = 1u;
    }
#undef SB_DMA
    ATT_WAITV_BAR();
    stage_o(o, stg, nullptr, r32, hi);
    bf16* Ow = OC + (rowbase + q0 + wid * 32) * 1024 + 512 + h * 64;
#pragma unroll
    for (int i = 0; i < 4; ++i) { const int row = i * 8 + (lane >> 3), ch = lane & 7; const u32x4 v = *(const LAS u32x4*)(stg + row * 64 + ch * 8); *(u32x4*)(Ow + (long)row * 1024 + ch * 8) = v; }
    ATT_WAITV_BAR();
}

constexpr int MB_NB = SEQ / 256;
constexpr int MB_OFF_K = 0, MB_OFF_V = 32768, MB_OFF_WS = 65536, MB_OFF_ST = MB_OFF_WS + 8 * 256, MB_OFF_TAB = MB_OFF_ST + 8 * 4096, MB_OFF_RING = MB_OFF_TAB + 512,
              MB_OFF_WC = MB_OFF_RING + 32768, MB_OFF_Q = MB_OFF_WC + 64, MB_LDS = MB_OFF_Q + 64;
DI int t5_bucket(int d) { if (d < 16) return d; const int l = 16 + (int)(__logf((float)d * (1.f / 16.f)) * (16.f / 2.0794415416798357f)); return l < 31 ? l : 31; }
DI void mb_load_kv(const bf16* K2, const bf16* V2, long row0, int h, unsigned lds0, int lane, int wid) {
    const bf16* ksrc = K2 + (row0 + lane) * 1024 + h * 64 + wid * 8;
    const bf16* vsrc = V2 + (row0 + 16 * (wid & 3) + (lane >> 2)) * 1024 + h * 64 + (wid >> 2) * 32 + (lane & 3) * 8;
#pragma unroll
    for (int t = 0; t < 4; ++t) { glds16(ksrc + (long)t * 64 * 1024, (unsigned)rfl((int)(lds0 + MB_OFF_K + t * 8192 + wid * 1024)));
        glds16(vsrc + (long)t * 64 * 1024, (unsigned)rfl((int)(lds0 + MB_OFF_V + t * 8192 + wid * 1024))); }
}
DI void mb_fill_tab(const float* rel_bias, int h, LAS float* tab, int tid) { if (tid < 128) tab[tid] = rel_bias[h * 32 + t5_bucket(tid)] * LOG2E; }

DI void top3_ins(float v, unsigned i, float& v0, unsigned& i0, float& v1, unsigned& i1, float& v2, unsigned& i2) {
    const bool b0 = v > v0 || (v == v0 && i < i0), b1 = v > v1 || (v == v1 && i < i1), b2 = v > v2 || (v == v2 && i < i2);
    const float n2 = b1 ? v1 : (b2 ? v : v2); const unsigned m2 = b1 ? i1 : (b2 ? i : i2);
    const float n1 = b0 ? v0 : (b1 ? v : v1); const unsigned m1 = b0 ? i0 : (b1 ? i : i1);
    const float n0 = b0 ? v : v0; const unsigned m0 = b0 ? i : i0;
    v0 = n0; i0 = m0; v1 = n1; i1 = m1; v2 = n2; i2 = m2;
}
DI void moba_gate_unit(int bh, int g, const bf16* Q2, const float* KMP, unsigned* SEL, unsigned* MASK32, LAS unsigned char* lds) {
    using namespace att;
    int tid_ = threadIdx.x; asm volatile("" : "+v"(tid_));
    const int tid = tid_, lane = tid & 63, r32 = lane & 31, hi = lane >> 5, wid = rfl(tid >> 6);
    const int b = bh >> 4, h = bh & 15;
    LAS bf16* khi = (LAS bf16*)lds; LAS bf16* klo = (LAS bf16*)(lds + 8192);
#pragma unroll
    for (int it_ = 0; it_ < 8; ++it_) { const int i = tid + 512 * it_; const int n = i >> 6, d = i & 63; const size_t src = (size_t)(b * MB_NB + n) * 1024 + h * 64 + d;
        const float v = (KMP[src] + KMP[(size_t)(T / 256) * 1024 + src]) * (1.f / 256.f);
        const unsigned ph = cvtpk(v, 0.f) & 0xffffu; const float rem = v - __uint_as_float(ph << 16); const unsigned pl = cvtpk(rem, 0.f) & 0xffffu;
        const int off = (d >> 3) * 512 + n * 8 + (d & 7); khi[off] = (bf16)ph; klo[off] = (bf16)pl; }
    const bf16* qbase = Q2 + ((long)b * SEQ + wid * 32 + r32) * 1024 + h * 64 + hi * 8;
    bf16x8 qn[4];
#pragma unroll
    for (int d0 = 0; d0 < 4; ++d0) qn[d0] = *(const bf16x8*)(qbase + (long)g * 256 * 1024 + d0 * 16);
    __syncthreads();
    const lcp kfr = (lcp)lds + hi * 1024 + r32 * 16;
#pragma unroll 1
    for (int j = 0; j < 8; ++j) {
        const int qb = g + 8 * j;
        bf16x8 qr[4] = {qn[0], qn[1], qn[2], qn[3]};
        if (j < 7) {
#pragma unroll
            for (int d0 = 0; d0 < 4; ++d0) qn[d0] = *(const bf16x8*)(qbase + (long)(qb + 8) * 256 * 1024 + d0 * 16); }
        f32x16 p0, p1, q0, q1; qk_tile<4>(p0, p1, kfr, qr); qk_tile<4>(q0, q1, kfr + 8192, qr);
        float v0 = -INFINITY, v1 = -INFINITY, v2 = -INFINITY; unsigned i0 = 0xFFu, i1 = 0xFFu, i2 = 0xFFu;
#pragma unroll
        for (int r = 0; r < 16; ++r) { const unsigned n = (unsigned)crow(r, hi); const bool in = (int)n < qb;
            top3_ins(in ? p0[r] + q0[r] : -INFINITY, in ? n : 0xFFu, v0, i0, v1, i1, v2, i2); }
        if (qb > 32) {
#pragma unroll
            for (int r = 0; r < 16; ++r) { const unsigned n = 32u + (unsigned)crow(r, hi); const bool in = (int)n < qb;
                top3_ins(in ? p1[r] + q1[r] : -INFINITY, in ? n : 0xFFu, v0, i0, v1, i1, v2, i2); } }
        { float pa, pb, pc; unsigned qa, qb_, qc;
#define MB_SWAPF(dst, src) do { auto rr_ = __builtin_amdgcn_permlane32_swap(__float_as_uint(src), __float_as_uint(src), false, false); dst = __uint_as_float(hi ? rr_[0] : rr_[1]); } while (0)
#define MB_SWAPU(dst, src) do { auto rr_ = __builtin_amdgcn_permlane32_swap(src, src, false, false); dst = hi ? rr_[0] : rr_[1]; } while (0)
          MB_SWAPF(pa, v0); MB_SWAPF(pb, v1); MB_SWAPF(pc, v2); MB_SWAPU(qa, i0); MB_SWAPU(qb_, i1); MB_SWAPU(qc, i2);
#undef MB_SWAPF
#undef MB_SWAPU
          top3_ins(pa, qa, v0, i0, v1, i1, v2, i2); top3_ins(pb, qb_, v0, i0, v1, i1, v2, i2); top3_ins(pc, qc, v0, i0, v1, i1, v2, i2); }
        if (hi == 0) SEL[(size_t)bh * SEQ + qb * 256 + wid * 32 + r32] = i0 | (i1 << 8) | (i2 << 16);
        for (int n = 0; n < qb; ++n) { const unsigned m0 = (unsigned)__ballot(i0 == (unsigned)n), m1 = (unsigned)__ballot(i1 == (unsigned)n), m2 = (unsigned)__ballot(i2 == (unsigned)n);
            if (lane == 0) { unsigned* dst = MASK32 + ((((size_t)bh * 64 + n) * 64 + qb) * 3) * 8 + wid; dst[0] = m0; dst[8] = m1; dst[16] = m2; } }
    }
    __syncthreads();
}

DI void moba_sel_unit(int bh, int n, const bf16* Q2, const bf16* K2, const bf16* V2, const unsigned long long* MASK, const float* rel_bias, bf16* PO0, bf16* PO1, bf16* PO2, bf16* PO3, float2* PMS, LAS unsigned char* lds) {
    using namespace att;
    int tid_ = threadIdx.x; asm volatile("" : "+v"(tid_));
    const int tid = tid_, lane = tid & 63, r32 = lane & 31, hi = lane >> 5, wid = rfl(tid >> 6);
    const int b = bh >> 4, h = bh & 15; const unsigned lds0 = (unsigned)(size_t)lds;
    mb_load_kv(K2, V2, (long)b * SEQ + n * 256, h, lds0, lane, wid);
    mb_fill_tab(rel_bias, h, (LAS float*)(lds + MB_OFF_TAB), tid);
    LAS unsigned short* list = (LAS unsigned short*)(lds + MB_OFF_RING);
    volatile LAS unsigned* wc = (volatile LAS unsigned*)(lds + MB_OFF_WC);
    bf16x8 qo[4];
    { const bf16* qp = Q2 + ((long)b * SEQ + n * 256 + wid * 32 + r32) * 1024 + h * 64 + hi * 8;
#pragma unroll
      for (int d0 = 0; d0 < 4; ++d0) qo[d0] = *(const bf16x8*)(qp + d0 * 16); }
    const unsigned* mw = (const unsigned*)(MASK + (((size_t)bh * 64 + n) * 64 + (n + 1)) * 12);
    const int nwords = (63 - n) * 24;
    unsigned w[3]; unsigned c = 0;
#pragma unroll
    for (int i = 0; i < 3; ++i) { const int j = tid + 512 * i; w[i] = j < nwords ? mw[j] : 0u; c += (unsigned)__popc(w[i]); }
    unsigned inc = c;
#pragma unroll
    for (int o = 1; o < 64; o <<= 1) { const unsigned t = __shfl_up(inc, o); if (lane >= o) inc += t; }
    if (lane == 63) wc[wid] = inc;
    ATT_WAITV_BAR();
    unsigned base = inc - c, total = 0;
#pragma unroll
    for (int i = 0; i < 8; ++i) { const unsigned x = wc[i]; total += x; if (i < wid) base += x; }
#pragma unroll
    for (int i = 0; i < 3; ++i) { const int j = tid + 512 * i; const int qb = n + 1 + j / 24, rem = j % 24, k = rem >> 3, s0 = qb * 256 + (rem & 7) * 32; unsigned ww = w[i];
        while (ww) { const int bit = __ffs(ww) - 1; ww &= ww - 1u; list[base++] = (unsigned short)(((unsigned)(s0 + bit) << 2) | (unsigned)k); } }
    ATT_BAR();
    const int nchunk = ((int)total + 255) >> 8;
    LAS float* wsf = (LAS float*)(lds + MB_OFF_WS) + wid * 64;
    LAS bf16* stg = (LAS bf16*)(lds + MB_OFF_ST) + wid * 2048;
    const LAS float* tab = (const LAS float*)(lds + MB_OFF_TAB);
    const lcp kfr = (lcp)lds + MB_OFF_K + hi * 1024 + r32 * 16;
    const lcp vfr = (lcp)lds + MB_OFF_V + ((lane >> 4) & 1) * 32 + (lane & 3) * 8 + (4 * hi + ((lane & 15) >> 2)) * 64;
    const int nchunk_ = ((int)total + 255) >> 8;
    const bf16* qbase = Q2 + (long)b * SEQ * 1024 + h * 64 + hi * 8;
    const int kend = n * 256 + 255;
    bf16x8 qn[4]; unsigned en = 0; bool vn = false;
#define MB_QLOAD(cc) do { const int idx_ = (cc) * 256 + 32 * wid + r32; vn = idx_ < (int)total; en = vn ? (unsigned)list[idx_] : 0u; const bf16* qp_ = qbase + (long)(en >> 2) * 1024; \
        _Pragma("unroll") for (int d0 = 0; d0 < 4; ++d0) { bf16x8 z_; _Pragma("unroll") for (int j_ = 0; j_ < 8; ++j_) z_[j_] = 0; qn[d0] = vn ? *(const bf16x8*)(qp_ + d0 * 16) : z_; } } while (0)
    if (nchunk_ > 0) MB_QLOAD(0);
    { float mref = -INFINITY, lsum = 0.f; f32x16 o[2];
#pragma unroll
      for (int r = 0; r < 16; ++r) { o[0][r] = 0.f; o[1][r] = 0.f; }
      const int qrel = 32 * wid + r32, tlast = wid >> 1;
#pragma unroll 1
      for (int t = 0; t <= tlast; ++t) {
          f32x16 p0, p1; qk_tile<4>(p0, p1, kfr + t * 8192, qo);
          const int dbase = qrel - 64 * t;
#pragma unroll
          for (int r = 0; r < 16; ++r) { const int d0 = dbase - crow(r, hi), d1 = d0 - 32;
              const int c0 = d0 > 127 ? 127 : (d0 < 0 ? 0 : d0), c1 = d1 > 127 ? 127 : (d1 < 0 ? 0 : d1);
              p0[r] = d0 < 0 ? -INFINITY : p0[r] + tab[c0]; p1[r] = d1 < 0 ? -INFINITY : p1[r] + tab[c1]; }
          smax_update(p0, p1, mref, lsum, o, wsf, r32, hi);
          pv_tile(o, vfr + t * 8192, p0, p1);
      }
      lsum = hsum(lsum);
      const int sq = n * 256 + qrel;
      if (hi == 0) PMS[((size_t)(3 * 32 + bh)) * SEQ + sq] = make_float2(mref, lsum);
      stage_o(o, stg, nullptr, r32, hi);
#pragma unroll
      for (int i = 0; i < 4; ++i) { const int row = i * 8 + (lane >> 3), ch = lane & 7;
          const u32x4 v = *(const LAS u32x4*)(stg + row * 64 + ch * 8); __builtin_nontemporal_store(v, (u32x4*)(PO3 + ((size_t)bh * SEQ + (n * 256 + 32 * wid + row)) * 64 + ch * 8)); }
      WAVE_LDS_SYNC(); }
#if defined(PROBE_DUP) && ((PROBE_DUP >> 19) & 1)
    for (int prb_ = 0; prb_ < 2; ++prb_) {
#else
    {
#endif
#if defined(PROBE_DUP) && ((PROBE_DUP >> 19) & 1)
    if (prb_ > 0 && nchunk > 0) MB_QLOAD(0);
#endif
    if (wid >= 4) __builtin_amdgcn_s_sleep(10);
#pragma unroll 1
    for (int cc = 0; cc < nchunk; ++cc) {
        const int cnt = ((int)total - cc * 256) < 256 ? ((int)total - cc * 256) : 256;
        bf16x8 qr[4] = {qn[0], qn[1], qn[2], qn[3]}; const unsigned e = en; const bool valid = vn;
        if (cc + 1 < nchunk) MB_QLOAD(cc + 1);
        if (32 * wid >= cnt) continue;
        const bool far = __all(!valid || ((int)(e >> 2) - kend >= 113)) != 0;
        float mref = 0.f, lsum = 0.f; f32x16 o[2], negm;
#pragma unroll
        for (int r = 0; r < 16; ++r) { o[0][r] = 0.f; o[1][r] = 0.f; negm[r] = 0.f; }
#pragma unroll 1
        for (int t = 0; t < 4; ++t) {
            f32x16 p0, p1; qk_tile_ref<4>(p0, p1, kfr + t * 8192, qr, negm);
            if (!far) { const int dbase = (int)(e >> 2) - (n * 256 + 64 * t);
#pragma unroll
                for (int r = 0; r < 16; ++r) { int d0 = dbase - crow(r, hi), d1 = d0 - 32; d0 = d0 > 127 ? 127 : (d0 < 0 ? 0 : d0); d1 = d1 > 127 ? 127 : (d1 < 0 ? 0 : d1); p0[r] += tab[d0]; p1[r] += tab[d1]; } }
            smax_update_ref(p0, p1, mref, negm, lsum, o, wsf, r32, hi, t == 0);
            pv_tile(o, vfr + t * 8192, p0, p1);
        }
        lsum = hsum(lsum);
        if (far) mref += tab[127];
        if (valid && hi == 0) { unsigned e_ = e; asm volatile("" : "+v"(e_)); PMS[((size_t)((int)(e_ & 3u) * 32 + bh)) * SEQ + (int)(e_ >> 2)] = make_float2(mref, lsum); }
        stage_o(o, stg, nullptr, r32, hi);
#pragma unroll
        for (int i = 0; i < 4; ++i) { const int row = i * 8 + (lane >> 3), ch = lane & 7; const int ridx = 32 * wid + row;
            if (ridx < cnt) { const unsigned e2 = list[cc * 256 + ridx]; const int s2 = (int)(e2 >> 2), k2 = (int)(e2 & 3u);
                const u32x4 v = *(const LAS u32x4*)(stg + row * 64 + ch * 8); bf16* pob = k2 == 0 ? PO0 : (k2 == 1 ? PO1 : PO2); __builtin_nontemporal_store(v, (u32x4*)(pob + ((size_t)bh * SEQ + s2) * 64 + ch * 8)); } }
        WAVE_LDS_SYNC();
    }
    }
#undef MB_QLOAD
    ATT_WAITV_BAR();
}

DI void moba_merge(int gw, int ngw, const unsigned* SEL, const bf16* PO0, const bf16* PO1, const bf16* PO2, const bf16* PO3, const float2* PMS, bf16* O2) {
    using namespace att;
    int tid_ = threadIdx.x; asm volatile("" : "+v"(tid_));
    const int lane = tid_ & 63, sub = lane >> 3, ch = lane & 7;
    const int NST = 32 * (SEQ / 8);
    unsigned nsel = 0u; float2 nms[4]; u32x4 npv[4];
#define MB_MLOAD(st) do { const int bh_ = (st) / (SEQ / 8), s_ = ((st) % (SEQ / 8)) * 8 + sub; const size_t it_ = (size_t)bh_ * SEQ + s_; nsel = SEL[it_]; \
        _Pragma("unroll") for (int k = 0; k < 4; ++k) { nms[k] = PMS[(size_t)k * 32 * SEQ + it_]; const bf16* pob = k == 0 ? PO0 : (k == 1 ? PO1 : (k == 2 ? PO2 : PO3)); npv[k] = __builtin_nontemporal_load((const u32x4*)(pob + it_ * 64 + ch * 8)); } } while (0)
    if (gw < NST) MB_MLOAD(gw);
    for (int st = gw; st < NST; st += ngw) {
        const int bh = st / (SEQ / 8), s = (st % (SEQ / 8)) * 8 + sub;
        const unsigned sel = nsel; float2 ms[4] = {nms[0], nms[1], nms[2], nms[3]}; u32x4 pv[4] = {npv[0], npv[1], npv[2], npv[3]};
        if (st + ngw < NST) MB_MLOAD(st + ngw);
        float mall = ms[3].x;
#pragma unroll
        for (int k = 0; k < 3; ++k) { const bool ok = ((sel >> (8 * k)) & 0xFFu) != 0xFFu; if (!ok) { ms[k].x = -INFINITY; ms[k].y = 0.f; pv[k] = (u32x4){0u, 0u, 0u, 0u}; } mall = fmaxf(mall, ms[k].x); }
        float den = 0.f, acc[8] = {0.f, 0.f, 0.f, 0.f, 0.f, 0.f, 0.f, 0.f};
#pragma unroll
        for (int k = 0; k < 4; ++k) { const float w = ex2(ms[k].x - mall); den += w * ms[k].y; const u32x4 v = pv[k];
            acc[0] += w * bflo(v.x); acc[1] += w * bfhi(v.x); acc[2] += w * bflo(v.y); acc[3] += w * bfhi(v.y); acc[4] += w * bflo(v.z); acc[5] += w * bfhi(v.z); acc[6] += w * bflo(v.w); acc[7] += w * bfhi(v.w); }
        const float rd = __builtin_amdgcn_rcpf(den);
        const u32x4 ov = (u32x4){cvtpk(acc[0] * rd, acc[1] * rd), cvtpk(acc[2] * rd, acc[3] * rd), cvtpk(acc[4] * rd, acc[5] * rd), cvtpk(acc[6] * rd, acc[7] * rd)};
        *(u32x4*)(O2 + ((size_t)(bh >> 4) * SEQ + s) * 1024 + (bh & 15) * 64 + ch * 8) = ov;
    }
#undef MB_MLOAD
}
}

constexpr size_t MiB = 1u << 20;
constexpr int NSLOT = 2 * T + 8 * 256;
constexpr size_t WS_CTL = 0, CTL_ZERO_BYTES = 64 * 1024;
constexpr size_t WS_RSTD0 = 1 * MiB, WS_TOKW = WS_RSTD0 + 128 * 1024, WS_TOKR = WS_TOKW + 256 * 1024, WS_TOKE = WS_TOKR + 128 * 1024, WS_PRANK = WS_TOKE + 128 * 1024;
constexpr size_t WS_PQKV = 2 * MiB, WS_PS1 = 6 * MiB, WS_PS2 = 8 * MiB, WS_PS3 = 10 * MiB, WS_ROPE = 12 * MiB, WS_KMP = 14 * MiB;
constexpr size_t WS_SDST = 15 * MiB, WS_SW = WS_SDST + 272 * 1024, WS_SRS = WS_SW + 272 * 1024;
constexpr size_t WS_WRT = 16 * MiB, WS_CNT = WS_WRT + 64 * 1024, WS_TILEE = WS_CNT + 64 * 1024;
constexpr size_t WS_STOK = 17 * MiB;
constexpr size_t WS_SEL = 18 * MiB;
constexpr size_t WS_W = 20 * MiB;
constexpr size_t W_IN = WS_W, W_UQ = W_IN + (size_t)2304 * 1024 * 2, W_UKV = W_UQ + (size_t)768 * 384 * 2, W_O0 = W_UKV + (size_t)1024 * 256 * 2, W_GU0 = W_O0 + (size_t)1024 * 1024 * 2,
                 W_DN0 = W_GU0 + (size_t)4096 * 1024 * 2, W_QKV = W_DN0 + (size_t)1024 * 2048 * 2, W_O1 = W_QKV + (size_t)3072 * 1024 * 2, W_EGU = W_O1 + (size_t)1024 * 1024 * 2,
                 W_EDN = W_EGU + (size_t)8192 * 1024 * 2, W_END = W_EDN + (size_t)8192 * 512 * 2;
static_assert(W_END <= 76 * MiB, "weights region");
constexpr size_t WS_XB = 76 * MiB, WS_OCAT = 76 * MiB, WS_SBQ = 140 * MiB, WS_SBK = 172 * MiB, WS_SBV = 204 * MiB, WS_CQ = 236 * MiB, WS_CKV = 260 * MiB, WS_KR = 276 * MiB,
                 WS_QA = 278 * MiB, WS_KN = 326 * MiB, WS_VA = 358 * MiB, WS_X1B = 390 * MiB, WS_HID = 76 * MiB;
constexpr size_t WS_Q2 = 204 * MiB, WS_K2 = 268 * MiB, WS_V2 = 332 * MiB, WS_PO0 = 76 * MiB, WS_PO1 = 140 * MiB, WS_PO2 = 396 * MiB, WS_PMS = 460 * MiB;
constexpr size_t WS_X3B = 268 * MiB, WS_XPERM = 332 * MiB, WS_YP = 332 * MiB, WS_HIDE = 76 * MiB;
constexpr size_t WS_MASK = 476 * MiB;
constexpr size_t WS_NEED = 489 * MiB;
static_assert(WS_SBK == WS_SBQ + 32 * MiB && WS_SBV == WS_SBQ + 64 * MiB && WS_VA == WS_KN + 32 * MiB && WS_K2 == WS_Q2 + 64 * MiB && WS_V2 == WS_Q2 + 128 * MiB, "epilogue pointer arithmetic");
static_assert(WS_XPERM + (size_t)NSLOT * 2048 <= 464 * MiB && WS_HIDE + (size_t)NSLOT * 1024 <= 204 * MiB && WS_SRS + 272 * 1024 <= 16 * MiB && NSLOT * 4 <= 272 * 1024, "ws map");
constexpr int CW_BAR = 4096, CW_QUEUE = 8192, CW_NRT = 8256;
static_assert((8320 + 64) * 4 <= (int)CTL_ZERO_BYTES && CW_BAR + 3456 <= CW_QUEUE, "control words inside the zeroed region");
constexpr int RING_BYTES = 131072, LDS_BYTES = 147456, MISC_OFF = LDS_BYTES - 256, PHASE_LDS = LDS_BYTES - 512;
static_assert(att::MLA_LDS <= PHASE_LDS && att::SB_LDS <= PHASE_LDS && att::MB_LDS <= PHASE_LDS && RING_BYTES <= PHASE_LDS, "phase LDS");

#define XB_TMO      128
#define XB_XCNT(j)  (256  + 64 * (j))
#define XB_XSUB(j)  (1280 + 64 * (j))
#define XB_XGEN(j)  (2304 + 64 * (j))
#define XB_TOP      3328
#define XB_TOPGEN   3392
#define XCD_BAR_WORDS 3456
#define XB_SPIN_CAP (1u << 18)
__device__ __forceinline__ unsigned xb_ld(unsigned* p)              { return __hip_atomic_load(p, __ATOMIC_RELAXED, __HIP_MEMORY_SCOPE_AGENT); }
__device__ __forceinline__ unsigned xb_add(unsigned* p, unsigned v) { return __hip_atomic_fetch_add(p, v, __ATOMIC_RELAXED, __HIP_MEMORY_SCOPE_AGENT); }
__device__ __forceinline__ unsigned xb_xcc_id() { return (unsigned)__builtin_amdgcn_s_getreg((3 << 11) | 20) & 0xFu; }
#define XB_SPIN(cond, bar) do { unsigned _sp = 0; while (cond) { __builtin_amdgcn_s_sleep(1); \
    if ((++_sp & 255u) == 0u) { if (xb_ld(&(bar)[XB_TMO])) break; if (_sp > XB_SPIN_CAP) { atomicAdd(&(bar)[XB_TMO], 1u); break; } } } } while (0)
struct XcdBarrier { unsigned* bar; unsigned x; volatile LAS unsigned* st; };
__device__ __forceinline__ XcdBarrier xcd_barrier_post(unsigned* bar, volatile LAS unsigned* st) {
    XcdBarrier b; b.bar = bar; b.x = xb_xcc_id(); b.st = st;
    if (threadIdx.x == 0) (void)xb_add(&bar[XB_XCNT(b.x)], 1u);
    return b;
}
__device__ __forceinline__ void xcd_barrier_complete(unsigned* bar, unsigned x, unsigned& nloc, unsigned& nx) {
    const unsigned G = gridDim.x * gridDim.y * gridDim.z;
    unsigned sum, cnt, mine, sp = 0u;
    for (;;) {
        sum = 0u; cnt = 0u; mine = 0u;
#pragma unroll
        for (unsigned j = 0; j < 16; ++j) { const unsigned c = xb_ld(&bar[XB_XCNT(j)]); sum += c; cnt += (c > 0u) ? 1u : 0u; mine = (j == x) ? c : mine; }
        if (sum == G) break;
        __builtin_amdgcn_s_sleep(1);
        if ((++sp & 255u) == 0u) { if (xb_ld(&bar[XB_TMO])) break; if (sp > XB_SPIN_CAP) { atomicAdd(&bar[XB_TMO], 1u); break; } }
    }
    nloc = mine > 0u ? mine : 1u; nx = cnt > 0u ? cnt : 1u;
}
__device__ __forceinline__ void xcd_barrier(const XcdBarrier& b) {
    asm volatile("s_waitcnt vmcnt(0)" ::: "memory");
    __syncthreads();
    if (threadIdx.x == 0) {
        unsigned* bar = b.bar;
        __builtin_amdgcn_s_waitcnt(0);
        unsigned nloc = b.st[0], nx = b.st[1];
        if (nloc == 0u) { xcd_barrier_complete(bar, b.x, nloc, nx); b.st[0] = nloc; b.st[1] = nx; }
        const unsigned old = xb_add(&bar[XB_XSUB(b.x)], 1u);
        const unsigned gen = old / nloc;
        if (old + 1u == (gen + 1u) * nloc) {
            __builtin_amdgcn_fence(__ATOMIC_RELEASE, "agent");
            asm volatile("s_waitcnt vmcnt(0)" ::: "memory");
            const unsigned og = xb_add(&bar[XB_TOP], 1u);
            const unsigned tg = og / nx;
            if (og + 1u == (tg + 1u) * nx) xb_add(&bar[XB_TOPGEN], 1u);
            else XB_SPIN(xb_ld(&bar[XB_TOPGEN]) == tg, bar);
            __builtin_amdgcn_fence(__ATOMIC_ACQUIRE, "agent");
            xb_add(&bar[XB_XGEN(b.x)], 1u);
            asm volatile("s_waitcnt vmcnt(0)" ::: "memory");
        } else {
            XB_SPIN(xb_ld(&bar[XB_XGEN(b.x)]) == gen, bar);
            __builtin_amdgcn_fence(__ATOMIC_ACQUIRE, "agent");
            asm volatile("s_waitcnt vmcnt(0)" ::: "memory");
        }
    }
    __syncthreads();
}

struct Args { const float* in[22]; float* out; unsigned char* ws; int ph_lo, ph_hi; };
enum { I_X = 0, I_EV_AN, I_EV_WIN, I_EV_QN, I_EV_WUQ, I_EV_KVN, I_EV_WUKV, I_EV_WO, I_EV_FN, I_EV_WG, I_EV_WU, I_EV_WD, I_OD_AN, I_OD_WQKV, I_OD_WO, I_OD_FN, I_OD_WR, I_OD_WG, I_OD_WU, I_OD_WD, I_RELB, I_FINN };
constexpr int NPH = 17;

constexpr float C_MLA = 0.10206207261596575f * LOG2E;
constexpr float C_64 = 0.125f * LOG2E;
DI int map_rope32(int p) { return 16 * ((p >> 2) & 1) + 4 * (p >> 3) + (p & 3); }
DI void cvt_item(const float* W, int ld, int col, float scale, const float* gain, int K, bf16* WT, int k0, LAS float* scr, int lane) {
    const int colc = col < 0 ? 0 : col; const float sc = col < 0 ? 0.f : scale;
    const float* wp = W + (size_t)(k0 + (lane >> 5)) * ld + colc;
    float v[32];
#pragma unroll
    for (int i = 0; i < 32; ++i) v[i] = __builtin_nontemporal_load(wp + (size_t)(2 * i) * ld);
    const int c = lane & 7;
    f32x4 g0 = (f32x4){1.f, 1.f, 1.f, 1.f}, g1 = g0;
    if (gain) { g0 = *(const f32x4*)(gain + k0 + 8 * c); g1 = *(const f32x4*)(gain + k0 + 8 * c + 4); }
#pragma unroll
    for (int i = 0; i < 32; ++i) scr[(2 * i + (lane >> 5)) * 33 + (lane & 31)] = v[i] * sc;
    asm volatile("s_waitcnt lgkmcnt(0)" ::: "memory");
#pragma unroll
    for (int j = 0; j < 4; ++j) { const int n = (lane >> 3) + 8 * j; const LAS float* s = scr + (8 * c) * 33 + n;
        v4u o; o.x = cvtpk(s[0 * 33] * g0[0], s[1 * 33] * g0[1]); o.y = cvtpk(s[2 * 33] * g0[2], s[3 * 33] * g0[3]); o.z = cvtpk(s[4 * 33] * g1[0], s[5 * 33] * g1[1]); o.w = cvtpk(s[6 * 33] * g1[2], s[7 * 33] * g1[3]);
        *(v4u*)(WT + (size_t)n * K + k0 + 8 * c) = o; }
    asm volatile("s_waitcnt lgkmcnt(0)" ::: "memory");
}
DI void p0_weights(const Args& a, LAS unsigned char* lds, int gw, int NGW, bool layer1) {
    int tid_ = threadIdx.x; asm volatile("" : "+v"(tid_)); const int tid = tid_, lane = tid & 63, wave = rfl(tid >> 6);
    LAS float* scr = (LAS float*)(lds + wave * 8704);
    unsigned char* ws = a.ws;
    constexpr int J0 = 72 * 16, J1 = J0 + 24 * 6, J2 = J1 + 32 * 4, J3 = J2 + 32 * 16, J4 = J3 + 128 * 16, J5 = J4 + 32 * 32, J6 = J5 + 96 * 16, J7 = J6 + 32 * 16, J8 = J7 + 256 * 16, J9 = J8 + 256 * 8;
    for (int it = (layer1 ? J5 : 0) + gw; it < (layer1 ? J9 : J5); it += NGW) {
        const int ln = lane & 31;
        if (it < J0) { const int nb = it / 16, kb = it % 16, n = nb * 32 + ln; int col; float sc = 1.f;
            if (n < 1536) { col = 672 + n; if (n < 512) sc = C_64; } else if (n < 1920) col = n - 1536; else if (n < 2176) col = 384 + (n - 1920); else if (n < 2208) col = 640 + map_rope32(n - 2176); else col = -1;
            cvt_item(a.in[I_EV_WIN], 2208, col, sc, a.in[I_EV_AN], 1024, (bf16*)(ws + W_IN) + (size_t)nb * 32 * 1024, kb * 64, scr, lane); }
        else if (it < J1) { const int r = it - J0, nb = r / 6, kb = r % 6, n = nb * 32 + ln; const int col = (nb % 3 == 2) ? nb * 32 + map_rope32(ln) : n;
            cvt_item(a.in[I_EV_WUQ], 768, col, C_MLA, a.in[I_EV_QN], 384, (bf16*)(ws + W_UQ) + (size_t)nb * 32 * 384, kb * 64, scr, lane); }
        else if (it < J2) { const int r = it - J1, nb = r / 4, kb = r % 4, n = nb * 32 + ln; const int col = n < 512 ? (n >> 6) * 128 + (n & 63) : ((n - 512) >> 6) * 128 + 64 + ((n - 512) & 63);
            cvt_item(a.in[I_EV_WUKV], 1024, col, 1.f, a.in[I_EV_KVN], 256, (bf16*)(ws + W_UKV) + (size_t)nb * 32 * 256, kb * 64, scr, lane); }
        else if (it < J3) { const int r = it - J2, nb = r / 16, kb = r % 16;
            cvt_item(a.in[I_EV_WO], 1024, nb * 32 + ln, 1.f, nullptr, 1024, (bf16*)(ws + W_O0) + (size_t)nb * 32 * 1024, kb * 64, scr, lane); }
        else if (it < J4) { const int r = it - J3, nb = r / 16, kb = r % 16, n = nb * 32 + ln; const int tile = n >> 8, half = (n >> 7) & 1, col = tile * 128 + (n & 127);
            cvt_item(half ? a.in[I_EV_WU] : a.in[I_EV_WG], 2048, col, 1.f, a.in[I_EV_FN], 1024, (bf16*)(ws + W_GU0) + (size_t)nb * 32 * 1024, kb * 64, scr, lane); }
        else if (it < J5) { const int r = it - J4, nb = r / 32, kb = r % 32;
            cvt_item(a.in[I_EV_WD], 1024, nb * 32 + ln, 1.f, nullptr, 2048, (bf16*)(ws + W_DN0) + (size_t)nb * 32 * 2048, kb * 64, scr, lane); }
        else if (it < J6) { const int r = it - J5, nb = r / 16, kb = r % 16, n = nb * 32 + ln;
            cvt_item(a.in[I_OD_WQKV], 3072, n, n < 1024 ? C_64 : 1.f, a.in[I_OD_AN], 1024, (bf16*)(ws + W_QKV) + (size_t)nb * 32 * 1024, kb * 64, scr, lane); }
        else if (it < J7) { const int r = it - J6, nb = r / 16, kb = r % 16;
            cvt_item(a.in[I_OD_WO], 1024, nb * 32 + ln, 1.f, nullptr, 1024, (bf16*)(ws + W_O1) + (size_t)nb * 32 * 1024, kb * 64, scr, lane); }
        else if (it < J8) { const int r = it - J7, nb = r / 16, kb = r % 16, n = nb * 32 + ln; const int e = n >> 10, m = n & 1023, tile = m >> 8, half = (m >> 7) & 1, col = tile * 128 + (m & 127);
            cvt_item((half ? a.in[I_OD_WU] : a.in[I_OD_WG]) + (size_t)e * 1024 * 512, 512, col, 1.f, a.in[I_OD_FN], 1024, (bf16*)(ws + W_EGU) + (size_t)nb * 32 * 1024, kb * 64, scr, lane); }
        else { const int r = it - J8, nb = r / 8, kb = r % 8, n = nb * 32 + ln; const int e = n >> 10, m = n & 1023;
            cvt_item(a.in[I_OD_WD] + (size_t)e * 512 * 1024, 1024, m, 1.f, nullptr, 512, (bf16*)(ws + W_EDN) + (size_t)nb * 32 * 512, kb * 64, scr, lane); }
    }
}
DI void p0_prologue(const Args& a, LAS unsigned char* lds, int vcu, int G) {
    int tid_ = threadIdx.x; asm volatile("" : "+v"(tid_)); const int tid = tid_, lane = tid & 63, wave = rfl(tid >> 6);
    const int gw = vcu * 8 + wave, NGW = G * 8;
    unsigned char* ws = a.ws;
    p0_weights(a, lds, gw, NGW, false);
    { const float* x = a.in[I_X]; bf16* XB = (bf16*)(ws + WS_XB); float* rs0 = (float*)(ws + WS_RSTD0);
      f32x4 nv[4];
      if (gw < T) { const f32x4* xr = (const f32x4*)(x + (size_t)gw * DM) + lane;
#pragma unroll
          for (int j = 0; j < 4; ++j) nv[j] = __builtin_nontemporal_load(xr + 64 * j); }
      for (int m = gw; m < T; m += NGW) { f32x4 v[4]; float s = 0.f;
#pragma unroll
          for (int j = 0; j < 4; ++j) v[j] = nv[j];
          if (m + NGW < T) { const f32x4* xr = (const f32x4*)(x + (size_t)(m + NGW) * DM) + lane;
#pragma unroll
              for (int j = 0; j < 4; ++j) nv[j] = __builtin_nontemporal_load(xr + 64 * j); }
#pragma unroll
          for (int j = 0; j < 4; ++j) s += (v[j].x * v[j].x + v[j].y * v[j].y) + (v[j].z * v[j].z + v[j].w * v[j].w);
          s = wave_sum(s); if (lane == 0) rs0[m] = rsqrtf(s * (1.f / DM) + RMS_EPS);
          unsigned long long* o8 = (unsigned long long*)(XB + (size_t)m * DM) + lane;
#pragma unroll
          for (int j = 0; j < 4; ++j) o8[64 * j] = (unsigned long long)cvtpk(v[j].x, v[j].y) | ((unsigned long long)cvtpk(v[j].z, v[j].w) << 32); } }
    { float2* rope = (float2*)(ws + WS_ROPE); const int gt = vcu * 512 + tid, NT_ = G * 512;
      for (int i = gt; i < SEQ * 16; i += NT_) { const int pos = i >> 4, f = i & 15;
          const double inv = (f & 8 ? 0.01 : 1.0) * (f & 4 ? 0.1 : 1.0) * (f & 2 ? 0.31622776601683794 : 1.0) * (f & 1 ? 0.5623413251903491 : 1.0);
          double rev = (double)pos * inv * 0.15915494309189535; rev -= __builtin_rint(rev);
          rope[i] = make_float2(__builtin_amdgcn_cosf((float)rev), __builtin_amdgcn_sinf((float)rev)); } }
    { float* wrt = (float*)(ws + WS_WRT); const int gt = vcu * 512 + tid, NT_ = G * 512;
      for (int i = gt; i < 8 * 1024; i += NT_) { const int e = i >> 10, k = i & 1023; wrt[i] = a.in[I_OD_FN][k] * a.in[I_OD_WR][k * 8 + e]; } }
}

using pg8::Unit;
typedef const f32x4 (&AccRef)[2][2][4][2];
DI v4u pack8(f32x4 a, f32x4 b) { v4u w; w.x = cvtpk(a[0], a[1]); w.y = cvtpk(a[2], a[3]); w.z = cvtpk(b[0], b[1]); w.w = cvtpk(b[2], b[3]); return w; }
DI float sumsq8(f32x4 a, f32x4 b) { return (a[0] * a[0] + a[1] * a[1]) + (a[2] * a[2] + a[3] * a[3]) + (b[0] * b[0] + b[1] * b[1]) + (b[2] * b[2] + b[3] * b[3]); }
DI float fq_sum(float s) { s += __shfl_xor(s, 16); s += __shfl_xor(s, 32); return s; }
DI float rstd_from(const float* P, int n4, float invn) { float s = 0.f;
#pragma unroll 4
    for (int i = 0; i < n4; ++i) { const f32x4 v = ((const f32x4*)P)[i]; s += (v[0] + v[1]) + (v[2] + v[3]); } return rsqrtf(s * invn + RMS_EPS); }
DI void rope_pair(f32x4& t1, f32x4& t2, const float2* rp  ) {
#pragma unroll
    for (int j = 0; j < 4; ++j) { const float2 cs = rp[j]; const float a = t1[j], b = t2[j]; t1[j] = a * cs.x - b * cs.y; t2[j] = b * cs.x + a * cs.y; }
}
DI unsigned long long pack4(f32x4 a) { return (unsigned long long)cvtpk(a[0], a[1]) | ((unsigned long long)cvtpk(a[2], a[3]) << 32); }

#define EPI_ROW(q) (u.pm * 256 + ((q) >> 2) * 128 + wr * 64 + ((q) & 3) * 16 + fr)
#define EPI_RSTD8(rs, NP4, P, stride, off, invn) do { f32x4 pv_[8]; const int fqc_ = fq < (NP4) ? fq : 0; \
        _Pragma("unroll") for (int q = 0; q < 8; ++q) pv_[q] = *(const f32x4*)((P) + (size_t)EPI_ROW(q) * (stride) + (off) + fqc_ * 4); \
        _Pragma("unroll") for (int q = 0; q < 8; ++q) { float s_ = (pv_[q][0] + pv_[q][1]) + (pv_[q][2] + pv_[q][3]); if (fq >= (NP4)) s_ = 0.f; s_ = fq_sum(s_); rs[q] = rsqrtf(s_ * (invn) + RMS_EPS); } } while (0)
struct EpiInProj {
    static constexpr bool PERM = true, AFTER_DRAIN = false;
    bf16 *SBQ, *CQ, *CKV, *KR; const float* rstd0; float* PQKV; const float2* rope;
    DI void operator()(AccRef acc, const Unit& u, int wr, int wc, int fr, int fq) const {
        { int ln_ = (int)__builtin_amdgcn_mbcnt_hi(~0u, __builtin_amdgcn_mbcnt_lo(~0u, 0u)); asm volatile("" : "+v"(ln_)); fr = ln_ & 15; fq = ln_ >> 4; }
        float rs[8];
#pragma unroll
        for (int q = 0; q < 8; ++q) rs[q] = rstd0[EPI_ROW(q)];
#pragma unroll
        for (int bj = 0; bj < 2; ++bj) {
            const int col0 = u.pn * 256 + bj * 128, cw = wc * 32 + fq * 8;
#pragma unroll
            for (int q = 0; q < 8; ++q) { const int ai = q >> 2, m = q & 3; const int r = EPI_ROW(q);
                f32x4 v0 = acc[ai][bj][m][0] * rs[q], v1 = acc[ai][bj][m][1] * rs[q];
                if (col0 < 1536) { bf16* dst = SBQ + (size_t)(col0 >> 9) * (size_t)(16u << 20) + (size_t)r * 512 + (col0 & 511) + cw; *(v4u*)dst = pack8(v0, v1); }
                else if (col0 < 1920) { *(v4u*)(CQ + (size_t)r * 384 + (col0 - 1536) + cw) = pack8(v0, v1); const float s = fq_sum(sumsq8(v0, v1)); if (fq == 0) PQKV[(size_t)r * 32 + (col0 - 1536) / 32 + wc] = s; }
                else if (col0 < 2176) { *(v4u*)(CKV + (size_t)r * 256 + (col0 - 1920) + cw) = pack8(v0, v1); const float s = fq_sum(sumsq8(v0, v1)); if (fq == 0) PQKV[(size_t)r * 32 + 16 + (col0 - 1920) / 32 + wc] = s; }
                else if (wc == 0) {
                    const f32x4* rp = (const f32x4*)(rope + (size_t)(r & (SEQ - 1)) * 16 + 4 * fq); const f32x4 ca = rp[0], cb = rp[1];
                    const float c[4] = {ca[0], ca[2], cb[0], cb[2]}, sn[4] = {ca[1], ca[3], cb[1], cb[3]};
#pragma unroll
                    for (int j = 0; j < 4; ++j) { const float a = v0[j], b = v1[j]; v0[j] = a * c[j] - b * sn[j]; v1[j] = b * c[j] + a * sn[j]; }
                    *(unsigned long long*)(KR + (size_t)r * 32 + 4 * fq) = pack4(v0); *(unsigned long long*)(KR + (size_t)r * 32 + 16 + 4 * fq) = pack4(v1); }
            }
        }
    }
};
struct EpiQUp {
    static constexpr bool PERM = true, AFTER_DRAIN = false;
    bf16* QA; const float* PQKV; const float2* rope;
    DI void operator()(AccRef acc, const Unit& u, int wr, int wc, int fr, int fq) const {
        { int ln_ = (int)__builtin_amdgcn_mbcnt_hi(~0u, __builtin_amdgcn_mbcnt_lo(~0u, 0u)); asm volatile("" : "+v"(ln_)); fr = ln_ & 15; fq = ln_ >> 4; }
        float rs[8]; EPI_RSTD8(rs, 3, PQKV, 32, 0, 1.f / 384.f);
        const bool rope0 = (u.pn * 8 + wc) % 3 == 2, rope1 = (u.pn * 8 + 4 + wc) % 3 == 2;
#pragma unroll
        for (int hb = 0; hb < 2; ++hb) {
            f32x4 cs[4][2];
            if (rope0 || rope1) {
#pragma unroll
                for (int qq = 0; qq < 4; ++qq) { const f32x4* rp = (const f32x4*)(rope + (size_t)(EPI_ROW(hb * 4 + qq) & (SEQ - 1)) * 16 + 4 * fq); cs[qq][0] = rp[0]; cs[qq][1] = rp[1]; } }
#pragma unroll
            for (int qq = 0; qq < 4; ++qq) { const int q = hb * 4 + qq, ai = q >> 2, m = q & 3; const int r = EPI_ROW(q);
#pragma unroll
                for (int bj = 0; bj < 2; ++bj) { const int gi = u.pn * 8 + bj * 4 + wc; const bool isr = bj ? rope1 : rope0;
                    f32x4 v0 = acc[ai][bj][m][0] * rs[q], v1 = acc[ai][bj][m][1] * rs[q];
                    if (!isr) *(v4u*)(QA + (size_t)r * 768 + gi * 32 + fq * 8) = pack8(v0, v1);
                    else { const float c[4] = {cs[qq][0][0], cs[qq][0][2], cs[qq][1][0], cs[qq][1][2]}, sn[4] = {cs[qq][0][1], cs[qq][0][3], cs[qq][1][1], cs[qq][1][3]};
#pragma unroll
                        for (int j = 0; j < 4; ++j) { const float a = v0[j], b = v1[j]; v0[j] = a * c[j] - b * sn[j]; v1[j] = b * c[j] + a * sn[j]; }
                        *(unsigned long long*)(QA + (size_t)r * 768 + gi * 32 + 4 * fq) = pack4(v0); *(unsigned long long*)(QA + (size_t)r * 768 + gi * 32 + 16 + 4 * fq) = pack4(v1); } }
            }
        }
    }
};
struct EpiKvUp {
    static constexpr bool PERM = true, AFTER_DRAIN = false;
    bf16* KN; const float* PQKV;
    DI void operator()(AccRef acc, const Unit& u, int wr, int wc, int fr, int fq) const {
        { int ln_ = (int)__builtin_amdgcn_mbcnt_hi(~0u, __builtin_amdgcn_mbcnt_lo(~0u, 0u)); asm volatile("" : "+v"(ln_)); fr = ln_ & 15; fq = ln_ >> 4; }
        float rs[8]; EPI_RSTD8(rs, 2, PQKV, 32, 16, 1.f / 256.f);
#pragma unroll
        for (int q = 0; q < 8; ++q) { const int ai = q >> 2, m = q & 3; const int r = EPI_ROW(q);
#pragma unroll
            for (int bj = 0; bj < 2; ++bj) { const int c = u.pn * 256 + bj * 128 + wc * 32 + fq * 8;
                bf16* dst = KN + (size_t)(c >> 9) * (size_t)(16u << 20) + (size_t)r * 512 + (c & 511);
                *(v4u*)dst = pack8(acc[ai][bj][m][0] * rs[q], acc[ai][bj][m][1] * rs[q]); }
        }
    }
};
template <bool RES_F32> struct EpiRes {
    static constexpr bool PERM = true, AFTER_DRAIN = false;
    const void* res; bf16* Y; float* PS;
    DI void operator()(AccRef acc, const Unit& u, int wr, int wc, int fr, int fq) const {
        { int ln_ = (int)__builtin_amdgcn_mbcnt_hi(~0u, __builtin_amdgcn_mbcnt_lo(~0u, 0u)); asm volatile("" : "+v"(ln_)); fr = ln_ & 15; fq = ln_ >> 4; }
        const size_t cb = (size_t)u.pn * 256 + wc * 32 + fq * 8;
#pragma unroll
        for (int hb = 0; hb < 2; ++hb) {
            f32x4 x0[4][2], x1[4][2];
#pragma unroll
            for (int qq = 0; qq < 4; ++qq)
#pragma unroll
                for (int bj = 0; bj < 2; ++bj) { const size_t o = (size_t)EPI_ROW(hb * 4 + qq) * 1024 + cb + bj * 128;
                    if (RES_F32) { x0[qq][bj] = *(const f32x4*)((const float*)res + o); x1[qq][bj] = *(const f32x4*)((const float*)res + o + 4); }
                    else { const v4u w = *(const v4u*)((const bf16*)res + o); x0[qq][bj] = (f32x4){bflo(w.x), bfhi(w.x), bflo(w.y), bfhi(w.y)}; x1[qq][bj] = (f32x4){bflo(w.z), bfhi(w.z), bflo(w.w), bfhi(w.w)}; } }
#pragma unroll
            for (int qq = 0; qq < 4; ++qq) { const int q = hb * 4 + qq, ai = q >> 2, m = q & 3; const int r = EPI_ROW(q); float ss = 0.f;
#pragma unroll
                for (int bj = 0; bj < 2; ++bj) { const f32x4 v0 = acc[ai][bj][m][0] + x0[qq][bj], v1 = acc[ai][bj][m][1] + x1[qq][bj]; ss += sumsq8(v0, v1); *(v4u*)(Y + (size_t)r * 1024 + cb + bj * 128) = pack8(v0, v1); }
                ss = fq_sum(ss); if (fq == 0) PS[(size_t)r * 16 + u.pn * 4 + wc] = ss; }
        }
    }
};
DI f32x4 silu_mul(f32x4 g, f32x4 u) { f32x4 o;
#pragma unroll
    for (int j = 0; j < 4; ++j) o[j] = g[j] * u[j] * __builtin_amdgcn_rcpf(1.f + ex2(-g[j] * LOG2E)); return o; }
struct EpiSwiGLU {
    static constexpr bool PERM = true, AFTER_DRAIN = false;
    bf16* H; int ldh, ntile; const float* PS; const float* srs;
    DI void operator()(AccRef acc, const Unit& u, int wr, int wc, int fr, int fq) const {
        { int ln_ = (int)__builtin_amdgcn_mbcnt_hi(~0u, __builtin_amdgcn_mbcnt_lo(~0u, 0u)); asm volatile("" : "+v"(ln_)); fr = ln_ & 15; fq = ln_ >> 4; }
        float rs[8];
        if (PS) EPI_RSTD8(rs, 4, PS, 16, 0, 1.f / 1024.f);
        else {
#pragma unroll
            for (int q = 0; q < 8; ++q) rs[q] = srs[EPI_ROW(q)]; }
#pragma unroll
        for (int q = 0; q < 8; ++q) { const int ai = q >> 2, m = q & 3; const int r = EPI_ROW(q);
            const f32x4 h0 = silu_mul(acc[ai][0][m][0] * rs[q], acc[ai][1][m][0] * rs[q]), h1 = silu_mul(acc[ai][0][m][1] * rs[q], acc[ai][1][m][1] * rs[q]);
            *(v4u*)(H + (size_t)r * ldh + (u.pn % ntile) * 128 + wc * 32 + fq * 8) = pack8(h0, h1); }
    }
};
struct EpiQkv {
    static constexpr bool PERM = true, AFTER_DRAIN = false;
    bf16* Q2; const float* PS; float* KMP;
    DI void operator()(AccRef acc, const Unit& u, int wr, int wc, int fr, int fq) const {
        { int ln_ = (int)__builtin_amdgcn_mbcnt_hi(~0u, __builtin_amdgcn_mbcnt_lo(~0u, 0u)); asm volatile("" : "+v"(ln_)); fr = ln_ & 15; fq = ln_ >> 4; }
        float rs[8]; EPI_RSTD8(rs, 4, PS, 16, 0, 1.f / 1024.f);
        const int sec = u.pn >> 2; bf16* dstb = Q2 + (size_t)sec * (size_t)(32u << 20);
        f32x4 cs[2][2];
#pragma unroll
        for (int bj = 0; bj < 2; ++bj) { cs[bj][0] = (f32x4){0.f, 0.f, 0.f, 0.f}; cs[bj][1] = cs[bj][0]; }
#pragma unroll
        for (int q = 0; q < 8; ++q) { const int ai = q >> 2, m = q & 3; const int r = EPI_ROW(q);
#pragma unroll
            for (int bj = 0; bj < 2; ++bj) { const f32x4 v0 = acc[ai][bj][m][0] * rs[q], v1 = acc[ai][bj][m][1] * rs[q]; cs[bj][0] += v0; cs[bj][1] += v1;
                *(v4u*)(dstb + (size_t)r * 1024 + (u.pn & 3) * 256 + bj * 128 + wc * 32 + fq * 8) = pack8(v0, v1); }
        }
        if (sec == 1) {
#pragma unroll
            for (int bj = 0; bj < 2; ++bj)
#pragma unroll
                for (int n = 0; n < 2; ++n) { f32x4 s = cs[bj][n];
#pragma unroll
                    for (int j = 0; j < 4; ++j) { float t = s[j]; t += __shfl_xor(t, 1); t += __shfl_xor(t, 2); t += __shfl_xor(t, 4); t += __shfl_xor(t, 8); s[j] = t; }
                    if (fr == 0) *(f32x4*)(KMP + ((size_t)wr * (T / 256) + u.pm) * 1024 + (u.pn & 3) * 256 + bj * 128 + wc * 32 + fq * 8 + n * 4) = s; }
        }
    }
};
struct EpiMoeDown {
    static constexpr bool PERM = true, AFTER_DRAIN = false;
    bf16* YP; const int* sdst; const float* sw;
    DI void operator()(AccRef acc, const Unit& u, int wr, int wc, int fr, int fq) const {
        { int ln_ = (int)__builtin_amdgcn_mbcnt_hi(~0u, __builtin_amdgcn_mbcnt_lo(~0u, 0u)); asm volatile("" : "+v"(ln_)); fr = ln_ & 15; fq = ln_ >> 4; }
        int d[8]; float w[8];
#pragma unroll
        for (int q = 0; q < 8; ++q) { d[q] = sdst[EPI_ROW(q)]; w[q] = sw[EPI_ROW(q)]; }
#pragma unroll
        for (int q = 0; q < 8; ++q) { const int ai = q >> 2, m = q & 3;
            if (d[q] >= 0) {
#pragma unroll
                for (int bj = 0; bj < 2; ++bj) __builtin_nontemporal_store(pack8(acc[ai][bj][m][0] * w[q], acc[ai][bj][m][1] * w[q]), (v4u*)(YP + (size_t)d[q] * 1024 + (u.pn & 3) * 256 + bj * 128 + wc * 32 + fq * 8)); }
        }
    }
};
struct MoeOrder {
    const int* tile_e; int nrt, G, c;
    DI bool next(int i, Unit& u) const { const long L = (long)i * G + c; if (L >= (long)nrt * 4) return false; const int rt = (int)(L >> 2); u.pm = rt; u.pn = tile_e[rt] * 4 + (int)(L & 3); return true; }
    DI void a_ready(const Unit&) const {}
    DI void done(const Unit&) const {}
};

#ifndef DBG_CHECK
#define DBG_CHECK 0
#endif
constexpr int CW_ERR = 8320;
#if DBG_CHECK
DI float bf2f(bf16 v) { return __uint_as_float((unsigned)v << 16); }
DI void dbg_flag(unsigned* ctl, unsigned bit) { atomicOr(ctl + CW_ERR, bit); }
DI float blk_max(float v, LAS float* red, int tid) { red[tid] = v; __syncthreads(); for (int o = 256; o > 0; o >>= 1) { if (tid < o) red[tid] = fmaxf(red[tid], red[tid + o]); __syncthreads(); } const float r = red[0]; __syncthreads(); return r; }
DI float blk_sum(float v, LAS float* red, int tid) { red[tid] = v; __syncthreads(); for (int o = 256; o > 0; o >>= 1) { if (tid < o) red[tid] = red[tid] + red[tid + o]; __syncthreads(); } const float r = red[0]; __syncthreads(); return r; }
DI unsigned dbg_hash(unsigned i) { i ^= i >> 16; i *= 0x7feb352du; i ^= i >> 15; i *= 0x846ca68bu; i ^= i >> 16; return i; }
DI int dbg_pos(int i) { switch (i) { case 0: return 0; case 1: return 1; case 2: return 31; case 3: return 32; case 4: return 63; case 5: return 64; case 6: return 65; case 7: return 255; case 8: return 256; case 9: return 257;
    case 10: return 511; case 11: return 512; case 12: return 4095; case 13: return 4096; case 14: return 8191; case 15: return 16383; default: return (int)(dbg_hash((unsigned)i) % SEQ); } }
template <int MODE> DI void naive_attn(const Args& a, int b, int h, int s, LAS unsigned char* lds, unsigned sel) {
    const int tid = threadIdx.x; unsigned char* ws = a.ws;
    LAS float* lg = (LAS float*)lds; LAS float* red = (LAS float*)(lds + 65536); LAS float* qv = (LAS float*)(lds + 67584); LAS float* opart = (LAS float*)(lds + 68096); LAS float* oref = (LAS float*)(lds + 70144);
    const size_t r = (size_t)b * SEQ + s;
    const int DQ = MODE == 0 ? 96 : 64; float mblk = 0.f;
    if (tid < DQ) { float q;
        if (MODE == 0) q = bf2f(((const bf16*)(ws + WS_QA))[r * 768 + h * 96 + tid]); else if (MODE == 1) q = bf2f(((const bf16*)(ws + WS_SBQ))[r * 512 + h * 64 + tid]); else q = bf2f(((const bf16*)(ws + WS_Q2))[r * 1024 + h * 64 + tid]);
        qv[tid] = q; }
    __syncthreads();
    const int nk = MODE == 1 ? s : s + 1;
    float lmax = -INFINITY;
    for (int k = tid; k < nk; k += 512) { const size_t kr = (size_t)b * SEQ + k; float acc = 0.f;
        if (MODE == 0) { const bf16* kn = (const bf16*)(ws + WS_KN) + kr * 512 + h * 64; const bf16* kp = (const bf16*)(ws + WS_KR) + kr * 32;
            for (int d = 0; d < 64; ++d) acc += qv[d] * bf2f(kn[d]); for (int d = 0; d < 32; ++d) acc += qv[64 + d] * bf2f(kp[d]); }
        else if (MODE == 1) { const bf16* kk = (const bf16*)(ws + WS_SBK) + kr * 512 + h * 64; for (int d = 0; d < 64; ++d) acc += qv[d] * bf2f(kk[d]); }
        else { const int kb = k >> 8, qb = s >> 8; (void)qb; const bool ok = (MODE == 2 && kb == qb) || kb == (int)(sel & 0xFFu) || kb == (int)((sel >> 8) & 0xFFu) || kb == (int)((sel >> 16) & 0xFFu);
            if (ok) { const bf16* kk = (const bf16*)(ws + WS_K2) + kr * 1024 + h * 64; for (int d = 0; d < 64; ++d) acc += qv[d] * bf2f(kk[d]);
                const int dist = s - k; int bucket = dist; if (dist >= 16) { bucket = 16 + (int)(logf((float)dist / 16.f) / 2.0794415416798357f * 16.f); if (bucket > 31) bucket = 31; }
                acc += a.in[I_RELB][h * 32 + bucket] * LOG2E; } else acc = -INFINITY; }
        lg[k] = acc; lmax = fmaxf(lmax, acc); }
    __syncthreads();
    float tot = 1.f;
    if (MODE == 1) { if (tid == 0) { float run = 0.f; for (int k = nk - 1; k >= 0; --k) { const float y = lg[k]; const float sp = fmaxf(y, 0.f) + log2f(1.f + exp2f(-fabsf(y))); lg[k] = exp2f(y - sp + run); run -= sp; } } __syncthreads(); }
    else { const float m = blk_max(lmax, red, tid); mblk = m; float ls = 0.f; for (int k = tid; k < nk; k += 512) { const float p = exp2f(lg[k] - m); lg[k] = p; ls += p; } __syncthreads(); tot = blk_sum(ls, red, tid); }
    { const int g = tid >> 6, d = tid & 63; float acc = 0.f;
      for (int k = g; k < nk; k += 8) { const size_t kr = (size_t)b * SEQ + k; float v;
          if (MODE == 0) v = bf2f(((const bf16*)(ws + WS_VA))[kr * 512 + h * 64 + d]); else if (MODE == 1) v = bf2f(((const bf16*)(ws + WS_SBV))[kr * 512 + h * 64 + d]); else v = bf2f(((const bf16*)(ws + WS_V2))[kr * 1024 + h * 64 + d]);
          const float p = lg[k]; if (p != 0.f) acc += p * v; }
      opart[g * 64 + d] = acc; }
    __syncthreads();
    if (tid < 64) { float acc = 0.f; for (int g = 0; g < 8; ++g) acc += opart[g * 64 + tid]; oref[tid] = acc / tot; }
    if (tid == 0) oref[64] = mblk + log2f(tot);
    __syncthreads();
}
DI void dbg_cmp64(const bf16* got, LAS unsigned char* lds, unsigned* ctl, unsigned bit) {
    const int tid = threadIdx.x; LAS float* red = (LAS float*)(lds + 65536); LAS float* oref = (LAS float*)(lds + 70144);
    const float v = tid < 64 ? fabsf(oref[tid]) : 0.f; const float mx = blk_max(v, red, tid);
    if (tid < 64) { const float g = bf2f(got[tid]); if (!(fabsf(g - oref[tid]) <= 0.02f * mx + 2e-3f)) dbg_flag(ctl, bit); }
    __syncthreads();
}
DI void dbg_check_a(const Args& a, LAS unsigned char* lds, unsigned* ctl, int bx, int G) {
    const int tid = threadIdx.x; unsigned char* ws = a.ws;
    LAS float* red = (LAS float*)(lds + 65536); LAS float* hrow = (LAS float*)lds;
    LAS float* cq = (LAS float*)(lds + 4096); LAS float* ckv = (LAS float*)(lds + 8192);
    const float2* rope = (const float2*)(ws + WS_ROPE);
    for (int i = bx; i < 256; i += G) {
        const int b = i & 1, s = dbg_pos(i >> 1); const size_t r = (size_t)b * SEQ + s;
        float ss = 0.f; for (int k = tid; k < 1024; k += 512) { const float x = a.in[I_X][r * 1024 + k]; ss += x * x; }
        const float rs = rsqrtf(blk_sum(ss, red, tid) / 1024.f + RMS_EPS);
        for (int k = tid; k < 1024; k += 512) hrow[k] = a.in[I_X][r * 1024 + k] * rs * a.in[I_EV_AN][k];
        __syncthreads();
        for (int j = tid; j < 2208; j += 512) { float acc = 0.f; for (int k = 0; k < 1024; ++k) acc += hrow[k] * a.in[I_EV_WIN][(size_t)k * 2208 + j];
            float got, ref = acc; bool cmp = true;
            if (j < 384) got = bf2f(((const bf16*)(ws + WS_CQ))[r * 384 + j]);
            else if (j < 640) got = bf2f(((const bf16*)(ws + WS_CKV))[r * 256 + (j - 384)]);
            else if (j < 672) { cmp = false; got = 0.f; }
            else if (j < 1184) { got = bf2f(((const bf16*)(ws + WS_SBQ))[r * 512 + (j - 672)]); ref = acc * C_64; }
            else if (j < 1696) got = bf2f(((const bf16*)(ws + WS_SBK))[r * 512 + (j - 1184)]);
            else got = bf2f(((const bf16*)(ws + WS_SBV))[r * 512 + (j - 1696)]);
            if (cmp && !(fabsf(got - ref) <= 0.03f * fabsf(ref) + 0.03f)) dbg_flag(ctl, 1u); }
        if (tid < 16) { float t1 = 0.f, t2 = 0.f; for (int k = 0; k < 1024; ++k) { t1 += hrow[k] * a.in[I_EV_WIN][(size_t)k * 2208 + 640 + tid]; t2 += hrow[k] * a.in[I_EV_WIN][(size_t)k * 2208 + 656 + tid]; }
            const float ang = (float)s * powf(10000.f, -(float)tid / 16.f); const float c = cosf(ang), sn = sinf(ang);
            const float o1 = t1 * c - t2 * sn, o2 = t2 * c + t1 * sn; const float g1 = bf2f(((const bf16*)(ws + WS_KR))[r * 32 + tid]), g2 = bf2f(((const bf16*)(ws + WS_KR))[r * 32 + 16 + tid]);
            if (!(fabsf(g1 - o1) <= 0.03f * fabsf(o1) + 0.03f) || !(fabsf(g2 - o2) <= 0.03f * fabsf(o2) + 0.03f)) dbg_flag(ctl, 1u);
            const float2 tb = rope[(size_t)s * 16 + tid]; if (!(fabsf(tb.x - c) < 2e-3f && fabsf(tb.y - sn) < 2e-3f)) dbg_flag(ctl, 1u); }
        __syncthreads();
        float s1 = 0.f, s2 = 0.f;
        if (tid < 384) { const float v = bf2f(((const bf16*)(ws + WS_CQ))[r * 384 + tid]); s1 = v * v; cq[tid] = v; }
        if (tid < 256) { const float v = bf2f(((const bf16*)(ws + WS_CKV))[r * 256 + tid]); s2 = v * v; ckv[tid] = v; }
        const float rq = rsqrtf(blk_sum(s1, red, tid) / 384.f + RMS_EPS), rk = rsqrtf(blk_sum(s2, red, tid) / 256.f + RMS_EPS);
        if (tid < 384) cq[tid] *= rq * a.in[I_EV_QN][tid];
        if (tid < 256) ckv[tid] *= rk * a.in[I_EV_KVN][tid];
        __syncthreads();
        for (int j = tid; j < 768; j += 512) { const int hh = j / 96, dd = j % 96; float acc = 0.f; for (int k = 0; k < 384; ++k) acc += cq[k] * a.in[I_EV_WUQ][(size_t)k * 768 + j];
            float ref = acc;
            if (dd >= 64) { const int ri = dd - 64, pi = ri < 16 ? ri : ri - 16; const int jp = hh * 96 + 64 + (ri < 16 ? ri + 16 : ri - 16); float accp = 0.f; for (int k = 0; k < 384; ++k) accp += cq[k] * a.in[I_EV_WUQ][(size_t)k * 768 + jp];
                const float ang = (float)s * powf(10000.f, -(float)pi / 16.f); const float c = cosf(ang), sn = sinf(ang); ref = ri < 16 ? acc * c - accp * sn : acc * c + accp * sn; }
            ref *= C_MLA; const float got = bf2f(((const bf16*)(ws + WS_QA))[r * 768 + j]);
            if (!(fabsf(got - ref) <= 0.03f * fabsf(ref) + 0.02f)) dbg_flag(ctl, 1u); }
        for (int j = tid; j < 1024; j += 512) { const int hh = j >> 7, dd = j & 127; float acc = 0.f; for (int k = 0; k < 256; ++k) acc += ckv[k] * a.in[I_EV_WUKV][(size_t)k * 1024 + j];
            const float got = dd < 64 ? bf2f(((const bf16*)(ws + WS_KN))[r * 512 + hh * 64 + dd]) : bf2f(((const bf16*)(ws + WS_VA))[r * 512 + hh * 64 + dd - 64]);
            if (!(fabsf(got - acc) <= 0.03f * fabsf(acc) + 0.03f)) dbg_flag(ctl, 1u); }
        __syncthreads();
        const int h = (int)(dbg_hash((unsigned)i * 7u + 1u) & 7u);
        naive_attn<0>(a, b, h, s, lds, 0u); dbg_cmp64((const bf16*)(ws + WS_OCAT) + r * 1024 + h * 64, lds, ctl, 2u);
        naive_attn<1>(a, b, h, s, lds, 0u); dbg_cmp64((const bf16*)(ws + WS_OCAT) + r * 1024 + 512 + h * 64, lds, ctl, 4u);
    }
}
DI void dbg_check_b(const Args& a, LAS unsigned char* lds, unsigned* ctl, int bx, int G, const bf16* O2) {
    const int tid = threadIdx.x; unsigned char* ws = a.ws;
    LAS float* red = (LAS float*)(lds + 65536); LAS float* hrow = (LAS float*)lds; LAS float* gate = (LAS float*)(lds + 8192);
    const bf16* X2 = (const bf16*)a.out;
    for (int i = bx; i < 256; i += G) {
        const int b = i & 1, s = dbg_pos(i >> 1), h = (int)(dbg_hash((unsigned)i * 11u + 5u) & 15u); const size_t r = (size_t)b * SEQ + s;
        float ss = 0.f; for (int k = tid; k < 1024; k += 512) { const float x = bf2f(X2[r * 1024 + k]); ss += x * x; }
        const float rs = rsqrtf(blk_sum(ss, red, tid) / 1024.f + RMS_EPS);
        for (int k = tid; k < 1024; k += 512) hrow[k] = bf2f(X2[r * 1024 + k]) * rs * a.in[I_OD_AN][k];
        __syncthreads();
        for (int j = tid; j < 3072; j += 512) { float acc = 0.f; for (int k = 0; k < 1024; ++k) acc += hrow[k] * a.in[I_OD_WQKV][(size_t)k * 3072 + j];
            float ref = acc; float got;
            if (j < 1024) { ref = acc * C_64; got = bf2f(((const bf16*)(ws + WS_Q2))[r * 1024 + j]); } else if (j < 2048) got = bf2f(((const bf16*)(ws + WS_K2))[r * 1024 + j - 1024]); else got = bf2f(((const bf16*)(ws + WS_V2))[r * 1024 + j - 2048]);
            if (!(fabsf(got - ref) <= 0.03f * fabsf(ref) + 0.03f)) dbg_flag(ctl, 8u); }
        __syncthreads();
        const int qb = s >> 8; const unsigned sel = ((const unsigned*)(ws + WS_SEL))[((size_t)(b * 16 + h)) * SEQ + s];
        if (tid < 64) gate[tid] = -INFINITY;
        __syncthreads();
        { const int n = tid >> 3, part = tid & 7;
          float acc = 0.f; if (n < qb) { for (int kk = part * 32; kk < part * 32 + 32; ++kk) { const size_t kr = (size_t)b * SEQ + n * 256 + kk; for (int d = 0; d < 64; ++d) acc += bf2f(((const bf16*)(ws + WS_Q2))[r * 1024 + h * 64 + d]) * bf2f(((const bf16*)(ws + WS_K2))[kr * 1024 + h * 64 + d]); } }
          acc += __shfl_xor(acc, 1); acc += __shfl_xor(acc, 2); acc += __shfl_xor(acc, 4); if (part == 0 && n < qb) gate[n] = acc / 256.f; }
        __syncthreads();
        if (tid == 0) { const int nsel_exp = qb < 3 ? qb : 3; int nsel = 0; float gmin = INFINITY; bool bad = false;
            for (int k = 0; k < 3; ++k) { const unsigned e = (sel >> (8 * k)) & 0xFFu; if (e != 0xFFu) { if ((int)e >= qb) bad = true; else { ++nsel; gmin = fminf(gmin, gate[e]); } } }
            if (nsel != nsel_exp) bad = true;
            if ((sel & 0xFFu) != 0xFFu && ((sel & 0xFFu) == ((sel >> 8) & 0xFFu) || (sel & 0xFFu) == ((sel >> 16) & 0xFFu))) bad = true;
            if (((sel >> 8) & 0xFFu) != 0xFFu && ((sel >> 8) & 0xFFu) == ((sel >> 16) & 0xFFu)) bad = true;
            if (!bad && nsel > 0) { float gsc = 0.f; for (int n = 0; n < qb; ++n) gsc = fmaxf(gsc, fabsf(gate[n]));
                for (int n = 0; n < qb; ++n) { const bool chosen = n == (int)(sel & 0xFFu) || n == (int)((sel >> 8) & 0xFFu) || n == (int)((sel >> 16) & 0xFFu); if (!chosen && gate[n] > gmin + 0.02f * gsc + 1e-3f) bad = true; } }
            if (bad) dbg_flag(ctl, 8u); }
        __syncthreads();
        { LAS float* oref = (LAS float*)(lds + 70144); float* dref = (float*)(ws + WS_WRT + 256 * 1024) + (size_t)i * 64;
          naive_attn<2>(a, b, h, s, lds, 0xFFFFFFu);
          { const float v = tid < 64 ? fabsf(oref[tid]) : 0.f; const float mx = blk_max(v, red, tid);
            const float2 ms = ((const float2*)(ws + WS_PMS))[((size_t)(3 * 32 + b * 16 + h)) * SEQ + s]; const bf16* pob = (const bf16*)a.out + (size_t)32 * 1024 * 1024 + (((size_t)(b * 16 + h)) * SEQ + s) * 64;
            if (tid == 0) { if (!(fabsf(ms.x + log2f(ms.y) - oref[64]) <= 0.05f)) dbg_flag(ctl, 8u); }
            if (tid < 64) { const float g = bf2f(pob[tid]) / ms.y; if (!(fabsf(g - oref[tid]) <= 0.02f * mx + 2e-3f)) dbg_flag(ctl, 8u); }
            __syncthreads(); }
          naive_attn<2>(a, b, h, s, lds, sel);
          if (tid < 64) dref[tid] = oref[tid];
          __syncthreads(); }
    }
}
DI void dbg_check_b2(const Args& a, LAS unsigned char* lds, unsigned* ctl, int bx, int G, const bf16* O2) {
    const int tid = threadIdx.x; unsigned char* ws = a.ws; LAS float* red = (LAS float*)(lds + 65536);
    for (int i = bx; i < 256; i += G) {
        const int b = i & 1, s = dbg_pos(i >> 1), h = (int)(dbg_hash((unsigned)i * 11u + 5u) & 15u); const size_t r = (size_t)b * SEQ + s;
        const float* dref = (const float*)(ws + WS_WRT + 256 * 1024) + (size_t)i * 64;
        const float rf = tid < 64 ? dref[tid] : 0.f; const float mx = blk_max(fabsf(rf), red, tid);
        if (tid < 64) { const float g = bf2f(O2[r * 1024 + h * 64 + tid]); if (!(fabsf(g - rf) <= 0.02f * mx + 2e-3f)) dbg_flag(ctl, 8u); }
        __syncthreads();
    }
}
#endif

DI void router_chunk(const Args& a, int ch, LAS unsigned char* lds) {
    int tid_ = threadIdx.x; asm volatile("" : "+v"(tid_)); const int tid = tid_, lane = tid & 63, wave = rfl(tid >> 6);
    unsigned char* ws = a.ws;
    const bf16* X3 = (const bf16*)(ws + WS_X3B); const float* PS3 = (const float*)(ws + WS_PS3);
    volatile LAS unsigned* te = (volatile LAS unsigned*)(lds + 32768);
    float2* TOKW = (float2*)(ws + WS_TOKW); float* TOKR = (float*)(ws + WS_TOKR); unsigned* TOKE = (unsigned*)(ws + WS_TOKE);
    f32x4 wr[8][4];
    { const f32x4* wg = (const f32x4*)(ws + WS_WRT);
#pragma unroll
      for (int e = 0; e < 8; ++e) { wr[e][0] = wg[e * 256 + lane * 2]; wr[e][1] = wg[e * 256 + lane * 2 + 1]; wr[e][2] = wg[e * 256 + 128 + lane * 2]; wr[e][3] = wg[e * 256 + 128 + lane * 2 + 1]; } }
    v4u nw0 = *((const v4u*)(X3 + (size_t)(ch * 128 + wave * 16) * 1024) + lane), nw1 = *((const v4u*)(X3 + (size_t)(ch * 128 + wave * 16) * 1024 + 512) + lane);
    float npss = PS3[(size_t)(ch * 128 + wave * 16) * 16 + (lane & 15)];
#pragma unroll 1
    for (int i = 0; i < 16; ++i) {
        const int tl = wave * 16 + i, tok = ch * 128 + tl;
        const v4u w0 = nw0, w1 = nw1; float pss = npss;
        if (i < 15) { nw0 = *((const v4u*)(X3 + (size_t)(tok + 1) * 1024) + lane); nw1 = *((const v4u*)(X3 + (size_t)(tok + 1) * 1024 + 512) + lane); npss = PS3[(size_t)(tok + 1) * 16 + (lane & 15)]; }
        float xv[16] = {bflo(w0.x), bfhi(w0.x), bflo(w0.y), bfhi(w0.y), bflo(w0.z), bfhi(w0.z), bflo(w0.w), bfhi(w0.w), bflo(w1.x), bfhi(w1.x), bflo(w1.y), bfhi(w1.y), bflo(w1.z), bfhi(w1.z), bflo(w1.w), bfhi(w1.w)};
        float pv[8];
#pragma unroll
        for (int e = 0; e < 8; ++e) { const f32x4 a0 = wr[e][0], a1 = wr[e][1], b0 = wr[e][2], b1 = wr[e][3];
            float s = xv[0] * a0[0] + xv[1] * a0[1] + xv[2] * a0[2] + xv[3] * a0[3] + xv[4] * a1[0] + xv[5] * a1[1] + xv[6] * a1[2] + xv[7] * a1[3];
            s += xv[8] * b0[0] + xv[9] * b0[1] + xv[10] * b0[2] + xv[11] * b0[3] + xv[12] * b1[0] + xv[13] * b1[1] + xv[14] * b1[2] + xv[15] * b1[3];
            pv[e] = s; }
        float k4[4], k2[2], k1;
        { const bool h5 = (lane >> 5) & 1, h4 = (lane >> 4) & 1, h3 = (lane >> 3) & 1;
#pragma unroll
          for (int i = 0; i < 4; ++i) { const float send = h5 ? pv[i] : pv[4 + i]; k4[i] = (h5 ? pv[4 + i] : pv[i]) + __shfl_xor(send, 32); }
#pragma unroll
          for (int i = 0; i < 2; ++i) { const float send = h4 ? k4[i] : k4[2 + i]; k2[i] = (h4 ? k4[2 + i] : k4[i]) + __shfl_xor(send, 16); }
          { const float send = h3 ? k2[0] : k2[1]; k1 = (h3 ? k2[1] : k2[0]) + __shfl_xor(send, 8); }
          k1 += __shfl_xor(k1, 4); k1 += __shfl_xor(k1, 2); k1 += __shfl_xor(k1, 1); }
        float lg[8];
#pragma unroll
        for (int e = 0; e < 8; ++e) lg[e] = __uint_as_float(__builtin_amdgcn_readlane(__float_as_uint(k1), e * 8));
        pss += __shfl_xor(pss, 1); pss += __shfl_xor(pss, 2); pss += __shfl_xor(pss, 4); pss += __shfl_xor(pss, 8);
        const float rs = rsqrtf(pss * (1.f / 1024.f) + RMS_EPS);
        float v1 = -INFINITY, v2 = -INFINITY; unsigned i1 = 0, i2 = 0;
#pragma unroll
        for (int e = 0; e < 8; ++e) { const float l = lg[e] * rs; if (l > v1) { v2 = v1; i2 = i1; v1 = l; i1 = (unsigned)e; } else if (l > v2) { v2 = l; i2 = (unsigned)e; } }
        const float w1g = 1.f / (1.f + __expf(v2 - v1));
        if (lane == 0) { TOKW[tok] = make_float2(w1g, 1.f - w1g); TOKR[tok] = rs; TOKE[tok] = i1 | (i2 << 8); te[tl] = i1 | (i2 << 8); }
    }
    __syncthreads();
    { const unsigned e = (unsigned)wave; const unsigned ta = te[2 * lane], tb = te[2 * lane + 1];
      const unsigned m0 = (ta & 0xFFu) == e, m1 = ((ta >> 8) & 0xFFu) == e, m2 = (tb & 0xFFu) == e, m3 = ((tb >> 8) & 0xFFu) == e;
      const unsigned c = m0 + m1 + m2 + m3; unsigned inc = c;
#pragma unroll
      for (int o = 1; o < 64; o <<= 1) { const unsigned t = __shfl_up(inc, o); if (lane >= o) inc += t; }
      unsigned base = inc - c; int* PR = (int*)(ws + WS_PRANK) + (size_t)ch * 256 + 4 * lane;
      if (m0) { PR[0] = (int)base; ++base; } if (m1) { PR[1] = (int)base; ++base; } if (m2) { PR[2] = (int)base; ++base; } if (m3) { PR[3] = (int)base; ++base; }
      if (lane == 63) ((int*)(ws + WS_CNT))[ch * 8 + wave] = (int)inc; }
    __syncthreads();
}

DI void permute_phase(const Args& a, LAS unsigned char* lds, int G) {
    int tid_ = threadIdx.x; asm volatile("" : "+v"(tid_)); const int tid = tid_;
    unsigned char* ws = a.ws;
    LAS int* cnt = (LAS int*)lds;
    LAS int* off = (LAS int*)(lds + 8192);
    LAS int* ebase = (LAS int*)(lds + 16384);
    const int* CNT = (const int*)(ws + WS_CNT);
    for (int i = tid; i < 2048; i += 512) cnt[i] = CNT[i];
    __syncthreads();
    if (tid < 8) { int s = 0; for (int c = 0; c < 256; ++c) { off[c * 8 + tid] = s; s += cnt[c * 8 + tid]; } ebase[16 + tid] = s; }
    __syncthreads();
    if (tid == 0) { int s = 0; for (int e = 0; e < 8; ++e) { ebase[e] = s; s += (ebase[16 + e] + 255) & ~255; } ebase[8] = s; }
    __syncthreads();
    int* SDST = (int*)(ws + WS_SDST); float* SW = (float*)(ws + WS_SW); float* SRS = (float*)(ws + WS_SRS);
    int* STOK = (int*)(ws + WS_STOK);
    const float2* TOKW = (const float2*)(ws + WS_TOKW); const float* TOKR = (const float*)(ws + WS_TOKR); const unsigned* TOKE = (const unsigned*)(ws + WS_TOKE); const int* PRANK = (const int*)(ws + WS_PRANK);
    if (blockIdx.x == 0) {
        int* TE = (int*)(ws + WS_TILEE); const int nrt = ebase[8] >> 8;
        for (int rt = tid; rt < nrt; rt += 512) { int e = 0; for (int k = 1; k < 8; ++k) if (rt * 256 >= ebase[k]) e = k; TE[rt] = e; }
        if (tid == 0) ((unsigned*)(ws + WS_CTL))[CW_NRT] = (unsigned)nrt;
    }
    for (int e = blockIdx.x; e < 8; e += G) {
        const int lo = ebase[e] + ebase[16 + e], hi = ebase[e + 1];
        for (int s = lo + tid; s < hi; s += 512) { SDST[s] = -1; SW[s] = 0.f; SRS[s] = 0.f; STOK[s] = 0; }
    }
    for (int ch = blockIdx.x; ch < 256; ch += G) {
        if (tid < 256) { const int tok = ch * 128 + (tid >> 1), k = tid & 1; const unsigned te = TOKE[tok]; const int e = (int)((te >> (8 * k)) & 0xFFu);
            const int slot = ebase[e] + off[ch * 8 + e] + PRANK[(size_t)ch * 256 + tid];
            const float2 w = TOKW[tok]; SDST[slot] = tok * 2 + k; SW[slot] = k ? w.y : w.x; SRS[slot] = TOKR[tok]; STOK[slot] = tok; }
    }
}

DI void final_phase(const Args& a, int vcu, int G, float oscale) {
    int tid_ = threadIdx.x; asm volatile("" : "+v"(tid_)); const int tid = tid_, lane = tid & 63, wave = rfl(tid >> 6);
    const bf16* X3 = (const bf16*)(a.ws + WS_X3B); const bf16* YP = (const bf16*)(a.ws + WS_YP); const float* g = a.in[I_FINN];
    const int gw = vcu * 8 + wave, NGW = G * 8;
    f32x4 gv[4];
#pragma unroll
    for (int j = 0; j < 4; ++j) gv[j] = *((const f32x4*)g + 2 * lane + (j & 1) + 128 * (j >> 1));
    v4u nx[2], ny0[2], ny1[2];
#define FN_LOAD(m) do { _Pragma("unroll") for (int hlf = 0; hlf < 2; ++hlf) { nx[hlf] = __builtin_nontemporal_load((const v4u*)(X3 + (size_t)(m) * 1024 + hlf * 512) + lane); \
        ny0[hlf] = __builtin_nontemporal_load((const v4u*)(YP + (size_t)(2 * (m)) * 1024 + hlf * 512) + lane); ny1[hlf] = __builtin_nontemporal_load((const v4u*)(YP + (size_t)(2 * (m) + 1) * 1024 + hlf * 512) + lane); } } while (0)
    if (gw < T) FN_LOAD(gw);
    for (int m = gw; m < T; m += NGW) {
        float v[16]; float ss = 0.f;
        const v4u cx[2] = {nx[0], nx[1]}, cy0[2] = {ny0[0], ny0[1]}, cy1[2] = {ny1[0], ny1[1]};
        if (m + NGW < T) FN_LOAD(m + NGW);
#pragma unroll
        for (int hlf = 0; hlf < 2; ++hlf) {
            const v4u x = cx[hlf], y0 = cy0[hlf], y1 = cy1[hlf];
            const unsigned xs[4] = {x.x, x.y, x.z, x.w}, as[4] = {y0.x, y0.y, y0.z, y0.w}, bs[4] = {y1.x, y1.y, y1.z, y1.w};
#pragma unroll
            for (int j = 0; j < 4; ++j) { const float lo = bflo(xs[j]) + (bflo(as[j]) + bflo(bs[j])), hh = bfhi(xs[j]) + (bfhi(as[j]) + bfhi(bs[j])); v[hlf * 8 + 2 * j] = lo; v[hlf * 8 + 2 * j + 1] = hh; ss += lo * lo + hh * hh; }
        }
        ss = wave_sum(ss); const float rs = rsqrtf(ss * (1.f / 1024.f) + RMS_EPS) * oscale;
        float* o = a.out + (size_t)m * 1024;
#pragma unroll
        for (int hlf = 0; hlf < 2; ++hlf) { f32x4 o0, o1;
#pragma unroll
            for (int j = 0; j < 4; ++j) { o0[j] = v[hlf * 8 + j] * rs * gv[hlf * 2][j]; o1[j] = v[hlf * 8 + 4 + j] * rs * gv[hlf * 2 + 1][j]; }
            __builtin_nontemporal_store(o0, (f32x4*)(o + hlf * 512) + 2 * lane); __builtin_nontemporal_store(o1, (f32x4*)(o + hlf * 512) + 2 * lane + 1); }
    }
}

__global__ void __launch_bounds__(512, 2) hybrid_fwd(Args args) {
    extern __shared__ __attribute__((aligned(16))) unsigned char lds_raw[];
    LAS unsigned char* lds = (LAS unsigned char*)lds_raw;
    volatile LAS unsigned* MISC = (volatile LAS unsigned*)(lds + MISC_OFF);
    const int tid = threadIdx.x, wave = rfl(tid >> 6), lane = tid & 63;
    const int G = gridDim.x; const int bx = blockIdx.x; const int vcu = (G % 8 == 0) ? (bx % 8) * (G / 8) + bx / 8 : bx;
    unsigned char* ws = args.ws;
    unsigned* ctl = (unsigned*)(ws + WS_CTL);
    for (int u = tid; u < (LDS_BYTES - PHASE_LDS) / 4; u += 512) ((LAS unsigned*)(lds + PHASE_LDS))[u] = 0u;
    __syncthreads();
    XcdBarrier bar; bar.bar = ctl + CW_BAR; bar.x = 0; bar.st = nullptr;
#if MK_ONE_LAUNCH
    (void)xcd_barrier_post(ctl + CW_BAR, MISC + 8);
#if defined(PROBE_DUP) && ((PROBE_DUP >> 21) & 1)
#define GRID_BAR() do { const unsigned long long t0_ = __builtin_amdgcn_s_memrealtime(); XcdBarrier b_; b_.bar = (unsigned*)(args.ws + WS_CTL) + CW_BAR; b_.x = xb_xcc_id(); b_.st = (volatile LAS unsigned*)(lds + MISC_OFF) + 8; xcd_barrier(b_); if ((PROBE_SEAMS >> prb_k_) & 1) prb_wait_ += __builtin_amdgcn_s_memrealtime() - t0_; } while (0)
#else
#define GRID_BAR() do { XcdBarrier b_; b_.bar = (unsigned*)(args.ws + WS_CTL) + CW_BAR; b_.x = xb_xcc_id(); b_.st = (volatile LAS unsigned*)(lds + MISC_OFF) + 8; xcd_barrier(b_); } while (0)
#endif
#else
#define GRID_BAR() do { } while (0)
#endif
    int prb_k_ = 0; (void)prb_k_; unsigned long long prb_wait_ = 0; (void)prb_wait_;
    const int lo = args.ph_lo, hi = args.ph_hi;
#ifndef PH_MASK
#define PH_MASK 0x1FFFF
#endif
#define IN(k) (((PH_MASK >> (k)) & 1) && lo <= (k) && (k) < hi)
#if defined(PROBE_DUP) && ((PROBE_DUP >> 20) & 1)
#define SEAM(k) do { if (IN((k) + 1)) { GRID_BAR(); GRID_BAR(); } } while (0)
#else
#define SEAM(k) do { prb_k_ = (k); if (IN((k) + 1)) GRID_BAR(); } while (0)
#endif
#ifndef PROBE_DUP
#define PROBE_DUP 0
#endif
#define REP(k) for (int rep_ = 0; rep_ < (((PROBE_DUP >> (k)) & 1) ? 2 : 1); ++rep_)
    (void)lane; (void)wave;

    bf16* XB = (bf16*)(ws + WS_XB); bf16* OCAT = (bf16*)(ws + WS_OCAT);
    bf16 *SBQ = (bf16*)(ws + WS_SBQ), *SBK = (bf16*)(ws + WS_SBK), *SBV = (bf16*)(ws + WS_SBV), *CQ = (bf16*)(ws + WS_CQ), *CKV = (bf16*)(ws + WS_CKV), *KR = (bf16*)(ws + WS_KR);
    bf16 *QA = (bf16*)(ws + WS_QA), *KN = (bf16*)(ws + WS_KN), *VA = (bf16*)(ws + WS_VA), *X1B = (bf16*)(ws + WS_X1B), *HID = (bf16*)(ws + WS_HID), *X2B = (bf16*)args.out;
    bf16 *Q2 = (bf16*)(ws + WS_Q2), *K2 = (bf16*)(ws + WS_K2), *V2 = (bf16*)(ws + WS_V2), *X3B = (bf16*)(ws + WS_X3B), *YP = (bf16*)(ws + WS_YP), *HIDE = (bf16*)(ws + WS_HIDE);
    float *PQKV = (float*)(ws + WS_PQKV), *PS1 = (float*)(ws + WS_PS1), *PS2 = (float*)(ws + WS_PS2), *PS3 = (float*)(ws + WS_PS3), *KMP = (float*)(ws + WS_KMP);
    bf16* O2 = Q2;
    bf16* PO3 = (bf16*)args.out + (size_t)32 * 1024 * 1024;
    const float2* ROPE = (const float2*)(ws + WS_ROPE); unsigned* SEL = (unsigned*)(ws + WS_SEL); float2* PMS = (float2*)(ws + WS_PMS);

    if (IN(0)) REP(0) { p0_prologue(args, lds, vcu, G); SEAM(0); }
    if (IN(1)) REP(1) {
        pg8::Gemm g{XB, (const bf16*)(ws + W_IN), T, 2304, 1024}; pg8::StaticOrder S; S.init(T, 2304, G, bx);
        EpiInProj E{SBQ, CQ, CKV, KR, (const float*)(ws + WS_RSTD0), PQKV, ROPE};
        pg8::gemm_phase<EpiInProj, pg8::StaticOrder, true, true>(lds, g, S, E);
        { const bool half = (G == 256); if (!half || bx >= 128) { __syncthreads(); p0_weights(args, lds, (half ? bx - 128 : bx) * 8 + wave, (half ? 128 : G) * 8, true); } }
        SEAM(1);
    }
    if (IN(2)) REP(2) {
        { pg8::Gemm g{CQ, (const bf16*)(ws + W_UQ), T, 768, 384}; pg8::StaticOrder S; S.init(T, 768, G, bx);
          EpiQUp E{QA, PQKV, ROPE}; pg8::gemm_phase<EpiQUp, pg8::StaticOrder, true, true>(lds, g, S, E); }
        __syncthreads();
        { pg8::Gemm g{CKV, (const bf16*)(ws + W_UKV), T, 1024, 256}; pg8::StaticOrder S; S.init(T, 1024, G, bx);
          EpiKvUp E{KN, PQKV}; pg8::gemm_phase<EpiKvUp, pg8::StaticOrder, true, true>(lds, g, S, E); }
        SEAM(2);
    }
    if (IN(3)) REP(3) {
        REP(17) for (int v = vcu; v < 256; v += G) { const int bh = v >> 4, s = v & 15;
            att::mla_unit(bh, 63 - s, QA, KN, KR, VA, OCAT, lds); att::mla_unit(bh, 32 + s, QA, KN, KR, VA, OCAT, lds);
            att::mla_unit(bh, 31 - s, QA, KN, KR, VA, OCAT, lds); att::mla_unit(bh, s, QA, KN, KR, VA, OCAT, lds); }
        REP(18) { volatile LAS int* qslot = (volatile LAS int*)(lds + PHASE_LDS - 64);
          unsigned* qw = ctl + CW_QUEUE + 192 + 64 * rep_;
          if (tid == 0) qslot[0] = (int)atomicAdd(qw, 1u);
          __syncthreads();
          int uidx = qslot[0];
          __syncthreads();
          while (uidx < 1024) {
              unsigned nx = 0u; if (tid == 0) nx = atomicAdd(qw, 1u);
              att::sb_unit(uidx & 15, 63 - (uidx >> 4), SBQ, SBK, SBV, OCAT, lds);
              if (tid == 0) qslot[0] = (int)nx;
              __syncthreads();
              uidx = qslot[0];
              __syncthreads();
          } }
        SEAM(3);
#if DBG_CHECK & 1
        dbg_check_a(args, lds, ctl, bx, G);
#endif
    }
    if (IN(4)) REP(4) {
        pg8::Gemm g{OCAT, (const bf16*)(ws + W_O0), T, 1024, 1024}; pg8::StaticOrder S; S.init(T, 1024, G, bx);
        EpiRes<true> E{args.in[I_X], X1B, PS1}; pg8::gemm_phase<EpiRes<true>, pg8::StaticOrder, true, true>(lds, g, S, E);
        SEAM(4);
    }
    if (IN(5)) REP(5) {
        pg8::Gemm g{X1B, (const bf16*)(ws + W_GU0), T, 4096, 1024}; pg8::StaticOrder S; S.init(T, 4096, G, bx);
        EpiSwiGLU E{HID, 2048, 16, PS1, nullptr}; pg8::gemm_phase<EpiSwiGLU, pg8::StaticOrder, true, true>(lds, g, S, E);
        SEAM(5);
    }
    if (IN(6)) REP(6) {
        pg8::Gemm g{HID, (const bf16*)(ws + W_DN0), T, 1024, 2048}; pg8::StaticOrder S; S.init(T, 1024, G, bx);
        EpiRes<false> E{X1B, X2B, PS2}; pg8::gemm_phase<EpiRes<false>, pg8::StaticOrder, true, true>(lds, g, S, E);
        SEAM(6);
    }
    if (IN(7)) REP(7) {
        pg8::Gemm g{X2B, (const bf16*)(ws + W_QKV), T, 3072, 1024}; pg8::StaticOrder S; S.init(T, 3072, G, bx);
        EpiQkv E{Q2, PS2, KMP}; pg8::gemm_phase<EpiQkv, pg8::StaticOrder, true, true>(lds, g, S, E);
        SEAM(7);
    }
    if (IN(8)) REP(8) {
        for (int v = vcu; v < 256; v += G) att::moba_gate_unit(v & 31, v >> 5, Q2, KMP, SEL, (unsigned*)(ws + WS_MASK), lds);
        SEAM(8);
    }
    if (IN(9)) REP(9) {
        volatile LAS int* qslot = (volatile LAS int*)(lds + att::MB_OFF_Q);
        if (tid == 0) qslot[0] = (int)atomicAdd(ctl + CW_QUEUE + 64 * rep_, 1u);
        __syncthreads();
        int uidx = qslot[0];
        __syncthreads();
        while (uidx < 64 * 32) {
            unsigned nx = 0u; if (tid == 0) nx = atomicAdd(ctl + CW_QUEUE + 64 * rep_, 1u);
            att::moba_sel_unit(uidx & 31, uidx >> 5, Q2, K2, V2, (const unsigned long long*)(ws + WS_MASK), args.in[I_RELB], (bf16*)(ws + WS_PO0), (bf16*)(ws + WS_PO1), (bf16*)(ws + WS_PO2), PO3, PMS, lds);
            if (tid == 0) qslot[0] = (int)nx;
            __syncthreads();
            uidx = qslot[0];
            __syncthreads();
        }
        SEAM(9);
#if DBG_CHECK & 2
        dbg_check_b(args, lds, ctl, bx, G, O2); GRID_BAR();
#endif
    }
    if (IN(10)) REP(10) {
        att::moba_merge(vcu * 8 + wave, G * 8, SEL, (const bf16*)(ws + WS_PO0), (const bf16*)(ws + WS_PO1), (const bf16*)(ws + WS_PO2), PO3, PMS, O2);
        SEAM(10);
#if DBG_CHECK & 2
        dbg_check_b2(args, lds, ctl, bx, G, O2);
#endif
    }
    if (IN(11)) REP(11) {
        pg8::Gemm g{O2, (const bf16*)(ws + W_O1), T, 1024, 1024}; pg8::StaticOrder S; S.init(T, 1024, G, bx);
        EpiRes<false> E{X2B, X3B, PS3}; pg8::gemm_phase<EpiRes<false>, pg8::StaticOrder, true, true>(lds, g, S, E);
        SEAM(11);
    }
    if (IN(12)) REP(12) {
        for (int ch = bx; ch < 256; ch += G) router_chunk(args, ch, lds);
        SEAM(12);
    }
    if (IN(13)) REP(13) { permute_phase(args, lds, G); SEAM(13); }
    if (IN(14)) REP(14) {
        const int nrt = (int)ctl[CW_NRT];
        pg8::Gemm g{X3B, (const bf16*)(ws + W_EGU), NSLOT, 8192, 1024, (const int*)(ws + WS_STOK)}; MoeOrder S{(const int*)(ws + WS_TILEE), nrt, G, bx};
        EpiSwiGLU E{HIDE, 512, 4, nullptr, (const float*)(ws + WS_SRS)}; pg8::gemm_phase<EpiSwiGLU, MoeOrder, true, true, true>(lds, g, S, E);
        SEAM(14);
    }
    if (IN(15)) REP(15) {
        const int nrt = (int)ctl[CW_NRT];
        pg8::Gemm g{HIDE, (const bf16*)(ws + W_EDN), NSLOT, 8192, 512}; MoeOrder S{(const int*)(ws + WS_TILEE), nrt, G, bx};
        EpiMoeDown E{YP, (const int*)(ws + WS_SDST), (const float*)(ws + WS_SW)}; pg8::gemm_phase<EpiMoeDown, MoeOrder, true, true>(lds, g, S, E);
        SEAM(15);
    }
    if (IN(16)) REP(16) {
        float oscale = 1.f;
#if DBG_CHECK
        oscale = 1.f + 0.25f * (float)__hip_atomic_load(ctl + CW_ERR, __ATOMIC_RELAXED, __HIP_MEMORY_SCOPE_AGENT);
#endif
        final_phase(args, vcu, G, oscale);
#if defined(PROBE_DUP) && ((PROBE_DUP >> 21) & 1)
        if (bx == ((PROBE_DUP >> 22) & 0xFF)) { const unsigned long long t0_ = __builtin_amdgcn_s_memrealtime(); while (__builtin_amdgcn_s_memrealtime() - t0_ < 4ull * prb_wait_) __builtin_amdgcn_s_sleep(8); }
#endif
#if MK_ONE_LAUNCH
        if (bx == 0 && tid == 0) { if (__hip_atomic_load(ctl + CW_BAR + XB_TMO, __ATOMIC_RELAXED, __HIP_MEMORY_SCOPE_AGENT) != 0u) args.out[0] = __builtin_nanf(""); }
#endif
    }
#undef IN
#undef SEAM
}

extern "C" void kernel_launch(void* const* d_in, const int* in_sizes, int n_in, void* d_out, int out_size, void* d_ws, size_t ws_size, hipStream_t stream) {
    static int grid = 0;
    if (grid == 0) {
        if (n_in != 22 || in_sizes[0] != T * DM || out_size != T * DM || ws_size < WS_NEED) { fprintf(stderr, "kernel_launch: unexpected shapes (n_in %d, in0 %d, out %d, ws %zu < %zu); nothing launched\n", n_in, n_in > 0 ? in_sizes[0] : -1, out_size, ws_size, (size_t)WS_NEED); grid = -1; return; }
        int dev = 0, cus = 0, per_cu = 0;
        if (hipGetDevice(&dev) != hipSuccess || hipDeviceGetAttribute(&cus, hipDeviceAttributeMultiprocessorCount, dev) != hipSuccess) { grid = -1; return; }
        if (hipFuncSetAttribute((const void*)hybrid_fwd, hipFuncAttributeMaxDynamicSharedMemorySize, LDS_BYTES) != hipSuccess) { fprintf(stderr, "kernel_launch: hipFuncSetAttribute failed\n"); grid = -1; return; }
        if (hipOccupancyMaxActiveBlocksPerMultiprocessor(&per_cu, (const void*)hybrid_fwd, 512, LDS_BYTES) != hipSuccess || per_cu < 1) fprintf(stderr, "kernel_launch: occupancy query reports %d workgroups per CU\n", per_cu);
        (void)hipGetLastError();
        grid = cus;
    }
    if (grid < 0) return;
    if (hipMemsetAsync((char*)d_ws + WS_CTL, 0, CTL_ZERO_BYTES, stream) != hipSuccess) return;
    Args a{};
    for (int i = 0; i < 22; ++i) a.in[i] = (const float*)d_in[i];
    a.out = (float*)d_out; a.ws = (unsigned char*)d_ws;
#if MK_ONE_LAUNCH
    a.ph_lo = 0; a.ph_hi = NPH;
    hipLaunchKernelGGL(hybrid_fwd, dim3(grid), dim3(512), LDS_BYTES, stream, a);
#else
    for (int p = 0; p < NPH; ++p) { a.ph_lo = p; a.ph_hi = p + 1; hipLaunchKernelGGL(hybrid_fwd, dim3(grid), dim3(512), LDS_BYTES, stream, a); }
#endif
}
```

```cpp
#include <hip/hip_runtime.h>
#include <cstdio>
#include <cstdint>
#ifndef MK_ONE_LAUNCH
#define MK_ONE_LAUNCH 1
#endif
#ifndef PROBE_SEAMS
#define PROBE_SEAMS 0xFFFFF
#endif
#ifndef PROBE_DUP
#define PROBE_DUP 0
#endif
namespace pg8 {
#define PG8_LAS __attribute__((address_space(3)))
typedef unsigned short bf16_t;
typedef short bf16x8 __attribute__((ext_vector_type(8)));
typedef float f32x4 __attribute__((ext_vector_type(4)));
typedef unsigned u32x4 __attribute__((ext_vector_type(4)));
constexpr int BM = 256, BK = 64, HALF = 128, HTB = HALF * BK * 2  , STAGE_BYTES = 8 * HTB, NXCD = 8, WGM = 8;

__host__ __device__ __forceinline__ int lds_byte(int r, int c) { const int st = (r >> 4) * 2 + (c >> 5), rr = r & 15, cc = c & 31, ob = rr * 64 + cc * 2; return st * 1024 + (ob ^ (((ob >> 9) & 1) << 5)); }
__host__ __device__ __forceinline__ void stage_rc(int b, int& R, int& C) { const int st = b / 1024, sb = b % 1024, swz = sb ^ (((sb >> 9) & 1) << 5); R = (st >> 1) * 16 + swz / 64; C = (st & 1) * 32 + (swz % 64) / 2; }
__host__ __device__ __forceinline__ int perm32(int rho) { const int n = rho >> 4, i = rho & 15; return 8 * (i >> 2) + 4 * n + (i & 3); }

struct Unit { int pm, pn; };
struct Gemm { const bf16_t* A; const bf16_t* Bt; int M, N, K; const int* aidx; };

struct StaticOrder {
    int nM, nN, nwg, G, c;
    __host__ __device__ void init(int M, int N, int G_, int c_) { nM = M / BM; nN = N / BM; nwg = nM * nN; G = G_; c = c_; }
    __host__ __device__ bool next(int i, Unit& u) const {
        const long L = (long)i * G + c; if (L >= nwg) return false;
        int wgid = (int)L; { const int q = nwg / NXCD, r = nwg % NXCD, xcd = wgid % NXCD, off = wgid / NXCD; wgid = (xcd < r ? xcd * (q + 1) : r * (q + 1) + (xcd - r) * q) + off; }
        const int nig = WGM * nN, gid = wgid / nig, fm = gid * WGM, gsz = (nM - fm) < WGM ? (nM - fm) : WGM;
        u.pm = fm + ((wgid % nig) % gsz); u.pn = (wgid % nig) / gsz; return true;
    }
    __device__ __forceinline__ void a_ready(const Unit&) const {}
    __device__ __forceinline__ void done(const Unit&) const {}
};

__device__ __forceinline__ unsigned cvt_pk_bf16(float lo, float hi) { unsigned r; asm volatile("v_cvt_pk_bf16_f32 %0, %1, %2" : "=v"(r) : "v"(lo), "v"(hi)); return r; }
typedef float f32x2 __attribute__((ext_vector_type(2)));
template <class Epi, class Sched, bool ALIGN_EPI = false, bool SP2 = false, bool GATHER = false>
__device__ __forceinline__ void gemm_phase(PG8_LAS unsigned char* lds, const Gemm g, const Sched& S, const Epi& E) {
    static_assert(!GATHER || SP2, "the gather A path is wired into the two-super-phase loop only");
    int tid_ = threadIdx.x; asm volatile("" : "+v"(tid_));
    const int tid = tid_, wid = __builtin_amdgcn_readfirstlane(tid >> 6), lane = tid & 63, wr = wid >> 2, wc = wid & 3, fr = lane & 15, fq = lane >> 4;
    const int K = g.K, nt = K / BK;
    unsigned voffA[2], voffB[2];
#pragma unroll
    for (int i = 0; i < 2; ++i) { int R, C; stage_rc(tid * 16 + i * 8192, R, C); const int Rb = Epi::PERM ? ((R & ~31) + perm32(R & 31)) : R;
        voffA[i] = (unsigned)(R * K + C) * 2u; voffB[i] = (unsigned)(Rb * K + C) * 2u; }
    unsigned gA[2][2] = {{0u, 0u}, {0u, 0u}}, gN[2][2] = {{0u, 0u}, {0u, 0u}}; int gR[2] = {0, 0}, gC[2] = {0, 0};
    if constexpr (GATHER) {
#pragma unroll
        for (int i = 0; i < 2; ++i) stage_rc(tid * 16 + i * 8192, gR[i], gC[i]); }
#define PG8_GIDX(dst, pm) do { _Pragma("unroll") for (int _h = 0; _h < 2; ++_h) _Pragma("unroll") for (int _i = 0; _i < 2; ++_i) \
        dst[_h][_i] = (unsigned)(g.aidx[(pm) * BM + _h * HALF + gR[_i]] * K + gC[_i]) * 2u; } while (0)
    const size_t kstep = (size_t)(BK * 2);
    const size_t hstep = (size_t)HALF * K * 2;
    const size_t tstep = 2 * hstep;
    const unsigned ldsw = (unsigned)wid * 1024u;
    const int aoff = lds_byte(wr * 64 + fr, fq * 8), boff = lds_byte(wc * 32 + fr, fq * 8);
#define PG8_SA(b, h) (((b) * 2 + (h)) * HTB)
#define PG8_SB(b, h) ((4 + (b) * 2 + (h)) * HTB)
#define PG8_STAGE(bufoff, gbase, voff) do { _Pragma("unroll") for (int _i = 0; _i < 2; ++_i) \
        __builtin_amdgcn_global_load_lds((const unsigned*)((const char*)(gbase) + (voff)[_i]), (PG8_LAS unsigned*)(lds + (bufoff) + ldsw + _i * 8192), 16, 0, 0); } while (0)
#define PG8_STAGE_A(bufoff, gbase, hh, nx) do { if constexpr (GATHER) { _Pragma("unroll") for (int _i = 0; _i < 2; ++_i) \
        __builtin_amdgcn_global_load_lds((const unsigned*)((const char*)(gbase) + ((nx) ? gN[hh][_i] : gA[hh][_i])), (PG8_LAS unsigned*)(lds + (bufoff) + ldsw + _i * 8192), 16, 0, 0); } \
    else { PG8_STAGE(bufoff, (gbase) + (hh) * hstep, voffA); } } while (0)
#define PG8_LDA(dst, b, h) do { _Pragma("unroll") for (int m = 0; m < 4; ++m) _Pragma("unroll") for (int k = 0; k < 2; ++k) dst[m][k] = *(const PG8_LAS bf16x8*)(lds + PG8_SA(b, h) + aoff + m * 2048 + k * 1024); } while (0)
#define PG8_LDB(dst, b, h) do { _Pragma("unroll") for (int n = 0; n < 2; ++n) _Pragma("unroll") for (int k = 0; k < 2; ++k) dst[n][k] = *(const PG8_LAS bf16x8*)(lds + PG8_SB(b, h) + boff + n * 2048 + k * 1024); } while (0)
#define PG8_MMA(ai, bj, At, Bt) do { __builtin_amdgcn_s_setprio(1); _Pragma("unroll") for (int m = 0; m < 4; ++m) _Pragma("unroll") for (int n = 0; n < 2; ++n) _Pragma("unroll") for (int k = 0; k < 2; ++k) \
        acc[ai][bj][m][n] = __builtin_amdgcn_mfma_f32_16x16x32_bf16(Bt[n][k], At[m][k], acc[ai][bj][m][n], 0, 0, 0); __builtin_amdgcn_s_setprio(0); } while (0)
#define PG8_WAIT_V(n) asm volatile("s_waitcnt vmcnt(" #n ")" ::: "memory")
#define PG8_WAIT_L(n) asm volatile("s_waitcnt lgkmcnt(" #n ")" ::: "memory")
#define PG8_BAR __builtin_amdgcn_s_barrier()
#define PG8_SCHED __builtin_amdgcn_sched_barrier(0)
    Unit cur, nxt; int ui = 0;
    if (!S.next(0, cur)) return;
    f32x4 acc[2][2][4][2];
#pragma unroll
    for (int a = 0; a < 2; ++a)
#pragma unroll
        for (int b = 0; b < 2; ++b)
#pragma unroll
            for (int m = 0; m < 4; ++m)
#pragma unroll
                for (int n = 0; n < 2; ++n) acc[a][b][m][n] = (f32x4){0.f, 0.f, 0.f, 0.f};
    bf16x8 At[4][2], B0[2][2], B1[2][2];
    const char* cA = GATHER ? (const char*)g.A : (const char*)g.A + (size_t)cur.pm * tstep; const char* cB = (const char*)g.Bt + (size_t)cur.pn * tstep;
    if constexpr (GATHER) { PG8_GIDX(gA, cur.pm); }
    S.a_ready(cur);
    if constexpr (SP2) {
        PG8_STAGE(PG8_SB(0, 0), cB, voffB); PG8_STAGE(PG8_SB(0, 1), cB + hstep, voffB); PG8_STAGE_A(PG8_SA(0, 0), cA, 0, false); PG8_STAGE_A(PG8_SA(0, 1), cA, 1, false);
        if (wr == 1) PG8_BAR;
        PG8_WAIT_V(2); PG8_BAR;
        PG8_STAGE(PG8_SB(1, 0), cB + kstep, voffB); PG8_STAGE_A(PG8_SA(1, 0), cA + kstep, 0, false); PG8_STAGE(PG8_SB(1, 1), cB + hstep + kstep, voffB);
        PG8_WAIT_V(6); PG8_BAR;
    } else {
        PG8_STAGE(PG8_SB(0, 0), cB, voffB); PG8_STAGE(PG8_SA(0, 0), cA, voffA); PG8_STAGE(PG8_SB(0, 1), cB + hstep, voffB); PG8_STAGE(PG8_SA(0, 1), cA + hstep, voffA);
        if (wr == 1) PG8_BAR;
        PG8_WAIT_V(4); PG8_BAR;
        PG8_STAGE(PG8_SB(1, 0), cB + kstep, voffB); PG8_STAGE(PG8_SA(1, 0), cA + kstep, voffA); PG8_STAGE(PG8_SB(1, 1), cB + hstep + kstep, voffB);
        PG8_WAIT_V(6); PG8_BAR;
    }
    for (;;) {
        const bool has_next = S.next(ui + 1, nxt);
        const char* nA = GATHER ? (const char*)g.A : (has_next ? (const char*)g.A + (size_t)nxt.pm * tstep : cA); const char* nB = has_next ? (const char*)g.Bt + (size_t)nxt.pn * tstep : cB;
        if constexpr (GATHER) { if (has_next) { PG8_GIDX(gN, nxt.pm); } else { _Pragma("unroll") for (int _h = 0; _h < 2; ++_h) _Pragma("unroll") for (int _i = 0; _i < 2; ++_i) gN[_h][_i] = gA[_h][_i]; } }
#pragma unroll 1
        for (int t = 0; t < nt; t += 2) {
            const bool last = (t == nt - 2);
            const char* a1 = cA + (size_t)(t + 1) * kstep;
            const char* a2 = last ? nA : cA + (size_t)(t + 2) * kstep; const char* b2 = last ? nB : cB + (size_t)(t + 2) * kstep;
            const char* a3 = a2 + kstep; const char* b3 = b2 + kstep;
            if (last && has_next) S.a_ready(nxt);
            if constexpr (SP2) {
            PG8_LDB(B0, 0, 0); PG8_LDB(B1, 0, 1); PG8_SCHED; PG8_LDA(At, 0, 0); PG8_STAGE_A(PG8_SA(1, 1), a1, 1, false);
            PG8_WAIT_V(8); PG8_WAIT_L(0); PG8_BAR; PG8_MMA(0, 0, At, B0); PG8_MMA(0, 1, At, B1); PG8_BAR; PG8_SCHED;
            PG8_LDA(At, 0, 1); PG8_STAGE(PG8_SB(0, 0), b2, voffB); PG8_STAGE(PG8_SB(0, 1), b2 + hstep, voffB); PG8_STAGE_A(PG8_SA(0, 0), a2, 0, last);
            PG8_WAIT_V(8); PG8_WAIT_L(0); PG8_BAR; PG8_MMA(1, 0, At, B0); PG8_MMA(1, 1, At, B1); PG8_BAR; PG8_SCHED;
            PG8_LDB(B0, 1, 0); PG8_LDB(B1, 1, 1); PG8_SCHED; PG8_LDA(At, 1, 0); PG8_STAGE_A(PG8_SA(0, 1), a2, 1, last);
            PG8_WAIT_V(8); PG8_WAIT_L(0); PG8_BAR; PG8_MMA(0, 0, At, B0); PG8_MMA(0, 1, At, B1); PG8_BAR; PG8_SCHED;
            PG8_LDA(At, 1, 1); PG8_STAGE(PG8_SB(1, 0), b3, voffB); PG8_STAGE(PG8_SB(1, 1), b3 + hstep, voffB); PG8_STAGE_A(PG8_SA(1, 0), a3, 0, last);
            PG8_WAIT_V(8); PG8_WAIT_L(0); PG8_BAR; PG8_MMA(1, 0, At, B0); PG8_MMA(1, 1, At, B1); PG8_BAR; PG8_SCHED;
            } else {
            PG8_LDB(B0, 0, 0); PG8_SCHED; PG8_LDA(At, 0, 0); PG8_STAGE(PG8_SA(1, 1), a1 + hstep, voffA);
            PG8_WAIT_L(8); PG8_BAR; PG8_WAIT_L(0); PG8_MMA(0, 0, At, B0); PG8_BAR; PG8_SCHED;
            PG8_LDB(B1, 0, 1); PG8_STAGE(PG8_SB(0, 0), b2, voffB);
            PG8_BAR; PG8_WAIT_L(0); PG8_MMA(0, 1, At, B1); PG8_BAR;
            PG8_LDA(At, 0, 1); PG8_STAGE(PG8_SA(0, 0), a2, voffA);
            PG8_BAR; PG8_WAIT_L(0); PG8_MMA(1, 0, At, B0); PG8_BAR; PG8_SCHED;
            PG8_STAGE(PG8_SB(0, 1), b2 + hstep, voffB);
            PG8_WAIT_V(6); PG8_BAR; PG8_MMA(1, 1, At, B1); PG8_BAR;
            PG8_LDB(B0, 1, 0); PG8_SCHED; PG8_LDA(At, 1, 0); PG8_STAGE(PG8_SA(0, 1), a2 + hstep, voffA);
            PG8_WAIT_L(8); PG8_BAR; PG8_WAIT_L(0); PG8_MMA(0, 0, At, B0); PG8_BAR; PG8_SCHED;
            PG8_LDB(B1, 1, 1); PG8_STAGE(PG8_SB(1, 0), b3, voffB);
            PG8_BAR; PG8_WAIT_L(0); PG8_MMA(0, 1, At, B1); PG8_BAR;
            PG8_LDA(At, 1, 1); PG8_STAGE(PG8_SA(1, 0), a3, voffA);
            PG8_BAR; PG8_WAIT_L(0); PG8_MMA(1, 0, At, B0); PG8_BAR; PG8_SCHED;
            PG8_STAGE(PG8_SB(1, 1), b3 + hstep, voffB);
            PG8_WAIT_V(6); PG8_BAR; PG8_MMA(1, 1, At, B1); PG8_BAR;
            }
        }
        if constexpr (ALIGN_EPI) { if (wr == 0) PG8_BAR; }
        if constexpr (!Epi::AFTER_DRAIN) { E(acc, cur, wr, wc, fr, fq); S.done(cur); }
        if (!has_next) break;
#pragma unroll
        for (int a = 0; a < 2; ++a)
#pragma unroll
            for (int b = 0; b < 2; ++b)
#pragma unroll
                for (int m = 0; m < 4; ++m)
#pragma unroll
                    for (int n = 0; n < 2; ++n) acc[a][b][m][n] = (f32x4){0.f, 0.f, 0.f, 0.f};
        cur = nxt; cA = nA; cB = nB; ++ui;
        if constexpr (GATHER) { _Pragma("unroll") for (int _h = 0; _h < 2; ++_h) _Pragma("unroll") for (int _i = 0; _i < 2; ++_i) gA[_h][_i] = gN[_h][_i]; }
        if constexpr (ALIGN_EPI) { if (wr == 1) PG8_BAR; }
    }
    PG8_WAIT_V(0);
    if constexpr (!ALIGN_EPI) { if (wr == 0) PG8_BAR; }
    PG8_BAR;
    if constexpr (Epi::AFTER_DRAIN) { E.fused(acc, cur, wr, wc, fr, fq, lds, wid, lane); S.done(cur); }
#undef PG8_SA
#undef PG8_SB
#undef PG8_STAGE
#undef PG8_STAGE_A
#undef PG8_GIDX
#undef PG8_LDA
#undef PG8_LDB
#undef PG8_MMA
#undef PG8_WAIT_V
#undef PG8_WAIT_L
#undef PG8_BAR
#undef PG8_SCHED
}
}

#define DI __device__ __forceinline__
#define LAS __attribute__((address_space(3)))
#define GAS __attribute__((address_space(1)))
typedef unsigned short bf16;
constexpr int BATCH = 2, SEQ = 16384, T = BATCH * SEQ, DM = 1024;
constexpr float LOG2E = 1.4426950408889634f;
constexpr float RMS_EPS = 1e-6f;
DI int rfl(int v) { return __builtin_amdgcn_readfirstlane(v); }
DI float bflo(unsigned w) { return __uint_as_float(w << 16); }
DI float bfhi(unsigned w) { return __uint_as_float(w & 0xffff0000u); }
typedef float f32x2_t __attribute__((ext_vector_type(2))); typedef __bf16 bf16x2_t __attribute__((ext_vector_type(2)));
DI unsigned cvtpk(float lo, float hi) { f32x2_t v = {lo, hi}; bf16x2_t b = __builtin_convertvector(v, bf16x2_t); return __builtin_bit_cast(unsigned, b); }
typedef float f32x4 __attribute__((ext_vector_type(4)));
typedef unsigned v4u __attribute__((ext_vector_type(4)));
DI float ex2(float x) { return __builtin_amdgcn_exp2f(x); }
DI float lg2(float x) { return __builtin_amdgcn_logf(x); }
DI float wave_sum(float v) {
#pragma unroll
    for (int o = 1; o < 64; o <<= 1) v += __shfl_xor(v, o);
    return v;
}

namespace att {
typedef short bf16x8 __attribute__((ext_vector_type(8)));
typedef short s16x4 __attribute__((ext_vector_type(4)));
typedef float f32x16 __attribute__((ext_vector_type(16)));
typedef unsigned u32x4 __attribute__((ext_vector_type(4)));
typedef LAS const char* lcp;
typedef short v4i16_t __attribute__((ext_vector_type(4)));
DI int crow(int r, int hi) { return (r & 3) + 8 * (r >> 2) + 4 * hi; }
DI void glds16(const void* gsrc, unsigned lds_dst) { unsigned keep;
    asm volatile("s_mov_b32 %0, m0\n\ts_mov_b32 m0, %2\n\ts_nop 0\n\tglobal_load_lds_dwordx4 %1, off\n\ts_mov_b32 m0, %0" : "=&s"(keep) : "v"(gsrc), "s"(lds_dst) : "memory"); }
#define ATT_WAITV_BAR() asm volatile("s_waitcnt vmcnt(0) lgkmcnt(0)\n\ts_barrier" ::: "memory")
#define ATT_BAR() asm volatile("s_waitcnt lgkmcnt(0)\n\ts_barrier" ::: "memory")
#define WAVE_LDS_SYNC() asm volatile("" ::: "memory")
DI s16x4 vtr(lcp p) { return __builtin_bit_cast(s16x4, __builtin_amdgcn_ds_read_tr16_b64_v4i16((LAS v4i16_t*)p)); }
DI float hmax(float x) { auto rr = __builtin_amdgcn_permlane32_swap(__float_as_uint(x), __float_as_uint(x), false, false); return fmaxf(__uint_as_float(rr[0]), __uint_as_float(rr[1])); }
DI float hsum(float x) { auto rr = __builtin_amdgcn_permlane32_swap(__float_as_uint(x), __float_as_uint(x), false, false); return __uint_as_float(rr[0]) + __uint_as_float(rr[1]); }

template <int NK> DI void qk_tile(f32x16& p0, f32x16& p1, lcp kfr, const bf16x8* qr) {
    f32x16 z;
#pragma unroll
    for (int r = 0; r < 16; ++r) z[r] = 0.f;
    p0 = z; p1 = z;
    bf16x8 kf[2 * NK];
#pragma unroll
    for (int d0 = 0; d0 < NK; ++d0) { kf[2 * d0] = *(const LAS bf16x8*)(kfr + d0 * 2048); kf[2 * d0 + 1] = *(const LAS bf16x8*)(kfr + d0 * 2048 + 512); }
    __builtin_amdgcn_sched_barrier(0);
#pragma unroll
    for (int d0 = 0; d0 < NK; ++d0) { p0 = __builtin_amdgcn_mfma_f32_32x32x16_bf16(kf[2 * d0], qr[d0], p0, 0, 0, 0); p1 = __builtin_amdgcn_mfma_f32_32x32x16_bf16(kf[2 * d0 + 1], qr[d0], p1, 0, 0, 0); }
    __builtin_amdgcn_sched_barrier(0);
}
DI void pv_tile(f32x16* o, lcp vfr, const f32x16& p0, const f32x16& p1) {
    u32x4 pw[4];
    pw[0] = (u32x4){cvtpk(p0[0], p0[1]), cvtpk(p0[2], p0[3]), cvtpk(p0[4], p0[5]), cvtpk(p0[6], p0[7])};
    pw[1] = (u32x4){cvtpk(p0[8], p0[9]), cvtpk(p0[10], p0[11]), cvtpk(p0[12], p0[13]), cvtpk(p0[14], p0[15])};
    pw[2] = (u32x4){cvtpk(p1[0], p1[1]), cvtpk(p1[2], p1[3]), cvtpk(p1[4], p1[5]), cvtpk(p1[6], p1[7])};
    pw[3] = (u32x4){cvtpk(p1[8], p1[9]), cvtpk(p1[10], p1[11]), cvtpk(p1[12], p1[13]), cvtpk(p1[14], p1[15])};
#pragma unroll
    for (int d0 = 0; d0 < 2; ++d0) {
        s16x4 lo[4], hh[4];
#pragma unroll
        for (int ks = 0; ks < 4; ++ks) { lo[ks] = vtr(vfr + d0 * 4096 + ks * 1024); hh[ks] = vtr(vfr + d0 * 4096 + ks * 1024 + 512); }
        __builtin_amdgcn_sched_barrier(0);
#pragma unroll
        for (int ks = 0; ks < 4; ++ks) { const bf16x8 vf = (bf16x8){lo[ks][0], lo[ks][1], lo[ks][2], lo[ks][3], hh[ks][0], hh[ks][1], hh[ks][2], hh[ks][3]};
            o[d0] = __builtin_amdgcn_mfma_f32_32x32x16_bf16(__builtin_bit_cast(bf16x8, pw[ks]), vf, o[d0], 0, 0, 0); }
        __builtin_amdgcn_sched_barrier(0);
    }
}
DI void smax_update(f32x16& p0, f32x16& p1, float& mref, float& lsum, f32x16* o, LAS float* wsf, int r32, int hi) {
    float rm = fmaxf(p0[0], p1[0]);
#pragma unroll
    for (int r = 1; r < 16; ++r) rm = fmaxf(rm, fmaxf(p0[r], p1[r]));
    rm = hmax(rm);
    if (__any(rm > mref + 8.f)) {
        const float mnew = fmaxf(mref, rm);
        const float alpha = (mnew == mref) ? 1.f : ex2(mref - mnew);
        lsum *= alpha; mref = mnew;
        if (hi == 0) wsf[r32] = alpha;
        WAVE_LDS_SYNC();
#pragma unroll
        for (int r = 0; r < 16; ++r) { const float a = wsf[crow(r, hi)]; o[0][r] *= a; o[1][r] *= a; }
        WAVE_LDS_SYNC();
    }
    float s = 0.f;
#pragma unroll
    for (int r = 0; r < 16; ++r) { p0[r] = ex2(p0[r] - mref); p1[r] = ex2(p1[r] - mref); s += p0[r] + p1[r]; }
    lsum += s;
}
DI void stage_o(const f32x16* o, LAS bf16* stg, const LAS float* rowscale, int r32, int hi) {
    WAVE_LDS_SYNC();
#pragma unroll
    for (int r = 0; r < 16; ++r) { const int orow = crow(r, hi); const float sc = rowscale ? rowscale[orow] : 1.f;
        const unsigned a = cvtpk(o[0][r] * sc, o[1][r] * sc);
        stg[orow * 64 + r32] = (bf16)(a & 0xffffu); stg[orow * 64 + 32 + r32] = (bf16)(a >> 16); }
    WAVE_LDS_SYNC();
}

constexpr int MLA_KSLOT = 12288, VSLOT = 8192;
constexpr int MLA_OFF_V = 3 * MLA_KSLOT, MLA_OFF_WS = MLA_OFF_V + 3 * VSLOT, MLA_OFF_ST = MLA_OFF_WS + 8 * 256, MLA_LDS = MLA_OFF_ST + 8 * 4096;
template <int NK> DI void qk_tile_ref(f32x16& p0, f32x16& p1, lcp kfr, const bf16x8* qr, const f32x16& negm) {
    p0 = negm; p1 = negm;
    constexpr int H = NK / 2;
#pragma unroll
    for (int hb = 0; hb < 2; ++hb) {
        bf16x8 kf[2 * H];
#pragma unroll
        for (int d = 0; d < H; ++d) { const int d0 = hb * H + d; kf[2 * d] = *(const LAS bf16x8*)(kfr + d0 * 2048); kf[2 * d + 1] = *(const LAS bf16x8*)(kfr + d0 * 2048 + 512); }
        __builtin_amdgcn_sched_barrier(0);
#pragma unroll
        for (int d = 0; d < H; ++d) { const int d0 = hb * H + d; p0 = __builtin_amdgcn_mfma_f32_32x32x16_bf16(kf[2 * d], qr[d0], p0, 0, 0, 0); p1 = __builtin_amdgcn_mfma_f32_32x32x16_bf16(kf[2 * d + 1], qr[d0], p1, 0, 0, 0); }
        __builtin_amdgcn_sched_barrier(0);
    }
}
DI void smax_update_ref(f32x16& p0, f32x16& p1, float& mref, f32x16& negm, float& lsum, f32x16* o, LAS float* wsf, int r32, int hi, bool first) {
    float ra = __builtin_fmaxf(__builtin_fmaxf(p0[0], p0[1]), p1[0]), rb = __builtin_fmaxf(__builtin_fmaxf(p0[2], p0[3]), p1[1]);
    ra = __builtin_fmaxf(__builtin_fmaxf(ra, p1[2]), p1[3]);
#pragma unroll
    for (int r = 4; r < 16; r += 4) { ra = __builtin_fmaxf(__builtin_fmaxf(ra, p0[r]), p0[r + 1]); rb = __builtin_fmaxf(__builtin_fmaxf(rb, p0[r + 2]), p0[r + 3]);
        ra = __builtin_fmaxf(__builtin_fmaxf(ra, p1[r]), p1[r + 1]); rb = __builtin_fmaxf(__builtin_fmaxf(rb, p1[r + 2]), p1[r + 3]); }
    const float rm = hmax(fmaxf(ra, rb));
    if (first || __any(rm > 8.f)) {
        const float dl = first ? rm : fmaxf(rm, 0.f);
        mref += dl;
#pragma unroll
        for (int r = 0; r < 16; ++r) { p0[r] -= dl; p1[r] -= dl; }
#pragma unroll
        for (int r = 0; r < 16; ++r) negm[r] = -mref;
        if (!first) { const float alpha = ex2(-dl); lsum *= alpha;
            if (hi == 0) wsf[r32] = alpha;
            WAVE_LDS_SYNC();
#pragma unroll
            for (int r = 0; r < 16; ++r) { const float a = wsf[crow(r, hi)]; o[0][r] *= a; o[1][r] *= a; }
            WAVE_LDS_SYNC(); }
    }
    float s = 0.f;
#pragma unroll
    for (int r = 0; r < 16; ++r) { p0[r] = ex2(p0[r]); p1[r] = ex2(p1[r]); s += p0[r] + p1[r]; }
    lsum += s;
}
DI void mla_unit(int bh, int qb, const bf16* QA, const bf16* KN, const bf16* KR, const bf16* VA, bf16* OC, LAS unsigned char* lds) {
    int tid_ = threadIdx.x; asm volatile("" : "+v"(tid_));
    const int tid = tid_, lane = tid & 63, r32 = lane & 31, hi = lane >> 5, wid = rfl(tid >> 6);
    const int b = bh >> 3, h = bh & 7; const long rowbase = (long)b * SEQ; const int q0 = qb * 256;
    const unsigned lds0 = (unsigned)(size_t)lds;
    LAS float* wsf = (LAS float*)(lds + MLA_OFF_WS) + wid * 64;
    LAS bf16* stg = (LAS bf16*)(lds + MLA_OFF_ST) + wid * 2048;
    const bf16* ksrc = KN + (rowbase + lane) * 512 + h * 64 + wid * 8;
    const bf16* rsrc = KR + (rowbase + lane) * 32 + (wid & 3) * 8;
    const bf16* vsrc = VA + (rowbase + 16 * (wid & 3) + (lane >> 2)) * 512 + h * 64 + (wid >> 2) * 32 + (lane & 3) * 8;
#define MLA_DMA_K(t, s) do { glds16(ksrc + (long)(t) * 64 * 512, (unsigned)rfl((int)(lds0 + (s) * MLA_KSLOT + wid * 1024))); \
        if (wid < 4) glds16(rsrc + (long)(t) * 64 * 32, (unsigned)rfl((int)(lds0 + (s) * MLA_KSLOT + (8 + wid) * 1024))); } while (0)
#define MLA_DMA_V(t, s) glds16(vsrc + (long)(t) * 64 * 512, (unsigned)rfl((int)(lds0 + MLA_OFF_V + (s) * VSLOT + wid * 1024)))
    const bf16* qp = QA + (rowbase + q0 + wid * 32 + r32) * 768 + h * 96 + hi * 8;
    bf16x8 qr[6];
#pragma unroll
    for (int d0 = 0; d0 < 6; ++d0) qr[d0] = *(const bf16x8*)(qp + d0 * 16);
    const int NT = 4 * (qb + 1);
    const lcp kfr = (lcp)lds + hi * 1024 + r32 * 16;
    const lcp vfr = (lcp)lds + MLA_OFF_V + ((lane >> 4) & 1) * 32 + (lane & 3) * 8 + (4 * hi + ((lane & 15) >> 2)) * 64;
    float mref = 0.f, lsum = 0.f; f32x16 o[2], negm;
#pragma unroll
    for (int r = 0; r < 16; ++r) { o[0][r] = 0.f; o[1][r] = 0.f; negm[r] = 0.f; }
    const int qrel = 32 * wid + r32;
#define MLA_MASK(P0, P1, t) do { const int jb_ = (t) - (NT - 4); if (jb_ >= 0 && 64 * jb_ + 63 > 32 * wid) { \
        _Pragma("unroll") for (int r = 0; r < 16; ++r) { const int kv = 64 * jb_ + crow(r, hi); if (kv > qrel) P0[r] = -INFINITY; if (kv + 32 > qrel) P1[r] = -INFINITY; } } } while (0)
#define MLA_ROWMAX(P0, P1, rm) do { float ra_ = __builtin_fmaxf(__builtin_fmaxf(P0[0], P0[1]), P1[0]), rb_ = __builtin_fmaxf(__builtin_fmaxf(P0[2], P0[3]), P1[1]); ra_ = __builtin_fmaxf(__builtin_fmaxf(ra_, P1[2]), P1[3]); \
        _Pragma("unroll") for (int r = 4; r < 16; r += 4) { ra_ = __builtin_fmaxf(__builtin_fmaxf(ra_, P0[r]), P0[r + 1]); rb_ = __builtin_fmaxf(__builtin_fmaxf(rb_, P0[r + 2]), P0[r + 3]); \
            ra_ = __builtin_fmaxf(__builtin_fmaxf(ra_, P1[r]), P1[r + 1]); rb_ = __builtin_fmaxf(__builtin_fmaxf(rb_, P1[r + 2]), P1[r + 3]); } rm = hmax(fmaxf(ra_, rb_)); } while (0)
    MLA_DMA_K(0, 0); MLA_DMA_V(0, 0); MLA_DMA_K(1, 1);
    ATT_WAITV_BAR();
    MLA_DMA_K(2, 2); MLA_DMA_V(1, 1);
    f32x16 pa0, pa1, pb0, pb1;
    qk_tile_ref<6>(pa0, pa1, kfr, qr, negm); MLA_MASK(pa0, pa1, 0);
    { float rm; MLA_ROWMAX(pa0, pa1, rm); mref = rm;
#pragma unroll
      for (int r = 0; r < 16; ++r) { pa0[r] = ex2(pa0[r] - rm); pa1[r] = ex2(pa1[r] - rm); negm[r] = -rm; } }
    int kc = 1, kn = 2, kf_ = 0, vc = 0, vn = 1, vf_ = 2;
#define MLA_KLD(i) kf_##i = *(const LAS bf16x8*)(kb_ + ((i) >> 1) * 2048 + ((i) & 1) * 512)
#define MLA_VLD(i) do { vl_[i] = vtr(vb_ + ((i) >> 2) * 4096 + ((i) & 3) * 1024); vh_[i] = vtr(vb_ + ((i) >> 2) * 4096 + ((i) & 3) * 1024 + 512); } while (0)
#define MLA_PIN(x) asm volatile("" : "+v"(x))
#define MLA_STEP(C0, C1, P0, P1, t) do { \
        ATT_WAITV_BAR();                                               \
        if ((t) + 2 < NT) MLA_DMA_K((t) + 2, kf_); \
        if ((t) + 1 < NT) MLA_DMA_V((t) + 1, vf_); \
          \
        const lcp kb_ = kfr + kc * MLA_KSLOT; const lcp vb_ = vfr + vc * VSLOT; \
        bf16x8 kf_0, kf_1, kf_2, kf_3, kf_4, kf_5, kf_6, kf_7, kf_8, kf_9, kf_10, kf_11; s16x4 vl_[8], vh_[8]; u32x4 pw_[4]; float sacc_ = 0.f; \
        MLA_KLD(0); MLA_KLD(1); MLA_KLD(2); MLA_KLD(3); \
        MLA_KLD(4); C0 = __builtin_amdgcn_mfma_f32_32x32x16_bf16(kf_0, qr[0], negm, 0, 0, 0); sacc_ += P0[0]; sacc_ += P0[1]; sacc_ += P0[2]; MLA_PIN(sacc_); pw_[0][0] = cvtpk(P0[0], P0[1]); MLA_PIN(pw_[0]); __builtin_amdgcn_sched_barrier(0); \
        MLA_KLD(5); C1 = __builtin_amdgcn_mfma_f32_32x32x16_bf16(kf_1, qr[0], negm, 0, 0, 0); sacc_ += P0[3]; sacc_ += P0[4]; sacc_ += P0[5]; MLA_PIN(sacc_); pw_[0][1] = cvtpk(P0[2], P0[3]); MLA_PIN(pw_[0]); __builtin_amdgcn_sched_barrier(0); \
        MLA_KLD(6); C0 = __builtin_amdgcn_mfma_f32_32x32x16_bf16(kf_2, qr[1], C0, 0, 0, 0); sacc_ += P0[6]; sacc_ += P0[7]; sacc_ += P0[8]; MLA_PIN(sacc_); pw_[0][2] = cvtpk(P0[4], P0[5]); MLA_PIN(pw_[0]); __builtin_amdgcn_sched_barrier(0); \
        MLA_KLD(7); C1 = __builtin_amdgcn_mfma_f32_32x32x16_bf16(kf_3, qr[1], C1, 0, 0, 0); sacc_ += P0[9]; sacc_ += P0[10]; sacc_ += P0[11]; MLA_PIN(sacc_); pw_[0][3] = cvtpk(P0[6], P0[7]); MLA_PIN(pw_[0]); __builtin_amdgcn_sched_barrier(0); \
        MLA_KLD(8); MLA_VLD(0); C0 = __builtin_amdgcn_mfma_f32_32x32x16_bf16(kf_4, qr[2], C0, 0, 0, 0); sacc_ += P0[12]; sacc_ += P0[13]; sacc_ += P0[14]; MLA_PIN(sacc_); pw_[1][0] = cvtpk(P0[8], P0[9]); MLA_PIN(pw_[1]); pw_[1][1] = cvtpk(P0[10], P0[11]); MLA_PIN(pw_[1]); __builtin_amdgcn_sched_barrier(0); \
        MLA_KLD(9); MLA_VLD(1); C1 = __builtin_amdgcn_mfma_f32_32x32x16_bf16(kf_5, qr[2], C1, 0, 0, 0); sacc_ += P0[15]; sacc_ += P1[0]; sacc_ += P1[1]; MLA_PIN(sacc_); pw_[1][2] = cvtpk(P0[12], P0[13]); MLA_PIN(pw_[1]); pw_[1][3] = cvtpk(P0[14], P0[15]); MLA_PIN(pw_[1]); __builtin_amdgcn_sched_barrier(0); \
        MLA_KLD(10); MLA_VLD(2); C0 = __builtin_amdgcn_mfma_f32_32x32x16_bf16(kf_6, qr[3], C0, 0, 0, 0); sacc_ += P1[2]; sacc_ += P1[3]; sacc_ += P1[4]; MLA_PIN(sacc_); pw_[2][0] = cvtpk(P1[0], P1[1]); MLA_PIN(pw_[2]); pw_[2][1] = cvtpk(P1[2], P1[3]); MLA_PIN(pw_[2]); __builtin_amdgcn_sched_barrier(0); \
        MLA_KLD(11); MLA_VLD(3); C1 = __builtin_amdgcn_mfma_f32_32x32x16_bf16(kf_7, qr[3], C1, 0, 0, 0); sacc_ += P1[5]; sacc_ += P1[6]; sacc_ += P1[7]; MLA_PIN(sacc_); pw_[2][2] = cvtpk(P1[4], P1[5]); MLA_PIN(pw_[2]); pw_[2][3] = cvtpk(P1[6], P1[7]); MLA_PIN(pw_[2]); __builtin_amdgcn_sched_barrier(0); \
        MLA_VLD(4); C0 = __builtin_amdgcn_mfma_f32_32x32x16_bf16(kf_8, qr[4], C0, 0, 0, 0); sacc_ += P1[8]; sacc_ += P1[9]; MLA_PIN(sacc_); pw_[3][0] = cvtpk(P1[8], P1[9]); MLA_PIN(pw_[3]); __builtin_amdgcn_sched_barrier(0); \
        MLA_VLD(5); C1 = __builtin_amdgcn_mfma_f32_32x32x16_bf16(kf_9, qr[4], C1, 0, 0, 0); sacc_ += P1[10]; sacc_ += P1[11]; MLA_PIN(sacc_); pw_[3][1] = cvtpk(P1[10], P1[11]); MLA_PIN(pw_[3]); __builtin_amdgcn_sched_barrier(0); \
        MLA_VLD(6); C0 = __builtin_amdgcn_mfma_f32_32x32x16_bf16(kf_10, qr[5], C0, 0, 0, 0); sacc_ += P1[12]; sacc_ += P1[13]; MLA_PIN(sacc_); pw_[3][2] = cvtpk(P1[12], P1[13]); MLA_PIN(pw_[3]); __builtin_amdgcn_sched_barrier(0); \
        MLA_VLD(7); C1 = __builtin_amdgcn_mfma_f32_32x32x16_bf16(kf_11, qr[5], C1, 0, 0, 0); sacc_ += P1[14]; sacc_ += P1[15]; MLA_PIN(sacc_); pw_[3][3] = cvtpk(P1[14], P1[15]); MLA_PIN(pw_[3]); __builtin_amdgcn_sched_barrier(0); \
        lsum += sacc_; \
          \
        __builtin_amdgcn_sched_barrier(0); \
        o[0] = __builtin_amdgcn_mfma_f32_32x32x16_bf16(__builtin_bit_cast(bf16x8, pw_[0]), (bf16x8){vl_[0][0], vl_[0][1], vl_[0][2], vl_[0][3], vh_[0][0], vh_[0][1], vh_[0][2], vh_[0][3]}, o[0], 0, 0, 0); o[1] = __builtin_amdgcn_mfma_f32_32x32x16_bf16(__builtin_bit_cast(bf16x8, pw_[0]), (bf16x8){vl_[4][0], vl_[4][1], vl_[4][2], vl_[4][3], vh_[4][0], vh_[4][1], vh_[4][2], vh_[4][3]}, o[1], 0, 0, 0); \
        MLA_MASK(C0, C1, t); \
        float rm_; MLA_ROWMAX(C0, C1, rm_); \
        bool resc_ = false; float alpha_ = 1.f; \
        if (__any(rm_ > 8.f)) { const float dl = fmaxf(rm_, 0.f); mref += dl; alpha_ = ex2(-dl); lsum *= alpha_; resc_ = true; \
            _Pragma("unroll") for (int r = 0; r < 16; ++r) { C0[r] -= dl; C1[r] -= dl; negm[r] = -mref; } } \
          \
        __builtin_amdgcn_sched_barrier(0); \
        o[0] = __builtin_amdgcn_mfma_f32_32x32x16_bf16(__builtin_bit_cast(bf16x8, pw_[1]), (bf16x8){vl_[1][0], vl_[1][1], vl_[1][2], vl_[1][3], vh_[1][0], vh_[1][1], vh_[1][2], vh_[1][3]}, o[0], 0, 0, 0); C0[0] = ex2(C0[0]); C0[1] = ex2(C0[1]); C0[2] = ex2(C0[2]); C0[3] = ex2(C0[3]); C0[4] = ex2(C0[4]); MLA_PIN(C0); MLA_PIN(C1); __builtin_amdgcn_sched_barrier(0); \
        o[1] = __builtin_amdgcn_mfma_f32_32x32x16_bf16(__builtin_bit_cast(bf16x8, pw_[1]), (bf16x8){vl_[5][0], vl_[5][1], vl_[5][2], vl_[5][3], vh_[5][0], vh_[5][1], vh_[5][2], vh_[5][3]}, o[1], 0, 0, 0); C0[5] = ex2(C0[5]); C0[6] = ex2(C0[6]); C0[7] = ex2(C0[7]); C0[8] = ex2(C0[8]); C0[9] = ex2(C0[9]); MLA_PIN(C0); MLA_PIN(C1); __builtin_amdgcn_sched_barrier(0); \
        o[0] = __builtin_amdgcn_mfma_f32_32x32x16_bf16(__builtin_bit_cast(bf16x8, pw_[2]), (bf16x8){vl_[2][0], vl_[2][1], vl_[2][2], vl_[2][3], vh_[2][0], vh_[2][1], vh_[2][2], vh_[2][3]}, o[0], 0, 0, 0); C0[10] = ex2(C0[10]); C0[11] = ex2(C0[11]); C0[12] = ex2(C0[12]); C0[13] = ex2(C0[13]); C0[14] = ex2(C0[14]); MLA_PIN(C0); MLA_PIN(C1); __builtin_amdgcn_sched_barrier(0); \
        o[1] = __builtin_amdgcn_mfma_f32_32x32x16_bf16(__builtin_bit_cast(bf16x8, pw_[2]), (bf16x8){vl_[6][0], vl_[6][1], vl_[6][2], vl_[6][3], vh_[6][0], vh_[6][1], vh_[6][2], vh_[6][3]}, o[1], 0, 0, 0); C0[15] = ex2(C0[15]); C1[0] = ex2(C1[0]); C1[1] = ex2(C1[1]); C1[2] = ex2(C1[2]); C1[3] = ex2(C1[3]); MLA_PIN(C0); MLA_PIN(C1); __builtin_amdgcn_sched_barrier(0); \
        o[0] = __builtin_amdgcn_mfma_f32_32x32x16_bf16(__builtin_bit_cast(bf16x8, pw_[3]), (bf16x8){vl_[3][0], vl_[3][1], vl_[3][2], vl_[3][3], vh_[3][0], vh_[3][1], vh_[3][2], vh_[3][3]}, o[0], 0, 0, 0); C1[4] = ex2(C1[4]); C1[5] = ex2(C1[5]); C1[6] = ex2(C1[6]); C1[7] = ex2(C1[7]); C1[8] = ex2(C1[8]); MLA_PIN(C0); MLA_PIN(C1); __builtin_amdgcn_sched_barrier(0); \
        o[1] = __builtin_amdgcn_mfma_f32_32x32x16_bf16(__builtin_bit_cast(bf16x8, pw_[3]), (bf16x8){vl_[7][0], vl_[7][1], vl_[7][2], vl_[7][3], vh_[7][0], vh_[7][1], vh_[7][2], vh_[7][3]}, o[1], 0, 0, 0); C1[9] = ex2(C1[9]); C1[10] = ex2(C1[10]); C1[11] = ex2(C1[11]); C1[12] = ex2(C1[12]); C1[13] = ex2(C1[13]); MLA_PIN(C0); MLA_PIN(C1); __builtin_amdgcn_sched_barrier(0); \
        C1[14] = ex2(C1[14]); C1[15] = ex2(C1[15]); \
        if (resc_) { if (hi == 0) wsf[r32] = alpha_; WAVE_LDS_SYNC(); \
            _Pragma("unroll") for (int r = 0; r < 16; ++r) { const float a = wsf[crow(r, hi)]; o[0][r] *= a; o[1][r] *= a; } WAVE_LDS_SYNC(); } \
        { const int t_ = kc; kc = kn; kn = kf_; kf_ = t_; } { const int t_ = vc; vc = vn; vn = vf_; vf_ = t_; } } while (0)
    for (int t = 1; t + 1 < NT; t += 2) { MLA_STEP(pb0, pb1, pa0, pa1, t); MLA_STEP(pa0, pa1, pb0, pb1, t + 1); }
    MLA_STEP(pb0, pb1, pa0, pa1, NT - 1);
    { float s_ = 0.f;
#pragma unroll
      for (int r = 0; r < 16; ++r) s_ += pb0[r] + pb1[r];
      lsum += s_; ATT_WAITV_BAR(); pv_tile(o, vfr + vc * VSLOT, pb0, pb1); }
#undef MLA_STEP
#undef MLA_KLD
#undef MLA_VLD
#undef MLA_PIN
#undef MLA_ROWMAX
#undef MLA_MASK
#undef MLA_DMA_K
#undef MLA_DMA_V
    lsum = hsum(lsum);
    if (hi == 0) wsf[32 + r32] = __builtin_amdgcn_rcpf(lsum);
    stage_o(o, stg, wsf + 32, r32, hi);
    bf16* Ow = OC + (rowbase + q0 + wid * 32) * 1024 + h * 64;
#pragma unroll
    for (int i = 0; i < 4; ++i) { const int row = i * 8 + (lane >> 3), ch = lane & 7; const u32x4 v = *(const LAS u32x4*)(stg + row * 64 + ch * 8); *(u32x4*)(Ow + (long)row * 1024 + ch * 8) = v; }
    ATT_WAITV_BAR();
}

constexpr int SB_KSLOT = 8192, SB_OFF_V = 2 * SB_KSLOT, SB_OFF_WS = SB_OFF_V + 2 * VSLOT, SB_OFF_ST = SB_OFF_WS + 8 * 256, SB_OFF_FL = SB_OFF_ST + 8 * 4096, SB_LDS = SB_OFF_FL + 64;
DI void sb_unit(int bh, int qb, const bf16* Q, const bf16* K, const bf16* V, bf16* OC, LAS unsigned char* lds) {
    int tid_ = threadIdx.x; asm volatile("" : "+v"(tid_));
    const int tid = tid_, lane = tid & 63, r32 = lane & 31, hi = lane >> 5, wid = rfl(tid >> 6);
    const int b = bh >> 3, h = bh & 7; const long rowbase = (long)b * SEQ; const int q0 = qb * 256;
    const unsigned lds0 = (unsigned)(size_t)lds;
    LAS bf16* stg = (LAS bf16*)(lds + SB_OFF_ST) + wid * 2048;
    volatile LAS unsigned* fl = (volatile LAS unsigned*)(lds + SB_OFF_FL);
    const bf16* ksrc = K + (rowbase + lane) * 512 + h * 64 + wid * 8;
    const bf16* vsrc = V + (rowbase + 16 * (wid & 3) + (lane >> 2)) * 512 + h * 64 + (wid >> 2) * 32 + (lane & 3) * 8;
#define SB_DMA(t, s) do { glds16(ksrc + (long)(t) * 64 * 512, (unsigned)rfl((int)(lds0 + (s) * SB_KSLOT + wid * 1024))); \
        glds16(vsrc + (long)(t) * 64 * 512, (unsigned)rfl((int)(lds0 + SB_OFF_V + (s) * VSLOT + wid * 1024))); } while (0)
    const bf16* qp = Q + (rowbase + q0 + wid * 32 + r32) * 512 + h * 64 + hi * 8;
    bf16x8 qr[4];
#pragma unroll
    for (int d0 = 0; d0 < 4; ++d0) qr[d0] = *(const bf16x8*)(qp + d0 * 16);
    const int NT = 4 * (qb + 1);
    const lcp kfr = (lcp)lds + hi * 1024 + r32 * 16;
    const lcp vfr = (lcp)lds + SB_OFF_V + ((lane >> 4) & 1) * 32 + (lane & 3) * 8 + (4 * hi + ((lane & 15) >> 2)) * 64;
    float carry = 1.f; f32x16 o[2];
#pragma unroll
    for (int r = 0; r < 16; ++r) { o[0][r] = 0.f; o[1][r] = 0.f; }
    if (tid == 0) { fl[0] = 0u; fl[1] = 0u; fl[2] = 0u; }
    SB_DMA(NT - 1, 0);
    for (int i = 0; i < NT; ++i) {
        const int t = NT - 1 - i;
        ATT_WAITV_BAR();
        if (i > 0 && fl[(i - 1) % 3] == 0u) break;
        if (tid == 0) fl[(i + 1) % 3] = 0u;
        const int s = i & 1;
        if (t > 0) SB_DMA(t - 1, s ^ 1);
        const int jb = t - (NT - 4), qlo = 32 * wid;
        const bool skip = (jb >= 0 && 64 * jb >= qlo + 31);
        const bool dead = __all(carry == 0.f) != 0;
        if (!skip && !dead) {
            f32x16 p0, p1; qk_tile<4>(p0, p1, kfr + s * SB_KSLOT, qr);
            f32x16 f0, f1;
#pragma unroll
            for (int r = 0; r < 16; ++r) {
                { const float y = p0[r], e = ex2(-fabsf(y)), rr = __builtin_amdgcn_rcpf(1.f + e), er = e * rr; const bool pos = y >= 0.f; p0[r] = pos ? rr : er; f0[r] = pos ? er : rr; }
                { const float y = p1[r], e = ex2(-fabsf(y)), rr = __builtin_amdgcn_rcpf(1.f + e), er = e * rr; const bool pos = y >= 0.f; p1[r] = pos ? rr : er; f1[r] = pos ? er : rr; }
            }
            if (jb >= 0 && 64 * jb + 63 >= qlo) { const int qrel = qlo + r32;
#pragma unroll
                for (int r = 0; r < 16; ++r) { const int kv = 64 * jb + crow(r, hi);
                    if (kv >= qrel) { f0[r] = 1.f; p0[r] = 0.f; } if (kv + 32 >= qrel) { f1[r] = 1.f; p1[r] = 0.f; } } }
            float mine[8], oth[8], ps[8];
#pragma unroll
            for (int g = 0; g < 4; ++g) {
                { const float a0 = f0[4 * g], a1 = f0[4 * g + 1], a2 = f0[4 * g + 2], a3 = f0[4 * g + 3]; const float e1 = a3 * a2, e0 = e1 * a1;
                  f0[4 * g + 3] = 1.f; f0[4 * g + 2] = a3; f0[4 * g + 1] = e1; f0[4 * g] = e0; mine[g] = e0 * a0; }
                { const float a0 = f1[4 * g], a1 = f1[4 * g + 1], a2 = f1[4 * g + 2], a3 = f1[4 * g + 3]; const float e1 = a3 * a2, e0 = e1 * a1;
                  f1[4 * g + 3] = 1.f; f1[4 * g + 2] = a3; f1[4 * g + 1] = e1; f1[4 * g] = e0; mine[4 + g] = e0 * a0; }
            }
#pragma unroll
            for (int g = 0; g < 8; ++g) { auto rr = __builtin_amdgcn_permlane32_swap(__float_as_uint(mine[g]), __float_as_uint(mine[g]), false, false);
                const float x0 = __uint_as_float(rr[0]), x1 = __uint_as_float(rr[1]); oth[g] = hi ? x0 : x1; ps[g] = x0 * x1; }
            float sp = 1.f; float off[8];
#pragma unroll
            for (int g = 7; g >= 0; --g) { off[g] = sp * (hi ? 1.f : oth[g]) * carry; sp *= ps[g]; }
#pragma unroll
            for (int g = 0; g < 4; ++g)
#pragma unroll
                for (int j = 0; j < 4; ++j) { p0[4 * g + j] = p0[4 * g + j] * f0[4 * g + j] * off[g]; p1[4 * g + j] = p1[4 * g + j] * f1[4 * g + j] * off[4 + g]; }
            carry *= sp;
            pv_tile(o, vfr + s * VSLOT, p0, p1);
        }
        if (t > 0 && __any(carry != 0.f) && lane == 0) fl[i % 3] = 1u;
    }
#undef SB_DMA
    ATT_WAITV_BAR();
    stage_o(o, stg, nullptr, r32, hi);
    bf16* Ow = OC + (rowbase + q0 + wid * 32) * 1024 + 512 + h * 64;
#pragma unroll
    for (int i = 0; i < 4; ++i) { const int row = i * 8 + (lane >> 3), ch = lane & 7; const u32x4 v = *(const LAS u32x4*)(stg + row * 64 + ch * 8); *(u32x4*)(Ow + (long)row * 1024 + ch * 8) = v; }
    ATT_WAITV_BAR();
}

constexpr int MB_NB = SEQ / 256;
constexpr int MB_OFF_K = 0, MB_OFF_V = 32768, MB_OFF_WS = 65536, MB_OFF_ST = MB_OFF_WS + 8 * 256, MB_OFF_TAB = MB_OFF_ST + 8 * 4096, MB_OFF_RING = MB_OFF_TAB + 512,
              MB_OFF_WC = MB_OFF_RING + 32768, MB_OFF_Q = MB_OFF_WC + 64, MB_LDS = MB_OFF_Q + 64;
DI int t5_bucket(int d) { if (d < 16) return d; const int l = 16 + (int)(__logf((float)d * (1.f / 16.f)) * (16.f / 2.0794415416798357f)); return l < 31 ? l : 31; }
DI void mb_load_kv(const bf16* K2, const bf16* V2, long row0, int h, unsigned lds0, int lane, int wid) {
    const bf16* ksrc = K2 + (row0 + lane) * 1024 + h * 64 + wid * 8;
    const bf16* vsrc = V2 + (row0 + 16 * (wid & 3) + (lane >> 2)) * 1024 + h * 64 + (wid >> 2) * 32 + (lane & 3) * 8;
#pragma unroll
    for (int t = 0; t < 4; ++t) { glds16(ksrc + (long)t * 64 * 1024, (unsigned)rfl((int)(lds0 + MB_OFF_K + t * 8192 + wid * 1024)));
        glds16(vsrc + (long)t * 64 * 1024, (unsigned)rfl((int)(lds0 + MB_OFF_V + t * 8192 + wid * 1024))); }
}
DI void mb_fill_tab(const float* rel_bias, int h, LAS float* tab, int tid) { if (tid < 128) tab[tid] = rel_bias[h * 32 + t5_bucket(tid)] * LOG2E; }

DI void moba_gate_unit(int bh, int g, const bf16* Q2, const float* KMP, unsigned* SEL, unsigned* MASK32, LAS unsigned char* lds) {
    using namespace att;
    int tid_ = threadIdx.x; asm volatile("" : "+v"(tid_));
    const int tid = tid_, lane = tid & 63, r32 = lane & 31, hi = lane >> 5, wid = rfl(tid >> 6);
    const int b = bh >> 4, h = bh & 15;
    LAS bf16* khi = (LAS bf16*)lds; LAS bf16* klo = (LAS bf16*)(lds + 8192);
#pragma unroll
    for (int it_ = 0; it_ < 8; ++it_) { const int i = tid + 512 * it_; const int n = i >> 6, d = i & 63; const size_t src = (size_t)(b * MB_NB + n) * 1024 + h * 64 + d;
        const float v = (KMP[src] + KMP[(size_t)(T / 256) * 1024 + src]) * (1.f / 256.f);
        const unsigned ph = cvtpk(v, 0.f) & 0xffffu; const float rem = v - __uint_as_float(ph << 16); const unsigned pl = cvtpk(rem, 0.f) & 0xffffu;
        const int off = (d >> 3) * 512 + n * 8 + (d & 7); khi[off] = (bf16)ph; klo[off] = (bf16)pl; }
    const bf16* qbase = Q2 + ((long)b * SEQ + wid * 32 + r32) * 1024 + h * 64 + hi * 8;
    bf16x8 qn[4];
#pragma unroll
    for (int d0 = 0; d0 < 4; ++d0) qn[d0] = *(const bf16x8*)(qbase + (long)g * 256 * 1024 + d0 * 16);
    __syncthreads();
    const lcp kfr = (lcp)lds + hi * 1024 + r32 * 16;
#pragma unroll 1
    for (int j = 0; j < 8; ++j) {
        const int qb = g + 8 * j;
        bf16x8 qr[4] = {qn[0], qn[1], qn[2], qn[3]};
        if (j < 7) {
#pragma unroll
            for (int d0 = 0; d0 < 4; ++d0) qn[d0] = *(const bf16x8*)(qbase + (long)(qb + 8) * 256 * 1024 + d0 * 16); }
        f32x16 p0, p1, q0, q1; qk_tile<4>(p0, p1, kfr, qr); qk_tile<4>(q0, q1, kfr + 8192, qr);
        unsigned ka = 0u, kb = 0u, kc = 0u;
#define MB_KEY(g, n) ((((__float_as_uint(g)) ^ ((unsigned)((int)__float_as_uint(g) >> 31) | 0x80000000u)) & ~63u) | (63u - (n)))
#define MB_INS(x) do { const unsigned x_ = (x); const unsigned t_ = ka < x_ ? ka : x_; ka = ka < x_ ? x_ : ka; const unsigned u_ = kb < t_ ? kb : t_; kb = kb < t_ ? t_ : kb; kc = kc < u_ ? u_ : kc; } while (0)
#pragma unroll
        for (int r = 0; r < 16; ++r) { const unsigned n = (unsigned)crow(r, hi); const float gsc = p0[r] + q0[r]; MB_INS((int)n < qb ? MB_KEY(gsc, n) : 0u); }
        if (qb > 32) {
#pragma unroll
            for (int r = 0; r < 16; ++r) { const unsigned n = 32u + (unsigned)crow(r, hi); const float gsc = p1[r] + q1[r]; MB_INS((int)n < qb ? MB_KEY(gsc, n) : 0u); } }
        { unsigned pa, pb, pc;
#define MB_SWAPU(dst, src) do { auto rr_ = __builtin_amdgcn_permlane32_swap(src, src, false, false); dst = hi ? rr_[0] : rr_[1]; } while (0)
          MB_SWAPU(pa, ka); MB_SWAPU(pb, kb); MB_SWAPU(pc, kc);
#undef MB_SWAPU
          MB_INS(pa); MB_INS(pb); MB_INS(pc); }
#undef MB_KEY
#undef MB_INS
        const unsigned i0 = ka ? 63u - (ka & 63u) : 0xFFu, i1 = kb ? 63u - (kb & 63u) : 0xFFu, i2 = kc ? 63u - (kc & 63u) : 0xFFu;
        if (hi == 0) SEL[(size_t)bh * SEQ + qb * 256 + wid * 32 + r32] = i0 | (i1 << 8) | (i2 << 16);
        { LAS unsigned* mt = (LAS unsigned*)(lds + 16384);
          __syncthreads();
#pragma unroll
          for (int i = 0; i < 3; ++i) mt[tid + 512 * i] = 0u;
          __syncthreads();
          if (hi == 0) { if (i0 != 0xFFu) (void)__hip_atomic_fetch_or(&mt[(i0 * 3 + 0) * 8 + wid], 1u << r32, __ATOMIC_RELAXED, __HIP_MEMORY_SCOPE_WORKGROUP); if (i1 != 0xFFu) (void)__hip_atomic_fetch_or(&mt[(i1 * 3 + 1) * 8 + wid], 1u << r32, __ATOMIC_RELAXED, __HIP_MEMORY_SCOPE_WORKGROUP); if (i2 != 0xFFu) (void)__hip_atomic_fetch_or(&mt[(i2 * 3 + 2) * 8 + wid], 1u << r32, __ATOMIC_RELAXED, __HIP_MEMORY_SCOPE_WORKGROUP); }
          __syncthreads();
#pragma unroll
          for (int i = 0; i < 3; ++i) { const int j = tid + 512 * i; if (j < qb * 24) { const int n = j / 24, rem = j % 24; MASK32[(((size_t)bh * 64 + n) * 64 + qb) * 24 + rem] = mt[j]; } } }
    }
    __syncthreads();
}

DI void moba_sel_unit(int bh, int n, const bf16* Q2, const bf16* K2, const bf16* V2, const unsigned long long* MASK, const float* rel_bias, bf16* PO0, bf16* PO1, bf16* PO2, bf16* PO3, float2* PMS, LAS unsigned char* lds) {
    using namespace att;
    int tid_ = threadIdx.x; asm volatile("" : "+v"(tid_));
    const int tid = tid_, lane = tid & 63, r32 = lane & 31, hi = lane >> 5, wid = rfl(tid >> 6);
    const int b = bh >> 4, h = bh & 15; const unsigned lds0 = (unsigned)(size_t)lds;
    mb_load_kv(K2, V2, (long)b * SEQ + n * 256, h, lds0, lane, wid);
    mb_fill_tab(rel_bias, h, (LAS float*)(lds + MB_OFF_TAB), tid);
    LAS unsigned short* list = (LAS unsigned short*)(lds + MB_OFF_RING);
    volatile LAS unsigned* wc = (volatile LAS unsigned*)(lds + MB_OFF_WC);
    bf16x8 qo[4];
    { const bf16* qp = Q2 + ((long)b * SEQ + n * 256 + wid * 32 + r32) * 1024 + h * 64 + hi * 8;
#pragma unroll
      for (int d0 = 0; d0 < 4; ++d0) qo[d0] = *(const bf16x8*)(qp + d0 * 16); }
    const unsigned* mw = (const unsigned*)(MASK + (((size_t)bh * 64 + n) * 64 + (n + 1)) * 12);
    const int nwords = (63 - n) * 24;
    unsigned w[3]; unsigned c = 0;
#pragma unroll
    for (int i = 0; i < 3; ++i) { const int j = tid + 512 * i; w[i] = j < nwords ? mw[j] : 0u; c += (unsigned)__popc(w[i]); }
    unsigned inc = c;
#pragma unroll
    for (int o = 1; o < 64; o <<= 1) { const unsigned t = __shfl_up(inc, o); if (lane >= o) inc += t; }
    if (lane == 63) wc[wid] = inc;
    ATT_WAITV_BAR();
    unsigned base = inc - c, total = 0;
#pragma unroll
    for (int i = 0; i < 8; ++i) { const unsigned x = wc[i]; total += x; if (i < wid) base += x; }
#pragma unroll
    for (int i = 0; i < 3; ++i) { const int j = tid + 512 * i; const int qb = n + 1 + j / 24, rem = j % 24, k = rem >> 3, s0 = qb * 256 + (rem & 7) * 32; unsigned ww = w[i];
        while (ww) { const int bit = __ffs(ww) - 1; ww &= ww - 1u; list[base++] = (unsigned short)(((unsigned)(s0 + bit) << 2) | (unsigned)k); } }
    ATT_BAR();
    const int nchunk = ((int)total + 255) >> 8;
    LAS float* wsf = (LAS float*)(lds + MB_OFF_WS) + wid * 64;
    LAS bf16* stg = (LAS bf16*)(lds + MB_OFF_ST) + wid * 2048;
    const LAS float* tab = (const LAS float*)(lds + MB_OFF_TAB);
    const lcp kfr = (lcp)lds + MB_OFF_K + hi * 1024 + r32 * 16;
    const lcp vfr = (lcp)lds + MB_OFF_V + ((lane >> 4) & 1) * 32 + (lane & 3) * 8 + (4 * hi + ((lane & 15) >> 2)) * 64;
    const int nchunk_ = ((int)total + 255) >> 8;
    const bf16* qbase = Q2 + (long)b * SEQ * 1024 + h * 64 + hi * 8;
    const int kend = n * 256 + 255;
    bf16x8 qn[4]; unsigned en = 0; bool vn = false;
#define MB_QLOAD(cc) do { const int idx_ = (cc) * 256 + 32 * wid + r32; vn = idx_ < (int)total; en = vn ? (unsigned)list[idx_] : 0u; const bf16* qp_ = qbase + (long)(en >> 2) * 1024; \
        _Pragma("unroll") for (int d0 = 0; d0 < 4; ++d0) { bf16x8 z_; _Pragma("unroll") for (int j_ = 0; j_ < 8; ++j_) z_[j_] = 0; qn[d0] = vn ? *(const bf16x8*)(qp_ + d0 * 16) : z_; } } while (0)
    if (nchunk_ > 0) MB_QLOAD(0);
    { float mref = -INFINITY, lsum = 0.f; f32x16 o[2];
#pragma unroll
      for (int r = 0; r < 16; ++r) { o[0][r] = 0.f; o[1][r] = 0.f; }
      const int qrel = 32 * wid + r32, tlast = wid >> 1;
#pragma unroll 1
      for (int t = 0; t <= tlast; ++t) {
          f32x16 p0, p1; qk_tile<4>(p0, p1, kfr + t * 8192, qo);
          const int dbase = qrel - 64 * t;
#pragma unroll
          for (int r = 0; r < 16; ++r) { const int d0 = dbase - crow(r, hi), d1 = d0 - 32;
              const int c0 = d0 > 127 ? 127 : (d0 < 0 ? 0 : d0), c1 = d1 > 127 ? 127 : (d1 < 0 ? 0 : d1);
              p0[r] = d0 < 0 ? -INFINITY : p0[r] + tab[c0]; p1[r] = d1 < 0 ? -INFINITY : p1[r] + tab[c1]; }
          smax_update(p0, p1, mref, lsum, o, wsf, r32, hi);
          pv_tile(o, vfr + t * 8192, p0, p1);
      }
      lsum = hsum(lsum);
      const int sq = n * 256 + qrel;
      if (hi == 0) PMS[((size_t)(3 * 32 + bh)) * SEQ + sq] = make_float2(mref, lsum);
      stage_o(o, stg, nullptr, r32, hi);
#pragma unroll
      for (int i = 0; i < 4; ++i) { const int row = i * 8 + (lane >> 3), ch = lane & 7;
          const u32x4 v = *(const LAS u32x4*)(stg + row * 64 + ch * 8); __builtin_nontemporal_store(v, (u32x4*)(PO3 + ((size_t)bh * SEQ + (n * 256 + 32 * wid + row)) * 64 + ch * 8)); }
      WAVE_LDS_SYNC(); }
#if defined(PROBE_DUP) && ((PROBE_DUP >> 19) & 1)
    for (int prb_ = 0; prb_ < 2; ++prb_) {
#else
    {
#endif
#if defined(PROBE_DUP) && ((PROBE_DUP >> 19) & 1)
    if (prb_ > 0 && nchunk > 0) MB_QLOAD(0);
#endif
    if (wid >= 4) __builtin_amdgcn_s_sleep(10);
#pragma unroll 1
    for (int cc = 0; cc < nchunk; ++cc) {
        const int cnt = ((int)total - cc * 256) < 256 ? ((int)total - cc * 256) : 256;
        bf16x8 qr[4] = {qn[0], qn[1], qn[2], qn[3]}; const unsigned e = en; const bool valid = vn;
        if (cc + 1 < nchunk) MB_QLOAD(cc + 1);
        if (32 * wid >= cnt) continue;
        const bool far = __all(!valid || ((int)(e >> 2) - kend >= 113)) != 0;
        float mref = 0.f, lsum = 0.f; f32x16 o[2], negm;
#pragma unroll
        for (int r = 0; r < 16; ++r) { o[0][r] = 0.f; o[1][r] = 0.f; negm[r] = 0.f; }
#pragma unroll 1
        for (int t = 0; t < 4; ++t) {
            f32x16 p0, p1; qk_tile_ref<4>(p0, p1, kfr + t * 8192, qr, negm);
            if (!far) { const int dbase = (int)(e >> 2) - (n * 256 + 64 * t);
#pragma unroll
                for (int r = 0; r < 16; ++r) { int d0 = dbase - crow(r, hi), d1 = d0 - 32; d0 = d0 > 127 ? 127 : (d0 < 0 ? 0 : d0); d1 = d1 > 127 ? 127 : (d1 < 0 ? 0 : d1); p0[r] += tab[d0]; p1[r] += tab[d1]; } }
            smax_update_ref(p0, p1, mref, negm, lsum, o, wsf, r32, hi, t == 0);
            pv_tile(o, vfr + t * 8192, p0, p1);
        }
        lsum = hsum(lsum);
        if (far) mref += tab[127];
        if (valid && hi == 0) { unsigned e_ = e; asm volatile("" : "+v"(e_)); PMS[((size_t)((int)(e_ & 3u) * 32 + bh)) * SEQ + (int)(e_ >> 2)] = make_float2(mref, lsum); }
        stage_o(o, stg, nullptr, r32, hi);
#pragma unroll
        for (int i = 0; i < 4; ++i) { const int row = i * 8 + (lane >> 3), ch = lane & 7; const int ridx = 32 * wid + row;
            if (ridx < cnt) { const unsigned e2 = list[cc * 256 + ridx]; const int s2 = (int)(e2 >> 2), k2 = (int)(e2 & 3u);
                const u32x4 v = *(const LAS u32x4*)(stg + row * 64 + ch * 8); bf16* pob = k2 == 0 ? PO0 : (k2 == 1 ? PO1 : PO2); __builtin_nontemporal_store(v, (u32x4*)(pob + ((size_t)bh * SEQ + s2) * 64 + ch * 8)); } }
        WAVE_LDS_SYNC();
    }
    }
#undef MB_QLOAD
    ATT_WAITV_BAR();
}

DI void moba_merge(int gw, int ngw, const unsigned* SEL, const bf16* PO0, const bf16* PO1, const bf16* PO2, const bf16* PO3, const float2* PMS, bf16* O2) {
    using namespace att;
    int tid_ = threadIdx.x; asm volatile("" : "+v"(tid_));
    const int lane = tid_ & 63, sub = lane >> 3, ch = lane & 7;
    const int NST = 32 * (SEQ / 8);
    unsigned nsel = 0u; float2 nms[4]; u32x4 npv[4];
#define MB_MLOAD(st) do { const int bh_ = (st) / (SEQ / 8), s_ = ((st) % (SEQ / 8)) * 8 + sub; const size_t it_ = (size_t)bh_ * SEQ + s_; nsel = SEL[it_]; \
        _Pragma("unroll") for (int k = 0; k < 4; ++k) { nms[k] = PMS[(size_t)k * 32 * SEQ + it_]; const bf16* pob = k == 0 ? PO0 : (k == 1 ? PO1 : (k == 2 ? PO2 : PO3)); npv[k] = __builtin_nontemporal_load((const u32x4*)(pob + it_ * 64 + ch * 8)); } } while (0)
    if (gw < NST) MB_MLOAD(gw);
    for (int st = gw; st < NST; st += ngw) {
        const int bh = st / (SEQ / 8), s = (st % (SEQ / 8)) * 8 + sub;
        const unsigned sel = nsel; float2 ms[4] = {nms[0], nms[1], nms[2], nms[3]}; u32x4 pv[4] = {npv[0], npv[1], npv[2], npv[3]};
        if (st + ngw < NST) MB_MLOAD(st + ngw);
        float mall = ms[3].x;
#pragma unroll
        for (int k = 0; k < 3; ++k) { const bool ok = ((sel >> (8 * k)) & 0xFFu) != 0xFFu; if (!ok) { ms[k].x = -INFINITY; ms[k].y = 0.f; pv[k] = (u32x4){0u, 0u, 0u, 0u}; } mall = fmaxf(mall, ms[k].x); }
        float den = 0.f, acc[8] = {0.f, 0.f, 0.f, 0.f, 0.f, 0.f, 0.f, 0.f};
#pragma unroll
        for (int k = 0; k < 4; ++k) { const float w = ex2(ms[k].x - mall); den += w * ms[k].y; const u32x4 v = pv[k];
            acc[0] += w * bflo(v.x); acc[1] += w * bfhi(v.x); acc[2] += w * bflo(v.y); acc[3] += w * bfhi(v.y); acc[4] += w * bflo(v.z); acc[5] += w * bfhi(v.z); acc[6] += w * bflo(v.w); acc[7] += w * bfhi(v.w); }
        const float rd = __builtin_amdgcn_rcpf(den);
        const u32x4 ov = (u32x4){cvtpk(acc[0] * rd, acc[1] * rd), cvtpk(acc[2] * rd, acc[3] * rd), cvtpk(acc[4] * rd, acc[5] * rd), cvtpk(acc[6] * rd, acc[7] * rd)};
        *(u32x4*)(O2 + ((size_t)(bh >> 4) * SEQ + s) * 1024 + (bh & 15) * 64 + ch * 8) = ov;
    }
#undef MB_MLOAD
}
}

constexpr size_t MiB = 1u << 20;
constexpr int NSLOT = 2 * T + 8 * 256;
constexpr size_t WS_CTL = 0, CTL_ZERO_BYTES = 64 * 1024;
constexpr size_t WS_RSTD0 = 1 * MiB, WS_TOKW = WS_RSTD0 + 128 * 1024, WS_TOKR = WS_TOKW + 256 * 1024, WS_TOKE = WS_TOKR + 128 * 1024, WS_PRANK = WS_TOKE + 128 * 1024;
constexpr size_t WS_PQKV = 2 * MiB, WS_PS1 = 6 * MiB, WS_PS2 = 8 * MiB, WS_PS3 = 10 * MiB, WS_ROPE = 12 * MiB, WS_KMP = 14 * MiB;
constexpr size_t WS_SDST = 15 * MiB, WS_SW = WS_SDST + 272 * 1024, WS_SRS = WS_SW + 272 * 1024;
constexpr size_t WS_WRT = 16 * MiB, WS_CNT = WS_WRT + 64 * 1024, WS_TILEE = WS_CNT + 64 * 1024;
constexpr size_t WS_STOK = 17 * MiB;
constexpr size_t WS_SEL = 18 * MiB;
constexpr size_t WS_W = 20 * MiB;
constexpr size_t W_IN = WS_W, W_UQ = W_IN + (size_t)2304 * 1024 * 2, W_UKV = W_UQ + (size_t)768 * 384 * 2, W_O0 = W_UKV + (size_t)1024 * 256 * 2, W_GU0 = W_O0 + (size_t)1024 * 1024 * 2,
                 W_DN0 = W_GU0 + (size_t)4096 * 1024 * 2, W_QKV = W_DN0 + (size_t)1024 * 2048 * 2, W_O1 = W_QKV + (size_t)3072 * 1024 * 2, W_EGU = W_O1 + (size_t)1024 * 1024 * 2,
                 W_EDN = W_EGU + (size_t)8192 * 1024 * 2, W_END = W_EDN + (size_t)8192 * 512 * 2;
static_assert(W_END <= 76 * MiB, "weights region");
constexpr size_t WS_XB = 76 * MiB, WS_OCAT = 76 * MiB, WS_SBQ = 140 * MiB, WS_SBK = 172 * MiB, WS_SBV = 204 * MiB, WS_CQ = 236 * MiB, WS_CKV = 260 * MiB, WS_KR = 276 * MiB,
                 WS_QA = 278 * MiB, WS_KN = 326 * MiB, WS_VA = 358 * MiB, WS_X1B = 390 * MiB, WS_HID = 76 * MiB;
constexpr size_t WS_Q2 = 204 * MiB, WS_K2 = 268 * MiB, WS_V2 = 332 * MiB, WS_PO0 = 76 * MiB, WS_PO1 = 140 * MiB, WS_PO2 = 396 * MiB, WS_PMS = 460 * MiB;
constexpr size_t WS_X3B = 268 * MiB, WS_XPERM = 332 * MiB, WS_YP = 332 * MiB, WS_HIDE = 76 * MiB;
constexpr size_t WS_MASK = 476 * MiB;
constexpr size_t WS_NEED = 489 * MiB;
static_assert(WS_SBK == WS_SBQ + 32 * MiB && WS_SBV == WS_SBQ + 64 * MiB && WS_VA == WS_KN + 32 * MiB && WS_K2 == WS_Q2 + 64 * MiB && WS_V2 == WS_Q2 + 128 * MiB, "epilogue pointer arithmetic");
static_assert(WS_XPERM + (size_t)NSLOT * 2048 <= 464 * MiB && WS_HIDE + (size_t)NSLOT * 1024 <= 204 * MiB && WS_SRS + 272 * 1024 <= 16 * MiB && NSLOT * 4 <= 272 * 1024, "ws map");
constexpr int CW_BAR = 4096, CW_QUEUE = 8192, CW_NRT = 8256;
static_assert((8320 + 64) * 4 <= (int)CTL_ZERO_BYTES && CW_BAR + 3456 <= CW_QUEUE, "control words inside the zeroed region");
constexpr int RING_BYTES = 131072, LDS_BYTES = 147456, MISC_OFF = LDS_BYTES - 256, PHASE_LDS = LDS_BYTES - 512;
static_assert(att::MLA_LDS <= PHASE_LDS && att::SB_LDS <= PHASE_LDS && att::MB_LDS <= PHASE_LDS && RING_BYTES <= PHASE_LDS, "phase LDS");

#define XB_TMO      128
#define XB_XCNT(j)  (256  + 64 * (j))
#define XB_XSUB(j)  (1280 + 64 * (j))
#define XB_XGEN(j)  (2304 + 64 * (j))
#define XB_TOP      3328
#define XB_TOPGEN   3392
#define XCD_BAR_WORDS 3456
#define XB_SPIN_CAP (1u << 18)
__device__ __forceinline__ unsigned xb_ld(unsigned* p)              { return __hip_atomic_load(p, __ATOMIC_RELAXED, __HIP_MEMORY_SCOPE_AGENT); }
__device__ __forceinline__ unsigned xb_add(unsigned* p, unsigned v) { return __hip_atomic_fetch_add(p, v, __ATOMIC_RELAXED, __HIP_MEMORY_SCOPE_AGENT); }
__device__ __forceinline__ unsigned xb_xcc_id() { return (unsigned)__builtin_amdgcn_s_getreg((3 << 11) | 20) & 0xFu; }
#define XB_SPIN(cond, bar) do { unsigned _sp = 0; while (cond) { __builtin_amdgcn_s_sleep(1); \
    if ((++_sp & 255u) == 0u) { if (xb_ld(&(bar)[XB_TMO])) break; if (_sp > XB_SPIN_CAP) { atomicAdd(&(bar)[XB_TMO], 1u); break; } } } } while (0)
struct XcdBarrier { unsigned* bar; unsigned x; volatile LAS unsigned* st; };
__device__ __forceinline__ XcdBarrier xcd_barrier_post(unsigned* bar, volatile LAS unsigned* st) {
    XcdBarrier b; b.bar = bar; b.x = xb_xcc_id(); b.st = st;
    if (threadIdx.x == 0) (void)xb_add(&bar[XB_XCNT(b.x)], 1u);
    return b;
}
__device__ __forceinline__ void xcd_barrier_complete(unsigned* bar, unsigned x, unsigned& nloc, unsigned& nx) {
    const unsigned G = gridDim.x * gridDim.y * gridDim.z;
    unsigned sum, cnt, mine, sp = 0u;
    for (;;) {
        sum = 0u; cnt = 0u; mine = 0u;
#pragma unroll
        for (unsigned j = 0; j < 16; ++j) { const unsigned c = xb_ld(&bar[XB_XCNT(j)]); sum += c; cnt += (c > 0u) ? 1u : 0u; mine = (j == x) ? c : mine; }
        if (sum == G) break;
        __builtin_amdgcn_s_sleep(1);
        if ((++sp & 255u) == 0u) { if (xb_ld(&bar[XB_TMO])) break; if (sp > XB_SPIN_CAP) { atomicAdd(&bar[XB_TMO], 1u); break; } }
    }
    nloc = mine > 0u ? mine : 1u; nx = cnt > 0u ? cnt : 1u;
}
__device__ __forceinline__ void xcd_barrier(const XcdBarrier& b) {
    asm volatile("s_waitcnt vmcnt(0)" ::: "memory");
    __syncthreads();
    if (threadIdx.x == 0) {
        unsigned* bar = b.bar;
        __builtin_amdgcn_s_waitcnt(0);
        unsigned nloc = b.st[0], nx = b.st[1];
        if (nloc == 0u) { xcd_barrier_complete(bar, b.x, nloc, nx); b.st[0] = nloc; b.st[1] = nx; }
        const unsigned old = xb_add(&bar[XB_XSUB(b.x)], 1u);
        const unsigned gen = old / nloc;
        if (old + 1u == (gen + 1u) * nloc) {
            __builtin_amdgcn_fence(__ATOMIC_RELEASE, "agent");
            asm volatile("s_waitcnt vmcnt(0)" ::: "memory");
            const unsigned og = xb_add(&bar[XB_TOP], 1u);
            const unsigned tg = og / nx;
            if (og + 1u == (tg + 1u) * nx) xb_add(&bar[XB_TOPGEN], 1u);
            else XB_SPIN(xb_ld(&bar[XB_TOPGEN]) == tg, bar);
            __builtin_amdgcn_fence(__ATOMIC_ACQUIRE, "agent");
            xb_add(&bar[XB_XGEN(b.x)], 1u);
            asm volatile("s_waitcnt vmcnt(0)" ::: "memory");
        } else {
            XB_SPIN(xb_ld(&bar[XB_XGEN(b.x)]) == gen, bar);
            __builtin_amdgcn_fence(__ATOMIC_ACQUIRE, "agent");
            asm volatile("s_waitcnt vmcnt(0)" ::: "memory");
        }
    }
    __syncthreads();
}

struct Args { const float* in[22]; float* out; unsigned char* ws; int ph_lo, ph_hi; };
enum { I_X = 0, I_EV_AN, I_EV_WIN, I_EV_QN, I_EV_WUQ, I_EV_KVN, I_EV_WUKV, I_EV_WO, I_EV_FN, I_EV_WG, I_EV_WU, I_EV_WD, I_OD_AN, I_OD_WQKV, I_OD_WO, I_OD_FN, I_OD_WR, I_OD_WG, I_OD_WU, I_OD_WD, I_RELB, I_FINN };
constexpr int NPH = 17;

constexpr float C_MLA = 0.10206207261596575f * LOG2E;
constexpr float C_64 = 0.125f * LOG2E;
DI int map_rope32(int p) { return 16 * ((p >> 2) & 1) + 4 * (p >> 3) + (p & 3); }
DI void cvt_item(const float* W, int ld, int col, float scale, const float* gain, int K, bf16* WT, int k0, LAS float* scr, int lane) {
    const int colc = col < 0 ? 0 : col; const float sc = col < 0 ? 0.f : scale;
    const float* wp = W + (size_t)(k0 + (lane >> 5)) * ld + colc;
    float v[32];
#pragma unroll
    for (int i = 0; i < 32; ++i) v[i] = __builtin_nontemporal_load(wp + (size_t)(2 * i) * ld);
    const int c = lane & 7;
    f32x4 g0 = (f32x4){1.f, 1.f, 1.f, 1.f}, g1 = g0;
    if (gain) { g0 = *(const f32x4*)(gain + k0 + 8 * c); g1 = *(const f32x4*)(gain + k0 + 8 * c + 4); }
#pragma unroll
    for (int i = 0; i < 32; ++i) scr[(2 * i + (lane >> 5)) * 33 + (lane & 31)] = v[i] * sc;
    asm volatile("s_waitcnt lgkmcnt(0)" ::: "memory");
#pragma unroll
    for (int j = 0; j < 4; ++j) { const int n = (lane >> 3) + 8 * j; const LAS float* s = scr + (8 * c) * 33 + n;
        v4u o; o.x = cvtpk(s[0 * 33] * g0[0], s[1 * 33] * g0[1]); o.y = cvtpk(s[2 * 33] * g0[2], s[3 * 33] * g0[3]); o.z = cvtpk(s[4 * 33] * g1[0], s[5 * 33] * g1[1]); o.w = cvtpk(s[6 * 33] * g1[2], s[7 * 33] * g1[3]);
        *(v4u*)(WT + (size_t)n * K + k0 + 8 * c) = o; }
    asm volatile("s_waitcnt lgkmcnt(0)" ::: "memory");
}
DI void p0_weights(const Args& a, LAS unsigned char* lds, int gw, int NGW, bool layer1) {
    int tid_ = threadIdx.x; asm volatile("" : "+v"(tid_)); const int tid = tid_, lane = tid & 63, wave = rfl(tid >> 6);
    LAS float* scr = (LAS float*)(lds + wave * 8704);
    unsigned char* ws = a.ws;
    constexpr int J0 = 72 * 16, J1 = J0 + 24 * 6, J2 = J1 + 32 * 4, J3 = J2 + 32 * 16, J4 = J3 + 128 * 16, J5 = J4 + 32 * 32, J6 = J5 + 96 * 16, J7 = J6 + 32 * 16, J8 = J7 + 256 * 16, J9 = J8 + 256 * 8;
    for (int it = (layer1 ? J5 : 0) + gw; it < (layer1 ? J9 : J5); it += NGW) {
        const int ln = lane & 31;
        if (it < J0) { const int nb = it / 16, kb = it % 16, n = nb * 32 + ln; int col; float sc = 1.f;
            if (n < 1536) { col = 672 + n; if (n < 512) sc = C_64; } else if (n < 1920) col = n - 1536; else if (n < 2176) col = 384 + (n - 1920); else if (n < 2208) col = 640 + map_rope32(n - 2176); else col = -1;
            cvt_item(a.in[I_EV_WIN], 2208, col, sc, a.in[I_EV_AN], 1024, (bf16*)(ws + W_IN) + (size_t)nb * 32 * 1024, kb * 64, scr, lane); }
        else if (it < J1) { const int r = it - J0, nb = r / 6, kb = r % 6, n = nb * 32 + ln; const int col = (nb % 3 == 2) ? nb * 32 + map_rope32(ln) : n;
            cvt_item(a.in[I_EV_WUQ], 768, col, C_MLA, a.in[I_EV_QN], 384, (bf16*)(ws + W_UQ) + (size_t)nb * 32 * 384, kb * 64, scr, lane); }
        else if (it < J2) { const int r = it - J1, nb = r / 4, kb = r % 4, n = nb * 32 + ln; const int col = n < 512 ? (n >> 6) * 128 + (n & 63) : ((n - 512) >> 6) * 128 + 64 + ((n - 512) & 63);
            cvt_item(a.in[I_EV_WUKV], 1024, col, 1.f, a.in[I_EV_KVN], 256, (bf16*)(ws + W_UKV) + (size_t)nb * 32 * 256, kb * 64, scr, lane); }
        else if (it < J3) { const int r = it - J2, nb = r / 16, kb = r % 16;
            cvt_item(a.in[I_EV_WO], 1024, nb * 32 + ln, 1.f, nullptr, 1024, (bf16*)(ws + W_O0) + (size_t)nb * 32 * 1024, kb * 64, scr, lane); }
        else if (it < J4) { const int r = it - J3, nb = r / 16, kb = r % 16, n = nb * 32 + ln; const int tile = n >> 8, half = (n >> 7) & 1, col = tile * 128 + (n & 127);
            cvt_item(half ? a.in[I_EV_WU] : a.in[I_EV_WG], 2048, col, 1.f, a.in[I_EV_FN], 1024, (bf16*)(ws + W_GU0) + (size_t)nb * 32 * 1024, kb * 64, scr, lane); }
        else if (it < J5) { const int r = it - J4, nb = r / 32, kb = r % 32;
            cvt_item(a.in[I_EV_WD], 1024, nb * 32 + ln, 1.f, nullptr, 2048, (bf16*)(ws + W_DN0) + (size_t)nb * 32 * 2048, kb * 64, scr, lane); }
        else if (it < J6) { const int r = it - J5, nb = r / 16, kb = r % 16, n = nb * 32 + ln;
            cvt_item(a.in[I_OD_WQKV], 3072, n, n < 1024 ? C_64 : 1.f, a.in[I_OD_AN], 1024, (bf16*)(ws + W_QKV) + (size_t)nb * 32 * 1024, kb * 64, scr, lane); }
        else if (it < J7) { const int r = it - J6, nb = r / 16, kb = r % 16;
            cvt_item(a.in[I_OD_WO], 1024, nb * 32 + ln, 1.f, nullptr, 1024, (bf16*)(ws + W_O1) + (size_t)nb * 32 * 1024, kb * 64, scr, lane); }
        else if (it < J8) { const int r = it - J7, nb = r / 16, kb = r % 16, n = nb * 32 + ln; const int e = n >> 10, m = n & 1023, tile = m >> 8, half = (m >> 7) & 1, col = tile * 128 + (m & 127);
            cvt_item((half ? a.in[I_OD_WU] : a.in[I_OD_WG]) + (size_t)e * 1024 * 512, 512, col, 1.f, a.in[I_OD_FN], 1024, (bf16*)(ws + W_EGU) + (size_t)nb * 32 * 1024, kb * 64, scr, lane); }
        else { const int r = it - J8, nb = r / 8, kb = r % 8, n = nb * 32 + ln; const int e = n >> 10, m = n & 1023;
            cvt_item(a.in[I_OD_WD] + (size_t)e * 512 * 1024, 1024, m, 1.f, nullptr, 512, (bf16*)(ws + W_EDN) + (size_t)nb * 32 * 512, kb * 64, scr, lane); }
    }
}
DI void p0_prologue(const Args& a, LAS unsigned char* lds, int vcu, int G) {
    int tid_ = threadIdx.x; asm volatile("" : "+v"(tid_)); const int tid = tid_, lane = tid & 63, wave = rfl(tid >> 6);
    const int gw = vcu * 8 + wave, NGW = G * 8;
    unsigned char* ws = a.ws;
    p0_weights(a, lds, gw, NGW, false);
    { const float* x = a.in[I_X]; bf16* XB = (bf16*)(ws + WS_XB); float* rs0 = (float*)(ws + WS_RSTD0);
      f32x4 nv[4];
      if (gw < T) { const f32x4* xr = (const f32x4*)(x + (size_t)gw * DM) + lane;
#pragma unroll
          for (int j = 0; j < 4; ++j) nv[j] = __builtin_nontemporal_load(xr + 64 * j); }
      for (int m = gw; m < T; m += NGW) { f32x4 v[4]; float s = 0.f;
#pragma unroll
          for (int j = 0; j < 4; ++j) v[j] = nv[j];
          if (m + NGW < T) { const f32x4* xr = (const f32x4*)(x + (size_t)(m + NGW) * DM) + lane;
#pragma unroll
              for (int j = 0; j < 4; ++j) nv[j] = __builtin_nontemporal_load(xr + 64 * j); }
#pragma unroll
          for (int j = 0; j < 4; ++j) s += (v[j].x * v[j].x + v[j].y * v[j].y) + (v[j].z * v[j].z + v[j].w * v[j].w);
          s = wave_sum(s); if (lane == 0) rs0[m] = rsqrtf(s * (1.f / DM) + RMS_EPS);
          unsigned long long* o8 = (unsigned long long*)(XB + (size_t)m * DM) + lane;
#pragma unroll
          for (int j = 0; j < 4; ++j) o8[64 * j] = (unsigned long long)cvtpk(v[j].x, v[j].y) | ((unsigned long long)cvtpk(v[j].z, v[j].w) << 32); } }
    { float2* rope = (float2*)(ws + WS_ROPE); const int gt = vcu * 512 + tid, NT_ = G * 512;
      for (int i = gt; i < SEQ * 16; i += NT_) { const int pos = i >> 4, f = i & 15;
          const double inv = (f & 8 ? 0.01 : 1.0) * (f & 4 ? 0.1 : 1.0) * (f & 2 ? 0.31622776601683794 : 1.0) * (f & 1 ? 0.5623413251903491 : 1.0);
          double rev = (double)pos * inv * 0.15915494309189535; rev -= __builtin_rint(rev);
          rope[i] = make_float2(__builtin_amdgcn_cosf((float)rev), __builtin_amdgcn_sinf((float)rev)); } }
    { float* wrt = (float*)(ws + WS_WRT); const int gt = vcu * 512 + tid, NT_ = G * 512;
      for (int i = gt; i < 8 * 1024; i += NT_) { const int e = i >> 10, k = i & 1023; wrt[i] = a.in[I_OD_FN][k] * a.in[I_OD_WR][k * 8 + e]; } }
}

using pg8::Unit;
typedef const f32x4 (&AccRef)[2][2][4][2];
DI v4u pack8(f32x4 a, f32x4 b) { v4u w; w.x = cvtpk(a[0], a[1]); w.y = cvtpk(a[2], a[3]); w.z = cvtpk(b[0], b[1]); w.w = cvtpk(b[2], b[3]); return w; }
DI float sumsq8(f32x4 a, f32x4 b) { return (a[0] * a[0] + a[1] * a[1]) + (a[2] * a[2] + a[3] * a[3]) + (b[0] * b[0] + b[1] * b[1]) + (b[2] * b[2] + b[3] * b[3]); }
DI float fq_sum(float s) { s += __shfl_xor(s, 16); s += __shfl_xor(s, 32); return s; }
DI float rstd_from(const float* P, int n4, float invn) { float s = 0.f;
#pragma unroll 4
    for (int i = 0; i < n4; ++i) { const f32x4 v = ((const f32x4*)P)[i]; s += (v[0] + v[1]) + (v[2] + v[3]); } return rsqrtf(s * invn + RMS_EPS); }
DI void rope_pair(f32x4& t1, f32x4& t2, const float2* rp  ) {
#pragma unroll
    for (int j = 0; j < 4; ++j) { const float2 cs = rp[j]; const float a = t1[j], b = t2[j]; t1[j] = a * cs.x - b * cs.y; t2[j] = b * cs.x + a * cs.y; }
}
DI unsigned long long pack4(f32x4 a) { return (unsigned long long)cvtpk(a[0], a[1]) | ((unsigned long long)cvtpk(a[2], a[3]) << 32); }

#define EPI_ROW(q) (u.pm * 256 + ((q) >> 2) * 128 + wr * 64 + ((q) & 3) * 16 + fr)
#define EPI_RSTD8(rs, NP4, P, stride, off, invn) do { f32x4 pv_[8]; const int fqc_ = fq < (NP4) ? fq : 0; \
        _Pragma("unroll") for (int q = 0; q < 8; ++q) pv_[q] = *(const f32x4*)((P) + (size_t)EPI_ROW(q) * (stride) + (off) + fqc_ * 4); \
        _Pragma("unroll") for (int q = 0; q < 8; ++q) { float s_ = (pv_[q][0] + pv_[q][1]) + (pv_[q][2] + pv_[q][3]); if (fq >= (NP4)) s_ = 0.f; s_ = fq_sum(s_); rs[q] = rsqrtf(s_ * (invn) + RMS_EPS); } } while (0)
struct EpiInProj {
    static constexpr bool PERM = true, AFTER_DRAIN = false;
    bf16 *SBQ, *CQ, *CKV, *KR; const float* rstd0; float* PQKV; const float2* rope;
    DI void operator()(AccRef acc, const Unit& u, int wr, int wc, int fr, int fq) const {
        { int ln_ = (int)__builtin_amdgcn_mbcnt_hi(~0u, __builtin_amdgcn_mbcnt_lo(~0u, 0u)); asm volatile("" : "+v"(ln_)); fr = ln_ & 15; fq = ln_ >> 4; }
        float rs[8];
#pragma unroll
        for (int q = 0; q < 8; ++q) rs[q] = rstd0[EPI_ROW(q)];
#pragma unroll
        for (int bj = 0; bj < 2; ++bj) {
            const int col0 = u.pn * 256 + bj * 128, cw = wc * 32 + fq * 8;
#pragma unroll
            for (int q = 0; q < 8; ++q) { const int ai = q >> 2, m = q & 3; const int r = EPI_ROW(q);
                f32x4 v0 = acc[ai][bj][m][0] * rs[q], v1 = acc[ai][bj][m][1] * rs[q];
                if (col0 < 1536) { bf16* dst = SBQ + (size_t)(col0 >> 9) * (size_t)(16u << 20) + (size_t)r * 512 + (col0 & 511) + cw; *(v4u*)dst = pack8(v0, v1); }
                else if (col0 < 1920) { *(v4u*)(CQ + (size_t)r * 384 + (col0 - 1536) + cw) = pack8(v0, v1); const float s = fq_sum(sumsq8(v0, v1)); if (fq == 0) PQKV[(size_t)r * 32 + (col0 - 1536) / 32 + wc] = s; }
                else if (col0 < 2176) { *(v4u*)(CKV + (size_t)r * 256 + (col0 - 1920) + cw) = pack8(v0, v1); const float s = fq_sum(sumsq8(v0, v1)); if (fq == 0) PQKV[(size_t)r * 32 + 16 + (col0 - 1920) / 32 + wc] = s; }
                else if (wc == 0) {
                    const f32x4* rp = (const f32x4*)(rope + (size_t)(r & (SEQ - 1)) * 16 + 4 * fq); const f32x4 ca = rp[0], cb = rp[1];
                    const float c[4] = {ca[0], ca[2], cb[0], cb[2]}, sn[4] = {ca[1], ca[3], cb[1], cb[3]};
#pragma unroll
                    for (int j = 0; j < 4; ++j) { const float a = v0[j], b = v1[j]; v0[j] = a * c[j] - b * sn[j]; v1[j] = b * c[j] + a * sn[j]; }
                    *(unsigned long long*)(KR + (size_t)r * 32 + 4 * fq) = pack4(v0); *(unsigned long long*)(KR + (size_t)r * 32 + 16 + 4 * fq) = pack4(v1); }
            }
        }
    }
};
struct EpiQUp {
    static constexpr bool PERM = true, AFTER_DRAIN = false;
    bf16* QA; const float* PQKV; const float2* rope;
    DI void operator()(AccRef acc, const Unit& u, int wr, int wc, int fr, int fq) const {
        { int ln_ = (int)__builtin_amdgcn_mbcnt_hi(~0u, __builtin_amdgcn_mbcnt_lo(~0u, 0u)); asm volatile("" : "+v"(ln_)); fr = ln_ & 15; fq = ln_ >> 4; }
        float rs[8]; EPI_RSTD8(rs, 3, PQKV, 32, 0, 1.f / 384.f);
        const bool rope0 = (u.pn * 8 + wc) % 3 == 2, rope1 = (u.pn * 8 + 4 + wc) % 3 == 2;
#pragma unroll
        for (int hb = 0; hb < 2; ++hb) {
            f32x4 cs[4][2];
            if (rope0 || rope1) {
#pragma unroll
                for (int qq = 0; qq < 4; ++qq) { const f32x4* rp = (const f32x4*)(rope + (size_t)(EPI_ROW(hb * 4 + qq) & (SEQ - 1)) * 16 + 4 * fq); cs[qq][0] = rp[0]; cs[qq][1] = rp[1]; } }
#pragma unroll
            for (int qq = 0; qq < 4; ++qq) { const int q = hb * 4 + qq, ai = q >> 2, m = q & 3; const int r = EPI_ROW(q);
#pragma unroll
                for (int bj = 0; bj < 2; ++bj) { const int gi = u.pn * 8 + bj * 4 + wc; const bool isr = bj ? rope1 : rope0;
                    f32x4 v0 = acc[ai][bj][m][0] * rs[q], v1 = acc[ai][bj][m][1] * rs[q];
                    if (!isr) *(v4u*)(QA + (size_t)r * 768 + gi * 32 + fq * 8) = pack8(v0, v1);
                    else { const float c[4] = {cs[qq][0][0], cs[qq][0][2], cs[qq][1][0], cs[qq][1][2]}, sn[4] = {cs[qq][0][1], cs[qq][0][3], cs[qq][1][1], cs[qq][1][3]};
#pragma unroll
                        for (int j = 0; j < 4; ++j) { const float a = v0[j], b = v1[j]; v0[j] = a * c[j] - b * sn[j]; v1[j] = b * c[j] + a * sn[j]; }
                        *(unsigned long long*)(QA + (size_t)r * 768 + gi * 32 + 4 * fq) = pack4(v0); *(unsigned long long*)(QA + (size_t)r * 768 + gi * 32 + 16 + 4 * fq) = pack4(v1); } }
            }
        }
    }
};
struct EpiKvUp {
    static constexpr bool PERM = true, AFTER_DRAIN = false;
    bf16* KN; const float* PQKV;
    DI void operator()(AccRef acc, const Unit& u, int wr, int wc, int fr, int fq) const {
        { int ln_ = (int)__builtin_amdgcn_mbcnt_hi(~0u, __builtin_amdgcn_mbcnt_lo(~0u, 0u)); asm volatile("" : "+v"(ln_)); fr = ln_ & 15; fq = ln_ >> 4; }
        float rs[8]; EPI_RSTD8(rs, 2, PQKV, 32, 16, 1.f / 256.f);
#pragma unroll
        for (int q = 0; q < 8; ++q) { const int ai = q >> 2, m = q & 3; const int r = EPI_ROW(q);
#pragma unroll
            for (int bj = 0; bj < 2; ++bj) { const int c = u.pn * 256 + bj * 128 + wc * 32 + fq * 8;
                bf16* dst = KN + (size_t)(c >> 9) * (size_t)(16u << 20) + (size_t)r * 512 + (c & 511);
                *(v4u*)dst = pack8(acc[ai][bj][m][0] * rs[q], acc[ai][bj][m][1] * rs[q]); }
        }
    }
};
template <bool RES_F32> struct EpiRes {
    static constexpr bool PERM = true, AFTER_DRAIN = false;
    const void* res; bf16* Y; float* PS;
    DI void operator()(AccRef acc, const Unit& u, int wr, int wc, int fr, int fq) const {
        { int ln_ = (int)__builtin_amdgcn_mbcnt_hi(~0u, __builtin_amdgcn_mbcnt_lo(~0u, 0u)); asm volatile("" : "+v"(ln_)); fr = ln_ & 15; fq = ln_ >> 4; }
        const size_t cb = (size_t)u.pn * 256 + wc * 32 + fq * 8;
#pragma unroll
        for (int hb = 0; hb < 2; ++hb) {
            f32x4 x0[4][2], x1[4][2];
#pragma unroll
            for (int qq = 0; qq < 4; ++qq)
#pragma unroll
                for (int bj = 0; bj < 2; ++bj) { const size_t o = (size_t)EPI_ROW(hb * 4 + qq) * 1024 + cb + bj * 128;
                    if (RES_F32) { x0[qq][bj] = *(const f32x4*)((const float*)res + o); x1[qq][bj] = *(const f32x4*)((const float*)res + o + 4); }
                    else { const v4u w = *(const v4u*)((const bf16*)res + o); x0[qq][bj] = (f32x4){bflo(w.x), bfhi(w.x), bflo(w.y), bfhi(w.y)}; x1[qq][bj] = (f32x4){bflo(w.z), bfhi(w.z), bflo(w.w), bfhi(w.w)}; } }
#pragma unroll
            for (int qq = 0; qq < 4; ++qq) { const int q = hb * 4 + qq, ai = q >> 2, m = q & 3; const int r = EPI_ROW(q); float ss = 0.f;
#pragma unroll
                for (int bj = 0; bj < 2; ++bj) { const f32x4 v0 = acc[ai][bj][m][0] + x0[qq][bj], v1 = acc[ai][bj][m][1] + x1[qq][bj]; ss += sumsq8(v0, v1); *(v4u*)(Y + (size_t)r * 1024 + cb + bj * 128) = pack8(v0, v1); }
                ss = fq_sum(ss); if (fq == 0) PS[(size_t)r * 16 + u.pn * 4 + wc] = ss; }
        }
    }
};
DI f32x4 silu_mul(f32x4 g, f32x4 u) { f32x4 o;
#pragma unroll
    for (int j = 0; j < 4; ++j) o[j] = g[j] * u[j] * __builtin_amdgcn_rcpf(1.f + ex2(-g[j] * LOG2E)); return o; }
struct EpiSwiGLU {
    static constexpr bool PERM = true, AFTER_DRAIN = false;
    bf16* H; int ldh, ntile; const float* PS; const float* srs;
    DI void operator()(AccRef acc, const Unit& u, int wr, int wc, int fr, int fq) const {
        { int ln_ = (int)__builtin_amdgcn_mbcnt_hi(~0u, __builtin_amdgcn_mbcnt_lo(~0u, 0u)); asm volatile("" : "+v"(ln_)); fr = ln_ & 15; fq = ln_ >> 4; }
        float rs[8];
        if (PS) EPI_RSTD8(rs, 4, PS, 16, 0, 1.f / 1024.f);
        else {
#pragma unroll
            for (int q = 0; q < 8; ++q) rs[q] = srs[EPI_ROW(q)]; }
#pragma unroll
        for (int q = 0; q < 8; ++q) { const int ai = q >> 2, m = q & 3; const int r = EPI_ROW(q);
            const f32x4 h0 = silu_mul(acc[ai][0][m][0] * rs[q], acc[ai][1][m][0] * rs[q]), h1 = silu_mul(acc[ai][0][m][1] * rs[q], acc[ai][1][m][1] * rs[q]);
            *(v4u*)(H + (size_t)r * ldh + (u.pn % ntile) * 128 + wc * 32 + fq * 8) = pack8(h0, h1); }
    }
};
struct EpiQkv {
    static constexpr bool PERM = true, AFTER_DRAIN = false;
    bf16* Q2; const float* PS; float* KMP;
    DI void operator()(AccRef acc, const Unit& u, int wr, int wc, int fr, int fq) const {
        { int ln_ = (int)__builtin_amdgcn_mbcnt_hi(~0u, __builtin_amdgcn_mbcnt_lo(~0u, 0u)); asm volatile("" : "+v"(ln_)); fr = ln_ & 15; fq = ln_ >> 4; }
        float rs[8]; EPI_RSTD8(rs, 4, PS, 16, 0, 1.f / 1024.f);
        const int sec = u.pn >> 2; bf16* dstb = Q2 + (size_t)sec * (size_t)(32u << 20);
        f32x4 cs[2][2];
#pragma unroll
        for (int bj = 0; bj < 2; ++bj) { cs[bj][0] = (f32x4){0.f, 0.f, 0.f, 0.f}; cs[bj][1] = cs[bj][0]; }
#pragma unroll
        for (int q = 0; q < 8; ++q) { const int ai = q >> 2, m = q & 3; const int r = EPI_ROW(q);
#pragma unroll
            for (int bj = 0; bj < 2; ++bj) { const f32x4 v0 = acc[ai][bj][m][0] * rs[q], v1 = acc[ai][bj][m][1] * rs[q]; cs[bj][0] += v0; cs[bj][1] += v1;
                *(v4u*)(dstb + (size_t)r * 1024 + (u.pn & 3) * 256 + bj * 128 + wc * 32 + fq * 8) = pack8(v0, v1); }
        }
        if (sec == 1) {
#pragma unroll
            for (int bj = 0; bj < 2; ++bj)
#pragma unroll
                for (int n = 0; n < 2; ++n) { f32x4 s = cs[bj][n];
#pragma unroll
                    for (int j = 0; j < 4; ++j) { float t = s[j]; t += __shfl_xor(t, 1); t += __shfl_xor(t, 2); t += __shfl_xor(t, 4); t += __shfl_xor(t, 8); s[j] = t; }
                    if (fr == 0) *(f32x4*)(KMP + ((size_t)wr * (T / 256) + u.pm) * 1024 + (u.pn & 3) * 256 + bj * 128 + wc * 32 + fq * 8 + n * 4) = s; }
        }
    }
};
struct EpiMoeDown {
    static constexpr bool PERM = true, AFTER_DRAIN = false;
    bf16* YP; const int* sdst; const float* sw;
    DI void operator()(AccRef acc, const Unit& u, int wr, int wc, int fr, int fq) const {
        { int ln_ = (int)__builtin_amdgcn_mbcnt_hi(~0u, __builtin_amdgcn_mbcnt_lo(~0u, 0u)); asm volatile("" : "+v"(ln_)); fr = ln_ & 15; fq = ln_ >> 4; }
        int d[8]; float w[8];
#pragma unroll
        for (int q = 0; q < 8; ++q) { d[q] = sdst[EPI_ROW(q)]; w[q] = sw[EPI_ROW(q)]; }
#pragma unroll
        for (int q = 0; q < 8; ++q) { const int ai = q >> 2, m = q & 3;
            if (d[q] >= 0) {
#pragma unroll
                for (int bj = 0; bj < 2; ++bj) __builtin_nontemporal_store(pack8(acc[ai][bj][m][0] * w[q], acc[ai][bj][m][1] * w[q]), (v4u*)(YP + (size_t)d[q] * 1024 + (u.pn & 3) * 256 + bj * 128 + wc * 32 + fq * 8)); }
        }
    }
};
struct MoeOrder {
    const int* tile_e; int nrt, G, c;
    DI bool next(int i, Unit& u) const { const long L = (long)i * G + c; if (L >= (long)nrt * 4) return false; const int rt = (int)(L >> 2); u.pm = rt; u.pn = tile_e[rt] * 4 + (int)(L & 3); return true; }
    DI void a_ready(const Unit&) const {}
    DI void done(const Unit&) const {}
};

#ifndef DBG_CHECK
#define DBG_CHECK 0
#endif
constexpr int CW_ERR = 8320;
#if DBG_CHECK
DI float bf2f(bf16 v) { return __uint_as_float((unsigned)v << 16); }
DI void dbg_flag(unsigned* ctl, unsigned bit) { atomicOr(ctl + CW_ERR, bit); }
DI float blk_max(float v, LAS float* red, int tid) { red[tid] = v; __syncthreads(); for (int o = 256; o > 0; o >>= 1) { if (tid < o) red[tid] = fmaxf(red[tid], red[tid + o]); __syncthreads(); } const float r = red[0]; __syncthreads(); return r; }
DI float blk_sum(float v, LAS float* red, int tid) { red[tid] = v; __syncthreads(); for (int o = 256; o > 0; o >>= 1) { if (tid < o) red[tid] = red[tid] + red[tid + o]; __syncthreads(); } const float r = red[0]; __syncthreads(); return r; }
DI unsigned dbg_hash(unsigned i) { i ^= i >> 16; i *= 0x7feb352du; i ^= i >> 15; i *= 0x846ca68bu; i ^= i >> 16; return i; }
DI int dbg_pos(int i) { switch (i) { case 0: return 0; case 1: return 1; case 2: return 31; case 3: return 32; case 4: return 63; case 5: return 64; case 6: return 65; case 7: return 255; case 8: return 256; case 9: return 257;
    case 10: return 511; case 11: return 512; case 12: return 4095; case 13: return 4096; case 14: return 8191; case 15: return 16383; default: return (int)(dbg_hash((unsigned)i) % SEQ); } }
template <int MODE> DI void naive_attn(const Args& a, int b, int h, int s, LAS unsigned char* lds, unsigned sel) {
    const int tid = threadIdx.x; unsigned char* ws = a.ws;
    LAS float* lg = (LAS float*)lds; LAS float* red = (LAS float*)(lds + 65536); LAS float* qv = (LAS float*)(lds + 67584); LAS float* opart = (LAS float*)(lds + 68096); LAS float* oref = (LAS float*)(lds + 70144);
    const size_t r = (size_t)b * SEQ + s;
    const int DQ = MODE == 0 ? 96 : 64; float mblk = 0.f;
    if (tid < DQ) { float q;
        if (MODE == 0) q = bf2f(((const bf16*)(ws + WS_QA))[r * 768 + h * 96 + tid]); else if (MODE == 1) q = bf2f(((const bf16*)(ws + WS_SBQ))[r * 512 + h * 64 + tid]); else q = bf2f(((const bf16*)(ws + WS_Q2))[r * 1024 + h * 64 + tid]);
        qv[tid] = q; }
    __syncthreads();
    const int nk = MODE == 1 ? s : s + 1;
    float lmax = -INFINITY;
    for (int k = tid; k < nk; k += 512) { const size_t kr = (size_t)b * SEQ + k; float acc = 0.f;
        if (MODE == 0) { const bf16* kn = (const bf16*)(ws + WS_KN) + kr * 512 + h * 64; const bf16* kp = (const bf16*)(ws + WS_KR) + kr * 32;
            for (int d = 0; d < 64; ++d) acc += qv[d] * bf2f(kn[d]); for (int d = 0; d < 32; ++d) acc += qv[64 + d] * bf2f(kp[d]); }
        else if (MODE == 1) { const bf16* kk = (const bf16*)(ws + WS_SBK) + kr * 512 + h * 64; for (int d = 0; d < 64; ++d) acc += qv[d] * bf2f(kk[d]); }
        else { const int kb = k >> 8, qb = s >> 8; (void)qb; const bool ok = (MODE == 2 && kb == qb) || kb == (int)(sel & 0xFFu) || kb == (int)((sel >> 8) & 0xFFu) || kb == (int)((sel >> 16) & 0xFFu);
            if (ok) { const bf16* kk = (const bf16*)(ws + WS_K2) + kr * 1024 + h * 64; for (int d = 0; d < 64; ++d) acc += qv[d] * bf2f(kk[d]);
                const int dist = s - k; int bucket = dist; if (dist >= 16) { bucket = 16 + (int)(logf((float)dist / 16.f) / 2.0794415416798357f * 16.f); if (bucket > 31) bucket = 31; }
                acc += a.in[I_RELB][h * 32 + bucket] * LOG2E; } else acc = -INFINITY; }
        lg[k] = acc; lmax = fmaxf(lmax, acc); }
    __syncthreads();
    float tot = 1.f;
    if (MODE == 1) { if (tid == 0) { float run = 0.f; for (int k = nk - 1; k >= 0; --k) { const float y = lg[k]; const float sp = fmaxf(y, 0.f) + log2f(1.f + exp2f(-fabsf(y))); lg[k] = exp2f(y - sp + run); run -= sp; } } __syncthreads(); }
    else { const float m = blk_max(lmax, red, tid); mblk = m; float ls = 0.f; for (int k = tid; k < nk; k += 512) { const float p = exp2f(lg[k] - m); lg[k] = p; ls += p; } __syncthreads(); tot = blk_sum(ls, red, tid); }
    { const int g = tid >> 6, d = tid & 63; float acc = 0.f;
      for (int k = g; k < nk; k += 8) { const size_t kr = (size_t)b * SEQ + k; float v;
          if (MODE == 0) v = bf2f(((const bf16*)(ws + WS_VA))[kr * 512 + h * 64 + d]); else if (MODE == 1) v = bf2f(((const bf16*)(ws + WS_SBV))[kr * 512 + h * 64 + d]); else v = bf2f(((const bf16*)(ws + WS_V2))[kr * 1024 + h * 64 + d]);
          const float p = lg[k]; if (p != 0.f) acc += p * v; }
      opart[g * 64 + d] = acc; }
    __syncthreads();
    if (tid < 64) { float acc = 0.f; for (int g = 0; g < 8; ++g) acc += opart[g * 64 + tid]; oref[tid] = acc / tot; }
    if (tid == 0) oref[64] = mblk + log2f(tot);
    __syncthreads();
}
DI void dbg_cmp64(const bf16* got, LAS unsigned char* lds, unsigned* ctl, unsigned bit) {
    const int tid = threadIdx.x; LAS float* red = (LAS float*)(lds + 65536); LAS float* oref = (LAS float*)(lds + 70144);
    const float v = tid < 64 ? fabsf(oref[tid]) : 0.f; const float mx = blk_max(v, red, tid);
    if (tid < 64) { const float g = bf2f(got[tid]); if (!(fabsf(g - oref[tid]) <= 0.02f * mx + 2e-3f)) dbg_flag(ctl, bit); }
    __syncthreads();
}
DI void dbg_check_a(const Args& a, LAS unsigned char* lds, unsigned* ctl, int bx, int G) {
    const int tid = threadIdx.x; unsigned char* ws = a.ws;
    LAS float* red = (LAS float*)(lds + 65536); LAS float* hrow = (LAS float*)lds;
    LAS float* cq = (LAS float*)(lds + 4096); LAS float* ckv = (LAS float*)(lds + 8192);
    const float2* rope = (const float2*)(ws + WS_ROPE);
    for (int i = bx; i < 256; i += G) {
        const int b = i & 1, s = dbg_pos(i >> 1); const size_t r = (size_t)b * SEQ + s;
        float ss = 0.f; for (int k = tid; k < 1024; k += 512) { const float x = a.in[I_X][r * 1024 + k]; ss += x * x; }
        const float rs = rsqrtf(blk_sum(ss, red, tid) / 1024.f + RMS_EPS);
        for (int k = tid; k < 1024; k += 512) hrow[k] = a.in[I_X][r * 1024 + k] * rs * a.in[I_EV_AN][k];
        __syncthreads();
        for (int j = tid; j < 2208; j += 512) { float acc = 0.f; for (int k = 0; k < 1024; ++k) acc += hrow[k] * a.in[I_EV_WIN][(size_t)k * 2208 + j];
            float got, ref = acc; bool cmp = true;
            if (j < 384) got = bf2f(((const bf16*)(ws + WS_CQ))[r * 384 + j]);
            else if (j < 640) got = bf2f(((const bf16*)(ws + WS_CKV))[r * 256 + (j - 384)]);
            else if (j < 672) { cmp = false; got = 0.f; }
            else if (j < 1184) { got = bf2f(((const bf16*)(ws + WS_SBQ))[r * 512 + (j - 672)]); ref = acc * C_64; }
            else if (j < 1696) got = bf2f(((const bf16*)(ws + WS_SBK))[r * 512 + (j - 1184)]);
            else got = bf2f(((const bf16*)(ws + WS_SBV))[r * 512 + (j - 1696)]);
            if (cmp && !(fabsf(got - ref) <= 0.03f * fabsf(ref) + 0.03f)) dbg_flag(ctl, 1u); }
        if (tid < 16) { float t1 = 0.f, t2 = 0.f; for (int k = 0; k < 1024; ++k) { t1 += hrow[k] * a.in[I_EV_WIN][(size_t)k * 2208 + 640 + tid]; t2 += hrow[k] * a.in[I_EV_WIN][(size_t)k * 2208 + 656 + tid]; }
            const float ang = (float)s * powf(10000.f, -(float)tid / 16.f); const float c = cosf(ang), sn = sinf(ang);
            const float o1 = t1 * c - t2 * sn, o2 = t2 * c + t1 * sn; const float g1 = bf2f(((const bf16*)(ws + WS_KR))[r * 32 + tid]), g2 = bf2f(((const bf16*)(ws + WS_KR))[r * 32 + 16 + tid]);
            if (!(fabsf(g1 - o1) <= 0.03f * fabsf(o1) + 0.03f) || !(fabsf(g2 - o2) <= 0.03f * fabsf(o2) + 0.03f)) dbg_flag(ctl, 1u);
            const float2 tb = rope[(size_t)s * 16 + tid]; if (!(fabsf(tb.x - c) < 2e-3f && fabsf(tb.y - sn) < 2e-3f)) dbg_flag(ctl, 1u); }
        __syncthreads();
        float s1 = 0.f, s2 = 0.f;
        if (tid < 384) { const float v = bf2f(((const bf16*)(ws + WS_CQ))[r * 384 + tid]); s1 = v * v; cq[tid] = v; }
        if (tid < 256) { const float v = bf2f(((const bf16*)(ws + WS_CKV))[r * 256 + tid]); s2 = v * v; ckv[tid] = v; }
        const float rq = rsqrtf(blk_sum(s1, red, tid) / 384.f + RMS_EPS), rk = rsqrtf(blk_sum(s2, red, tid) / 256.f + RMS_EPS);
        if (tid < 384) cq[tid] *= rq * a.in[I_EV_QN][tid];
        if (tid < 256) ckv[tid] *= rk * a.in[I_EV_KVN][tid];
        __syncthreads();
        for (int j = tid; j < 768; j += 512) { const int hh = j / 96, dd = j % 96; float acc = 0.f; for (int k = 0; k < 384; ++k) acc += cq[k] * a.in[I_EV_WUQ][(size_t)k * 768 + j];
            float ref = acc;
            if (dd >= 64) { const int ri = dd - 64, pi = ri < 16 ? ri : ri - 16; const int jp = hh * 96 + 64 + (ri < 16 ? ri + 16 : ri - 16); float accp = 0.f; for (int k = 0; k < 384; ++k) accp += cq[k] * a.in[I_EV_WUQ][(size_t)k * 768 + jp];
                const float ang = (float)s * powf(10000.f, -(float)pi / 16.f); const float c = cosf(ang), sn = sinf(ang); ref = ri < 16 ? acc * c - accp * sn : acc * c + accp * sn; }
            ref *= C_MLA; const float got = bf2f(((const bf16*)(ws + WS_QA))[r * 768 + j]);
            if (!(fabsf(got - ref) <= 0.03f * fabsf(ref) + 0.02f)) dbg_flag(ctl, 1u); }
        for (int j = tid; j < 1024; j += 512) { const int hh = j >> 7, dd = j & 127; float acc = 0.f; for (int k = 0; k < 256; ++k) acc += ckv[k] * a.in[I_EV_WUKV][(size_t)k * 1024 + j];
            const float got = dd < 64 ? bf2f(((const bf16*)(ws + WS_KN))[r * 512 + hh * 64 + dd]) : bf2f(((const bf16*)(ws + WS_VA))[r * 512 + hh * 64 + dd - 64]);
            if (!(fabsf(got - acc) <= 0.03f * fabsf(acc) + 0.03f)) dbg_flag(ctl, 1u); }
        __syncthreads();
        const int h = (int)(dbg_hash((unsigned)i * 7u + 1u) & 7u);
        naive_attn<0>(a, b, h, s, lds, 0u); dbg_cmp64((const bf16*)(ws + WS_OCAT) + r * 1024 + h * 64, lds, ctl, 2u);
        naive_attn<1>(a, b, h, s, lds, 0u); dbg_cmp64((const bf16*)(ws + WS_OCAT) + r * 1024 + 512 + h * 64, lds, ctl, 4u);
    }
}
DI void dbg_check_b(const Args& a, LAS unsigned char* lds, unsigned* ctl, int bx, int G, const bf16* O2) {
    const int tid = threadIdx.x; unsigned char* ws = a.ws;
    LAS float* red = (LAS float*)(lds + 65536); LAS float* hrow = (LAS float*)lds; LAS float* gate = (LAS float*)(lds + 8192);
    const bf16* X2 = (const bf16*)a.out;
    for (int i = bx; i < 256; i += G) {
        const int b = i & 1, s = dbg_pos(i >> 1), h = (int)(dbg_hash((unsigned)i * 11u + 5u) & 15u); const size_t r = (size_t)b * SEQ + s;
        float ss = 0.f; for (int k = tid; k < 1024; k += 512) { const float x = bf2f(X2[r * 1024 + k]); ss += x * x; }
        const float rs = rsqrtf(blk_sum(ss, red, tid) / 1024.f + RMS_EPS);
        for (int k = tid; k < 1024; k += 512) hrow[k] = bf2f(X2[r * 1024 + k]) * rs * a.in[I_OD_AN][k];
        __syncthreads();
        for (int j = tid; j < 3072; j += 512) { float acc = 0.f; for (int k = 0; k < 1024; ++k) acc += hrow[k] * a.in[I_OD_WQKV][(size_t)k * 3072 + j];
            float ref = acc; float got;
            if (j < 1024) { ref = acc * C_64; got = bf2f(((const bf16*)(ws + WS_Q2))[r * 1024 + j]); } else if (j < 2048) got = bf2f(((const bf16*)(ws + WS_K2))[r * 1024 + j - 1024]); else got = bf2f(((const bf16*)(ws + WS_V2))[r * 1024 + j - 2048]);
            if (!(fabsf(got - ref) <= 0.03f * fabsf(ref) + 0.03f)) dbg_flag(ctl, 8u); }
        __syncthreads();
        const int qb = s >> 8; const unsigned sel = ((const unsigned*)(ws + WS_SEL))[((size_t)(b * 16 + h)) * SEQ + s];
        if (tid < 64) gate[tid] = -INFINITY;
        __syncthreads();
        { const int n = tid >> 3, part = tid & 7;
          float acc = 0.f; if (n < qb) { for (int kk = part * 32; kk < part * 32 + 32; ++kk) { const size_t kr = (size_t)b * SEQ + n * 256 + kk; for (int d = 0; d < 64; ++d) acc += bf2f(((const bf16*)(ws + WS_Q2))[r * 1024 + h * 64 + d]) * bf2f(((const bf16*)(ws + WS_K2))[kr * 1024 + h * 64 + d]); } }
          acc += __shfl_xor(acc, 1); acc += __shfl_xor(acc, 2); acc += __shfl_xor(acc, 4); if (part == 0 && n < qb) gate[n] = acc / 256.f; }
        __syncthreads();
        if (tid == 0) { const int nsel_exp = qb < 3 ? qb : 3; int nsel = 0; float gmin = INFINITY; bool bad = false;
            for (int k = 0; k < 3; ++k) { const unsigned e = (sel >> (8 * k)) & 0xFFu; if (e != 0xFFu) { if ((int)e >= qb) bad = true; else { ++nsel; gmin = fminf(gmin, gate[e]); } } }
            if (nsel != nsel_exp) bad = true;
            if ((sel & 0xFFu) != 0xFFu && ((sel & 0xFFu) == ((sel >> 8) & 0xFFu) || (sel & 0xFFu) == ((sel >> 16) & 0xFFu))) bad = true;
            if (((sel >> 8) & 0xFFu) != 0xFFu && ((sel >> 8) & 0xFFu) == ((sel >> 16) & 0xFFu)) bad = true;
            if (!bad && nsel > 0) { float gsc = 0.f; for (int n = 0; n < qb; ++n) gsc = fmaxf(gsc, fabsf(gate[n]));
                for (int n = 0; n < qb; ++n) { const bool chosen = n == (int)(sel & 0xFFu) || n == (int)((sel >> 8) & 0xFFu) || n == (int)((sel >> 16) & 0xFFu); if (!chosen && gate[n] > gmin + 0.02f * gsc + 1e-3f) bad = true; } }
            if (bad) dbg_flag(ctl, 8u); }
        __syncthreads();
        { LAS float* oref = (LAS float*)(lds + 70144); float* dref = (float*)(ws + WS_WRT + 256 * 1024) + (size_t)i * 64;
          naive_attn<2>(a, b, h, s, lds, 0xFFFFFFu);
          { const float v = tid < 64 ? fabsf(oref[tid]) : 0.f; const float mx = blk_max(v, red, tid);
            const float2 ms = ((const float2*)(ws + WS_PMS))[((size_t)(3 * 32 + b * 16 + h)) * SEQ + s]; const bf16* pob = (const bf16*)a.out + (size_t)32 * 1024 * 1024 + (((size_t)(b * 16 + h)) * SEQ + s) * 64;
            if (tid == 0) { if (!(fabsf(ms.x + log2f(ms.y) - oref[64]) <= 0.05f)) dbg_flag(ctl, 8u); }
            if (tid < 64) { const float g = bf2f(pob[tid]) / ms.y; if (!(fabsf(g - oref[tid]) <= 0.02f * mx + 2e-3f)) dbg_flag(ctl, 8u); }
            __syncthreads(); }
          naive_attn<2>(a, b, h, s, lds, sel);
          if (tid < 64) dref[tid] = oref[tid];
          __syncthreads(); }
    }
}
DI void dbg_check_b2(const Args& a, LAS unsigned char* lds, unsigned* ctl, int bx, int G, const bf16* O2) {
    const int tid = threadIdx.x; unsigned char* ws = a.ws; LAS float* red = (LAS float*)(lds + 65536);
    for (int i = bx; i < 256; i += G) {
        const int b = i & 1, s = dbg_pos(i >> 1), h = (int)(dbg_hash((unsigned)i * 11u + 5u) & 15u); const size_t r = (size_t)b * SEQ + s;
        const float* dref = (const float*)(ws + WS_WRT + 256 * 1024) + (size_t)i * 64;
        const float rf = tid < 64 ? dref[tid] : 0.f; const float mx = blk_max(fabsf(rf), red, tid);
        if (tid < 64) { const float g = bf2f(O2[r * 1024 + h * 64 + tid]); if (!(fabsf(g - rf) <= 0.02f * mx + 2e-3f)) dbg_flag(ctl, 8u); }
        __syncthreads();
    }
}
#endif

DI void router_chunk(const Args& a, int ch, LAS unsigned char* lds) {
    int tid_ = threadIdx.x; asm volatile("" : "+v"(tid_)); const int tid = tid_, lane = tid & 63, wave = rfl(tid >> 6);
    unsigned char* ws = a.ws;
    const bf16* X3 = (const bf16*)(ws + WS_X3B); const float* PS3 = (const float*)(ws + WS_PS3);
    volatile LAS unsigned* te = (volatile LAS unsigned*)(lds + 32768);
    float2* TOKW = (float2*)(ws + WS_TOKW); float* TOKR = (float*)(ws + WS_TOKR); unsigned* TOKE = (unsigned*)(ws + WS_TOKE);
    f32x4 wr[8][4];
    { const f32x4* wg = (const f32x4*)(ws + WS_WRT);
#pragma unroll
      for (int e = 0; e < 8; ++e) { wr[e][0] = wg[e * 256 + lane * 2]; wr[e][1] = wg[e * 256 + lane * 2 + 1]; wr[e][2] = wg[e * 256 + 128 + lane * 2]; wr[e][3] = wg[e * 256 + 128 + lane * 2 + 1]; } }
    v4u nw0 = *((const v4u*)(X3 + (size_t)(ch * 128 + wave * 16) * 1024) + lane), nw1 = *((const v4u*)(X3 + (size_t)(ch * 128 + wave * 16) * 1024 + 512) + lane);
    float npss = PS3[(size_t)(ch * 128 + wave * 16) * 16 + (lane & 15)];
#pragma unroll 1
    for (int i = 0; i < 16; ++i) {
        const int tl = wave * 16 + i, tok = ch * 128 + tl;
        const v4u w0 = nw0, w1 = nw1; float pss = npss;
        if (i < 15) { nw0 = *((const v4u*)(X3 + (size_t)(tok + 1) * 1024) + lane); nw1 = *((const v4u*)(X3 + (size_t)(tok + 1) * 1024 + 512) + lane); npss = PS3[(size_t)(tok + 1) * 16 + (lane & 15)]; }
        float xv[16] = {bflo(w0.x), bfhi(w0.x), bflo(w0.y), bfhi(w0.y), bflo(w0.z), bfhi(w0.z), bflo(w0.w), bfhi(w0.w), bflo(w1.x), bfhi(w1.x), bflo(w1.y), bfhi(w1.y), bflo(w1.z), bfhi(w1.z), bflo(w1.w), bfhi(w1.w)};
        float pv[8];
#pragma unroll
        for (int e = 0; e < 8; ++e) { const f32x4 a0 = wr[e][0], a1 = wr[e][1], b0 = wr[e][2], b1 = wr[e][3];
            float s = xv[0] * a0[0] + xv[1] * a0[1] + xv[2] * a0[2] + xv[3] * a0[3] + xv[4] * a1[0] + xv[5] * a1[1] + xv[6] * a1[2] + xv[7] * a1[3];
            s += xv[8] * b0[0] + xv[9] * b0[1] + xv[10] * b0[2] + xv[11] * b0[3] + xv[12] * b1[0] + xv[13] * b1[1] + xv[14] * b1[2] + xv[15] * b1[3];
            pv[e] = s; }
        float k4[4], k2[2], k1;
        { const bool h5 = (lane >> 5) & 1, h4 = (lane >> 4) & 1, h3 = (lane >> 3) & 1;
#pragma unroll
          for (int i = 0; i < 4; ++i) { const float send = h5 ? pv[i] : pv[4 + i]; k4[i] = (h5 ? pv[4 + i] : pv[i]) + __shfl_xor(send, 32); }
#pragma unroll
          for (int i = 0; i < 2; ++i) { const float send = h4 ? k4[i] : k4[2 + i]; k2[i] = (h4 ? k4[2 + i] : k4[i]) + __shfl_xor(send, 16); }
          { const float send = h3 ? k2[0] : k2[1]; k1 = (h3 ? k2[1] : k2[0]) + __shfl_xor(send, 8); }
          k1 += __shfl_xor(k1, 4); k1 += __shfl_xor(k1, 2); k1 += __shfl_xor(k1, 1); }
        float lg[8];
#pragma unroll
        for (int e = 0; e < 8; ++e) lg[e] = __uint_as_float(__builtin_amdgcn_readlane(__float_as_uint(k1), e * 8));
        pss += __shfl_xor(pss, 1); pss += __shfl_xor(pss, 2); pss += __shfl_xor(pss, 4); pss += __shfl_xor(pss, 8);
        const float rs = rsqrtf(pss * (1.f / 1024.f) + RMS_EPS);
        float v1 = -INFINITY, v2 = -INFINITY; unsigned i1 = 0, i2 = 0;
#pragma unroll
        for (int e = 0; e < 8; ++e) { const float l = lg[e] * rs; if (l > v1) { v2 = v1; i2 = i1; v1 = l; i1 = (unsigned)e; } else if (l > v2) { v2 = l; i2 = (unsigned)e; } }
        const float w1g = 1.f / (1.f + __expf(v2 - v1));
        if (lane == 0) { TOKW[tok] = make_float2(w1g, 1.f - w1g); TOKR[tok] = rs; TOKE[tok] = i1 | (i2 << 8); te[tl] = i1 | (i2 << 8); }
    }
    __syncthreads();
    { const unsigned e = (unsigned)wave; const unsigned ta = te[2 * lane], tb = te[2 * lane + 1];
      const unsigned m0 = (ta & 0xFFu) == e, m1 = ((ta >> 8) & 0xFFu) == e, m2 = (tb & 0xFFu) == e, m3 = ((tb >> 8) & 0xFFu) == e;
      const unsigned c = m0 + m1 + m2 + m3; unsigned inc = c;
#pragma unroll
      for (int o = 1; o < 64; o <<= 1) { const unsigned t = __shfl_up(inc, o); if (lane >= o) inc += t; }
      unsigned base = inc - c; int* PR = (int*)(ws + WS_PRANK) + (size_t)ch * 256 + 4 * lane;
      if (m0) { PR[0] = (int)base; ++base; } if (m1) { PR[1] = (int)base; ++base; } if (m2) { PR[2] = (int)base; ++base; } if (m3) { PR[3] = (int)base; ++base; }
      if (lane == 63) ((int*)(ws + WS_CNT))[ch * 8 + wave] = (int)inc; }
    __syncthreads();
}

DI void permute_phase(const Args& a, LAS unsigned char* lds, int G) {
    int tid_ = threadIdx.x; asm volatile("" : "+v"(tid_)); const int tid = tid_;
    unsigned char* ws = a.ws;
    LAS int* cnt = (LAS int*)lds;
    LAS int* off = (LAS int*)(lds + 8192);
    LAS int* ebase = (LAS int*)(lds + 16384);
    const int* CNT = (const int*)(ws + WS_CNT);
    for (int i = tid; i < 2048; i += 512) cnt[i] = CNT[i];
    __syncthreads();
    if (tid < 8) { int s = 0; for (int c = 0; c < 256; ++c) { off[c * 8 + tid] = s; s += cnt[c * 8 + tid]; } ebase[16 + tid] = s; }
    __syncthreads();
    if (tid == 0) { int s = 0; for (int e = 0; e < 8; ++e) { ebase[e] = s; s += (ebase[16 + e] + 255) & ~255; } ebase[8] = s; }
    __syncthreads();
    int* SDST = (int*)(ws + WS_SDST); float* SW = (float*)(ws + WS_SW); float* SRS = (float*)(ws + WS_SRS);
    int* STOK = (int*)(ws + WS_STOK);
    const float2* TOKW = (const float2*)(ws + WS_TOKW); const float* TOKR = (const float*)(ws + WS_TOKR); const unsigned* TOKE = (const unsigned*)(ws + WS_TOKE); const int* PRANK = (const int*)(ws + WS_PRANK);
    if (blockIdx.x == 0) {
        int* TE = (int*)(ws + WS_TILEE); const int nrt = ebase[8] >> 8;
        for (int rt = tid; rt < nrt; rt += 512) { int e = 0; for (int k = 1; k < 8; ++k) if (rt * 256 >= ebase[k]) e = k; TE[rt] = e; }
        if (tid == 0) ((unsigned*)(ws + WS_CTL))[CW_NRT] = (unsigned)nrt;
    }
    for (int e = blockIdx.x; e < 8; e += G) {
        const int lo = ebase[e] + ebase[16 + e], hi = ebase[e + 1];
        for (int s = lo + tid; s < hi; s += 512) { SDST[s] = -1; SW[s] = 0.f; SRS[s] = 0.f; STOK[s] = 0; }
    }
    for (int ch = blockIdx.x; ch < 256; ch += G) {
        if (tid < 256) { const int tok = ch * 128 + (tid >> 1), k = tid & 1; const unsigned te = TOKE[tok]; const int e = (int)((te >> (8 * k)) & 0xFFu);
            const int slot = ebase[e] + off[ch * 8 + e] + PRANK[(size_t)ch * 256 + tid];
            const float2 w = TOKW[tok]; SDST[slot] = tok * 2 + k; SW[slot] = k ? w.y : w.x; SRS[slot] = TOKR[tok]; STOK[slot] = tok; }
    }
}

DI void final_phase(const Args& a, int vcu, int G, float oscale) {
    int tid_ = threadIdx.x; asm volatile("" : "+v"(tid_)); const int tid = tid_, lane = tid & 63, wave = rfl(tid >> 6);
    const bf16* X3 = (const bf16*)(a.ws + WS_X3B); const bf16* YP = (const bf16*)(a.ws + WS_YP); const float* g = a.in[I_FINN];
    const int gw = vcu * 8 + wave, NGW = G * 8;
    f32x4 gv[4];
#pragma unroll
    for (int j = 0; j < 4; ++j) gv[j] = *((const f32x4*)g + 2 * lane + (j & 1) + 128 * (j >> 1));
    v4u nx[2], ny0[2], ny1[2];
#define FN_LOAD(m) do { _Pragma("unroll") for (int hlf = 0; hlf < 2; ++hlf) { nx[hlf] = __builtin_nontemporal_load((const v4u*)(X3 + (size_t)(m) * 1024 + hlf * 512) + lane); \
        ny0[hlf] = __builtin_nontemporal_load((const v4u*)(YP + (size_t)(2 * (m)) * 1024 + hlf * 512) + lane); ny1[hlf] = __builtin_nontemporal_load((const v4u*)(YP + (size_t)(2 * (m) + 1) * 1024 + hlf * 512) + lane); } } while (0)
    if (gw < T) FN_LOAD(gw);
    for (int m = gw; m < T; m += NGW) {
        float v[16]; float ss = 0.f;
        const v4u cx[2] = {nx[0], nx[1]}, cy0[2] = {ny0[0], ny0[1]}, cy1[2] = {ny1[0], ny1[1]};
        if (m + NGW < T) FN_LOAD(m + NGW);
#pragma unroll
        for (int hlf = 0; hlf < 2; ++hlf) {
            const v4u x = cx[hlf], y0 = cy0[hlf], y1 = cy1[hlf];
            const unsigned xs[4] = {x.x, x.y, x.z, x.w}, as[4] = {y0.x, y0.y, y0.z, y0.w}, bs[4] = {y1.x, y1.y, y1.z, y1.w};
#pragma unroll
            for (int j = 0; j < 4; ++j) { const float lo = bflo(xs[j]) + (bflo(as[j]) + bflo(bs[j])), hh = bfhi(xs[j]) + (bfhi(as[j]) + bfhi(bs[j])); v[hlf * 8 + 2 * j] = lo; v[hlf * 8 + 2 * j + 1] = hh; ss += lo * lo + hh * hh; }
        }
        ss = wave_sum(ss); const float rs = rsqrtf(ss * (1.f / 1024.f) + RMS_EPS) * oscale;
        float* o = a.out + (size_t)m * 1024;
#pragma unroll
        for (int hlf = 0; hlf < 2; ++hlf) { f32x4 o0, o1;
#pragma unroll
            for (int j = 0; j < 4; ++j) { o0[j] = v[hlf * 8 + j] * rs * gv[hlf * 2][j]; o1[j] = v[hlf * 8 + 4 + j] * rs * gv[hlf * 2 + 1][j]; }
            __builtin_nontemporal_store(o0, (f32x4*)(o + hlf * 512) + 2 * lane); __builtin_nontemporal_store(o1, (f32x4*)(o + hlf * 512) + 2 * lane + 1); }
    }
}

__global__ void __launch_bounds__(512, 2) hybrid_fwd(Args args) {
    extern __shared__ __attribute__((aligned(16))) unsigned char lds_raw[];
    LAS unsigned char* lds = (LAS unsigned char*)lds_raw;
    volatile LAS unsigned* MISC = (volatile LAS unsigned*)(lds + MISC_OFF);
    const int tid = threadIdx.x, wave = rfl(tid >> 6), lane = tid & 63;
    const int G = gridDim.x; const int bx = blockIdx.x; const int vcu = (G % 8 == 0) ? (bx % 8) * (G / 8) + bx / 8 : bx;
    unsigned char* ws = args.ws;
    unsigned* ctl = (unsigned*)(ws + WS_CTL);
    for (int u = tid; u < (LDS_BYTES - PHASE_LDS) / 4; u += 512) ((LAS unsigned*)(lds + PHASE_LDS))[u] = 0u;
    __syncthreads();
    XcdBarrier bar; bar.bar = ctl + CW_BAR; bar.x = 0; bar.st = nullptr;
#if MK_ONE_LAUNCH
    (void)xcd_barrier_post(ctl + CW_BAR, MISC + 8);
#if defined(PROBE_DUP) && ((PROBE_DUP >> 21) & 1)
#define GRID_BAR() do { const unsigned long long t0_ = __builtin_amdgcn_s_memrealtime(); XcdBarrier b_; b_.bar = (unsigned*)(args.ws + WS_CTL) + CW_BAR; b_.x = xb_xcc_id(); b_.st = (volatile LAS unsigned*)(lds + MISC_OFF) + 8; xcd_barrier(b_); if ((PROBE_SEAMS >> prb_k_) & 1) prb_wait_ += __builtin_amdgcn_s_memrealtime() - t0_; } while (0)
#else
#define GRID_BAR() do { XcdBarrier b_; b_.bar = (unsigned*)(args.ws + WS_CTL) + CW_BAR; b_.x = xb_xcc_id(); b_.st = (volatile LAS unsigned*)(lds + MISC_OFF) + 8; xcd_barrier(b_); } while (0)
#endif
#else
#define GRID_BAR() do { } while (0)
#endif
    int prb_k_ = 0; (void)prb_k_; unsigned long long prb_wait_ = 0; (void)prb_wait_;
    const int lo = args.ph_lo, hi = args.ph_hi;
#ifndef PH_MASK
#define PH_MASK 0x1FFFF
#endif
#define IN(k) (((PH_MASK >> (k)) & 1) && lo <= (k) && (k) < hi)
#if defined(PROBE_DUP) && ((PROBE_DUP >> 20) & 1)
#define SEAM(k) do { if (IN((k) + 1)) { GRID_BAR(); GRID_BAR(); } } while (0)
#else
#define SEAM(k) do { prb_k_ = (k); if (IN((k) + 1)) GRID_BAR(); } while (0)
#endif
#ifndef PROBE_DUP
#define PROBE_DUP 0
#endif
#define REP(k) for (int rep_ = 0; rep_ < (((PROBE_DUP >> (k)) & 1) ? 2 : 1); ++rep_)
    (void)lane; (void)wave;

    bf16* XB = (bf16*)(ws + WS_XB); bf16* OCAT = (bf16*)(ws + WS_OCAT);
    bf16 *SBQ = (bf16*)(ws + WS_SBQ), *SBK = (bf16*)(ws + WS_SBK), *SBV = (bf16*)(ws + WS_SBV), *CQ = (bf16*)(ws + WS_CQ), *CKV = (bf16*)(ws + WS_CKV), *KR = (bf16*)(ws + WS_KR);
    bf16 *QA = (bf16*)(ws + WS_QA), *KN = (bf16*)(ws + WS_KN), *VA = (bf16*)(ws + WS_VA), *X1B = (bf16*)(ws + WS_X1B), *HID = (bf16*)(ws + WS_HID), *X2B = (bf16*)args.out;
    bf16 *Q2 = (bf16*)(ws + WS_Q2), *K2 = (bf16*)(ws + WS_K2), *V2 = (bf16*)(ws + WS_V2), *X3B = (bf16*)(ws + WS_X3B), *YP = (bf16*)(ws + WS_YP), *HIDE = (bf16*)(ws + WS_HIDE);
    float *PQKV = (float*)(ws + WS_PQKV), *PS1 = (float*)(ws + WS_PS1), *PS2 = (float*)(ws + WS_PS2), *PS3 = (float*)(ws + WS_PS3), *KMP = (float*)(ws + WS_KMP);
    bf16* O2 = Q2;
    bf16* PO3 = (bf16*)args.out + (size_t)32 * 1024 * 1024;
    const float2* ROPE = (const float2*)(ws + WS_ROPE); unsigned* SEL = (unsigned*)(ws + WS_SEL); float2* PMS = (float2*)(ws + WS_PMS);

    if (IN(0)) REP(0) { p0_prologue(args, lds, vcu, G); SEAM(0); }
    if (IN(1)) REP(1) {
        pg8::Gemm g{XB, (const bf16*)(ws + W_IN), T, 2304, 1024}; pg8::StaticOrder S; S.init(T, 2304, G, bx);
        EpiInProj E{SBQ, CQ, CKV, KR, (const float*)(ws + WS_RSTD0), PQKV, ROPE};
        pg8::gemm_phase<EpiInProj, pg8::StaticOrder, true, true>(lds, g, S, E);
        { const bool half = (G == 256); if (!half || bx >= 128) { __syncthreads(); p0_weights(args, lds, (half ? bx - 128 : bx) * 8 + wave, (half ? 128 : G) * 8, true); } }
        SEAM(1);
    }
    if (IN(2)) REP(2) {
        { pg8::Gemm g{CQ, (const bf16*)(ws + W_UQ), T, 768, 384}; pg8::StaticOrder S; S.init(T, 768, G, bx);
          EpiQUp E{QA, PQKV, ROPE}; pg8::gemm_phase<EpiQUp, pg8::StaticOrder, true, true>(lds, g, S, E); }
        __syncthreads();
        { pg8::Gemm g{CKV, (const bf16*)(ws + W_UKV), T, 1024, 256}; pg8::StaticOrder S; S.init(T, 1024, G, bx);
          EpiKvUp E{KN, PQKV}; pg8::gemm_phase<EpiKvUp, pg8::StaticOrder, true, true>(lds, g, S, E); }
        SEAM(2);
    }
    if (IN(3)) REP(3) {
        REP(17) for (int v = vcu; v < 256; v += G) { const int bh = v >> 4, s = v & 15;
            att::mla_unit(bh, 63 - s, QA, KN, KR, VA, OCAT, lds); att::mla_unit(bh, 32 + s, QA, KN, KR, VA, OCAT, lds);
            att::mla_unit(bh, 31 - s, QA, KN, KR, VA, OCAT, lds); att::mla_unit(bh, s, QA, KN, KR, VA, OCAT, lds); }
        REP(18) { volatile LAS int* qslot = (volatile LAS int*)(lds + PHASE_LDS - 64);
          unsigned* qw = ctl + CW_QUEUE + 192 + 64 * rep_;
          if (tid == 0) qslot[0] = (int)atomicAdd(qw, 1u);
          __syncthreads();
          int uidx = qslot[0];
          __syncthreads();
          while (uidx < 1024) {
              unsigned nx = 0u; if (tid == 0) nx = atomicAdd(qw, 1u);
              att::sb_unit(uidx & 15, 63 - (uidx >> 4), SBQ, SBK, SBV, OCAT, lds);
              if (tid == 0) qslot[0] = (int)nx;
              __syncthreads();
              uidx = qslot[0];
              __syncthreads();
          } }
        SEAM(3);
#if DBG_CHECK & 1
        dbg_check_a(args, lds, ctl, bx, G);
#endif
    }
    if (IN(4)) REP(4) {
        pg8::Gemm g{OCAT, (const bf16*)(ws + W_O0), T, 1024, 1024}; pg8::StaticOrder S; S.init(T, 1024, G, bx);
        EpiRes<true> E{args.in[I_X], X1B, PS1}; pg8::gemm_phase<EpiRes<true>, pg8::StaticOrder, true, true>(lds, g, S, E);
        SEAM(4);
    }
    if (IN(5)) REP(5) {
        pg8::Gemm g{X1B, (const bf16*)(ws + W_GU0), T, 4096, 1024}; pg8::StaticOrder S; S.init(T, 4096, G, bx);
        EpiSwiGLU E{HID, 2048, 16, PS1, nullptr}; pg8::gemm_phase<EpiSwiGLU, pg8::StaticOrder, true, true>(lds, g, S, E);
        SEAM(5);
    }
    if (IN(6)) REP(6) {
        pg8::Gemm g{HID, (const bf16*)(ws + W_DN0), T, 1024, 2048}; pg8::StaticOrder S; S.init(T, 1024, G, bx);
        EpiRes<false> E{X1B, X2B, PS2}; pg8::gemm_phase<EpiRes<false>, pg8::StaticOrder, true, true>(lds, g, S, E);
        SEAM(6);
    }
    if (IN(7)) REP(7) {
        pg8::Gemm g{X2B, (const bf16*)(ws + W_QKV), T, 3072, 1024}; pg8::StaticOrder S; S.init(T, 3072, G, bx);
        EpiQkv E{Q2, PS2, KMP}; pg8::gemm_phase<EpiQkv, pg8::StaticOrder, true, true>(lds, g, S, E);
        SEAM(7);
    }
    if (IN(8)) REP(8) {
        for (int v = vcu; v < 256; v += G) att::moba_gate_unit(v & 31, v >> 5, Q2, KMP, SEL, (unsigned*)(ws + WS_MASK), lds);
        SEAM(8);
    }
    if (IN(9)) REP(9) {
        volatile LAS int* qslot = (volatile LAS int*)(lds + att::MB_OFF_Q);
        if (tid == 0) qslot[0] = (int)atomicAdd(ctl + CW_QUEUE + 64 * rep_, 1u);
        __syncthreads();
        int uidx = qslot[0];
        __syncthreads();
        while (uidx < 64 * 32) {
            unsigned nx = 0u; if (tid == 0) nx = atomicAdd(ctl + CW_QUEUE + 64 * rep_, 1u);
            att::moba_sel_unit(uidx & 31, uidx >> 5, Q2, K2, V2, (const unsigned long long*)(ws + WS_MASK), args.in[I_RELB], (bf16*)(ws + WS_PO0), (bf16*)(ws + WS_PO1), (bf16*)(ws + WS_PO2), PO3, PMS, lds);
            if (tid == 0) qslot[0] = (int)nx;
            __syncthreads();
            uidx = qslot[0];
            __syncthreads();
        }
        SEAM(9);
#if DBG_CHECK & 2
        dbg_check_b(args, lds, ctl, bx, G, O2); GRID_BAR();
#endif
    }
    if (IN(10)) REP(10) {
        att::moba_merge(vcu * 8 + wave, G * 8, SEL, (const bf16*)(ws + WS_PO0), (const bf16*)(ws + WS_PO1), (const bf16*)(ws + WS_PO2), PO3, PMS, O2);
        SEAM(10);
#if DBG_CHECK & 2
        dbg_check_b2(args, lds, ctl, bx, G, O2);
#endif
    }
    if (IN(11)) REP(11) {
        pg8::Gemm g{O2, (const bf16*)(ws + W_O1), T, 1024, 1024}; pg8::StaticOrder S; S.init(T, 1024, G, bx);
        EpiRes<false> E{X2B, X3B, PS3}; pg8::gemm_phase<EpiRes<false>, pg8::StaticOrder, true, true>(lds, g, S, E);
        SEAM(11);
    }
    if (IN(12)) REP(12) {
        for (int ch = bx; ch < 256; ch += G) router_chunk(args, ch, lds);
        SEAM(12);
    }
    if (IN(13)) REP(13) { permute_phase(args, lds, G); SEAM(13); }
    if (IN(14)) REP(14) {
        const int nrt = (int)ctl[CW_NRT];
        pg8::Gemm g{X3B, (const bf16*)(ws + W_EGU), NSLOT, 8192, 1024, (const int*)(ws + WS_STOK)}; MoeOrder S{(const int*)(ws + WS_TILEE), nrt, G, bx};
        EpiSwiGLU E{HIDE, 512, 4, nullptr, (const float*)(ws + WS_SRS)}; pg8::gemm_phase<EpiSwiGLU, MoeOrder, true, true, true>(lds, g, S, E);
        SEAM(14);
    }
    if (IN(15)) REP(15) {
        const int nrt = (int)ctl[CW_NRT];
        pg8::Gemm g{HIDE, (const bf16*)(ws + W_EDN), NSLOT, 8192, 512}; MoeOrder S{(const int*)(ws + WS_TILEE), nrt, G, bx};
        EpiMoeDown E{YP, (const int*)(ws + WS_SDST), (const float*)(ws + WS_SW)}; pg8::gemm_phase<EpiMoeDown, MoeOrder, true, true>(lds, g, S, E);
        SEAM(15);
    }
    if (IN(16)) REP(16) {
        float oscale = 1.f;
#if DBG_CHECK
        oscale = 1.f + 0.25f * (float)__hip_atomic_load(ctl + CW_ERR, __ATOMIC_RELAXED, __HIP_MEMORY_SCOPE_AGENT);
#endif
        final_phase(args, vcu, G, oscale);
#if defined(PROBE_DUP) && ((PROBE_DUP >> 21) & 1)
        if (bx == ((PROBE_DUP >> 22) & 0xFF)) { const unsigned long long t0_ = __builtin_amdgcn_s_memrealtime(); while (__builtin_amdgcn_s_memrealtime() - t0_ < 4ull * prb_wait_) __builtin_amdgcn_s_sleep(8); }
#endif
#if MK_ONE_LAUNCH
        if (bx == 0 && tid == 0) { if (__hip_atomic_load(ctl + CW_BAR + XB_TMO, __ATOMIC_RELAXED, __HIP_MEMORY_SCOPE_AGENT) != 0u) args.out[0] = __builtin_nanf(""); }
#endif
    }
#undef IN
#undef SEAM
}

extern "C" void kernel_launch(void* const* d_in, const int* in_sizes, int n_in, void* d_out, int out_size, void* d_ws, size_t ws_size, hipStream_t stream) {
    static int grid = 0;
    if (grid == 0) {
        if (n_in != 22 || in_sizes[0] != T * DM || out_size != T * DM || ws_size < WS_NEED) { fprintf(stderr, "kernel_launch: unexpected shapes (n_in %d, in0 %d, out %d, ws %zu < %zu); nothing launched\n", n_in, n_in > 0 ? in_sizes[0] : -1, out_size, ws_size, (size_t)WS_NEED); grid = -1; return; }
        int dev = 0, cus = 0, per_cu = 0;
        if (hipGetDevice(&dev) != hipSuccess || hipDeviceGetAttribute(&cus, hipDeviceAttributeMultiprocessorCount, dev) != hipSuccess) { grid = -1; return; }
        if (hipFuncSetAttribute((const void*)hybrid_fwd, hipFuncAttributeMaxDynamicSharedMemorySize, LDS_BYTES) != hipSuccess) { fprintf(stderr, "kernel_launch: hipFuncSetAttribute failed\n"); grid = -1; return; }
        if (hipOccupancyMaxActiveBlocksPerMultiprocessor(&per_cu, (const void*)hybrid_fwd, 512, LDS_BYTES) != hipSuccess || per_cu < 1) fprintf(stderr, "kernel_launch: occupancy query reports %d workgroups per CU\n", per_cu);
        (void)hipGetLastError();
        grid = cus;
    }
    if (grid < 0) return;
    if (hipMemsetAsync((char*)d_ws + WS_CTL, 0, CTL_ZERO_BYTES, stream) != hipSuccess) return;
    Args a{};
    for (int i = 0; i < 22; ++i) a.in[i] = (const float*)d_in[i];
    a.out = (float*)d_out; a.ws = (unsigned char*)d_ws;
#if MK_ONE_LAUNCH
    a.ph_lo = 0; a.ph_hi = NPH;
    hipLaunchKernelGGL(hybrid_fwd, dim3(grid), dim3(512), LDS_BYTES, stream, a);
#else
    for (int p = 0; p < NPH; ++p) { a.ph_lo = p; a.ph_hi = p + 1; hipLaunchKernelGGL(hybrid_fwd, dim3(grid), dim3(512), LDS_BYTES, stream, a); }
#endif
}
```
